# Optimizing an MI355X kernel written in HIP

```python
import math
import jax
import jax.numpy as jnp
from jax import lax
import numpy as np

D_MODEL = 1024
BATCH = 2
SEQ = 8192
DEPTH = 2
DEC_BATCH = 8
DEC_SEQ = 2048
PAST_LEN = 128

HEAD_DIM = 64
N_A_HEADS = 4
N_A_KV_HEADS = 2
N_B_HEADS = 4
N_C_HEADS = 4
N_D_HEADS = 4
A_W = N_A_HEADS * HEAD_DIM
A_KV_W = N_A_KV_HEADS * HEAD_DIM
B_W = N_B_HEADS * HEAD_DIM
C_W = N_C_HEADS * HEAD_DIM
D_W = N_D_HEADS * HEAD_DIM
MIX_W = A_W + B_W + C_W + D_W
IN_WIDTHS = (A_W, A_KV_W, A_KV_W, A_W, B_W, B_W, B_W, B_W, C_W, C_W, C_W, C_W, D_W, D_W, D_W, D_W)
IN_W = 2 * A_W + 2 * A_KV_W + 4 * (B_W + C_W + D_W)
GRID_W = 64
Q_BLOCK = 128
B_Q_BLOCK = 32
ROPE_THETA = 10000.0
B_PATTERNS = ((128, 1), (512, 4), (2048, 16))
T5_BUCKETS = 32
T5_MAX_DIST = 128
N_BIAS_HEADS = N_B_HEADS + N_C_HEADS
C_HALF = HEAD_DIM // 2
NA_KH = 8
NA_KW = 16
RMS_EPS = 1e-6
NEG_INF = -1e30

kernel_name = 'hybrid_parallel_group_encoder'


def _rmsnorm(x, g):
    xf = x.astype(jnp.float32)
    y = xf * lax.rsqrt(jnp.mean(xf * xf, axis=-1, keepdims=True) + RMS_EPS)
    return (y * g.astype(jnp.float32)).astype(x.dtype)


def _t5_bucket(rel):
    half = T5_BUCKETS // 2
    max_exact = half // 2
    dist = jnp.abs(rel)
    large = max_exact + (jnp.log(jnp.maximum(dist, 1).astype(jnp.float32) / max_exact)
                         / math.log(T5_MAX_DIST / max_exact) * (half - max_exact)).astype(jnp.int32)
    large = jnp.minimum(large, half - 1)
    return jnp.where(rel > 0, half, 0) + jnp.where(dist < max_exact, dist, large)


def _rope_1d(x, pos):
    d = x.shape[-1]
    hf = d // 2
    freqs = ROPE_THETA ** (-jnp.arange(hf, dtype=jnp.float32) * 2.0 / d)
    ang = pos.astype(jnp.float32)[:, None] * freqs[None, :]
    cos = jnp.cos(ang)[None, :, None, :]
    sin = jnp.sin(ang)[None, :, None, :]
    xf = x.astype(jnp.float32)
    x1, x2 = xf[..., :hf], xf[..., hf:]
    return jnp.concatenate([x1 * cos - x2 * sin, x2 * cos + x1 * sin], axis=-1).astype(x.dtype)


def _axial_rope(x, row, col):
    half = x.shape[-1] // 2
    return jnp.concatenate([_rope_1d(x[..., :half], row), _rope_1d(x[..., half:], col)], axis=-1)


def _blocks(t, qb):
    bsz, n = t.shape[:2]
    return jnp.moveaxis(t.reshape(bsz, n // qb, qb, *t.shape[2:]), 1, 0)


def _unblocks(t):
    nb, bsz, qb = t.shape[:3]
    return jnp.moveaxis(t, 0, 1).reshape(bsz, nb * qb, *t.shape[3:])


def _mixer_a(q, k, v, q_gain, k_gain):
    bsz, n = q.shape[:2]
    q = _rmsnorm(q, q_gain)
    k = _rmsnorm(k, k_gain)
    t = jnp.arange(n, dtype=jnp.int32)
    row, col = t // GRID_W, t % GRID_W
    q = _axial_rope(q, row, col)
    k = _axial_rope(k, row, col)
    q = q.reshape(bsz, n, N_A_KV_HEADS, N_A_HEADS // N_A_KV_HEADS, HEAD_DIM)
    scale = HEAD_DIM ** -0.5

    def block(qb):
        s = jnp.einsum('bqkgd,bskd->bkgqs', qb, k).astype(jnp.float32) * scale
        p = jax.nn.softmax(s, axis=-1).astype(v.dtype)
        return jnp.einsum('bkgqs,bskd->bqkgd', p, v)

    o = _unblocks(lax.map(block, _blocks(q, Q_BLOCK)))
    return o.reshape(bsz, n, A_W)


def _dilated_offsets():
    return np.concatenate([d * np.arange(-(w // (2 * d)), w // (2 * d) + 1) for (w, d) in B_PATTERNS]).astype(np.int32)


def _mixer_b(q, k, v, t5_bias):
    bsz, n = q.shape[:2]
    offs_np = _dilated_offsets()
    n_pat = len(B_PATTERNS)
    n_key = offs_np.size // n_pat
    offs = jnp.asarray(offs_np)
    bias = jnp.take(t5_bias[:, :N_B_HEADS].T.astype(jnp.float32), _t5_bucket(offs), axis=1)
    scale = HEAD_DIM ** -0.5

    def block(args):
        qb, i0 = args
        idx = i0 + jnp.arange(B_Q_BLOCK, dtype=jnp.int32)[:, None] + offs[None, :]
        valid = (idx >= 0) & (idx < n)
        idx = jnp.clip(idx, 0, n - 1)
        kb = k[:, idx]
        vb = v[:, idx]
        s = jnp.einsum('bqhd,bqjhd->bhqj', qb, kb).astype(jnp.float32) * scale + bias[None, :, None, :]
        s = jnp.where(valid[None, None], s, NEG_INF)
        s = s.reshape(bsz, N_B_HEADS, B_Q_BLOCK, n_pat, n_key)
        m = jnp.max(s, axis=-1, keepdims=True)
        e = jnp.exp(s - m)
        den = jnp.sum(e, axis=-1, keepdims=True)
        vb = vb.reshape(bsz, B_Q_BLOCK, n_pat, n_key, N_B_HEADS, HEAD_DIM)
        o_pat = jnp.einsum('bhqgj,bqgjhd->bhqgd', (e / den).astype(v.dtype), vb)
        alpha = jax.nn.softmax((m + jnp.log(den))[..., 0], axis=-1)
        return jnp.einsum('bhqg,bhqgd->bqhd', alpha.astype(o_pat.dtype), o_pat)

    starts = jnp.arange(n // B_Q_BLOCK, dtype=jnp.int32) * B_Q_BLOCK
    o = _unblocks(lax.map(block, (_blocks(q, B_Q_BLOCK), starts)))
    return o.reshape(bsz, n, B_W)


def _mixer_c(q, k, v, t5_bias, lq1, lk1, lq2, lk2, subln_g, lambda_init):
    bsz, n = q.shape[:2]
    k1, k2 = k[..., :C_HALF], k[..., C_HALF:]
    lam = (jnp.exp(jnp.sum((lq1 * lk1).astype(jnp.float32)))
           - jnp.exp(jnp.sum((lq2 * lk2).astype(jnp.float32))) + lambda_init)
    table_c = t5_bias[:, N_B_HEADS:].T.astype(jnp.float32)
    scale = C_HALF ** -0.5
    keys = jnp.arange(n, dtype=jnp.int32)

    def block(args):
        qb, i0 = args
        rel = keys[None, :] - (i0 + jnp.arange(Q_BLOCK, dtype=jnp.int32))[:, None]
        bias = jnp.take(table_c, _t5_bucket(rel), axis=1)
        s1 = jnp.einsum('bqhd,bkhd->bhqk', qb[..., :C_HALF], k1).astype(jnp.float32) * scale + bias
        s2 = jnp.einsum('bqhd,bkhd->bhqk', qb[..., C_HALF:], k2).astype(jnp.float32) * scale + bias
        p = jax.nn.softmax(s1, axis=-1) - lam * jax.nn.softmax(s2, axis=-1)
        return jnp.einsum('bhqk,bkhd->bqhd', p.astype(v.dtype), v)

    starts = jnp.arange(n // Q_BLOCK, dtype=jnp.int32) * Q_BLOCK
    o = _unblocks(lax.map(block, (_blocks(q, Q_BLOCK), starts)))
    o = _rmsnorm(o, subln_g) * (1.0 - lambda_init)
    return o.reshape(bsz, n, C_W)


def _mixer_d(q, k, v, rpb):
    bsz, n = q.shape[:2]
    rows = n // GRID_W
    kh = min(NA_KH, rows)
    qg = q.reshape(bsz, rows, GRID_W, N_D_HEADS, HEAD_DIM)
    kg = k.reshape(bsz, rows, GRID_W, N_D_HEADS, HEAD_DIM)
    vg = v.reshape(bsz, rows, GRID_W, N_D_HEADS, HEAD_DIM)
    cols = np.arange(GRID_W)
    cs = np.clip(cols - NA_KW // 2, 0, GRID_W - NA_KW)
    col_idx = cs[:, None] + np.arange(NA_KW)[None, :]
    dc = col_idx - cols[:, None] + NA_KW - 1
    scale = HEAD_DIM ** -0.5

    def row_step(args):
        qr, r = args
        r0 = jnp.clip(r - kh // 2, 0, rows - kh)
        kr = lax.dynamic_slice_in_dim(kg, r0, kh, axis=1)
        vr = lax.dynamic_slice_in_dim(vg, r0, kh, axis=1)
        kn = kr[:, :, col_idx]
        vn = vr[:, :, col_idx]
        dr = r0 + jnp.arange(kh, dtype=jnp.int32) - r + NA_KH - 1
        bias = rpb[:, dr[None, :, None], dc[:, None, :]].astype(jnp.float32)
        s = jnp.einsum('bchd,bicjhd->bhcij', qr, kn).astype(jnp.float32) * scale + bias[None]
        p = jax.nn.softmax(s.reshape(bsz, N_D_HEADS, GRID_W, kh * NA_KW), axis=-1).reshape(s.shape)
        return jnp.einsum('bhcij,bicjhd->bchd', p.astype(v.dtype), vn)

    o = lax.map(row_step, (jnp.moveaxis(qg, 1, 0), jnp.arange(rows, dtype=jnp.int32)))
    return jnp.moveaxis(o, 0, 1).reshape(bsz, n, D_W)


def _layer(x, layer_idx, w_in, w_out, norm_g, a_q_gain, a_k_gain, t5_bias, lq1, lk1, lq2, lk2, subln_g, rpb):
    bsz, n, _ = x.shape
    proj = _rmsnorm(x, norm_g) @ w_in
    cuts = np.cumsum(IN_WIDTHS)[:-1].tolist()
    (aq, ak, av, ag, bq, bk, bv, bg, cq, ck, cv, cg, dq, dk, dv, dg) = jnp.split(proj, cuts, axis=-1)

    def heads(t):
        return t.reshape(bsz, n, -1, HEAD_DIM)

    lambda_init = 0.8 - 0.6 * math.exp(-0.3 * layer_idx)
    ya = _mixer_a(heads(aq), heads(ak), heads(av), a_q_gain, a_k_gain)
    yb = _mixer_b(heads(bq), heads(bk), heads(bv), t5_bias)
    yc = _mixer_c(heads(cq), heads(ck), heads(cv), t5_bias, lq1, lk1, lq2, lk2, subln_g, lambda_init)
    yd = _mixer_d(heads(dq), heads(dk), heads(dv), rpb)
    mixed = jnp.concatenate([ya * jax.nn.silu(ag), yb * jax.nn.silu(bg),
                             yc * jax.nn.silu(cg), yd * jax.nn.silu(dg)], axis=-1)
    return x + mixed @ w_out


def _trunk(x, w_in, w_out, norm_g, final_g, a_q_gain, a_k_gain, t5_bias,
           c_lambda_q1, c_lambda_k1, c_lambda_q2, c_lambda_k2, c_subln_g, d_rpb):
    for l in range(DEPTH):
        x = _layer(x, l, w_in[l], w_out[l], norm_g[l], a_q_gain[l], a_k_gain[l], t5_bias,
                   c_lambda_q1[l], c_lambda_k1[l], c_lambda_q2[l], c_lambda_k2[l], c_subln_g[l], d_rpb[l])
    return _rmsnorm(x, final_g)


def setup_inputs(seed: int = 0) -> dict:
    key = jax.random.key(seed)
    ks = jax.random.split(key, 16)
    nrm = jax.random.normal
    f32 = jnp.float32
    return {
        'x_prompt': nrm(ks[0], (BATCH, SEQ, D_MODEL), f32),
        'x_sample': nrm(ks[1], (DEC_BATCH, DEC_SEQ, D_MODEL), f32),
        'w_in': nrm(ks[2], (DEPTH, D_MODEL, IN_W), f32) * D_MODEL ** -0.5,
        'w_out': nrm(ks[3], (DEPTH, MIX_W, D_MODEL), f32) * MIX_W ** -0.5,
        'norm_g': 1.0 + 0.05 * nrm(ks[4], (DEPTH, D_MODEL), f32),
        'final_g': 1.0 + 0.05 * nrm(ks[5], (D_MODEL,), f32),
        'a_q_gain': 1.0 + 0.05 * nrm(ks[6], (DEPTH, HEAD_DIM), f32),
        'a_k_gain': 1.0 + 0.05 * nrm(ks[7], (DEPTH, HEAD_DIM), f32),
        't5_bias': 0.2 * nrm(ks[8], (T5_BUCKETS, N_BIAS_HEADS), f32),
        'c_lambda_q1': 0.1 * nrm(ks[9], (DEPTH, C_HALF), f32),
        'c_lambda_k1': 0.1 * nrm(ks[10], (DEPTH, C_HALF), f32),
        'c_lambda_q2': 0.1 * nrm(ks[11], (DEPTH, C_HALF), f32),
        'c_lambda_k2': 0.1 * nrm(ks[12], (DEPTH, C_HALF), f32),
        'c_subln_g': 1.0 + 0.05 * nrm(ks[13], (DEPTH, HEAD_DIM), f32),
        'd_rpb': 0.2 * nrm(ks[14], (DEPTH, N_D_HEADS, 2 * NA_KH - 1, 2 * NA_KW - 1), f32),
    }


def reference(x_prompt, x_sample, w_in, w_out, norm_g, final_g, a_q_gain, a_k_gain, t5_bias,
              c_lambda_q1, c_lambda_k1, c_lambda_q2, c_lambda_k2, c_subln_g, d_rpb):
    y_prompt = _trunk(x_prompt, w_in, w_out, norm_g, final_g, a_q_gain, a_k_gain, t5_bias,
                      c_lambda_q1, c_lambda_k1, c_lambda_q2, c_lambda_k2, c_subln_g, d_rpb)
    y_sample = _trunk(x_sample, w_in, w_out, norm_g, final_g, a_q_gain, a_k_gain, t5_bias,
                      c_lambda_q1, c_lambda_k1, c_lambda_q2, c_lambda_k2, c_subln_g, d_rpb)
    return (y_prompt, y_sample)
```

```cpp
#include <hip/hip_runtime.h>
#include <hip/hip_bf16.h>
#include <cstdio>
#include <cstdint>

#ifndef MK_ONE_LAUNCH
#define MK_ONE_LAUNCH 1
#endif

#define LAS __attribute__((address_space(3)))
#define GAS __attribute__((address_space(1)))
typedef unsigned short bf16_t;
typedef short bf16x8 __attribute__((ext_vector_type(8)));
typedef short s16x4 __attribute__((ext_vector_type(4)));
typedef short v4i16_t __attribute__((ext_vector_type(4)));
typedef float f32x2 __attribute__((ext_vector_type(2)));
typedef float f32x4 __attribute__((ext_vector_type(4)));
typedef float f32x16 __attribute__((ext_vector_type(16)));
typedef unsigned u32x2 __attribute__((ext_vector_type(2)));
typedef unsigned u32x4 __attribute__((ext_vector_type(4)));

constexpr int DMODEL = 1024, INW = 3840, MIXW = 1024, DEPTH = 2;
constexpr int RS = 16384;
constexpr int MTOT = 2 * RS;
constexpr float RMS_EPS = 1e-6f;
constexpr float LOG2E = 1.4426950408889634f;
constexpr int C_AQ = 0, C_AK = 256, C_AV = 384, C_AG = 512, C_BQ = 768, C_BK = 1024, C_BV = 1280, C_BG = 1536;
constexpr int C_CQ = 1792, C_CK = 2048, C_CV = 2304, C_CG = 2560, C_DQ = 2816, C_DK = 3072, C_DV = 3328, C_DG = 3584;

constexpr size_t MiB = 1u << 20;
constexpr size_t WS_CTL = 0, CTL_ZERO_BYTES = 192 * 1024;
constexpr size_t WS_XSLOT = 1 * MiB + 512 * 1024;
constexpr int CW_KMAXD = 40576;
constexpr int CW_KMAXB = 40512;
constexpr int CW_KMAXA = 40000, CW_KMAXC = 40192;
constexpr int CW_PANEL = 16384;
constexpr size_t WS_TAB = 1 * MiB;
constexpr size_t WS_WIN = 2 * MiB;
constexpr size_t WS_WOUT = 17 * MiB;
constexpr size_t WS_XNM = 22 * MiB;
constexpr size_t WS_PROJ = 86 * MiB;
constexpr size_t WS_BPART = 206 * MiB;
constexpr size_t WS_BLSE = 230 * MiB;
constexpr size_t WS_END = 231 * MiB;
constexpr int T_ROPE = 0;
constexpr int T_C = 4096;
constexpr int T_B = T_C + 4 * 641;
constexpr int T_LAM = T_B + 3 * 4 * 320;
constexpr int T_BMAX = T_LAM + 2;
constexpr int T_BMAXB = T_BMAX + 4;
constexpr int T_BMAXD = T_BMAXB + 4;
constexpr int CW_BAR = 1024;

constexpr int RING_BYTES = 131072;
constexpr int LDSCTL_OFF = RING_BYTES, MISC_OFF = LDSCTL_OFF + 320;
constexpr int LDS_BYTES = 163840;
constexpr int LT_ROPE = 0;
constexpr int LT_B = 143 * 1024;
constexpr int LT_C = 132 * 1024;
constexpr int LT_BK = LT_B + 12 * 320 * 4;
static_assert(LT_C + 4 * 641 * 4 <= LT_B && LT_BK + 64 <= LDS_BYTES, "LDS tables");

__device__ __forceinline__ unsigned f2bf(float f) { unsigned u = __builtin_bit_cast(unsigned, f); return (u + 0x7fffu + ((u >> 16) & 1u)) >> 16; }
typedef __bf16 bf16x2_hw __attribute__((ext_vector_type(2)));
__device__ __forceinline__ unsigned pk2(float lo, float hi) { f32x2 v = {lo, hi}; bf16x2_hw b = __builtin_convertvector(v, bf16x2_hw); return __builtin_bit_cast(unsigned, b); }
__device__ __forceinline__ float bf2f(unsigned short b) { return __builtin_bit_cast(float, (unsigned)b << 16); }
__device__ __forceinline__ float bflo(unsigned w) { return __builtin_bit_cast(float, w << 16); }
__device__ __forceinline__ float bfhi(unsigned w) { return __builtin_bit_cast(float, w & 0xffff0000u); }

namespace pg8 {
constexpr int BM = 256, BK = 64, HALF = 128, HTB = HALF * BK * 2, STAGE_BYTES = 8 * HTB, NXCD = 8, WGM = 8;
__host__ __device__ __forceinline__ int lds_byte(int r, int c) { const int st = (r >> 4) * 2 + (c >> 5), rr = r & 15, cc = c & 31, ob = rr * 64 + cc * 2; return st * 1024 + (ob ^ (((ob >> 9) & 1) << 5)); }
__host__ __device__ __forceinline__ void stage_rc(int b, int& R, int& C) { const int st = b / 1024, sb = b % 1024, swz = sb ^ (((sb >> 9) & 1) << 5); R = (st >> 1) * 16 + swz / 64; C = (st & 1) * 32 + (swz % 64) / 2; }
__host__ __device__ __forceinline__ int perm32(int rho) { const int n = rho >> 4, i = rho & 15; return 8 * (i >> 2) + 4 * n + (i & 3); }
struct Unit { int pm, pn; };
struct Gemm { const bf16_t* A; const bf16_t* Bt; int M, N, K; };
struct StaticOrder {
    int nM, nN, nwg, G, c;
    __host__ __device__ void init(int M, int N, int G_, int c_) { nM = M / BM; nN = N / BM; nwg = nM * nN; G = G_; c = c_; }
    __host__ __device__ bool next(int i, Unit& u) const {
        const long L = (long)i * G + c; if (L >= nwg) return false;
        int wgid = (int)L; { const int q = nwg / NXCD, r = nwg % NXCD, xcd = wgid % NXCD, off = wgid / NXCD; wgid = (xcd < r ? xcd * (q + 1) : r * (q + 1) + (xcd - r) * q) + off; }
        const int nig = WGM * nN, gid = wgid / nig, fm = gid * WGM, gsz = (nM - fm) < WGM ? (nM - fm) : WGM;
        u.pm = fm + ((wgid % nig) % gsz); u.pn = (wgid % nig) / gsz; return true;
    }
    __device__ __forceinline__ void a_ready(const Unit&) const {}
    __device__ __forceinline__ void done(const Unit&) const {}
};
__device__ __forceinline__ unsigned cvt_pk_bf16(float lo, float hi) { unsigned r; asm volatile("v_cvt_pk_bf16_f32 %0, %1, %2" : "=v"(r) : "v"(lo), "v"(hi)); return r; }

struct EpiBf16 {
    static constexpr bool PERM = true, AFTER_DRAIN = false, INIT_ACC = false;
    bf16_t* O; int ldc;
    __device__ __forceinline__ void operator()(const f32x4 (&acc)[2][2][4][2], const Unit& u, int wr, int wc, int fr, int fq) const {
        const int row0 = u.pm * BM + wr * 64 + fr; const int col0 = u.pn * BM + wc * 32 + 8 * fq;
#pragma unroll
        for (int ai = 0; ai < 2; ++ai)
#pragma unroll
            for (int m = 0; m < 4; ++m) { bf16_t* rowp = O + (size_t)(row0 + ai * HALF + m * 16) * ldc + col0;
#pragma unroll
                for (int bj = 0; bj < 2; ++bj) { const f32x4 v0 = acc[ai][bj][m][0], v1 = acc[ai][bj][m][1];
                    u32x4 w; w.x = cvt_pk_bf16(v0[0], v0[1]); w.y = cvt_pk_bf16(v0[2], v0[3]); w.z = cvt_pk_bf16(v1[0], v1[1]); w.w = cvt_pk_bf16(v1[2], v1[3]);
                    *(u32x4*)(rowp + bj * HALF) = w; } }
    }
};
struct EpiResF32 {
    static constexpr bool PERM = false, AFTER_DRAIN = false, INIT_ACC = false;
    const float* base0; const float* base1; int split_row; float* out; int ldc;
    __device__ __forceinline__ void operator()(const f32x4 (&acc)[2][2][4][2], const Unit& u, int wr, int wc, int fr, int fq) const {
        const int col0 = u.pn * BM + wc * 32 + 4 * fq;
#pragma unroll
        for (int ai = 0; ai < 2; ++ai)
#pragma unroll
            for (int m = 0; m < 4; ++m) { const int r = u.pm * BM + ai * HALF + wr * 64 + m * 16 + fr;
                const float* b = (r < split_row) ? base0 + (size_t)r * ldc : base1 + (size_t)(r - split_row) * ldc;
                float* o = out + (size_t)r * ldc;
#pragma unroll
                for (int bj = 0; bj < 2; ++bj)
#pragma unroll
                    for (int n = 0; n < 2; ++n) { const int off = col0 + bj * HALF + n * 16; const f32x4 bs = *(const f32x4*)(b + off); *(f32x4*)(o + off) = bs + acc[ai][bj][m][n]; } }
    }
};

struct PanelRms {
    float* xbuf; unsigned* cnt; float eps;
    __device__ __forceinline__ void run(const f32x4 (&v)[2][2][4][2], const Unit& u, int wr, int wc, int fr, int fq, LAS unsigned char* lds, int wid, int lane) const {
        LAS float* P = (LAS float*)lds;
        LAS float* S = (LAS float*)(lds + 8192);
        LAS unsigned* flag = (LAS unsigned*)(lds + 8192 + 2048);
#pragma unroll
        for (int ai = 0; ai < 2; ++ai)
#pragma unroll
            for (int m = 0; m < 4; ++m) { float q = 0.f;
#pragma unroll
                for (int bj = 0; bj < 2; ++bj)
#pragma unroll
                    for (int n = 0; n < 2; ++n) { const f32x4 x = v[ai][bj][m][n]; q += (x[0] * x[0] + x[1] * x[1]) + (x[2] * x[2] + x[3] * x[3]); }
                q += __shfl_xor(q, 16); q += __shfl_xor(q, 32);
                if (fq == 0) P[(ai * HALF + wr * 64 + m * 16 + fr) * 4 + wc] = q; }
        asm volatile("s_waitcnt lgkmcnt(0)" ::: "memory"); __builtin_amdgcn_s_barrier(); asm volatile("" ::: "memory");
        const int row = wid * 32 + (lane & 31);
        if (lane < 32) { const float t = (P[row * 4 + 0] + P[row * 4 + 1]) + (P[row * 4 + 2] + P[row * 4 + 3]);
            __hip_atomic_store(xbuf + ((size_t)(u.pm * BM + row) * 4 + u.pn), t, __ATOMIC_RELAXED, __HIP_MEMORY_SCOPE_AGENT); }
        asm volatile("s_waitcnt vmcnt(0)" ::: "memory");
        if (lane == 0) __hip_atomic_fetch_add(cnt + 64 * u.pm, 1u, __ATOMIC_RELAXED, __HIP_MEMORY_SCOPE_AGENT);
        if (wid == 0) {
            unsigned sp = 0u;
            for (;;) { if ((unsigned)__builtin_amdgcn_readfirstlane(__hip_atomic_load(cnt + 64 * u.pm, __ATOMIC_RELAXED, __HIP_MEMORY_SCOPE_AGENT)) >= 32u) break;
                __builtin_amdgcn_s_sleep(2); if (++sp > (1u << 22)) break; }
            __builtin_amdgcn_fence(__ATOMIC_ACQUIRE, "agent");
            if (lane == 0) flag[0] = 1u;
        }
        asm volatile("s_waitcnt vmcnt(0) lgkmcnt(0)" ::: "memory"); __builtin_amdgcn_s_barrier(); asm volatile("" ::: "memory");
        if (lane < 32) { const float* sl = xbuf + (size_t)(u.pm * BM + row) * 4; float t = 0.f;
#pragma unroll
            for (int k = 0; k < 4; ++k) t += __hip_atomic_load(sl + k, __ATOMIC_RELAXED, __HIP_MEMORY_SCOPE_AGENT);
            S[row] = 1.0f / sqrtf(t * (1.0f / 1024.0f) + eps); }
        asm volatile("s_waitcnt lgkmcnt(0)" ::: "memory"); __builtin_amdgcn_s_barrier(); asm volatile("" ::: "memory");
    }
};
template <bool FINAL> struct EpiRmsOut {
    static constexpr bool PERM = false, AFTER_DRAIN = true, INIT_ACC = true;
    const float* base0; const float* base1; int split_row; float* out; bf16_t* xn; const float* gain; int ldc; PanelRms st;
    __device__ __forceinline__ void init(f32x4 (&acc)[2][2][4][2], const Unit& u, int wr, int wc, int fr, int fq) const {
        const int r0 = u.pm * BM; const float* bt = ((r0 < split_row) ? base0 + (size_t)r0 * ldc : base1 + (size_t)(r0 - split_row) * ldc) + u.pn * BM;
        const unsigned o0 = (unsigned)((wr * 64 + fr) * ldc + wc * 32 + 4 * fq);
#pragma unroll
        for (int ai = 0; ai < 2; ++ai)
#pragma unroll
            for (int m = 0; m < 4; ++m) { const unsigned o = o0 + (unsigned)((ai * HALF + m * 16) * ldc);
#pragma unroll
                for (int bj = 0; bj < 2; ++bj)
#pragma unroll
                    for (int n = 0; n < 2; ++n) acc[ai][bj][m][n] = *(const f32x4*)(bt + o + bj * HALF + n * 16); }
    }
    __device__ __forceinline__ void fused(f32x4 (&acc)[2][2][4][2], const Unit& u, int wr, int wc, int fr, int fq, LAS unsigned char* lds, int wid, int lane) const {
        const LAS float* S = (const LAS float*)(lds + 8192);
        const int col0 = u.pn * BM + wc * 32 + 4 * fq;
        st.run(acc, u, wr, wc, fr, fq, lds, wid, lane);
#pragma unroll
        for (int ai = 0; ai < 2; ++ai)
#pragma unroll
            for (int m = 0; m < 4; ++m) { const int rl = ai * HALF + wr * 64 + m * 16 + fr; const float rs = S[rl]; const size_t off = (size_t)(u.pm * BM + rl) * ldc + col0;
#pragma unroll
                for (int bj = 0; bj < 2; ++bj)
#pragma unroll
                    for (int n = 0; n < 2; ++n) { const f32x4 x = acc[ai][bj][m][n]; const size_t o_ = off + bj * HALF + n * 16;
                        if (FINAL) { const f32x4 gg = *(const f32x4*)(gain + col0 + bj * HALF + n * 16); *(f32x4*)(out + o_) = x * rs * gg; }
                        else { *(f32x4*)(out + o_) = x; const f32x4 y = x * rs; u32x2 w; w.x = cvt_pk_bf16(y[0], y[1]); w.y = cvt_pk_bf16(y[2], y[3]); *(u32x2*)(xn + o_) = w; } }
                asm volatile("" ::: "memory"); }
        asm volatile("s_waitcnt lgkmcnt(0)" ::: "memory"); __builtin_amdgcn_s_barrier(); asm volatile("" ::: "memory");
    }
};
struct RoundOrder {
    StaticOrder so; int round;
    __device__ __forceinline__ bool next(int i, Unit& u) const { if (i > 0) return false; return so.next(round, u); }
    __device__ __forceinline__ void a_ready(const Unit&) const {}
    __device__ __forceinline__ void done(const Unit&) const {}
};

template <class Epi, class Sched, bool ALIGN_EPI = false, bool SP2 = false>
__device__ __forceinline__ void gemm_phase(LAS unsigned char* lds, const Gemm g, const Sched& S, const Epi& E, const int tid) {
    const int wid = __builtin_amdgcn_readfirstlane(tid >> 6), lane = tid & 63, wr = wid >> 2, wc = wid & 3, fr = lane & 15, fq = lane >> 4;
    const int K = g.K, nt = K / BK;
    unsigned voffA[2], voffB[2];
#pragma unroll
    for (int i = 0; i < 2; ++i) { int R, C; stage_rc(tid * 16 + i * 8192, R, C); const int Rb = Epi::PERM ? ((R & ~31) + perm32(R & 31)) : R;
        voffA[i] = (unsigned)(R * K + C) * 2u; voffB[i] = (unsigned)(Rb * K + C) * 2u; }
    const size_t kstep = (size_t)(BK * 2);
    const size_t hstep = (size_t)HALF * K * 2;
    const size_t tstep = 2 * hstep;
    const unsigned ldsw = (unsigned)wid * 1024u;
    const int aoff = lds_byte(wr * 64 + fr, fq * 8), boff = lds_byte(wc * 32 + fr, fq * 8);
#define PG8_SA(b, h) (((b) * 2 + (h)) * HTB)
#define PG8_SB(b, h) ((4 + (b) * 2 + (h)) * HTB)
#define PG8_STAGE(bufoff, gbase, voff) do { _Pragma("unroll") for (int _i = 0; _i < 2; ++_i) \
        __builtin_amdgcn_global_load_lds((const unsigned*)((const char*)(gbase) + (voff)[_i]), (LAS unsigned*)(lds + (bufoff) + ldsw + _i * 8192), 16, 0, 0); } while (0)
#define PG8_LDA(dst, b, h) do { _Pragma("unroll") for (int m = 0; m < 4; ++m) _Pragma("unroll") for (int k = 0; k < 2; ++k) dst[m][k] = *(const LAS bf16x8*)(lds + PG8_SA(b, h) + aoff + m * 2048 + k * 1024); } while (0)
#define PG8_LDB(dst, b, h) do { _Pragma("unroll") for (int n = 0; n < 2; ++n) _Pragma("unroll") for (int k = 0; k < 2; ++k) dst[n][k] = *(const LAS bf16x8*)(lds + PG8_SB(b, h) + boff + n * 2048 + k * 1024); } while (0)
#define PG8_MMA(ai, bj, At, Bt) do { __builtin_amdgcn_s_setprio(1); _Pragma("unroll") for (int m = 0; m < 4; ++m) _Pragma("unroll") for (int n = 0; n < 2; ++n) _Pragma("unroll") for (int k = 0; k < 2; ++k) \
        acc[ai][bj][m][n] = __builtin_amdgcn_mfma_f32_16x16x32_bf16(Bt[n][k], At[m][k], acc[ai][bj][m][n], 0, 0, 0); __builtin_amdgcn_s_setprio(0); } while (0)
#define PG8_WAIT_V(n) asm volatile("s_waitcnt vmcnt(" #n ")" ::: "memory")
#define PG8_WAIT_L(n) asm volatile("s_waitcnt lgkmcnt(" #n ")" ::: "memory")
#define PG8_BAR __builtin_amdgcn_s_barrier()
#define PG8_SCHED __builtin_amdgcn_sched_barrier(0)
    Unit cur, nxt; int ui = 0;
    if (!S.next(0, cur)) return;
    f32x4 acc[2][2][4][2];
    if constexpr (Epi::INIT_ACC) E.init(acc, cur, wr, wc, fr, fq);
    else {
#pragma unroll
    for (int a = 0; a < 2; ++a)
#pragma unroll
        for (int b = 0; b < 2; ++b)
#pragma unroll
            for (int m = 0; m < 4; ++m)
#pragma unroll
                for (int n = 0; n < 2; ++n) acc[a][b][m][n] = (f32x4){0.f, 0.f, 0.f, 0.f};
    }
    bf16x8 At[4][2], B0[2][2], B1[2][2];
    const char* cA = (const char*)g.A + (size_t)cur.pm * tstep; const char* cB = (const char*)g.Bt + (size_t)cur.pn * tstep;
    S.a_ready(cur);
    if constexpr (SP2) {
        PG8_STAGE(PG8_SB(0, 0), cB, voffB); PG8_STAGE(PG8_SB(0, 1), cB + hstep, voffB); PG8_STAGE(PG8_SA(0, 0), cA, voffA); PG8_STAGE(PG8_SA(0, 1), cA + hstep, voffA);
        if (wr == 1) PG8_BAR;
        PG8_WAIT_V(2); PG8_BAR;
        PG8_STAGE(PG8_SB(1, 0), cB + kstep, voffB); PG8_STAGE(PG8_SA(1, 0), cA + kstep, voffA); PG8_STAGE(PG8_SB(1, 1), cB + hstep + kstep, voffB);
        PG8_WAIT_V(6); PG8_BAR;
    } else {
        PG8_STAGE(PG8_SB(0, 0), cB, voffB); PG8_STAGE(PG8_SA(0, 0), cA, voffA); PG8_STAGE(PG8_SB(0, 1), cB + hstep, voffB); PG8_STAGE(PG8_SA(0, 1), cA + hstep, voffA);
        if (wr == 1) PG8_BAR;
        PG8_WAIT_V(4); PG8_BAR;
        PG8_STAGE(PG8_SB(1, 0), cB + kstep, voffB); PG8_STAGE(PG8_SA(1, 0), cA + kstep, voffA); PG8_STAGE(PG8_SB(1, 1), cB + hstep + kstep, voffB);
        PG8_WAIT_V(6); PG8_BAR;
    }
    for (;;) {
        const bool has_next = S.next(ui + 1, nxt);
        const char* nA = has_next ? (const char*)g.A + (size_t)nxt.pm * tstep : cA; const char* nB = has_next ? (const char*)g.Bt + (size_t)nxt.pn * tstep : cB;
        for (int t = 0; t < nt; t += 2) {
            const bool last = (t == nt - 2);
            const char* a1 = cA + (size_t)(t + 1) * kstep;
            const char* a2 = last ? nA : cA + (size_t)(t + 2) * kstep; const char* b2 = last ? nB : cB + (size_t)(t + 2) * kstep;
            const char* a3 = a2 + kstep; const char* b3 = b2 + kstep;
            if (last && has_next) S.a_ready(nxt);
            if constexpr (SP2) {
            PG8_LDB(B0, 0, 0); PG8_LDB(B1, 0, 1); PG8_SCHED; PG8_LDA(At, 0, 0); PG8_STAGE(PG8_SA(1, 1), a1 + hstep, voffA);
            PG8_WAIT_V(8); PG8_WAIT_L(0); PG8_BAR; PG8_MMA(0, 0, At, B0); PG8_MMA(0, 1, At, B1); PG8_BAR; PG8_SCHED;
            PG8_LDA(At, 0, 1); PG8_STAGE(PG8_SB(0, 0), b2, voffB); PG8_STAGE(PG8_SB(0, 1), b2 + hstep, voffB); PG8_STAGE(PG8_SA(0, 0), a2, voffA);
            PG8_WAIT_V(8); PG8_WAIT_L(0); PG8_BAR; PG8_MMA(1, 0, At, B0); PG8_MMA(1, 1, At, B1); PG8_BAR; PG8_SCHED;
            PG8_LDB(B0, 1, 0); PG8_LDB(B1, 1, 1); PG8_SCHED; PG8_LDA(At, 1, 0); PG8_STAGE(PG8_SA(0, 1), a2 + hstep, voffA);
            PG8_WAIT_V(8); PG8_WAIT_L(0); PG8_BAR; PG8_MMA(0, 0, At, B0); PG8_MMA(0, 1, At, B1); PG8_BAR; PG8_SCHED;
            PG8_LDA(At, 1, 1); PG8_STAGE(PG8_SB(1, 0), b3, voffB); PG8_STAGE(PG8_SB(1, 1), b3 + hstep, voffB); PG8_STAGE(PG8_SA(1, 0), a3, voffA);
            PG8_WAIT_V(8); PG8_WAIT_L(0); PG8_BAR; PG8_MMA(1, 0, At, B0); PG8_MMA(1, 1, At, B1); PG8_BAR; PG8_SCHED;
            } else {
            PG8_LDB(B0, 0, 0); PG8_SCHED; PG8_LDA(At, 0, 0); PG8_STAGE(PG8_SA(1, 1), a1 + hstep, voffA);
            PG8_WAIT_L(8); PG8_BAR; PG8_WAIT_L(0); PG8_MMA(0, 0, At, B0); PG8_BAR; PG8_SCHED;
            PG8_LDB(B1, 0, 1); PG8_STAGE(PG8_SB(0, 0), b2, voffB);
            PG8_BAR; PG8_WAIT_L(0); PG8_MMA(0, 1, At, B1); PG8_BAR;
            PG8_LDA(At, 0, 1); PG8_STAGE(PG8_SA(0, 0), a2, voffA);
            PG8_BAR; PG8_WAIT_L(0); PG8_MMA(1, 0, At, B0); PG8_BAR; PG8_SCHED;
            PG8_STAGE(PG8_SB(0, 1), b2 + hstep, voffB);
            PG8_WAIT_V(6); PG8_BAR; PG8_MMA(1, 1, At, B1); PG8_BAR;
            PG8_LDB(B0, 1, 0); PG8_SCHED; PG8_LDA(At, 1, 0); PG8_STAGE(PG8_SA(0, 1), a2 + hstep, voffA);
            PG8_WAIT_L(8); PG8_BAR; PG8_WAIT_L(0); PG8_MMA(0, 0, At, B0); PG8_BAR; PG8_SCHED;
            PG8_LDB(B1, 1, 1); PG8_STAGE(PG8_SB(1, 0), b3, voffB);
            PG8_BAR; PG8_WAIT_L(0); PG8_MMA(0, 1, At, B1); PG8_BAR;
            PG8_LDA(At, 1, 1); PG8_STAGE(PG8_SA(1, 0), a3, voffA);
            PG8_BAR; PG8_WAIT_L(0); PG8_MMA(1, 0, At, B0); PG8_BAR; PG8_SCHED;
            PG8_STAGE(PG8_SB(1, 1), b3 + hstep, voffB);
            PG8_WAIT_V(6); PG8_BAR; PG8_MMA(1, 1, At, B1); PG8_BAR;
            }
        }
        if constexpr (ALIGN_EPI) { if (wr == 0) PG8_BAR; }
        if constexpr (!Epi::AFTER_DRAIN) { E(acc, cur, wr, wc, fr, fq); S.done(cur); }
        if (!has_next) break;
        if constexpr (Epi::INIT_ACC) E.init(acc, nxt, wr, wc, fr, fq);
        else {
#pragma unroll
        for (int a = 0; a < 2; ++a)
#pragma unroll
            for (int b = 0; b < 2; ++b)
#pragma unroll
                for (int m = 0; m < 4; ++m)
#pragma unroll
                    for (int n = 0; n < 2; ++n) acc[a][b][m][n] = (f32x4){0.f, 0.f, 0.f, 0.f};
        }
        cur = nxt; cA = nA; cB = nB; ++ui;
        if constexpr (ALIGN_EPI) { if (wr == 1) PG8_BAR; }
    }
    PG8_WAIT_V(0);
    if constexpr (!ALIGN_EPI) { if (wr == 0) PG8_BAR; }
    PG8_BAR;
    if constexpr (Epi::AFTER_DRAIN) { E.fused(acc, cur, wr, wc, fr, fq, lds, wid, lane); S.done(cur); }
#undef PG8_SA
#undef PG8_SB
#undef PG8_STAGE
#undef PG8_LDA
#undef PG8_LDB
#undef PG8_MMA
#undef PG8_WAIT_V
#undef PG8_WAIT_L
#undef PG8_BAR
#undef PG8_SCHED
}
}

namespace fa {
constexpr int SLOTB = 8192;
constexpr int L_K = 0, L_V = 3 * SLOTB, L_OST = 6 * SLOTB, L_QST = L_OST, L_WS = 120 * 1024, L_TAB = L_WS + 2048, L_END = L_TAB + 4096;
constexpr int L_AK = 0, L_AV = 6 * SLOTB, L_AOST = 0;
static_assert(L_END <= RING_BYTES, "attention LDS map");
#define SBAR() __builtin_amdgcn_sched_barrier(0)
__device__ __forceinline__ int crow(int r, int hi) { return (r & 3) + 8 * (r >> 2) + 4 * hi; }
__device__ __forceinline__ void glds16(const void* gsrc, unsigned lds_dst) { unsigned keep;
    asm volatile("s_mov_b32 %0, m0\n\ts_mov_b32 m0, %2\n\ts_nop 0\n\tglobal_load_lds_dwordx4 %1, off\n\ts_mov_b32 m0, %0" : "=&s"(keep) : "v"(gsrc), "s"(lds_dst) : "memory"); }
__device__ __forceinline__ void glds16s(const void* sbase, unsigned voff, unsigned lds_dst) { unsigned keep;
    asm volatile("s_mov_b32 %0, m0\n\ts_mov_b32 m0, %3\n\ts_nop 0\n\tglobal_load_lds_dwordx4 %1, %2\n\ts_mov_b32 m0, %0" : "=&s"(keep) : "v"(voff), "s"(sbase), "s"(lds_dst) : "memory"); }
typedef __bf16 bf16x2_t __attribute__((ext_vector_type(2)));
__device__ __forceinline__ unsigned cvtpk_s(float lo, float hi) { f32x2 v = {lo, hi}; bf16x2_t b = __builtin_convertvector(v, bf16x2_t); return __builtin_bit_cast(unsigned, b); }
#define FA_WAIT_BAR(N) asm volatile("s_waitcnt vmcnt(" #N ") lgkmcnt(0)\n\ts_barrier" ::: "memory")

template <int NDQ>
__device__ __forceinline__ void qkt(f32x16& p0, f32x16& p1, LAS const unsigned char* Kslot, const bf16x8* qr, const f32x16& cin, int r32, int hi) {
    LAS const unsigned char* kb = Kslot + hi * 1024 + r32 * 16;
#pragma unroll
    for (int d0 = 0; d0 < NDQ; ++d0) {
        const bf16x8 b0 = *(LAS const bf16x8*)(kb + d0 * 2048);
        const bf16x8 b1 = *(LAS const bf16x8*)(kb + d0 * 2048 + 512);
        if (d0 == 0) { p0 = __builtin_amdgcn_mfma_f32_32x32x16_bf16(b0, qr[0], cin, 0, 0, 0); p1 = __builtin_amdgcn_mfma_f32_32x32x16_bf16(b1, qr[0], cin, 0, 0, 0); }
        else { p0 = __builtin_amdgcn_mfma_f32_32x32x16_bf16(b0, qr[d0], p0, 0, 0, 0); p1 = __builtin_amdgcn_mfma_f32_32x32x16_bf16(b1, qr[d0], p1, 0, 0, 0); } }
}
__device__ __forceinline__ float max3f(float a, float b, float c) { float r; asm("v_max3_f32 %0, %1, %2, %3" : "=v"(r) : "v"(a), "v"(b), "v"(c)); return r; }
__device__ __forceinline__ float max2f(float a, float b) { float r; asm("v_max_f32_e32 %0, %1, %2" : "=v"(r) : "v"(a), "v"(b)); return r; }
__device__ __forceinline__ float rowmax(const f32x16& p0, const f32x16& p1) {
    float a = max3f(p0[0], p0[1], p1[0]), b = max3f(p0[2], p0[3], p1[1]); a = max3f(a, p1[2], p1[3]);
#pragma unroll
    for (int r = 4; r < 16; r += 4) { a = max3f(a, p0[r], p0[r + 1]); b = max3f(b, p0[r + 2], p0[r + 3]); a = max3f(a, p1[r], p1[r + 1]); b = max3f(b, p1[r + 2], p1[r + 3]); }
    const float m = max2f(a, b);
    auto rr = __builtin_amdgcn_permlane32_swap(__float_as_uint(m), __float_as_uint(m), false, false);
    return max2f(__uint_as_float(rr[0]), __uint_as_float(rr[1]));
}
__device__ __forceinline__ void pv(f32x16* o, int vb, bf16x8 pa0, bf16x8 pa1, bf16x8 pa2, bf16x8 pa3) {
#pragma unroll
    for (int d0 = 0; d0 < 2; ++d0) { s16x4 lo[4], hi[4];
#pragma unroll
        for (int ks = 0; ks < 4; ++ks) {
            asm volatile("ds_read_b64_tr_b16 %0,%1 offset:%c2" : "=&v"(lo[ks]) : "v"(vb), "i"(d0 * 4096 + ks * 1024) : "memory");
            asm volatile("ds_read_b64_tr_b16 %0,%1 offset:%c2" : "=&v"(hi[ks]) : "v"(vb), "i"(d0 * 4096 + ks * 1024 + 512) : "memory"); }
        asm volatile("s_waitcnt lgkmcnt(0)" ::: "memory"); SBAR();
#define FA_PK(k) (bf16x8){lo[k][0], lo[k][1], lo[k][2], lo[k][3], hi[k][0], hi[k][1], hi[k][2], hi[k][3]}
        o[d0] = __builtin_amdgcn_mfma_f32_32x32x16_bf16(pa0, FA_PK(0), o[d0], 0, 0, 0);
        o[d0] = __builtin_amdgcn_mfma_f32_32x32x16_bf16(pa1, FA_PK(1), o[d0], 0, 0, 0);
        o[d0] = __builtin_amdgcn_mfma_f32_32x32x16_bf16(pa2, FA_PK(2), o[d0], 0, 0, 0);
        o[d0] = __builtin_amdgcn_mfma_f32_32x32x16_bf16(pa3, FA_PK(3), o[d0], 0, 0, 0);
#undef FA_PK
    }
}

constexpr float THR = 8.0f;
template <int NDQ, class KV, class Hook>
__device__ __forceinline__ void flash_core(LAS unsigned char* shm, const bf16_t* qptr, const KV& kv, int NT, const Hook& hk, int koff, f32x16 (&o)[2], float& mhat_out, float& l_out, const int tid) {
    const int lane = tid & 63, r32 = lane & 31, hi = lane >> 5; const int wid = __builtin_amdgcn_readfirstlane(tid >> 6);
    const unsigned lds0 = (unsigned)(uintptr_t)shm;
    LAS float* wsf = (LAS float*)(shm + L_WS) + wid * 64;
    const unsigned kdst = lds0 + L_K + wid * 1024, vdst = lds0 + L_V + wid * 1024;
    const int vrow_j = 16 * (wid & 3) + (lane >> 2), vcol = (wid >> 2) * 32 + (lane & 3) * 8;
#define FA_DMA(t, slot) do { glds16(kv.kptr((t), lane) + wid * 8, (unsigned)__builtin_amdgcn_readfirstlane(kdst + (slot) * SLOTB)); \
                             glds16(kv.vptr((t), vrow_j) + vcol, (unsigned)__builtin_amdgcn_readfirstlane(vdst + (slot) * SLOTB)); } while (0)
    FA_DMA(0, 0);
    bf16x8 qr[4];
#pragma unroll
    for (int d0 = 0; d0 < 4; ++d0) { if (d0 < NDQ) qr[d0] = *(const bf16x8*)(qptr + d0 * 16 + hi * 8); else qr[d0] = (bf16x8){0, 0, 0, 0, 0, 0, 0, 0}; }
    asm volatile("" : "+v"(qr[0]), "+v"(qr[1]), "+v"(qr[2]), "+v"(qr[3]));
    float mhat = 0.f, l = 0.f; o[0] = f32x16{}; o[1] = f32x16{}; const f32x16 zero16 = f32x16{};
    bool first = true;
    const int vb0 = (int)(lds0 + L_V) + ((lane >> 4) & 1) * 32 + (lane & 3) * 8 + (4 * hi + ((lane & 15) >> 2)) * 64;
    for (int t = 0; t < NT; ++t) {
        const int slot = t & 1;
        if (t + 1 < NT) { FA_DMA(t + 1, slot ^ 1); FA_WAIT_BAR(2); } else { FA_WAIT_BAR(0); }
        if (!hk.skip(t)) {
            f32x16 p0, p1;
            qkt<NDQ>(p0, p1, shm + L_K + slot * SLOTB + koff, qr, zero16, r32, hi);
            hk.apply(p0, p1, t);
            const float rmr = rowmax(p0, p1); const float rm = rmr - mhat;
            if (first) {
                first = false; mhat = (rmr > -1e29f) ? rmr : 0.f;
            } else if (__any(rm > THR)) {
                const float dl = fmaxf(rm, 0.f); mhat += dl;
                const float f = __builtin_amdgcn_exp2f(-dl); l *= f; if (hi == 0) wsf[r32] = f;
                asm volatile("s_waitcnt lgkmcnt(0)" ::: "memory");
#pragma unroll
                for (int r = 0; r < 16; ++r) { const float fr_ = wsf[crow(r, hi)]; o[0][r] *= fr_; o[1][r] *= fr_; }
            }
            float sacc = 0.f, sacc2 = 0.f;
#pragma unroll
            for (int r = 0; r < 16; ++r) { p0[r] = __builtin_amdgcn_exp2f(p0[r] - mhat); p1[r] = __builtin_amdgcn_exp2f(p1[r] - mhat); sacc += p0[r]; sacc2 += p1[r]; }
            l += sacc + sacc2;
            u32x4 pw0, pw1, pw2, pw3;
            pw0 = (u32x4){cvtpk_s(p0[0], p0[1]), cvtpk_s(p0[2], p0[3]), cvtpk_s(p0[4], p0[5]), cvtpk_s(p0[6], p0[7])};
            pw1 = (u32x4){cvtpk_s(p0[8], p0[9]), cvtpk_s(p0[10], p0[11]), cvtpk_s(p0[12], p0[13]), cvtpk_s(p0[14], p0[15])};
            pw2 = (u32x4){cvtpk_s(p1[0], p1[1]), cvtpk_s(p1[2], p1[3]), cvtpk_s(p1[4], p1[5]), cvtpk_s(p1[6], p1[7])};
            pw3 = (u32x4){cvtpk_s(p1[8], p1[9]), cvtpk_s(p1[10], p1[11]), cvtpk_s(p1[12], p1[13]), cvtpk_s(p1[14], p1[15])};
            SBAR();
            pv(o, vb0 + slot * SLOTB, __builtin_bit_cast(bf16x8, pw0), __builtin_bit_cast(bf16x8, pw1), __builtin_bit_cast(bf16x8, pw2), __builtin_bit_cast(bf16x8, pw3));
        }
        asm volatile("s_waitcnt lgkmcnt(0)\n\ts_barrier" ::: "memory");
    }
#undef FA_DMA
    { auto rr = __builtin_amdgcn_permlane32_swap(__float_as_uint(l), __float_as_uint(l), false, false); l = __uint_as_float(rr[0]) + __uint_as_float(rr[1]); }
    if (hi == 0) wsf[32 + r32] = l;
    asm volatile("s_waitcnt lgkmcnt(0)" ::: "memory");
#pragma unroll
    for (int r = 0; r < 16; ++r) { const float rl = __builtin_amdgcn_rcpf(wsf[32 + crow(r, hi)]); o[0][r] *= rl; o[1][r] *= rl; }
    mhat_out = mhat; l_out = l;
}
template <int NDQ, class KV, class Hook>
__device__ __forceinline__ void flash_core_sp(LAS unsigned char* shm, const bf16_t* qptr, const KV& kv, int NT, const Hook& hk, int koff, f32x16 (&o)[2], float& mhat_out, float& l_out, const int tid) {
    const int lane = tid & 63, r32 = lane & 31, hi = lane >> 5; const int wid = __builtin_amdgcn_readfirstlane(tid >> 6);
    const unsigned lds0 = (unsigned)(uintptr_t)shm;
    LAS float* wsf = (LAS float*)(shm + L_WS) + wid * 64;
    const unsigned kdst = lds0 + L_K + wid * 1024, vdst = lds0 + L_V + wid * 1024;
    const int vrow_j = 16 * (wid & 3) + (lane >> 2), vcol = (wid >> 2) * 32 + (lane & 3) * 8;
#define FA_DMAK(t, SL) glds16(kv.kptr((t), lane) + wid * 8, (unsigned)__builtin_amdgcn_readfirstlane(kdst + (SL) * SLOTB))
#define FA_DMAV(t, SL) glds16(kv.vptr((t), vrow_j) + vcol, (unsigned)__builtin_amdgcn_readfirstlane(vdst + (SL) * SLOTB))
    FA_DMAK(0, 0); FA_DMAV(0, 0); FA_DMAK(1, 1); FA_DMAK(2, 2); FA_DMAV(1, 1);
    bf16x8 qr[4];
#pragma unroll
    for (int d0 = 0; d0 < 4; ++d0) { if (d0 < NDQ) qr[d0] = *(const bf16x8*)(qptr + d0 * 16 + hi * 8); else qr[d0] = (bf16x8){0, 0, 0, 0, 0, 0, 0, 0}; }
    asm volatile("" : "+v"(qr[0]), "+v"(qr[1]), "+v"(qr[2]), "+v"(qr[3]));
    float mhat = 0.f, l = 0.f; o[0] = f32x16{}; o[1] = f32x16{}; const f32x16 zero16 = f32x16{};
    bool first = true;
    const int vb0 = (int)(lds0 + L_V) + ((lane >> 4) & 1) * 32 + (lane & 3) * 8 + (4 * hi + ((lane & 15) >> 2)) * 64;
    f32x16 pA0, pA1, pB0, pB1;
    FA_WAIT_BAR(2);
#define FA_ENDW(tt) do { if ((tt) + 3 < NT) { FA_WAIT_BAR(2); } else if ((tt) + 2 < NT) { FA_WAIT_BAR(1); } else { FA_WAIT_BAR(0); } } while (0)
    if (!hk.skip(0)) qkt<NDQ>(pA0, pA1, shm + L_K + koff, qr, zero16, r32, hi);
#define FA_SMPV(P0, P1, tt, SL) do { \
        hk.apply(P0, P1, (tt)); const float curb = hk.cbias(tt); \
        const float rmr = rowmax(P0, P1) + curb; const float rm = rmr - mhat; \
        if (first) { first = false; mhat = (rmr > -1e29f) ? rmr : 0.f; \
        } else if (__any(rm > THR)) { const float dl = fmaxf(rm, 0.f); mhat += dl; \
            const float f = __builtin_amdgcn_exp2f(-dl); l *= f; if (hi == 0) wsf[r32] = f; \
            asm volatile("s_waitcnt lgkmcnt(0)" ::: "memory"); \
            _Pragma("unroll") for (int r = 0; r < 16; ++r) { const float fr_ = wsf[crow(r, hi)]; o[0][r] *= fr_; o[1][r] *= fr_; } } \
        float sacc = 0.f, sacc2 = 0.f; const float mref_ = mhat - curb; \
        _Pragma("unroll") for (int r = 0; r < 16; ++r) { P0[r] = __builtin_amdgcn_exp2f(P0[r] - mref_); P1[r] = __builtin_amdgcn_exp2f(P1[r] - mref_); sacc += P0[r]; sacc2 += P1[r]; } \
        l += sacc + sacc2; \
        u32x4 pw0, pw1, pw2, pw3; \
        pw0 = (u32x4){cvtpk_s(P0[0], P0[1]), cvtpk_s(P0[2], P0[3]), cvtpk_s(P0[4], P0[5]), cvtpk_s(P0[6], P0[7])}; \
        pw1 = (u32x4){cvtpk_s(P0[8], P0[9]), cvtpk_s(P0[10], P0[11]), cvtpk_s(P0[12], P0[13]), cvtpk_s(P0[14], P0[15])}; \
        pw2 = (u32x4){cvtpk_s(P1[0], P1[1]), cvtpk_s(P1[2], P1[3]), cvtpk_s(P1[4], P1[5]), cvtpk_s(P1[6], P1[7])}; \
        pw3 = (u32x4){cvtpk_s(P1[8], P1[9]), cvtpk_s(P1[10], P1[11]), cvtpk_s(P1[12], P1[13]), cvtpk_s(P1[14], P1[15])}; \
        SBAR(); \
        pv(o, vb0 + (SL) * SLOTB, __builtin_bit_cast(bf16x8, pw0), __builtin_bit_cast(bf16x8, pw1), __builtin_bit_cast(bf16x8, pw2), __builtin_bit_cast(bf16x8, pw3)); \
    } while (0)
    bf16x8 kf[8];
#define FA_KLOAD(SL) do { LAS const unsigned char* kb_ = shm + L_K + (SL) * SLOTB + koff + hi * 1024 + r32 * 16; \
        _Pragma("unroll") for (int d0 = 0; d0 < NDQ; ++d0) { kf[2 * d0] = *(LAS const bf16x8*)(kb_ + d0 * 2048); kf[2 * d0 + 1] = *(LAS const bf16x8*)(kb_ + d0 * 2048 + 512); } } while (0)
#define FA_QKM(P0, P1) do { _Pragma("unroll") for (int d0 = 0; d0 < NDQ; ++d0) { \
        if (d0 == 0) { P0 = __builtin_amdgcn_mfma_f32_32x32x16_bf16(kf[0], qr[0], zero16, 0, 0, 0); P1 = __builtin_amdgcn_mfma_f32_32x32x16_bf16(kf[1], qr[0], zero16, 0, 0, 0); } \
        else { P0 = __builtin_amdgcn_mfma_f32_32x32x16_bf16(kf[2 * d0], qr[d0], P0, 0, 0, 0); P1 = __builtin_amdgcn_mfma_f32_32x32x16_bf16(kf[2 * d0 + 1], qr[d0], P1, 0, 0, 0); } } } while (0)
#define FA_STEP(tt, SC, PC0, PC1, PN0, PN1) do { \
        if ((tt) + 3 < NT) FA_DMAK((tt) + 3, (SC)); \
        if ((tt) + 2 < NT) FA_DMAV((tt) + 2, ((SC) + 2) % 3); \
        const bool nx_ = ((tt) + 1 < NT) && !hk.skip((tt) + 1); \
        if (true) { if (nx_) FA_KLOAD(((SC) + 1) % 3); } \
        SBAR(); \
        if (!hk.skip(tt)) { FA_SMPV(PC0, PC1, (tt), (SC)); } \
        SBAR(); \
        if (nx_) { FA_QKM(PN0, PN1); } \
        FA_ENDW(tt); \
    } while (0)
    for (int t = 0; t < NT; t += 6) {
        FA_STEP(t, 0, pA0, pA1, pB0, pB1);
        if (t + 1 < NT) { FA_STEP(t + 1, 1, pB0, pB1, pA0, pA1); }
        if (t + 2 < NT) { FA_STEP(t + 2, 2, pA0, pA1, pB0, pB1); }
        if (t + 3 < NT) { FA_STEP(t + 3, 0, pB0, pB1, pA0, pA1); }
        if (t + 4 < NT) { FA_STEP(t + 4, 1, pA0, pA1, pB0, pB1); }
        if (t + 5 < NT) { FA_STEP(t + 5, 2, pB0, pB1, pA0, pA1); }
    }
#undef FA_STEP
#undef FA_KLOAD
#undef FA_QKM
#undef FA_SMPV
#undef FA_DMAK
#undef FA_ENDW
#undef FA_DMAV
    { auto rr = __builtin_amdgcn_permlane32_swap(__float_as_uint(l), __float_as_uint(l), false, false); l = __uint_as_float(rr[0]) + __uint_as_float(rr[1]); }
    if (hi == 0) wsf[32 + r32] = l;
    asm volatile("s_waitcnt lgkmcnt(0)" ::: "memory");
#pragma unroll
    for (int r = 0; r < 16; ++r) { const float rl = __builtin_amdgcn_rcpf(wsf[32 + crow(r, hi)]); o[0][r] *= rl; o[1][r] *= rl; }
    mhat_out = mhat; l_out = l;
}
template <class KV, class Hook>
__device__ __forceinline__ void flash_core_all(LAS unsigned char* shm, const bf16_t* qptr, const KV& kv, int NT, const Hook& hk, f32x16 (&o)[2], float& mhat_out, float& l_out, const int tid) {
    const int lane = tid & 63, r32 = lane & 31, hi = lane >> 5; const int wid = __builtin_amdgcn_readfirstlane(tid >> 6);
    const unsigned lds0 = (unsigned)(uintptr_t)shm;
    LAS float* wsf = (LAS float*)(shm + L_WS) + wid * 64;
    const unsigned kdst = lds0 + L_AK + wid * 1024, vdst = lds0 + L_AV + wid * 1024;
    const int vrow_j = 16 * (wid & 3) + (lane >> 2), vcol = (wid >> 2) * 32 + (lane & 3) * 8;
    for (int t = 0; t < NT; ++t) {
        glds16(kv.kptr(t, lane) + wid * 8, (unsigned)__builtin_amdgcn_readfirstlane(kdst + t * SLOTB));
        glds16(kv.vptr(t, vrow_j) + vcol, (unsigned)__builtin_amdgcn_readfirstlane(vdst + t * SLOTB)); }
    bf16x8 qr[4];
#pragma unroll
    for (int d0 = 0; d0 < 4; ++d0) qr[d0] = *(const bf16x8*)(qptr + d0 * 16 + hi * 8);
    asm volatile("" : "+v"(qr[0]), "+v"(qr[1]), "+v"(qr[2]), "+v"(qr[3]));
    float mhat = 0.f, l = 0.f; o[0] = f32x16{}; o[1] = f32x16{}; const f32x16 zero16 = f32x16{};
    bool first = true;
    const int vb0 = (int)(lds0 + L_AV) + ((lane >> 4) & 1) * 32 + (lane & 3) * 8 + (4 * hi + ((lane & 15) >> 2)) * 64;
    FA_WAIT_BAR(0);
    for (int t = 0; t < NT; ++t) {
        if (hk.skip(t)) continue;
        f32x16 p0, p1;
        { bf16x8 kf[8]; LAS const unsigned char* kb_ = shm + L_AK + t * SLOTB + hi * 1024 + r32 * 16;
#pragma unroll
          for (int d0 = 0; d0 < 4; ++d0) { kf[2 * d0] = *(LAS const bf16x8*)(kb_ + d0 * 2048); kf[2 * d0 + 1] = *(LAS const bf16x8*)(kb_ + d0 * 2048 + 512); }
#pragma unroll
          for (int d0 = 0; d0 < 4; ++d0) {
              if (d0 == 0) { p0 = __builtin_amdgcn_mfma_f32_32x32x16_bf16(kf[0], qr[0], zero16, 0, 0, 0); p1 = __builtin_amdgcn_mfma_f32_32x32x16_bf16(kf[1], qr[0], zero16, 0, 0, 0); }
              else { p0 = __builtin_amdgcn_mfma_f32_32x32x16_bf16(kf[2 * d0], qr[d0], p0, 0, 0, 0); p1 = __builtin_amdgcn_mfma_f32_32x32x16_bf16(kf[2 * d0 + 1], qr[d0], p1, 0, 0, 0); } } }
        hk.apply(p0, p1, t);
        const float rmr = rowmax(p0, p1); const float rm = rmr - mhat;
        if (first) { first = false; mhat = (rmr > -1e29f) ? rmr : 0.f;
        } else if (__any(rm > THR)) { const float dl = fmaxf(rm, 0.f); mhat += dl;
            const float f = __builtin_amdgcn_exp2f(-dl); l *= f; if (hi == 0) wsf[r32] = f;
            asm volatile("s_waitcnt lgkmcnt(0)" ::: "memory");
#pragma unroll
            for (int r = 0; r < 16; ++r) { const float fr_ = wsf[crow(r, hi)]; o[0][r] *= fr_; o[1][r] *= fr_; } }
        float sacc = 0.f, sacc2 = 0.f;
#pragma unroll
        for (int r = 0; r < 16; ++r) { p0[r] = __builtin_amdgcn_exp2f(p0[r] - mhat); p1[r] = __builtin_amdgcn_exp2f(p1[r] - mhat); sacc += p0[r]; sacc2 += p1[r]; }
        l += sacc + sacc2;
        u32x4 pw0, pw1, pw2, pw3;
        pw0 = (u32x4){cvtpk_s(p0[0], p0[1]), cvtpk_s(p0[2], p0[3]), cvtpk_s(p0[4], p0[5]), cvtpk_s(p0[6], p0[7])};
        pw1 = (u32x4){cvtpk_s(p0[8], p0[9]), cvtpk_s(p0[10], p0[11]), cvtpk_s(p0[12], p0[13]), cvtpk_s(p0[14], p0[15])};
        pw2 = (u32x4){cvtpk_s(p1[0], p1[1]), cvtpk_s(p1[2], p1[3]), cvtpk_s(p1[4], p1[5]), cvtpk_s(p1[6], p1[7])};
        pw3 = (u32x4){cvtpk_s(p1[8], p1[9]), cvtpk_s(p1[10], p1[11]), cvtpk_s(p1[12], p1[13]), cvtpk_s(p1[14], p1[15])};
        SBAR();
        pv(o, vb0 + t * SLOTB, __builtin_bit_cast(bf16x8, pw0), __builtin_bit_cast(bf16x8, pw1), __builtin_bit_cast(bf16x8, pw2), __builtin_bit_cast(bf16x8, pw3));
    }
    asm volatile("s_waitcnt lgkmcnt(0)\n\ts_barrier" ::: "memory");
    { auto rr = __builtin_amdgcn_permlane32_swap(__float_as_uint(l), __float_as_uint(l), false, false); l = __uint_as_float(rr[0]) + __uint_as_float(rr[1]); }
    if (hi == 0) wsf[32 + r32] = l;
    asm volatile("s_waitcnt lgkmcnt(0)" ::: "memory");
#pragma unroll
    for (int r = 0; r < 16; ++r) { const float rl = __builtin_amdgcn_rcpf(wsf[32 + crow(r, hi)]); o[0][r] *= rl; o[1][r] *= rl; }
    mhat_out = mhat; l_out = l;
}
template <class KV>
__device__ __forceinline__ void flash_core_all3(LAS unsigned char* shm, const bf16_t* qptr, const KV& kv, int NTD, int NT, int slot_off, LAS const float* tab, int qw, int kb0, bool active, float kbound, float badd,
                                                f32x16 (&o)[2], float& mrow_out, float& l_out, const int tid) {
    const int lane = tid & 63, r32 = lane & 31, hi = lane >> 5; const int wid = __builtin_amdgcn_readfirstlane(tid >> 6);
    const unsigned lds0 = (unsigned)(uintptr_t)shm;
    LAS float* wsf = (LAS float*)(shm + L_WS) + wid * 64;
    const unsigned kdst = lds0 + L_AK + wid * 1024, vdst = lds0 + L_AV + wid * 1024;
    const int vrow_j = 16 * (wid & 3) + (lane >> 2), vcol = (wid >> 2) * 32 + (lane & 3) * 8;
    const unsigned koffv = (unsigned)(kv.rmul() * lane * INW + wid * 8) * 2u, voffv = (unsigned)(kv.rmul() * vrow_j * INW + vcol) * 2u;
    for (int t = 0; t < NTD; ++t) {
        glds16s(kv.tk(t), koffv, (unsigned)__builtin_amdgcn_readfirstlane(kdst + t * SLOTB));
        glds16s(kv.tv(t), voffv, (unsigned)__builtin_amdgcn_readfirstlane(vdst + t * SLOTB)); }
    bf16x8 qr[4];
#pragma unroll
    for (int d0 = 0; d0 < 4; ++d0) qr[d0] = *(const bf16x8*)(qptr + d0 * 16 + hi * 8);
    float q2 = 0.f;
#pragma unroll
    for (int d0 = 0; d0 < 4; ++d0)
#pragma unroll
        for (int e = 0; e < 8; ++e) { const float x = __builtin_bit_cast(float, (unsigned)(unsigned short)qr[d0][e] << 16); q2 += x * x; }
    { auto rr = __builtin_amdgcn_permlane32_swap(__float_as_uint(q2), __float_as_uint(q2), false, false); q2 = __uint_as_float(rr[0]) + __uint_as_float(rr[1]); }
    const float mrow = sqrtf(q2) * kbound + badd;
    f32x16 negm;
#pragma unroll
    for (int r = 0; r < 16; ++r) negm[r] = -mrow;
    asm volatile("" : "+v"(negm));
    float l = 0.f; o[0] = f32x16{}; o[1] = f32x16{};
    const int tf = (qw - 64 - kb0) >> 6;
    const unsigned kbase = lds0 + L_AK + hi * 1024 + r32 * 16;
    const unsigned vbase = lds0 + L_AV + ((lane >> 4) & 1) * 32 + (lane & 3) * 8 + (4 * hi + ((lane & 15) >> 2)) * 64;
    const unsigned tbase = (unsigned)(uintptr_t)tab + 4u * (unsigned)(kb0 + 4 * hi - (qw + r32) + 158);
    FA_WAIT_BAR(0);
    { int t_lo = tf < 0 ? 0 : tf, t_hi = tf + 2 >= NT ? NT - 1 : tf + 2; if (!active) t_hi = t_lo - 1;
    for (int t = t_lo; t <= t_hi; ++t) {
        {
            const unsigned ka = kbase + (unsigned)(t + slot_off) * SLOTB, va = vbase + (unsigned)(t + slot_off) * SLOTB, ta = tbase + 256u * (unsigned)t;
            bf16x8 kf[8]; f32x2 tv0[8], tv1[8]; s16x4 vlo[8], vhi[8];
#define B3_KRD(j) asm volatile("ds_read_b128 %0, %2 offset:%c3\n\tds_read_b128 %1, %2 offset:%c4" : "=&v"(kf[2 * (j)]), "=&v"(kf[2 * (j) + 1]) : "v"(ka), "i"((j) * 2048), "i"((j) * 2048 + 512) : "memory")
#define B3_TR1(dst, off) asm volatile("ds_read2_b32 %0, %1 offset0:%c2 offset1:%c3" : "=&v"(dst) : "v"(ta), "i"(off), "i"((off) + 1) : "memory")
#define B3_TRD(j2) do { B3_TR1(tv0[j2], 8 * ((j2) >> 1) + 2 * ((j2) & 1)); B3_TR1(tv1[j2], 8 * ((j2) >> 1) + 2 * ((j2) & 1) + 32); } while (0)
#define B3_VRD(ii) asm volatile("ds_read_b64_tr_b16 %0, %2 offset:%c3\n\tds_read_b64_tr_b16 %1, %2 offset:%c4" : "=&v"(vlo[ii]), "=&v"(vhi[ii]) : "v"(va), "i"(((ii) >> 2) * 4096 + ((ii) & 3) * 1024), "i"(((ii) >> 2) * 4096 + ((ii) & 3) * 1024 + 512) : "memory")
            B3_KRD(0); B3_KRD(1); B3_KRD(2); B3_KRD(3);
            B3_TRD(0); B3_TRD(1); B3_TRD(2);
            asm volatile("s_waitcnt lgkmcnt(6)" : "+v"(kf[0]), "+v"(kf[1]), "+v"(kf[2]), "+v"(kf[3]), "+v"(kf[4]), "+v"(kf[5]), "+v"(kf[6]), "+v"(kf[7]));
            SBAR();
            f32x16 p0 = __builtin_amdgcn_mfma_f32_32x32x16_bf16(kf[0], qr[0], negm, 0, 0, 0), p1 = __builtin_amdgcn_mfma_f32_32x32x16_bf16(kf[1], qr[0], negm, 0, 0, 0);
#pragma unroll
            for (int d0 = 1; d0 < 4; ++d0) { p0 = __builtin_amdgcn_mfma_f32_32x32x16_bf16(kf[2 * d0], qr[d0], p0, 0, 0, 0); p1 = __builtin_amdgcn_mfma_f32_32x32x16_bf16(kf[2 * d0 + 1], qr[d0], p1, 0, 0, 0); }
            SBAR();
            asm volatile("s_waitcnt lgkmcnt(5)" ::: "memory");
            B3_TRD(3); B3_TRD(4); B3_TRD(5); B3_TRD(6); B3_TRD(7);
            asm volatile("s_waitcnt lgkmcnt(7)" ::: "memory");
            B3_VRD(0); B3_VRD(1); B3_VRD(2); B3_VRD(3);
            asm volatile("s_waitcnt lgkmcnt(8)" : "+v"(tv0[0]), "+v"(tv0[1]), "+v"(tv0[2]), "+v"(tv0[3]), "+v"(tv0[4]), "+v"(tv0[5]), "+v"(tv0[6]), "+v"(tv0[7]),
                                                  "+v"(tv1[0]), "+v"(tv1[1]), "+v"(tv1[2]), "+v"(tv1[3]), "+v"(tv1[4]), "+v"(tv1[5]), "+v"(tv1[6]), "+v"(tv1[7]));
            SBAR();
            float sacc = 0.f;
#pragma unroll
            for (int r = 0; r < 16; ++r) { const int j2 = (r >> 2) * 2 + ((r & 3) >> 1), e = r & 1;
                p0[r] = __builtin_amdgcn_exp2f(p0[r] + tv0[j2][e]); p1[r] = __builtin_amdgcn_exp2f(p1[r] + tv1[j2][e]); sacc += p0[r]; sacc += p1[r]; }
            l += sacc;
            const u32x4 pw0 = (u32x4){cvtpk_s(p0[0], p0[1]), cvtpk_s(p0[2], p0[3]), cvtpk_s(p0[4], p0[5]), cvtpk_s(p0[6], p0[7])};
            const u32x4 pw1 = (u32x4){cvtpk_s(p0[8], p0[9]), cvtpk_s(p0[10], p0[11]), cvtpk_s(p0[12], p0[13]), cvtpk_s(p0[14], p0[15])};
            const u32x4 pw2 = (u32x4){cvtpk_s(p1[0], p1[1]), cvtpk_s(p1[2], p1[3]), cvtpk_s(p1[4], p1[5]), cvtpk_s(p1[6], p1[7])};
            const u32x4 pw3 = (u32x4){cvtpk_s(p1[8], p1[9]), cvtpk_s(p1[10], p1[11]), cvtpk_s(p1[12], p1[13]), cvtpk_s(p1[14], p1[15])};
            SBAR();
            asm volatile("s_waitcnt lgkmcnt(0)" : "+v"(vlo[0]), "+v"(vlo[1]), "+v"(vlo[2]), "+v"(vlo[3]), "+v"(vhi[0]), "+v"(vhi[1]), "+v"(vhi[2]), "+v"(vhi[3]));
            B3_VRD(4); B3_VRD(5); B3_VRD(6); B3_VRD(7);
            SBAR();
#define B3_VF(ii) (bf16x8){vlo[ii][0], vlo[ii][1], vlo[ii][2], vlo[ii][3], vhi[ii][0], vhi[ii][1], vhi[ii][2], vhi[ii][3]}
            o[0] = __builtin_amdgcn_mfma_f32_32x32x16_bf16(__builtin_bit_cast(bf16x8, pw0), B3_VF(0), o[0], 0, 0, 0);
            o[0] = __builtin_amdgcn_mfma_f32_32x32x16_bf16(__builtin_bit_cast(bf16x8, pw1), B3_VF(1), o[0], 0, 0, 0);
            o[0] = __builtin_amdgcn_mfma_f32_32x32x16_bf16(__builtin_bit_cast(bf16x8, pw2), B3_VF(2), o[0], 0, 0, 0);
            o[0] = __builtin_amdgcn_mfma_f32_32x32x16_bf16(__builtin_bit_cast(bf16x8, pw3), B3_VF(3), o[0], 0, 0, 0);
            SBAR();
            asm volatile("s_waitcnt lgkmcnt(0)" : "+v"(vlo[4]), "+v"(vlo[5]), "+v"(vlo[6]), "+v"(vlo[7]), "+v"(vhi[4]), "+v"(vhi[5]), "+v"(vhi[6]), "+v"(vhi[7]));
            SBAR();
            o[1] = __builtin_amdgcn_mfma_f32_32x32x16_bf16(__builtin_bit_cast(bf16x8, pw0), B3_VF(4), o[1], 0, 0, 0);
            o[1] = __builtin_amdgcn_mfma_f32_32x32x16_bf16(__builtin_bit_cast(bf16x8, pw1), B3_VF(5), o[1], 0, 0, 0);
            o[1] = __builtin_amdgcn_mfma_f32_32x32x16_bf16(__builtin_bit_cast(bf16x8, pw2), B3_VF(6), o[1], 0, 0, 0);
            o[1] = __builtin_amdgcn_mfma_f32_32x32x16_bf16(__builtin_bit_cast(bf16x8, pw3), B3_VF(7), o[1], 0, 0, 0);
            SBAR();
#undef B3_TR1
#undef B3_KRD
#undef B3_TRD
#undef B3_VRD
#undef B3_VF
        }
    } }
    asm volatile("s_waitcnt lgkmcnt(0)\n\ts_barrier" ::: "memory");
    { auto rr = __builtin_amdgcn_permlane32_swap(__float_as_uint(l), __float_as_uint(l), false, false); l = __uint_as_float(rr[0]) + __uint_as_float(rr[1]); }
    if (hi == 0) wsf[32 + r32] = l;
    asm volatile("s_waitcnt lgkmcnt(0)" ::: "memory");
#pragma unroll
    for (int r = 0; r < 16; ++r) { const float rl = __builtin_amdgcn_rcpf(wsf[32 + crow(r, hi)]); o[0][r] *= rl; o[1][r] *= rl; }
    asm volatile("s_waitcnt lgkmcnt(0)" ::: "memory");
    mrow_out = mrow; l_out = l;
}
constexpr int L_DT = L_OST + 8 * SLOTB;
static_assert(L_DT + 15 * 128 * 4 <= L_WS, "D table");
template <class KV>
__device__ __forceinline__ void flash_core_d(LAS unsigned char* shm, const bf16_t* qptr, const KV& kv, int NT, int t_first, int t_last, int dr0, int c, float kbound, float badd,
                                             const float* rpb, f32x16 (&o)[2], const int tid) {
    const int lane = tid & 63, r32 = lane & 31, hi = lane >> 5; const int wid = __builtin_amdgcn_readfirstlane(tid >> 6);
    const unsigned lds0 = (unsigned)(uintptr_t)shm;
    LAS float* wsf = (LAS float*)(shm + L_WS) + wid * 64;
    const unsigned kdst = lds0 + L_K + wid * 1024, vdst = lds0 + L_V + wid * 1024;
    const int vrow_j = 16 * (wid & 3) + (lane >> 2), vcol = (wid >> 2) * 32 + (lane & 3) * 8;
    const unsigned koffv = (unsigned)(kv.rmul() * lane * INW + wid * 8) * 2u, voffv = (unsigned)(kv.rmul() * vrow_j * INW + vcol) * 2u;
#define FD_DMA(t, slot) do { glds16s(kv.tk(t), koffv, (unsigned)__builtin_amdgcn_readfirstlane(kdst + (slot) * SLOTB)); \
                             glds16s(kv.tv(t), voffv, (unsigned)__builtin_amdgcn_readfirstlane(vdst + (slot) * SLOTB)); } while (0)
    FD_DMA(0, 0); FD_DMA(1, 1);
    const float rv = (tid < 465) ? rpb[tid] : 0.f;
    bf16x8 qr[4];
#pragma unroll
    for (int d0 = 0; d0 < 4; ++d0) qr[d0] = *(const bf16x8*)(qptr + d0 * 16 + hi * 8);
    float q2 = 0.f;
#pragma unroll
    for (int d0 = 0; d0 < 4; ++d0)
#pragma unroll
        for (int e = 0; e < 8; ++e) { const float x = __builtin_bit_cast(float, (unsigned)(unsigned short)qr[d0][e] << 16); q2 += x * x; }
    { auto rr = __builtin_amdgcn_permlane32_swap(__float_as_uint(q2), __float_as_uint(q2), false, false); q2 = __uint_as_float(rr[0]) + __uint_as_float(rr[1]); }
    const float mrow = sqrtf(q2) * kbound + badd;
    { LAS float* raw = (LAS float*)(shm + L_TAB); LAS float* dt = (LAS float*)(shm + L_DT);
      if (tid < 465) raw[tid] = rv * 1.4426950408889634f;
      asm volatile("s_waitcnt lgkmcnt(0)\n\ts_barrier" ::: "memory");
#pragma unroll
      for (int j = 0; j < 4; ++j) { const int i = tid + 512 * j; if (i < 15 * 128) { const int dr = i >> 7, dc = (i & 127) - 64; dt[i] = (dc >= -15 && dc <= 15) ? raw[dr * 31 + dc + 15] : 0.f; } } }
    int cs = c - 8; if (cs < 0) cs = 0; if (cs > 48) cs = 48;
    f32x16 cm0, cm1;
#pragma unroll
    for (int r = 0; r < 16; ++r) { const int kc = (r & 3) + 8 * (r >> 2) + 4 * hi;
        cm0[r] = ((unsigned)(kc - cs) < 16u) ? -mrow : -INFINITY; cm1[r] = ((unsigned)(kc + 32 - cs) < 16u) ? -mrow : -INFINITY; }
    asm volatile("" : "+v"(cm0), "+v"(cm1));
    float l = 0.f; o[0] = f32x16{}; o[1] = f32x16{};
    const unsigned kbase = lds0 + L_K + hi * 1024 + r32 * 16;
    const unsigned vbase = lds0 + L_V + ((lane >> 4) & 1) * 32 + (lane & 3) * 8 + (4 * hi + ((lane & 15) >> 2)) * 64;
    const unsigned tbase = lds0 + L_DT + 4u * (unsigned)(64 - c + 4 * hi);
#define B3_KRD(j) asm volatile("ds_read_b128 %0, %2 offset:%c3\n\tds_read_b128 %1, %2 offset:%c4" : "=&v"(kf[2 * (j)]), "=&v"(kf[2 * (j) + 1]) : "v"(ka), "i"((j) * 2048), "i"((j) * 2048 + 512) : "memory")
#define B3_TR1(dst, off) asm volatile("ds_read2_b32 %0, %1 offset0:%c2 offset1:%c3" : "=&v"(dst) : "v"(ta), "i"(off), "i"((off) + 1) : "memory")
#define B3_T0(j2) B3_TR1(tv0[j2], 8 * ((j2) >> 1) + 2 * ((j2) & 1))
#define B3_T1(j2) B3_TR1(tv1[j2], 8 * ((j2) >> 1) + 2 * ((j2) & 1) + 32)
#define B3_VRD(ii) asm volatile("ds_read_b64_tr_b16 %0, %2 offset:%c3\n\tds_read_b64_tr_b16 %1, %2 offset:%c4" : "=&v"(vlo[ii]), "=&v"(vhi[ii]) : "v"(va), "i"(((ii) >> 2) * 4096 + ((ii) & 3) * 1024), "i"(((ii) >> 2) * 4096 + ((ii) & 3) * 1024 + 512) : "memory")
#define B3_VF(ii) (bf16x8){vlo[ii][0], vlo[ii][1], vlo[ii][2], vlo[ii][3], vhi[ii][0], vhi[ii][1], vhi[ii][2], vhi[ii][3]}
#define B3_PV(dd, pw, ii) o[dd] = __builtin_amdgcn_mfma_f32_32x32x16_bf16(__builtin_bit_cast(bf16x8, pw), B3_VF(ii), o[dd], 0, 0, 0)
#define D_TILE(LEFT) do { \
            const unsigned ka = kbase + (unsigned)slot * SLOTB, va = vbase + (unsigned)slot * SLOTB, ta = tbase + 512u * (unsigned)(dr0 + t); \
            bf16x8 kf[8]; f32x2 tv0[8], tv1[8]; s16x4 vlo[8], vhi[8]; \
            B3_KRD(0); B3_KRD(1); B3_KRD(2); B3_KRD(3);                                          \
            if (LEFT) { B3_T0(0); B3_T0(1); B3_T0(2); B3_T0(3); B3_T0(4); B3_T0(5); }            \
            else      { B3_T1(0); B3_T1(1); B3_T1(2); B3_T1(3); B3_T1(4); B3_T1(5); } \
            asm volatile("s_waitcnt lgkmcnt(6)" : "+v"(kf[0]), "+v"(kf[1]), "+v"(kf[2]), "+v"(kf[3]), "+v"(kf[4]), "+v"(kf[5]), "+v"(kf[6]), "+v"(kf[7])); \
            SBAR(); \
            f32x16 p0 = __builtin_amdgcn_mfma_f32_32x32x16_bf16(kf[0], qr[0], cm0, 0, 0, 0), p1 = __builtin_amdgcn_mfma_f32_32x32x16_bf16(kf[1], qr[0], cm1, 0, 0, 0); \
            _Pragma("unroll") for (int d0 = 1; d0 < 4; ++d0) { p0 = __builtin_amdgcn_mfma_f32_32x32x16_bf16(kf[2 * d0], qr[d0], p0, 0, 0, 0); p1 = __builtin_amdgcn_mfma_f32_32x32x16_bf16(kf[2 * d0 + 1], qr[d0], p1, 0, 0, 0); } \
            SBAR(); \
            asm volatile("s_waitcnt lgkmcnt(5)" ::: "memory");                                    \
            if (LEFT) { B3_T0(6); B3_T0(7); B3_T1(0); B3_T1(1); B3_VRD(0); B3_VRD(1); B3_VRD(2); }     \
            else      { B3_T1(6); B3_T1(7); B3_T0(6); B3_T0(7); B3_VRD(1); B3_VRD(2); B3_VRD(3); } \
            if (LEFT) asm volatile("s_waitcnt lgkmcnt(6)" : "+v"(tv0[0]), "+v"(tv0[1]), "+v"(tv0[2]), "+v"(tv0[3]), "+v"(tv0[4]), "+v"(tv0[5]), "+v"(tv0[6]), "+v"(tv0[7]), "+v"(tv1[0]), "+v"(tv1[1])); \
            else      asm volatile("s_waitcnt lgkmcnt(6)" : "+v"(tv1[0]), "+v"(tv1[1]), "+v"(tv1[2]), "+v"(tv1[3]), "+v"(tv1[4]), "+v"(tv1[5]), "+v"(tv1[6]), "+v"(tv1[7]), "+v"(tv0[6]), "+v"(tv0[7])); \
            SBAR(); \
            float sacc = 0.f; u32x4 pw0, pw1, pw2, pw3; \
            if (LEFT) { \
                _Pragma("unroll") for (int r = 0; r < 16; ++r) { const int j2 = (r >> 2) * 2 + ((r & 3) >> 1), e = r & 1; p0[r] = __builtin_amdgcn_exp2f(p0[r] + tv0[j2][e]); sacc += p0[r]; } \
                _Pragma("unroll") for (int r = 0; r < 4; ++r) { const int j2 = (r & 3) >> 1, e = r & 1; p1[r] = __builtin_amdgcn_exp2f(p1[r] + tv1[j2][e]); sacc += p1[r]; } \
                pw0 = (u32x4){cvtpk_s(p0[0], p0[1]), cvtpk_s(p0[2], p0[3]), cvtpk_s(p0[4], p0[5]), cvtpk_s(p0[6], p0[7])}; \
                pw1 = (u32x4){cvtpk_s(p0[8], p0[9]), cvtpk_s(p0[10], p0[11]), cvtpk_s(p0[12], p0[13]), cvtpk_s(p0[14], p0[15])}; \
                pw2 = (u32x4){cvtpk_s(p1[0], p1[1]), cvtpk_s(p1[2], p1[3]), 0u, 0u}; pw3 = pw2; \
            } else { \
                _Pragma("unroll") for (int r = 0; r < 16; ++r) { const int j2 = (r >> 2) * 2 + ((r & 3) >> 1), e = r & 1; p1[r] = __builtin_amdgcn_exp2f(p1[r] + tv1[j2][e]); sacc += p1[r]; } \
                _Pragma("unroll") for (int r = 12; r < 16; ++r) { const int j2 = 6 + ((r & 3) >> 1), e = r & 1; p0[r] = __builtin_amdgcn_exp2f(p0[r] + tv0[j2][e]); sacc += p0[r]; } \
                pw1 = (u32x4){0u, 0u, cvtpk_s(p0[12], p0[13]), cvtpk_s(p0[14], p0[15])}; pw0 = pw1; \
                pw2 = (u32x4){cvtpk_s(p1[0], p1[1]), cvtpk_s(p1[2], p1[3]), cvtpk_s(p1[4], p1[5]), cvtpk_s(p1[6], p1[7])}; \
                pw3 = (u32x4){cvtpk_s(p1[8], p1[9]), cvtpk_s(p1[10], p1[11]), cvtpk_s(p1[12], p1[13]), cvtpk_s(p1[14], p1[15])}; \
            } \
            l += sacc; \
            SBAR(); \
            if (LEFT) { asm volatile("s_waitcnt lgkmcnt(0)" : "+v"(vlo[0]), "+v"(vlo[1]), "+v"(vlo[2]), "+v"(vhi[0]), "+v"(vhi[1]), "+v"(vhi[2])); \
                        B3_VRD(4); B3_VRD(5); B3_VRD(6); SBAR(); \
                        B3_PV(0, pw0, 0); B3_PV(0, pw1, 1); B3_PV(0, pw2, 2); SBAR(); \
                        asm volatile("s_waitcnt lgkmcnt(0)" : "+v"(vlo[4]), "+v"(vlo[5]), "+v"(vlo[6]), "+v"(vhi[4]), "+v"(vhi[5]), "+v"(vhi[6])); SBAR(); \
                        B3_PV(1, pw0, 4); B3_PV(1, pw1, 5); B3_PV(1, pw2, 6); SBAR(); } \
            else      { asm volatile("s_waitcnt lgkmcnt(0)" : "+v"(vlo[1]), "+v"(vlo[2]), "+v"(vlo[3]), "+v"(vhi[1]), "+v"(vhi[2]), "+v"(vhi[3])); \
                        B3_VRD(5); B3_VRD(6); B3_VRD(7); SBAR(); \
                        B3_PV(0, pw1, 1); B3_PV(0, pw2, 2); B3_PV(0, pw3, 3); SBAR(); \
                        asm volatile("s_waitcnt lgkmcnt(0)" : "+v"(vlo[5]), "+v"(vlo[6]), "+v"(vlo[7]), "+v"(vhi[5]), "+v"(vhi[6]), "+v"(vhi[7])); SBAR(); \
                        B3_PV(1, pw1, 5); B3_PV(1, pw2, 6); B3_PV(1, pw3, 7); SBAR(); } \
        } while (0)
#define D_LOOP(LEFT) do { int slot = 0; \
    for (int t = 0; t < NT; ++t) { \
        if (t + 1 < NT) asm volatile("s_waitcnt vmcnt(2) lgkmcnt(0)\n\ts_barrier" ::: "memory"); else asm volatile("s_waitcnt vmcnt(0) lgkmcnt(0)\n\ts_barrier" ::: "memory"); \
          \
        if (t + 2 < NT) { const int s2 = slot == 0 ? 2 : slot - 1; FD_DMA(t + 2, s2); } \
        if (t >= t_first && t <= t_last) D_TILE(LEFT);             \
        slot = slot == 2 ? 0 : slot + 1; } } while (0)
    if ((wid & 1) == 0) D_LOOP(1); else D_LOOP(0);
#undef D_LOOP
#undef D_TILE
#undef B3_TR1
#undef B3_T0
#undef B3_T1
#undef B3_KRD
#undef B3_VRD
#undef B3_VF
#undef B3_PV
#undef FD_DMA
    asm volatile("s_waitcnt lgkmcnt(0)\n\ts_barrier" ::: "memory");
    { auto rr = __builtin_amdgcn_permlane32_swap(__float_as_uint(l), __float_as_uint(l), false, false); l = __uint_as_float(rr[0]) + __uint_as_float(rr[1]); }
    if (hi == 0) wsf[32 + r32] = l;
    asm volatile("s_waitcnt lgkmcnt(0)" ::: "memory");
#pragma unroll
    for (int r = 0; r < 16; ++r) { const float rl = __builtin_amdgcn_rcpf(wsf[32 + crow(r, hi)]); o[0][r] *= rl; o[1][r] *= rl; }
    asm volatile("s_waitcnt lgkmcnt(0)" ::: "memory");
}
template <class KV, class Hook>
__device__ __forceinline__ void flash_core_dual(LAS unsigned char* shm, const bf16_t* qptr, const KV& kv, int NT, const Hook& hk, f32x16 (&o1)[2], f32x16 (&o2)[2], const int tid) {
    const int lane = tid & 63, r32 = lane & 31, hi = lane >> 5; const int wid = __builtin_amdgcn_readfirstlane(tid >> 6);
    const unsigned lds0 = (unsigned)(uintptr_t)shm;
    LAS float* wsf = (LAS float*)(shm + L_WS) + wid * 64;
    const unsigned kdst = lds0 + L_K + wid * 1024, vdst = lds0 + L_V + wid * 1024;
    const int vrow_j = 16 * (wid & 3) + (lane >> 2), vcol = (wid >> 2) * 32 + (lane & 3) * 8;
#define FA_DMA(t, slot) do { glds16(kv.kptr((t), lane) + wid * 8, (unsigned)__builtin_amdgcn_readfirstlane(kdst + (slot) * SLOTB)); \
                             glds16(kv.vptr((t), vrow_j) + vcol, (unsigned)__builtin_amdgcn_readfirstlane(vdst + (slot) * SLOTB)); } while (0)
    FA_DMA(0, 0);
    bf16x8 qr[4];
#pragma unroll
    for (int d0 = 0; d0 < 4; ++d0) qr[d0] = *(const bf16x8*)(qptr + d0 * 16 + hi * 8);
    asm volatile("" : "+v"(qr[0]), "+v"(qr[1]), "+v"(qr[2]), "+v"(qr[3]));
    float mA = 0.f, lA = 0.f, mB = 0.f, lB = 0.f, curb = 0.f;
    o1[0] = f32x16{}; o1[1] = f32x16{}; o2[0] = f32x16{}; o2[1] = f32x16{}; const f32x16 zero16 = f32x16{};
    bool first = true;
    const int vb0 = (int)(lds0 + L_V) + ((lane >> 4) & 1) * 32 + (lane & 3) * 8 + (4 * hi + ((lane & 15) >> 2)) * 64;
#define FA_MAP(MAP, mh, ll, neg, oo, PW0, PW1, PW2, PW3) do { \
        f32x16 p0, p1; \
        { LAS const unsigned char* kb = shm + L_K + slot * SLOTB + (MAP) * 4096 + hi * 1024 + r32 * 16; \
          const bf16x8 b0 = *(LAS const bf16x8*)(kb), b1 = *(LAS const bf16x8*)(kb + 512), b2 = *(LAS const bf16x8*)(kb + 2048), b3 = *(LAS const bf16x8*)(kb + 2048 + 512); \
          p0 = __builtin_amdgcn_mfma_f32_32x32x16_bf16(b0, qr[2 * (MAP)], zero16, 0, 0, 0); p1 = __builtin_amdgcn_mfma_f32_32x32x16_bf16(b1, qr[2 * (MAP)], zero16, 0, 0, 0); \
          p0 = __builtin_amdgcn_mfma_f32_32x32x16_bf16(b2, qr[2 * (MAP) + 1], p0, 0, 0, 0); p1 = __builtin_amdgcn_mfma_f32_32x32x16_bf16(b3, qr[2 * (MAP) + 1], p1, 0, 0, 0); } \
        hk.apply(p0, p1, t); \
        const float rm = rowmax(p0, p1) + curb - mh; \
        if (first) { mh += rm; \
        } else if (__any(rm > THR)) { const float dl = __builtin_fmaxf(rm, 0.f); mh += dl; \
            const float f = __builtin_amdgcn_exp2f(-dl); ll *= f; if (hi == 0) wsf[r32] = f; \
            asm volatile("s_waitcnt lgkmcnt(0)" ::: "memory"); \
            _Pragma("unroll") for (int r = 0; r < 16; ++r) { const float fr_ = wsf[crow(r, hi)]; oo[0][r] *= fr_; oo[1][r] *= fr_; } \
            asm volatile("s_waitcnt lgkmcnt(0)" ::: "memory"); } \
        float sacc = 0.f, sacc2 = 0.f; const float mref_ = mh - curb; \
        _Pragma("unroll") for (int r = 0; r < 16; ++r) { p0[r] = __builtin_amdgcn_exp2f(p0[r] - mref_); p1[r] = __builtin_amdgcn_exp2f(p1[r] - mref_); sacc += p0[r]; sacc2 += p1[r]; } \
        ll += sacc + sacc2; \
        PW0 = (u32x4){cvtpk_s(p0[0], p0[1]), cvtpk_s(p0[2], p0[3]), cvtpk_s(p0[4], p0[5]), cvtpk_s(p0[6], p0[7])}; \
        PW1 = (u32x4){cvtpk_s(p0[8], p0[9]), cvtpk_s(p0[10], p0[11]), cvtpk_s(p0[12], p0[13]), cvtpk_s(p0[14], p0[15])}; \
        PW2 = (u32x4){cvtpk_s(p1[0], p1[1]), cvtpk_s(p1[2], p1[3]), cvtpk_s(p1[4], p1[5]), cvtpk_s(p1[6], p1[7])}; \
        PW3 = (u32x4){cvtpk_s(p1[8], p1[9]), cvtpk_s(p1[10], p1[11]), cvtpk_s(p1[12], p1[13]), cvtpk_s(p1[14], p1[15])}; \
    } while (0)
    for (int t = 0; t < NT; ++t) {
        const int slot = t & 1;
        if (t + 1 < NT) { FA_DMA(t + 1, slot ^ 1); FA_WAIT_BAR(2); } else { FA_WAIT_BAR(0); }
        curb = hk.cbias(t);
        u32x4 a0, a1, a2, a3, b0_, b1_, b2_, b3_;
        FA_MAP(0, mA, lA, zero16, o1, a0, a1, a2, a3);
        SBAR();
        FA_MAP(1, mB, lB, zero16, o2, b0_, b1_, b2_, b3_);
        first = false;
        SBAR();
        { const int vb = vb0 + slot * SLOTB;
#pragma unroll
          for (int d0 = 0; d0 < 2; ++d0) { s16x4 lo[4], hi_[4];
#pragma unroll
              for (int ks = 0; ks < 4; ++ks) {
                  asm volatile("ds_read_b64_tr_b16 %0,%1 offset:%c2" : "=&v"(lo[ks]) : "v"(vb), "i"(d0 * 4096 + ks * 1024) : "memory");
                  asm volatile("ds_read_b64_tr_b16 %0,%1 offset:%c2" : "=&v"(hi_[ks]) : "v"(vb), "i"(d0 * 4096 + ks * 1024 + 512) : "memory"); }
              asm volatile("s_waitcnt lgkmcnt(0)" ::: "memory"); SBAR();
#define FA_PK(k) (bf16x8){lo[k][0], lo[k][1], lo[k][2], lo[k][3], hi_[k][0], hi_[k][1], hi_[k][2], hi_[k][3]}
              o1[d0] = __builtin_amdgcn_mfma_f32_32x32x16_bf16(__builtin_bit_cast(bf16x8, a0), FA_PK(0), o1[d0], 0, 0, 0);
              o2[d0] = __builtin_amdgcn_mfma_f32_32x32x16_bf16(__builtin_bit_cast(bf16x8, b0_), FA_PK(0), o2[d0], 0, 0, 0);
              o1[d0] = __builtin_amdgcn_mfma_f32_32x32x16_bf16(__builtin_bit_cast(bf16x8, a1), FA_PK(1), o1[d0], 0, 0, 0);
              o2[d0] = __builtin_amdgcn_mfma_f32_32x32x16_bf16(__builtin_bit_cast(bf16x8, b1_), FA_PK(1), o2[d0], 0, 0, 0);
              o1[d0] = __builtin_amdgcn_mfma_f32_32x32x16_bf16(__builtin_bit_cast(bf16x8, a2), FA_PK(2), o1[d0], 0, 0, 0);
              o2[d0] = __builtin_amdgcn_mfma_f32_32x32x16_bf16(__builtin_bit_cast(bf16x8, b2_), FA_PK(2), o2[d0], 0, 0, 0);
              o1[d0] = __builtin_amdgcn_mfma_f32_32x32x16_bf16(__builtin_bit_cast(bf16x8, a3), FA_PK(3), o1[d0], 0, 0, 0);
              o2[d0] = __builtin_amdgcn_mfma_f32_32x32x16_bf16(__builtin_bit_cast(bf16x8, b3_), FA_PK(3), o2[d0], 0, 0, 0);
#undef FA_PK
          } }
        asm volatile("s_waitcnt lgkmcnt(0)\n\ts_barrier" ::: "memory");
    }
#undef FA_DMA
#undef FA_MAP
    { auto rr = __builtin_amdgcn_permlane32_swap(__float_as_uint(lA), __float_as_uint(lA), false, false); lA = __uint_as_float(rr[0]) + __uint_as_float(rr[1]); }
    { auto rr = __builtin_amdgcn_permlane32_swap(__float_as_uint(lB), __float_as_uint(lB), false, false); lB = __uint_as_float(rr[0]) + __uint_as_float(rr[1]); }
    if (hi == 0) { wsf[r32] = lA; wsf[32 + r32] = lB; }
    asm volatile("s_waitcnt lgkmcnt(0)" ::: "memory");
#pragma unroll
    for (int r = 0; r < 16; ++r) { const float ra = __builtin_amdgcn_rcpf(wsf[crow(r, hi)]), rb = __builtin_amdgcn_rcpf(wsf[32 + crow(r, hi)]); o1[0][r] *= ra; o1[1][r] *= ra; o2[0][r] *= rb; o2[1][r] *= rb; }
}
template <class KV, class Hook>
__device__ __forceinline__ void flash_core_dual_sp(LAS unsigned char* shm, const bf16_t* qptr, const KV& kv, int NT, const Hook& hk, f32x16 (&o1)[2], f32x16 (&o2)[2], const int tid) {
    const int lane = tid & 63, r32 = lane & 31, hi = lane >> 5; const int wid = __builtin_amdgcn_readfirstlane(tid >> 6);
    const unsigned lds0 = (unsigned)(uintptr_t)shm;
    LAS float* wsf = (LAS float*)(shm + L_WS) + wid * 64;
    const unsigned kdst = lds0 + L_K + wid * 1024, vdst = lds0 + L_V + wid * 1024;
    const int vrow_j = 16 * (wid & 3) + (lane >> 2), vcol = (wid >> 2) * 32 + (lane & 3) * 8;
#define FA_DMAK(t) glds16(kv.kptr((t), lane) + wid * 8, (unsigned)__builtin_amdgcn_readfirstlane(kdst + ((t) & 1) * SLOTB))
#define FA_DMAV(t) glds16(kv.vptr((t), vrow_j) + vcol, (unsigned)__builtin_amdgcn_readfirstlane(vdst + ((t) & 1) * SLOTB))
    FA_DMAK(0); FA_DMAV(0); if (NT > 1) FA_DMAK(1);
    bf16x8 qr[4];
#pragma unroll
    for (int d0 = 0; d0 < 4; ++d0) qr[d0] = *(const bf16x8*)(qptr + d0 * 16 + hi * 8);
    asm volatile("" : "+v"(qr[0]), "+v"(qr[1]), "+v"(qr[2]), "+v"(qr[3]));
    LAS bf16x8* qst = (LAS bf16x8*)(shm + L_QST) + wid * 256 + lane;
    qst[0] = qr[0]; qst[64] = qr[1]; qst[128] = qr[2]; qst[192] = qr[3];
    float mA = 0.f, lA = 0.f, mB = 0.f, lB = 0.f;
    o1[0] = f32x16{}; o1[1] = f32x16{}; o2[0] = f32x16{}; o2[1] = f32x16{}; const f32x16 zero16 = f32x16{};
    const int vb0 = (int)(lds0 + L_V) + ((lane >> 4) & 1) * 32 + (lane & 3) * 8 + (4 * hi + ((lane & 15) >> 2)) * 64;
    bf16x8 kfA[4], kfB[4]; f32x16 pA0, pA1, pB0, pB1;
#define FA_KLOADA(tt) do { LAS const unsigned char* kb_ = shm + L_K + ((tt) & 1) * SLOTB + hi * 1024 + r32 * 16; \
        kfA[0] = *(LAS const bf16x8*)(kb_); kfA[1] = *(LAS const bf16x8*)(kb_ + 512); kfA[2] = *(LAS const bf16x8*)(kb_ + 2048); kfA[3] = *(LAS const bf16x8*)(kb_ + 2560); } while (0)
#define FA_KLOADB(tt) do { LAS const unsigned char* kb_ = shm + L_K + ((tt) & 1) * SLOTB + hi * 1024 + r32 * 16; \
        kfB[0] = *(LAS const bf16x8*)(kb_ + 4096); kfB[1] = *(LAS const bf16x8*)(kb_ + 4608); kfB[2] = *(LAS const bf16x8*)(kb_ + 6144); kfB[3] = *(LAS const bf16x8*)(kb_ + 6656); } while (0)
#define FA_QKA() do { const bf16x8 q0_ = qst[0], q1_ = qst[64]; pA0 = __builtin_amdgcn_mfma_f32_32x32x16_bf16(kfA[0], q0_, zero16, 0, 0, 0); pA1 = __builtin_amdgcn_mfma_f32_32x32x16_bf16(kfA[1], q0_, zero16, 0, 0, 0); \
        pA0 = __builtin_amdgcn_mfma_f32_32x32x16_bf16(kfA[2], q1_, pA0, 0, 0, 0); pA1 = __builtin_amdgcn_mfma_f32_32x32x16_bf16(kfA[3], q1_, pA1, 0, 0, 0); } while (0)
#define FA_QKB() do { const bf16x8 q2_ = qst[128], q3_ = qst[192]; pB0 = __builtin_amdgcn_mfma_f32_32x32x16_bf16(kfB[0], q2_, zero16, 0, 0, 0); pB1 = __builtin_amdgcn_mfma_f32_32x32x16_bf16(kfB[1], q2_, zero16, 0, 0, 0); \
        pB0 = __builtin_amdgcn_mfma_f32_32x32x16_bf16(kfB[2], q3_, pB0, 0, 0, 0); pB1 = __builtin_amdgcn_mfma_f32_32x32x16_bf16(kfB[3], q3_, pB1, 0, 0, 0); } while (0)
#define FA_SM(p0, p1, mh, ll, oo, PW0, PW1, PW2, PW3) do { \
        hk.apply(p0, p1, t); \
        const float rm = rowmax(p0, p1) + curb - mh; \
        if (__any(rm > THR)) { const float dl = __builtin_fmaxf(rm, 0.f); mh += dl; \
            const float f = __builtin_amdgcn_exp2f(-dl); ll *= f; if (hi == 0) wsf[r32] = f; \
            asm volatile("s_waitcnt lgkmcnt(0)" ::: "memory"); \
            _Pragma("unroll") for (int r = 0; r < 16; ++r) { const float fr_ = wsf[crow(r, hi)]; oo[0][r] *= fr_; oo[1][r] *= fr_; } \
            asm volatile("s_waitcnt lgkmcnt(0)" ::: "memory"); } \
        float sacc = 0.f, sacc2 = 0.f; const float mref_ = mh - curb; \
        _Pragma("unroll") for (int r = 0; r < 16; ++r) { p0[r] = __builtin_amdgcn_exp2f(p0[r] - mref_); p1[r] = __builtin_amdgcn_exp2f(p1[r] - mref_); sacc += p0[r]; sacc2 += p1[r]; } \
        ll += sacc + sacc2; \
        PW0 = (u32x4){cvtpk_s(p0[0], p0[1]), cvtpk_s(p0[2], p0[3]), cvtpk_s(p0[4], p0[5]), cvtpk_s(p0[6], p0[7])}; \
        PW1 = (u32x4){cvtpk_s(p0[8], p0[9]), cvtpk_s(p0[10], p0[11]), cvtpk_s(p0[12], p0[13]), cvtpk_s(p0[14], p0[15])}; \
        PW2 = (u32x4){cvtpk_s(p1[0], p1[1]), cvtpk_s(p1[2], p1[3]), cvtpk_s(p1[4], p1[5]), cvtpk_s(p1[6], p1[7])}; \
        PW3 = (u32x4){cvtpk_s(p1[8], p1[9]), cvtpk_s(p1[10], p1[11]), cvtpk_s(p1[12], p1[13]), cvtpk_s(p1[14], p1[15])}; \
    } while (0)
    FA_WAIT_BAR(0);
    FA_KLOADA(0); FA_KLOADB(0);
    FA_QKB();
    { const float cb0 = hk.cbias(0); mB = rowmax(pB0, pB1) + cb0; FA_QKA(); mA = rowmax(pA0, pA1) + cb0; }
#define FA_VTR(off) __builtin_bit_cast(s16x4, __builtin_amdgcn_ds_read_tr16_b64_v4i16((LAS v4i16_t*)(vp_ + (off))))
#define FA_PVM(oo, w0, w1, w2, w3) do { LAS const unsigned char* vp_ = shm + L_V + (t & 1) * SLOTB + vboff; \
        _Pragma("unroll") for (int d0 = 0; d0 < 2; ++d0) { s16x4 lo[4], hi_[4]; \
            _Pragma("unroll") for (int ks = 0; ks < 4; ++ks) { lo[ks] = FA_VTR(d0 * 4096 + ks * 1024); hi_[ks] = FA_VTR(d0 * 4096 + ks * 1024 + 512); } \
            oo[d0] = __builtin_amdgcn_mfma_f32_32x32x16_bf16(__builtin_bit_cast(bf16x8, w0), (bf16x8){lo[0][0], lo[0][1], lo[0][2], lo[0][3], hi_[0][0], hi_[0][1], hi_[0][2], hi_[0][3]}, oo[d0], 0, 0, 0); \
            oo[d0] = __builtin_amdgcn_mfma_f32_32x32x16_bf16(__builtin_bit_cast(bf16x8, w1), (bf16x8){lo[1][0], lo[1][1], lo[1][2], lo[1][3], hi_[1][0], hi_[1][1], hi_[1][2], hi_[1][3]}, oo[d0], 0, 0, 0); \
            oo[d0] = __builtin_amdgcn_mfma_f32_32x32x16_bf16(__builtin_bit_cast(bf16x8, w2), (bf16x8){lo[2][0], lo[2][1], lo[2][2], lo[2][3], hi_[2][0], hi_[2][1], hi_[2][2], hi_[2][3]}, oo[d0], 0, 0, 0); \
            oo[d0] = __builtin_amdgcn_mfma_f32_32x32x16_bf16(__builtin_bit_cast(bf16x8, w3), (bf16x8){lo[3][0], lo[3][1], lo[3][2], lo[3][3], hi_[3][0], hi_[3][1], hi_[3][2], hi_[3][3]}, oo[d0], 0, 0, 0); } } while (0)
    const int vboff = ((lane >> 4) & 1) * 32 + (lane & 3) * 8 + (4 * hi + ((lane & 15) >> 2)) * 64;
    for (int t = 0; t < NT; ++t) {
        if (t + 2 < NT) FA_DMAK(t + 2);
        if (t + 1 < NT) FA_DMAV(t + 1);
        const float curb = hk.cbias(t);
        FA_QKB();
        SBAR();
        if (t + 1 < NT) { FA_KLOADA(t + 1); FA_KLOADB(t + 1); }
        { u32x4 a0, a1, a2, a3;
          FA_SM(pA0, pA1, mA, lA, o1, a0, a1, a2, a3);
          SBAR();
          FA_PVM(o1, a0, a1, a2, a3); }
        SBAR();
        { u32x4 b0_, b1_, b2_, b3_;
          FA_SM(pB0, pB1, mB, lB, o2, b0_, b1_, b2_, b3_);
          SBAR();
          if (t + 1 < NT) FA_QKA();
          SBAR();
          FA_PVM(o2, b0_, b1_, b2_, b3_); }
        FA_WAIT_BAR(0);
    }
#undef FA_PVM
#undef FA_VTR
#undef FA_DMAK
#undef FA_DMAV
#undef FA_KLOADA
#undef FA_KLOADB
#undef FA_QKA
#undef FA_QKB
#undef FA_SM
    { auto rr = __builtin_amdgcn_permlane32_swap(__float_as_uint(lA), __float_as_uint(lA), false, false); lA = __uint_as_float(rr[0]) + __uint_as_float(rr[1]); }
    { auto rr = __builtin_amdgcn_permlane32_swap(__float_as_uint(lB), __float_as_uint(lB), false, false); lB = __uint_as_float(rr[0]) + __uint_as_float(rr[1]); }
    if (hi == 0) { wsf[r32] = lA; wsf[32 + r32] = lB; }
    asm volatile("s_waitcnt lgkmcnt(0)" ::: "memory");
#pragma unroll
    for (int r = 0; r < 16; ++r) { const float ra = __builtin_amdgcn_rcpf(wsf[crow(r, hi)]), rb = __builtin_amdgcn_rcpf(wsf[32 + crow(r, hi)]); o1[0][r] *= ra; o1[1][r] *= ra; o2[0][r] *= rb; o2[1][r] *= rb; }
}
__device__ __forceinline__ void stage_o(LAS float* stg, const f32x16 (&o)[2], int r32, int hi) {
#pragma unroll
    for (int r = 0; r < 16; ++r) { const int orow = crow(r, hi); stg[orow * 64 + r32] = o[0][r]; stg[orow * 64 + 32 + r32] = o[1][r]; }
    asm volatile("s_waitcnt lgkmcnt(0)" ::: "memory");
}
__device__ __forceinline__ float silu(float g) { return g * __builtin_amdgcn_rcpf(1.f + __builtin_amdgcn_exp2f(-1.4426950408889634f * g)); }
}

#undef SBAR
namespace tb {
using bf16=unsigned short;
constexpr int D=64,DM=INW;
constexpr int NW=8,QBLK=32,QB=QBLK*NW,KVBLK=64;
__device__ __forceinline__ int crow(int r,int hi){return (r&3)+8*(r>>2)+4*hi;}
#define SBAR() __builtin_amdgcn_sched_barrier(0)
constexpr int NSLOT=3, SLOTB=8192;
constexpr int LDS_K=0, LDS_V=NSLOT*SLOTB, LDS_WS=2*NSLOT*SLOTB, LDS_OST=LDS_WS+NW*64*4, LDS_BYTES=LDS_OST+NW*4096;
constexpr float C2=0.125f*1.4426950408889634f;
__device__ __forceinline__ void glds16(const void*gsrc,unsigned lds_dst){unsigned keep;
  asm volatile("s_mov_b32 %0, m0\n\ts_mov_b32 m0, %2\n\ts_nop 0\n\tglobal_load_lds_dwordx4 %1, off\n\ts_mov_b32 m0, %0":"=&s"(keep):"v"(gsrc),"s"(lds_dst):"memory");}
__device__ __forceinline__ void glds16s(const void*sbase,unsigned voff,unsigned lds_dst){
  asm volatile("s_mov_b32 m0, %2\n\ts_nop 0\n\tglobal_load_lds_dwordx4 %0, %1"::"v"(voff),"s"(sbase),"s"(lds_dst):"memory");}
__device__ __forceinline__ float max3f(float a,float b,float c){float r;asm("v_max3_f32 %0, %1, %2, %3":"=v"(r):"v"(a),"v"(b),"v"(c));return r;}
__device__ __forceinline__ float max2f(float a,float b){float r;asm("v_max_f32_e32 %0, %1, %2":"=v"(r):"v"(a),"v"(b));return r;}
__device__ __forceinline__ float fadd_s(float a,float b){float r;asm("v_add_f32_e32 %0, %1, %2":"=v"(r):"v"(a),"v"(b));return r;}
__device__ __forceinline__ float fsub_s(float a,float b){float r;asm("v_sub_f32_e32 %0, %1, %2":"=v"(r):"v"(a),"v"(b));return r;}
typedef float f32x2_t __attribute__((ext_vector_type(2))); typedef __bf16 bf16x2_t __attribute__((ext_vector_type(2)));
__device__ __forceinline__ unsigned cvtpk_s(float lo,float hi){f32x2_t v={lo,hi};bf16x2_t b=__builtin_convertvector(v,bf16x2_t);return __builtin_bit_cast(unsigned,b);}
#define LGKM_IMM(N) (0xC07F|((N)<<8))
#define WAIT_BAR(N) do{ asm volatile("s_waitcnt vmcnt(" #N ")":::"memory"); __builtin_amdgcn_s_waitcnt(LGKM_IMM(0)); __builtin_amdgcn_s_barrier(); asm volatile("":::"memory"); }while(0)

__device__ __forceinline__ void qkt(f32x16&p0,f32x16&p1,const char*Kslot,const bf16x8*qr,const f32x16&negm,int r32,int hi){
  const char*kb=Kslot+hi*1024+r32*16;
  #pragma unroll
  for(int d0=0;d0<4;++d0){
    const bf16x8 b0=*reinterpret_cast<const bf16x8*>(kb+d0*2048);
    const bf16x8 b1=*reinterpret_cast<const bf16x8*>(kb+d0*2048+512);
    if(d0==0){p0=__builtin_amdgcn_mfma_f32_32x32x16_bf16(b0,qr[0],negm,0,0,0);p1=__builtin_amdgcn_mfma_f32_32x32x16_bf16(b1,qr[0],negm,0,0,0);}
    else{p0=__builtin_amdgcn_mfma_f32_32x32x16_bf16(b0,qr[d0],p0,0,0,0);p1=__builtin_amdgcn_mfma_f32_32x32x16_bf16(b1,qr[d0],p1,0,0,0);}}
}
typedef __attribute__((address_space(3))) const char* lds_cptr;
__device__ __forceinline__ void kload8(bf16x8*kf,lds_cptr kp){
  kf[0]=*(const __attribute__((address_space(3))) bf16x8*)(kp);      kf[1]=*(const __attribute__((address_space(3))) bf16x8*)(kp+512);
  kf[2]=*(const __attribute__((address_space(3))) bf16x8*)(kp+2048); kf[3]=*(const __attribute__((address_space(3))) bf16x8*)(kp+2560);
  kf[4]=*(const __attribute__((address_space(3))) bf16x8*)(kp+4096); kf[5]=*(const __attribute__((address_space(3))) bf16x8*)(kp+4608);
  kf[6]=*(const __attribute__((address_space(3))) bf16x8*)(kp+6144); kf[7]=*(const __attribute__((address_space(3))) bf16x8*)(kp+6656);
}
__device__ __forceinline__ void kload4(bf16x8*kf,lds_cptr kp){
  kf[0]=*(const __attribute__((address_space(3))) bf16x8*)(kp);      kf[1]=*(const __attribute__((address_space(3))) bf16x8*)(kp+512);
  kf[2]=*(const __attribute__((address_space(3))) bf16x8*)(kp+2048); kf[3]=*(const __attribute__((address_space(3))) bf16x8*)(kp+2560);
}
__device__ __forceinline__ void kload2(bf16x8*kf,lds_cptr kp,int j){ kf[2*j]=*(const __attribute__((address_space(3))) bf16x8*)(kp+j*2048); kf[2*j+1]=*(const __attribute__((address_space(3))) bf16x8*)(kp+j*2048+512); }
__device__ __forceinline__ s16x4 vtr(lds_cptr p){ return __builtin_bit_cast(s16x4,__builtin_amdgcn_ds_read_tr16_b64_v4i16((__attribute__((address_space(3))) v4i16_t*)p)); }
__device__ __forceinline__ float rowmax(const f32x16&p0,const f32x16&p1){
  float a=max3f(p0[0],p0[1],p1[0]),b=max3f(p0[2],p0[3],p1[1]);a=max3f(a,p1[2],p1[3]);
  #pragma unroll
  for(int r=4;r<16;r+=4){a=max3f(a,p0[r],p0[r+1]);b=max3f(b,p0[r+2],p0[r+3]);a=max3f(a,p1[r],p1[r+1]);b=max3f(b,p1[r+2],p1[r+3]);}
  const float m=max2f(a,b);
  auto rr=__builtin_amdgcn_permlane32_swap(__float_as_uint(m),__float_as_uint(m),false,false);
  return max2f(__uint_as_float(rr[0]),__uint_as_float(rr[1]));
}
__device__ __forceinline__ void pv(f32x16*o,int vb,bf16x8 pa0,bf16x8 pa1,bf16x8 pa2,bf16x8 pa3){
  #pragma unroll
  for(int d0=0;d0<2;++d0){s16x4 lo[4],hi[4];
    #pragma unroll
    for(int ks=0;ks<4;++ks){
      asm volatile("ds_read_b64_tr_b16 %0,%1 offset:%c2":"=&v"(lo[ks]):"v"(vb),"i"(d0*4096+ks*1024):"memory");
      asm volatile("ds_read_b64_tr_b16 %0,%1 offset:%c2":"=&v"(hi[ks]):"v"(vb),"i"(d0*4096+ks*1024+512):"memory");}
    asm volatile("s_waitcnt lgkmcnt(0)":::"memory");SBAR();
    #define PK(k) (bf16x8){lo[k][0],lo[k][1],lo[k][2],lo[k][3],hi[k][0],hi[k][1],hi[k][2],hi[k][3]}
    o[d0]=__builtin_amdgcn_mfma_f32_32x32x16_bf16(pa0,PK(0),o[d0],0,0,0);
    o[d0]=__builtin_amdgcn_mfma_f32_32x32x16_bf16(pa1,PK(1),o[d0],0,0,0);
    o[d0]=__builtin_amdgcn_mfma_f32_32x32x16_bf16(pa2,PK(2),o[d0],0,0,0);
    o[d0]=__builtin_amdgcn_mfma_f32_32x32x16_bf16(pa3,PK(3),o[d0],0,0,0);
    #undef PK
  }
}

template<int THRL,int MODE,bool BOUND> __device__ __forceinline__ void attn_unit(const int tid,const bf16*Qw,const bf16*__restrict__ Kh,const bf16*__restrict__ Vh,const int NT,const bf16*Gp,bf16*Ow,char*shm,
                                                                 const int cmap,const __attribute__((address_space(3))) float*tabc,const int qw,const float bl,const float br,const float kbound,const float badd){
  const int lane=tid&63,r32=lane&31,hi=lane>>5; const int wid=__builtin_amdgcn_readfirstlane(tid>>6);
  unsigned m0keep; asm volatile("s_mov_b32 %0, m0":"=s"(m0keep)::"memory");
  const unsigned lds0=(unsigned)(uintptr_t)shm;
  float*wsf=(float*)(shm+LDS_WS)+wid*64;
  const unsigned koff=(unsigned)(lane*DM+wid*8)*2u;
  const unsigned voff=(unsigned)((16*(wid&3)+(lane>>2))*DM+(wid>>2)*32+(lane&3)*8)*2u;
  const unsigned kdst=lds0+LDS_K+wid*1024, vdst=lds0+LDS_V+wid*1024;
  #define DMA_K(t,slot) glds16s(Kh+(long)(t)*KVBLK*DM,koff,(unsigned)__builtin_amdgcn_readfirstlane(kdst+(slot)))
  #define DMA_V(t,slot) glds16s(Vh+(long)(t)*KVBLK*DM,voff,(unsigned)__builtin_amdgcn_readfirstlane(vdst+(slot)))
  const int vb0=(int)(lds0+LDS_V)+((lane>>4)&1)*32+(lane&3)*8+(4*hi+((lane&15)>>2))*64;
  const char*Kbase=shm+LDS_K; bf16x8 kf[8];
  const lds_cptr shm3=(lds_cptr)shm; const lds_cptr kp0=shm3+LDS_K+hi*1024+r32*16; const lds_cptr kpLo=kp0+(MODE==1?cmap*4096:0), kpHi=kp0+(MODE==1?(1-cmap)*4096:4096); const lds_cptr vp0=shm3+LDS_V+((lane>>4)&1)*32+(lane&3)*8+(4*hi+((lane&15)>>2))*64;
  DMA_K(0,0);DMA_V(0,0);DMA_K(1,SLOTB);
  bf16x8 qr[4];
  #pragma unroll
  for(int d0=0;d0<4;++d0){ if(MODE==0||d0<2)qr[d0]=*reinterpret_cast<const bf16x8*>(&Qw[(long)r32*DM+d0*16+hi*8]); else qr[d0]=(bf16x8){0,0,0,0,0,0,0,0}; }
  float mrow=0.f;
  if(BOUND){ float q2=0.f;
    #pragma unroll
    for(int d0=0;d0<(MODE==1?2:4);++d0){
      #pragma unroll
      for(int e=0;e<8;++e){ const float x=__builtin_bit_cast(float,(unsigned)(unsigned short)qr[d0][e]<<16); q2+=x*x; } }
    { auto rr=__builtin_amdgcn_permlane32_swap(__float_as_uint(q2),__float_as_uint(q2),false,false); q2=__uint_as_float(rr[0])+__uint_as_float(rr[1]); }
    mrow=sqrtf(q2)*kbound+badd; }
  float mhat=0.f,l_reg=0.f;f32x16 o[2];o[0]=f32x16{};o[1]=f32x16{};f32x16 negm=f32x16{};asm volatile("":"+v"(negm));
  const unsigned blu=__builtin_amdgcn_readfirstlane(__float_as_uint(bl)), bru=__builtin_amdgcn_readfirstlane(__float_as_uint(br)); unsigned curbu=0u; float curb=0.f;
  #define cbias_(t) ((64*(t)+63-qw<=-91)?blu:((64*(t)-qw-31>=91)?bru:0u))
  #define CBSET(t) do{ if(MODE==1){ const unsigned cb_=cbias_(t); if(cb_!=curbu){ curbu=cb_; curb=__uint_as_float(curbu); _Pragma("unroll") for(int r=0;r<16;++r)negm[r]=curb-mhat; asm volatile("":"+v"(negm)); } } }while(0)
  #define BIASHOOK(P0,P1,t) do{ if(MODE==1){ if(64*(t)+63-qw>-91&&64*(t)-qw-31<91){ const __attribute__((address_space(3))) float*tp_=tabc+(320+64*(t)-qw-r32+4*hi); \
      _Pragma("unroll") for(int r=0;r<16;++r){const int kk_=(r&3)+8*(r>>2);P0[r]+=tp_[kk_];P1[r]+=tp_[kk_+32];} } } }while(0)
  #define CMASK(P0,P1,t) BIASHOOK(P0,P1,t)
  bool resc=false;
  #define START(P0,P1) do{ const float rm=BOUND?mrow:rowmax(P0,P1); resc=false; \
    { const float dl=rm; mhat=fadd_s(mhat,dl); \
      _Pragma("unroll") for(int r=0;r<16;++r){P0[r]=fsub_s(P0[r],dl);P1[r]=fsub_s(P1[r],dl);} \
      _Pragma("unroll") for(int r=0;r<16;++r)negm[r]=curb-mhat; asm volatile("":"+v"(negm)); } \
    _Pragma("unroll") for(int r=0;r<16;++r)P0[r]=__builtin_amdgcn_exp2f(P0[r]); }while(0)
  #define RESC() do{ if(resc){ asm volatile("s_waitcnt lgkmcnt(0)":::"memory"); \
      _Pragma("unroll") for(int d_=0;d_<2;++d_) _Pragma("unroll") for(int r=0;r<16;++r)o[d_][r]*=wsf[crow(r,hi)]; } }while(0)
  f32x16 pA0,pA1,pB0,pB1;
  int sl_prev=0,sl_cur=0,sl_next=SLOTB;
  #define ROT() do{sl_prev=sl_cur;sl_cur=sl_next;sl_next=(sl_next==(NSLOT-1)*SLOTB)?0:sl_next+SLOTB;}while(0)
  DMA_K(2,2*SLOTB);
  WAIT_BAR(3);
  if(MODE==1){ curbu=cbias_(0); curb=__uint_as_float(curbu); _Pragma("unroll") for(int r=0;r<16;++r)negm[r]=curb; asm volatile("":"+v"(negm)); }
  kload4(kf,kpLo);if(MODE==0)kload4(kf+4,kpHi);
  pA0=__builtin_amdgcn_mfma_f32_32x32x16_bf16(kf[0],qr[0],negm,0,0,0);pA1=__builtin_amdgcn_mfma_f32_32x32x16_bf16(kf[1],qr[0],negm,0,0,0);
  _Pragma("unroll") for(int d0=1;d0<(MODE==1?2:4);++d0){pA0=__builtin_amdgcn_mfma_f32_32x32x16_bf16(kf[2*d0],qr[d0],pA0,0,0,0);pA1=__builtin_amdgcn_mfma_f32_32x32x16_bf16(kf[2*d0+1],qr[d0],pA1,0,0,0);}
  asm volatile("s_nop 15\n\ts_nop 7":"+v"(pA0),"+v"(pA1));CMASK(pA0,pA1,0);
  START(pA0,pA1);
  _Pragma("unroll") for(int r=0;r<16;++r)pA1[r]=__builtin_amdgcn_exp2f(pA1[r]);
  WAIT_BAR(0);
  DMA_K(3,0);DMA_V(1,SLOTB);
  ROT();
  kload4(kf,kpLo+sl_cur);if(MODE==0)kload4(kf+4,kpHi+sl_cur);
  WAIT_BAR(2);
  s16x4 vlo[8],vhi[8]; u32x4 pw0,pw1,pw2,pw3;
  #define PKW(P,B) cvtpk_s(P[B],P[B+1])
  #define PAF(k) __builtin_bit_cast(bf16x8,pw##k)
  #define VFR(i) (bf16x8){vlo[i][0],vlo[i][1],vlo[i][2],vlo[i][3],vhi[i][0],vhi[i][1],vhi[i][2],vhi[i][3]}
  #define PIN(x) asm volatile("":"+v"(x))
  #define MX3(a,b,c) __builtin_fmaxf(__builtin_fmaxf((a),(b)),(c))
  #define GAPA(MF,A0,A1,A2,A3,W0,W1,PW) do{ MF; sacc+=A0; sacc+=A1; sacc+=A2; sacc+=A3; PIN(sacc); W0; W1; PIN(PW); SBAR(); }while(0)
  #define EX(v) __builtin_amdgcn_exp2f(v)
  #define GAPB(MF,X,B) do{ MF; X[B]=EX(X[B]); X[B+1]=EX(X[B+1]); X[B+2]=EX(X[B+2]); X[B+3]=EX(X[B+3]); PIN(X); SBAR(); }while(0)
  #define VRD(i) do{ vlo[i]=vtr(vp_+(((i)>>2)*4096+((i)&3)*1024)); vhi[i]=vtr(vp_+(((i)>>2)*4096+((i)&3)*1024+512)); }while(0)
  #define KRD(G,j) do{ if(G){ if((j)<2){kload2(kf,kpLo+sl_next,(j));}else if(MODE==0){kload2(kf+4,kpHi+sl_next,(j)-2);} SBAR(); } }while(0)
  #define STEP(C0,C1,P0,P1,t,GK,GV,GL) do{ SBAR(); \
    const lds_cptr vp_=vp0+sl_prev; \
    VRD(0); SBAR(); float sacc=(P0[0]+P0[1]); \
    GAPA(C0=__builtin_amdgcn_mfma_f32_32x32x16_bf16(kf[0],qr[0],negm,0,0,0), P0[2],P0[3],P0[4],P0[5],     pw0[0]=PKW(P0,0), pw0[1]=PKW(P0,2), pw0); \
    VRD(4); SBAR(); GAPA(C1=__builtin_amdgcn_mfma_f32_32x32x16_bf16(kf[1],qr[0],negm,0,0,0), P0[6],P0[7],P0[8],P0[9],     pw0[2]=PKW(P0,4), pw0[3]=PKW(P0,6), pw0); \
    VRD(1); SBAR(); GAPA(C0=__builtin_amdgcn_mfma_f32_32x32x16_bf16(kf[2],qr[1],C0,0,0,0),   P0[10],P0[11],P0[12],P0[13], pw1[0]=PKW(P0,8), pw1[1]=PKW(P0,10), pw1); \
    VRD(5); SBAR(); GAPA(C1=__builtin_amdgcn_mfma_f32_32x32x16_bf16(kf[3],qr[1],C1,0,0,0),   P0[14],P0[15],P1[0],P1[1],   pw1[2]=PKW(P0,12),pw1[3]=PKW(P0,14), pw1); \
    VRD(2); SBAR(); GAPA(if(MODE==0)C0=__builtin_amdgcn_mfma_f32_32x32x16_bf16(kf[4],qr[2],C0,0,0,0),   P1[2],P1[3],P1[4],P1[5],     pw2[0]=PKW(P1,0), pw2[1]=PKW(P1,2), pw2); \
    VRD(6); SBAR(); GAPA(if(MODE==0)C1=__builtin_amdgcn_mfma_f32_32x32x16_bf16(kf[5],qr[2],C1,0,0,0),   P1[6],P1[7],P1[8],P1[9],     pw2[2]=PKW(P1,4), pw2[3]=PKW(P1,6), pw2); \
    VRD(3); SBAR(); GAPA(if(MODE==0)C0=__builtin_amdgcn_mfma_f32_32x32x16_bf16(kf[6],qr[3],C0,0,0,0),   P1[10],P1[11],P1[12],P1[13], pw3[0]=PKW(P1,8), pw3[1]=PKW(P1,10), pw3); \
    VRD(7); SBAR(); GAPA(if(MODE==0)C1=__builtin_amdgcn_mfma_f32_32x32x16_bf16(kf[7],qr[3],C1,0,0,0),   P1[14],P1[15],0.f,0.f,       pw3[2]=PKW(P1,12),pw3[3]=PKW(P1,14), pw3); \
    l_reg+=sacc; \
    if(GK){DMA_K((t)+3,sl_cur);} if(GV){DMA_V((t)+1,sl_next);} \
    CMASK(C0,C1,t); \
    if(!BOUND){ float a=MX3(C0[0],C0[1],C1[0]),b=MX3(C0[2],C0[3],C1[1]); a=MX3(a,C1[2],C1[3]); \
      _Pragma("unroll") for(int r=4;r<16;r+=4){a=MX3(a,C0[r],C0[r+1]);b=MX3(b,C0[r+2],C0[r+3]);a=MX3(a,C1[r],C1[r+1]);b=MX3(b,C1[r+2],C1[r+3]);} \
      float rm=__builtin_fmaxf(a,b); { auto rr=__builtin_amdgcn_permlane32_swap(__float_as_uint(rm),__float_as_uint(rm),false,false); rm=__builtin_fmaxf(__uint_as_float(rr[0]),__uint_as_float(rr[1])); } \
      resc=false; \
      if(__builtin_expect(__any(rm>(float)THRL),0)){ const float dl=__builtin_fmaxf(rm,0.f); mhat+=dl; \
        _Pragma("unroll") for(int r=0;r<16;++r){C0[r]-=dl;C1[r]-=dl;} \
        _Pragma("unroll") for(int r=0;r<16;++r)negm[r]=curb-mhat; asm volatile("":"+v"(negm)); \
        const float f=__builtin_amdgcn_exp2f(-dl); l_reg*=f; if(hi==0)wsf[r32]=f; resc=true; } } \
    SBAR(); \
    __builtin_amdgcn_s_waitcnt(LGKM_IMM(8)); SBAR();        \
    GAPB(o[0]=__builtin_amdgcn_mfma_f32_32x32x16_bf16(PAF(0),VFR(0),o[0],0,0,0), C0,0); \
    GAPB(o[1]=__builtin_amdgcn_mfma_f32_32x32x16_bf16(PAF(0),VFR(4),o[1],0,0,0), C0,4); \
    KRD(GL,0); GAPB(o[0]=__builtin_amdgcn_mfma_f32_32x32x16_bf16(PAF(1),VFR(1),o[0],0,0,0), C0,8); \
    KRD(GL,1); GAPB(o[1]=__builtin_amdgcn_mfma_f32_32x32x16_bf16(PAF(1),VFR(5),o[1],0,0,0), C0,12); \
    KRD(GL,2); if(GL){ __builtin_amdgcn_s_waitcnt(LGKM_IMM(4+(MODE==0?6:4))); }else{ __builtin_amdgcn_s_waitcnt(LGKM_IMM(4)); } SBAR();     \
    GAPB(o[0]=__builtin_amdgcn_mfma_f32_32x32x16_bf16(PAF(2),VFR(2),o[0],0,0,0), C1,0); \
    KRD(GL,3); GAPB(o[1]=__builtin_amdgcn_mfma_f32_32x32x16_bf16(PAF(2),VFR(6),o[1],0,0,0), C1,4); \
    if(GL){ __builtin_amdgcn_s_waitcnt(LGKM_IMM(MODE==0?8:4)); }else{ __builtin_amdgcn_s_waitcnt(LGKM_IMM(0)); } SBAR();                    \
    GAPB(o[0]=__builtin_amdgcn_mfma_f32_32x32x16_bf16(PAF(3),VFR(3),o[0],0,0,0), C1,8); \
    GAPB(o[1]=__builtin_amdgcn_mfma_f32_32x32x16_bf16(PAF(3),VFR(7),o[1],0,0,0), C1,12); \
    }while(0)
  int t=1;
  #undef CMASK
  #define CMASK(P0,P1,t) BIASHOOK(P0,P1,t)
  for(;t+9<NT;t+=6){
    { constexpr int sl_prev=0,sl_cur=SLOTB,sl_next=2*SLOTB; CBSET(t);   STEP(pB0,pB1,pA0,pA1,t,true,true,true);     WAIT_BAR(2); RESC(); }
    { constexpr int sl_prev=SLOTB,sl_cur=2*SLOTB,sl_next=0; CBSET(t+1); STEP(pA0,pA1,pB0,pB1,t+1,true,true,true);   WAIT_BAR(2); RESC(); }
    { constexpr int sl_prev=2*SLOTB,sl_cur=0,sl_next=SLOTB; CBSET(t+2); STEP(pB0,pB1,pA0,pA1,t+2,true,true,true);   WAIT_BAR(2); RESC(); }
    { constexpr int sl_prev=0,sl_cur=SLOTB,sl_next=2*SLOTB; CBSET(t+3); STEP(pA0,pA1,pB0,pB1,t+3,true,true,true);   WAIT_BAR(2); RESC(); }
    { constexpr int sl_prev=SLOTB,sl_cur=2*SLOTB,sl_next=0; CBSET(t+4); STEP(pB0,pB1,pA0,pA1,t+4,true,true,true);   WAIT_BAR(2); RESC(); }
    { constexpr int sl_prev=2*SLOTB,sl_cur=0,sl_next=SLOTB; CBSET(t+5); STEP(pA0,pA1,pB0,pB1,t+5,true,true,true);   WAIT_BAR(2); RESC(); }
  }
  for(;t+5<NT;t+=2){
    CBSET(t);   STEP(pB0,pB1,pA0,pA1,t,true,true,true);     WAIT_BAR(2); RESC(); ROT();
    CBSET(t+1); STEP(pA0,pA1,pB0,pB1,t+1,true,true,true);   WAIT_BAR(2); RESC(); ROT();
  }
  #undef CMASK
  #define CMASK(P0,P1,t) BIASHOOK(P0,P1,t)
  #define ENDW(tt) do{ if((tt)+3<NT){WAIT_BAR(2);} else if((tt)+2<NT){WAIT_BAR(1);} else {WAIT_BAR(0);} }while(0)
  for(;t+1<NT;t+=2){
    CBSET(t);   STEP(pB0,pB1,pA0,pA1,t,(t+3<NT),(t+1<NT),(t+1<NT));       ENDW(t);   RESC(); ROT();
    CBSET(t+1); STEP(pA0,pA1,pB0,pB1,t+1,(t+4<NT),(t+2<NT),(t+2<NT));     ENDW(t+1); RESC(); ROT();
  }
  CBSET(NT-1); STEP(pB0,pB1,pA0,pA1,NT-1,false,false,false); RESC();
  { float sacc=pB0[0]+pB0[1]; _Pragma("unroll") for(int r=2;r<16;++r)sacc+=pB0[r]; _Pragma("unroll") for(int r=0;r<16;++r)sacc+=pB1[r]; l_reg+=sacc;
    pw0=(u32x4){PKW(pB0,0),PKW(pB0,2),PKW(pB0,4),PKW(pB0,6)};pw1=(u32x4){PKW(pB0,8),PKW(pB0,10),PKW(pB0,12),PKW(pB0,14)};pw2=(u32x4){PKW(pB1,0),PKW(pB1,2),PKW(pB1,4),PKW(pB1,6)};pw3=(u32x4){PKW(pB1,8),PKW(pB1,10),PKW(pB1,12),PKW(pB1,14)};
    SBAR(); pv(o,vb0+sl_cur,PAF(0),PAF(1),PAF(2),PAF(3)); }
  #undef PKW
  #undef PAF
  #undef VFR
  #undef PIN
  #undef MX3
  #undef GAPA
  #undef GAPB
  #undef EX
  #undef VRD
  #undef KRD
  #undef STEP
  #undef ENDW
  {auto rr=__builtin_amdgcn_permlane32_swap(__float_as_uint(l_reg),__float_as_uint(l_reg),false,false);l_reg=__uint_as_float(rr[0])+__uint_as_float(rr[1]);}
  if(hi==0)wsf[32+r32]=l_reg;asm volatile("s_waitcnt lgkmcnt(0)":::"memory");
  float rli[16];
  #pragma unroll
  for(int r=0;r<16;++r)rli[r]=__builtin_amdgcn_rcpf(wsf[32+crow(r,hi)]);
  { bf16*stg=(bf16*)(shm+LDS_OST)+wid*2048;
    #pragma unroll
    for(int r=0;r<16;++r){const int orow=crow(r,hi);
      #pragma unroll
      for(int d0=0;d0<2;++d0)stg[orow*64+d0*32+r32]=(bf16)(pk2(o[d0][r]*rli[r],0.f)&0xffffu);}
    asm volatile("s_waitcnt lgkmcnt(0)":::"memory");
    if(MODE==0){
    #pragma unroll
    for(int i=0;i<4;++i){const int row=i*8+(lane>>3),ch=lane&7; const u32x4 v=*(const u32x4*)(stg+row*64+ch*8); const u32x4 g=*(const u32x4*)(Gp+(long)row*DM+ch*8);
      u32x4 w; w.x=pk2(bflo(v.x)*fa::silu(bflo(g.x)),bfhi(v.x)*fa::silu(bfhi(g.x))); w.y=pk2(bflo(v.y)*fa::silu(bflo(g.y)),bfhi(v.y)*fa::silu(bfhi(g.y)));
      w.z=pk2(bflo(v.z)*fa::silu(bflo(g.z)),bfhi(v.z)*fa::silu(bfhi(g.z))); w.w=pk2(bflo(v.w)*fa::silu(bflo(g.w)),bfhi(v.w)*fa::silu(bfhi(g.w)));
      *(u32x4*)(Ow+(long)row*MIXW+ch*8)=w;} } }
  asm volatile("s_waitcnt lgkmcnt(0)\n\ts_barrier\n\ts_mov_b32 m0, %0"::"s"(m0keep):"memory");
  #undef DMA_K
  #undef DMA_V
  #undef CMASK
  #undef cbias_
  #undef CBSET
  #undef BIASHOOK
  #undef START
  #undef RESC
  #undef ROT
}
#undef SBAR
#undef WAIT_BAR
}
#define SBAR() __builtin_amdgcn_sched_barrier(0)

typedef GAS unsigned gu32;
#define XB_TMO      128
#define XB_XCNT(j)  (256  + 64 * (j))
#define XB_XSUB(j)  (1280 + 64 * (j))
#define XB_XGEN(j)  (2304 + 64 * (j))
#define XB_TOP      3328
#define XB_TOPGEN   3392
#define XCD_BAR_WORDS 3456
#define XB_SPIN_CAP (1u << 22)
__device__ __forceinline__ unsigned xb_ld(unsigned* p)              { return __hip_atomic_load(p, __ATOMIC_RELAXED, __HIP_MEMORY_SCOPE_AGENT); }
__device__ __forceinline__ unsigned xb_add(unsigned* p, unsigned v) { return __hip_atomic_fetch_add(p, v, __ATOMIC_RELAXED, __HIP_MEMORY_SCOPE_AGENT); }
__device__ __forceinline__ unsigned xb_xcc_id() { return (unsigned)__builtin_amdgcn_s_getreg((3 << 11) | 20) & 0xFu; }
#define XB_SPIN(cond, bar) do { unsigned _sp = 0; while (cond) { __builtin_amdgcn_s_sleep(1); \
    if ((++_sp & 255u) == 0u) { if (xb_ld(&(bar)[XB_TMO])) break; if (_sp > XB_SPIN_CAP) { atomicAdd(&(bar)[XB_TMO], 1u); break; } } } } while (0)
struct XcdBarrier { unsigned* bar; unsigned x; volatile LAS unsigned* st; };
__device__ __forceinline__ XcdBarrier xcd_barrier_post(unsigned* bar, volatile LAS unsigned* st) {
    XcdBarrier b; b.bar = bar; b.x = xb_xcc_id(); b.st = st;
    if (threadIdx.x == 0) (void)xb_add(&bar[XB_XCNT(b.x)], 1u);
    return b;
}
__device__ __forceinline__ void xcd_barrier_complete(unsigned* bar, unsigned x, unsigned& nloc, unsigned& nx) {
    const unsigned G = gridDim.x * gridDim.y * gridDim.z;
    unsigned sum, cnt, mine, sp = 0u;
    for (;;) {
        sum = 0u; cnt = 0u; mine = 0u;
#pragma unroll
        for (unsigned j = 0; j < 16; ++j) { const unsigned c = xb_ld(&bar[XB_XCNT(j)]); sum += c; cnt += (c > 0u) ? 1u : 0u; mine = (j == x) ? c : mine; }
        if (sum == G) break;
        __builtin_amdgcn_s_sleep(1);
        if ((++sp & 255u) == 0u) { if (xb_ld(&bar[XB_TMO])) break; if (sp > XB_SPIN_CAP) { atomicAdd(&bar[XB_TMO], 1u); break; } }
    }
    nloc = mine > 0u ? mine : 1u; nx = cnt > 0u ? cnt : 1u;
}
__device__ __forceinline__ void xcd_barrier(const XcdBarrier& b) {
    asm volatile("s_waitcnt vmcnt(0)" ::: "memory");
    __syncthreads();
    if (threadIdx.x == 0) {
        unsigned* bar = b.bar;
        __builtin_amdgcn_s_waitcnt(0);
        unsigned nloc = b.st[0], nx = b.st[1];
        if (nloc == 0u) { xcd_barrier_complete(bar, b.x, nloc, nx); b.st[0] = nloc; b.st[1] = nx; }
        const unsigned old = xb_add(&bar[XB_XSUB(b.x)], 1u);
        const unsigned gen = old / nloc;
        if (old + 1u == (gen + 1u) * nloc) {
            __builtin_amdgcn_fence(__ATOMIC_RELEASE, "agent");
            asm volatile("s_waitcnt vmcnt(0)" ::: "memory");
            const unsigned og = xb_add(&bar[XB_TOP], 1u);
            const unsigned tg = og / nx;
            if (og + 1u == (tg + 1u) * nx) xb_add(&bar[XB_TOPGEN], 1u);
            else XB_SPIN(xb_ld(&bar[XB_TOPGEN]) == tg, bar);
            __builtin_amdgcn_fence(__ATOMIC_ACQUIRE, "agent");
            xb_add(&bar[XB_XGEN(b.x)], 1u);
            asm volatile("s_waitcnt vmcnt(0)" ::: "memory");
        } else {
            XB_SPIN(xb_ld(&bar[XB_XGEN(b.x)]) == gen, bar);
            __builtin_amdgcn_fence(__ATOMIC_ACQUIRE, "agent");
            asm volatile("s_waitcnt vmcnt(0)" ::: "memory");
        }
    }
    __syncthreads();
}

constexpr int CW_SPLIT = 8192;
__device__ __forceinline__ void split_arrive(unsigned* cnt) {
    asm volatile("s_waitcnt vmcnt(0)" ::: "memory");
    __syncthreads();
    if (threadIdx.x == 0) {
        __builtin_amdgcn_fence(__ATOMIC_RELEASE, "agent");
        asm volatile("s_waitcnt vmcnt(0)" ::: "memory");
        (void)__hip_atomic_fetch_add(cnt, 1u, __ATOMIC_RELAXED, __HIP_MEMORY_SCOPE_AGENT);
    }
}
__device__ __forceinline__ void split_wait(unsigned* cnt, unsigned want) {
    if (threadIdx.x == 0) {
        unsigned sp = 0u;
        while (__hip_atomic_load(cnt, __ATOMIC_RELAXED, __HIP_MEMORY_SCOPE_AGENT) < want) { __builtin_amdgcn_s_sleep(2); if (++sp > (1u << 24)) break; }
        __builtin_amdgcn_fence(__ATOMIC_ACQUIRE, "agent");
        asm volatile("s_waitcnt vmcnt(0)" ::: "memory");
    }
    __syncthreads();
}

struct Frame {
    LAS unsigned char* lds;
    int tid, lane, wave, vcu, G;
    const float* const __attribute__((address_space(4)))* in; float* out; unsigned char* ws;
    bf16_t *WIN, *WOUT, *XNM, *PROJ, *BPART; float *BLSE, *TAB;
};
__device__ __forceinline__ float wave_sum(float v) {
#pragma unroll
    for (int o = 1; o < 64; o <<= 1) v += __shfl_xor(v, o);
    return v;
}
__device__ __forceinline__ int t5_bucket(int rel) {
    const int dist = rel < 0 ? -rel : rel; int v;
    if (dist < 8) v = dist; else { const unsigned q = (unsigned)(dist * dist) >> 6; const int k = 31 - __builtin_clz(q); v = 8 + k; if (v > 15) v = 15; }
    return v + (rel > 0 ? 16 : 0);
}
__device__ __forceinline__ float in_colscale(int n) {
    if (n >= C_BQ && n < C_BK) return 0.125f * LOG2E;
    if (n >= C_CQ && n < C_CK) return 0.17677669529663687f * LOG2E;
    if (n >= C_DQ && n < C_DK) return 0.125f * LOG2E;
    return 1.f;
}
template <bool IN>
__device__ __forceinline__ void transpose_item(const float* W, const float* g, int K, int N, bf16_t* WT, LAS float* scr, int item, int lane) {
    const int nblk = N / 32, kb = item / nblk, nb = item % nblk, k0 = 64 * kb, n0 = 32 * nb;
#pragma unroll 8
    for (int i = 0; i < 32; ++i) { const int kk = 2 * i + (lane >> 5); float w = W[(size_t)(k0 + kk) * N + n0 + (lane & 31)]; if (IN) w *= g[k0 + kk]; scr[kk * 33 + (lane & 31)] = w; }
    asm volatile("s_waitcnt lgkmcnt(0)" ::: "memory");
    const int c = lane & 7;
#pragma unroll
    for (int j = 0; j < 4; ++j) { const int n = (lane >> 3) + 8 * j; const LAS float* s = scr + (8 * c) * 33 + n; const float cs = IN ? in_colscale(n0 + n) : 1.f;
        u32x4 o; o.x = pk2(s[0 * 33] * cs, s[1 * 33] * cs); o.y = pk2(s[2 * 33] * cs, s[3 * 33] * cs); o.z = pk2(s[4 * 33] * cs, s[5 * 33] * cs); o.w = pk2(s[6 * 33] * cs, s[7 * 33] * cs);
        *(u32x4*)(WT + (size_t)(n0 + n) * K + k0 + 8 * c) = o; }
    asm volatile("s_waitcnt lgkmcnt(0)" ::: "memory");
}
__device__ __forceinline__ void phase_prologue(Frame& F) {
    LAS float* scr = (LAS float*)(F.lds + F.wave * 16384);
    const int gw = F.vcu * 8 + F.wave, NGW = F.G * 8;
    constexpr int I_IN = (DMODEL / 64) * (INW / 32), I_OUT = (MIXW / 64) * (DMODEL / 32);
    constexpr int NITEMS = DEPTH * (I_IN + I_OUT);
    for (int it = gw; it < NITEMS; it += NGW) {
        int r = it;
        if (r < DEPTH * I_IN) { const int l = r / I_IN; r -= l * I_IN; transpose_item<true>(F.in[2] + (size_t)l * DMODEL * INW, F.in[4] + l * DMODEL, DMODEL, INW, F.WIN + (size_t)l * INW * DMODEL, scr, r, F.lane); continue; }
        r -= DEPTH * I_IN; { const int l = r / I_OUT; r -= l * I_OUT; transpose_item<false>(F.in[3] + (size_t)l * MIXW * DMODEL, nullptr, MIXW, DMODEL, F.WOUT + (size_t)l * DMODEL * MIXW, scr, r, F.lane); }
    }
    if (blockIdx.x == 0) {
        float* T = F.TAB; const float* t5 = F.in[8];
        for (int i = F.tid; i < 128 * 16; i += 512) { const int pos = i >> 4, k = i & 15; const float f = exp2f(-(float)k * (13.287712379549449f / 16.f)); const float a = (float)pos * f; T[T_ROPE + 2 * i] = cosf(a); T[T_ROPE + 2 * i + 1] = sinf(a); }
        for (int i = F.tid; i < 4 * 641; i += 512) { const int h = i / 641, rel = i % 641 - 320; T[T_C + i] = t5[t5_bucket(rel) * 8 + 4 + h] * LOG2E; }
        for (int i = F.tid; i < 3 * 4 * 320; i += 512) { const int g = i / (4 * 320), h = (i / 320) & 3, off = i % 320 - 158; const int d = (g == 0) ? 1 : (g == 1 ? 4 : 16); T[T_B + i] = (off < -64 || off > 64) ? -INFINITY : t5[t5_bucket(off * d) * 8 + h] * LOG2E; }
        { const int lh = F.wave; const float* rp = F.in[14] + (size_t)lh * 465; float m = -1e30f;
          for (int i = F.lane; i < 465; i += 64) m = fmaxf(m, rp[i] * LOG2E);
          for (int o_ = 32; o_; o_ >>= 1) m = fmaxf(m, __shfl_xor(m, o_));
          if (F.lane == 0) T[T_BMAXD + lh] = m; }
        if (F.tid >= 68 && F.tid < 72) { const int h = F.tid - 68; float m = -1e30f; for (int bk = 0; bk < 32; ++bk) m = fmaxf(m, t5[bk * 8 + h] * LOG2E); T[T_BMAXB + h] = m; }
        if (F.tid >= 64 && F.tid < 68) { const int h = F.tid - 64; float m = -1e30f; for (int bk = 0; bk < 32; ++bk) m = fmaxf(m, t5[bk * 8 + 4 + h] * LOG2E); T[T_BMAX + h] = m; }
        if (F.tid < DEPTH) { const int l = F.tid; float s1 = 0.f, s2 = 0.f; for (int i = 0; i < 32; ++i) { s1 += F.in[9][l * 32 + i] * F.in[10][l * 32 + i]; s2 += F.in[11][l * 32 + i] * F.in[12][l * 32 + i]; }
            const float li = 0.8f - 0.6f * expf(-0.3f * (float)l); T[T_LAM + l] = expf(s1) - expf(s2) + li; }
    }
}
__device__ __forceinline__ void phase_xn(Frame& F, int layer) {
    const int gw = F.vcu * 8 + F.wave, NGW = F.G * 8;
    for (int m = gw; m < MTOT; m += NGW) {
        const float* src = (layer == 0) ? (m < RS ? F.in[0] + (size_t)m * DMODEL : F.in[1] + (size_t)(m - RS) * DMODEL) : F.out + (size_t)m * DMODEL;
        const f32x4* xr = (const f32x4*)src + F.lane; f32x4 v[4]; float s = 0.f;
#pragma unroll
        for (int j = 0; j < 4; ++j) { v[j] = xr[64 * j]; s += (v[j].x * v[j].x + v[j].y * v[j].y) + (v[j].z * v[j].z + v[j].w * v[j].w); }
        const float r = 1.f / sqrtf(wave_sum(s) * (1.f / DMODEL) + RMS_EPS);
        u32x2* o8 = (u32x2*)(F.XNM + (size_t)m * DMODEL) + F.lane;
#pragma unroll
        for (int j = 0; j < 4; ++j) { u32x2 w; w.x = pk2(v[j].x * r, v[j].y * r); w.y = pk2(v[j].z * r, v[j].w * r); o8[64 * j] = w; }
    }
}
__device__ __forceinline__ void phase_final(Frame& F) {
    const int gw = F.vcu * 8 + F.wave, NGW = F.G * 8; const float* g = F.in[5];
    for (int m = gw; m < MTOT; m += NGW) {
        f32x4* xr = (f32x4*)(F.out + (size_t)m * DMODEL) + F.lane; f32x4 v[4]; float s = 0.f;
#pragma unroll
        for (int j = 0; j < 4; ++j) { v[j] = xr[64 * j]; s += (v[j].x * v[j].x + v[j].y * v[j].y) + (v[j].z * v[j].z + v[j].w * v[j].w); }
        const float r = 1.f / sqrtf(wave_sum(s) * (1.f / DMODEL) + RMS_EPS);
#pragma unroll
        for (int j = 0; j < 4; ++j) { const f32x4 gg = *((const f32x4*)g + F.lane + 64 * j); xr[64 * j] = v[j] * r * gg; }
    }
}
__device__ __forceinline__ void phase_prepB(Frame& F, int s, int layer) {
    const int gw = F.vcu * 8 + F.wave, NGW = F.G * 8; const int lane = F.lane, half = lane >> 5, l32 = lane & 31;
    unsigned* kmaxB = (unsigned*)(F.ws + WS_CTL) + CW_KMAXB + (layer * 2 + s) * 4; unsigned* kmaxD = (unsigned*)(F.ws + WS_CTL) + CW_KMAXD + (layer * 2 + s) * 4;
    float kmB = 0.f, kmD = 0.f;
    for (int i0 = 0; gw + NGW * 2 * i0 < RS; i0 += 4) {
        u32x4 w[4], wd[4];
#pragma unroll
        for (int i = 0; i < 4; ++i) { const int lr = gw + NGW * (2 * (i0 + i) + half);
            w[i] = (lr < RS) ? *(const u32x4*)(F.PROJ + (size_t)lr * INW + C_BK + l32 * 8) : (u32x4){0u, 0u, 0u, 0u};
            wd[i] = (lr < RS) ? *(const u32x4*)(F.PROJ + (size_t)lr * INW + C_DK + l32 * 8) : (u32x4){0u, 0u, 0u, 0u}; }
#pragma unroll
        for (int i = 0; i < 4; ++i) { const float r[8] = {bflo(w[i].x), bfhi(w[i].x), bflo(w[i].y), bfhi(w[i].y), bflo(w[i].z), bfhi(w[i].z), bflo(w[i].w), bfhi(w[i].w)}; float k2 = 0.f;
            const float rd[8] = {bflo(wd[i].x), bfhi(wd[i].x), bflo(wd[i].y), bfhi(wd[i].y), bflo(wd[i].z), bfhi(wd[i].z), bflo(wd[i].w), bfhi(wd[i].w)}; float d2 = 0.f;
#pragma unroll
            for (int j = 0; j < 8; ++j) { k2 += r[j] * r[j]; d2 += rd[j] * rd[j]; }
            k2 += __shfl_xor(k2, 1); k2 += __shfl_xor(k2, 2); k2 += __shfl_xor(k2, 4);
            d2 += __shfl_xor(d2, 1); d2 += __shfl_xor(d2, 2); d2 += __shfl_xor(d2, 4);
            kmB = fmaxf(kmB, k2); kmD = fmaxf(kmD, d2); }
    }
    kmB = fmaxf(kmB, __shfl_xor(kmB, 32)); kmD = fmaxf(kmD, __shfl_xor(kmD, 32));
    { LAS float* red = (LAS float*)(F.lds + fa::L_WS);
      if (lane < 32 && (lane & 7) == 0) { red[F.wave * 8 + (lane >> 3)] = kmB; red[F.wave * 8 + 4 + (lane >> 3)] = kmD; }
      asm volatile("s_waitcnt lgkmcnt(0)\n\ts_barrier" ::: "memory");
      if (F.tid < 8) { float m = 0.f;
#pragma unroll
          for (int w_ = 0; w_ < 8; ++w_) m = fmaxf(m, red[w_ * 8 + F.tid]);
          atomicMax(F.tid < 4 ? kmaxB + F.tid : kmaxD + (F.tid - 4), __float_as_uint(sqrtf(m))); }
      asm volatile("s_waitcnt lgkmcnt(0)\n\ts_barrier" ::: "memory"); }
}
__device__ __forceinline__ void phase_prep(Frame& F, int s, int layer) {
    const int gw = F.vcu * 8 + F.wave, NGW = F.G * 8; const int n = s ? 2048 : 8192;
    const float* gq = F.in[6] + layer * 64; const float* gk = F.in[7] + layer * 64;
    LAS const float* rope = (LAS const float*)(F.lds + LT_ROPE);
    const int lane = F.lane, hh = lane >> 3, c = lane & 7;
    unsigned* kmaxA = (unsigned*)(F.ws + WS_CTL) + CW_KMAXA + (layer * 2 + s) * 2; unsigned* kmaxC = (unsigned*)(F.ws + WS_CTL) + CW_KMAXC + (layer * 2 + s) * 8;
    float kmA = 0.f, kmC = 0.f;
    float gv[8];
#pragma unroll
    for (int j = 0; j < 8; ++j) gv[j] = ((hh < 4 ? gq : gk) + c * 8)[j];
    const float sgn = (c & 2) ? 1.f : -1.f; const float qs = (hh < 4) ? 0.125f * LOG2E : 1.f;
    constexpr int NB = 4;
    for (int lr0 = gw; lr0 < RS; lr0 += NB * NGW) {
        u32x4 wA[NB], wC[NB];
#pragma unroll
        for (int k = 0; k < NB; ++k) { const int lr = lr0 + k * NGW; wA[k] = (u32x4){0u, 0u, 0u, 0u}; wC[k] = wA[k];
            if (lr < RS) { if (lane < 48) wA[k] = *(const u32x4*)(F.PROJ + (size_t)lr * INW + hh * 64 + c * 8);
                           if (lane < 32) wC[k] = *(const u32x4*)(F.PROJ + (size_t)lr * INW + C_CK + lane * 8); } }
#pragma unroll
        for (int k = 0; k < NB; ++k) { const int lr = lr0 + k * NGW; if (lr < RS) {
            const u32x4 w = wA[k]; float v[8] = {bflo(w.x), bfhi(w.x), bflo(w.y), bfhi(w.y), bflo(w.z), bfhi(w.z), bflo(w.w), bfhi(w.w)};
            float ss = 0.f;
#pragma unroll
            for (int j = 0; j < 8; ++j) ss += v[j] * v[j];
            ss += __shfl_xor(ss, 1); ss += __shfl_xor(ss, 2); ss += __shfl_xor(ss, 4);
            const float rinv = 1.f / sqrtf(ss * (1.f / 64.f) + RMS_EPS);
            const int t = lr % n; const int pos = (c < 4) ? (t >> 6) : (t & 63);
            float o[8];
#pragma unroll
            for (int j = 0; j < 8; ++j) { v[j] = v[j] * rinv * gv[j]; }
#pragma unroll
            for (int j = 0; j < 8; ++j) { const float pr = __shfl_xor(v[j], 2); const int i = 8 * (c & 1) + j; const float cs = rope[(pos * 16 + i) * 2], sn = rope[(pos * 16 + i) * 2 + 1];
                o[j] = (v[j] * cs + sgn * pr * sn) * qs; }
            u32x4 ow; ow.x = pk2(o[0], o[1]); ow.y = pk2(o[2], o[3]); ow.z = pk2(o[4], o[5]); ow.w = pk2(o[6], o[7]);
            if (lane < 48) *(u32x4*)(F.PROJ + (size_t)lr * INW + hh * 64 + c * 8) = ow;
            { const float r[8] = {bflo(ow.x), bfhi(ow.x), bflo(ow.y), bfhi(ow.y), bflo(ow.z), bfhi(ow.z), bflo(ow.w), bfhi(ow.w)}; float k2 = 0.f;
#pragma unroll
              for (int j = 0; j < 8; ++j) k2 += r[j] * r[j];
              k2 += __shfl_xor(k2, 1); k2 += __shfl_xor(k2, 2); k2 += __shfl_xor(k2, 4);
              kmA = fmaxf(kmA, k2); }
            { const u32x4 wc = wC[k]; const float r[8] = {bflo(wc.x), bfhi(wc.x), bflo(wc.y), bfhi(wc.y), bflo(wc.z), bfhi(wc.z), bflo(wc.w), bfhi(wc.w)}; float k2 = 0.f;
#pragma unroll
              for (int j = 0; j < 8; ++j) k2 += r[j] * r[j];
              k2 += __shfl_xor(k2, 1); k2 += __shfl_xor(k2, 2);
              kmC = fmaxf(kmC, k2); } } }
    }
    { LAS float* red = (LAS float*)(F.lds + fa::L_WS);
      if (lane == 32 || lane == 40) red[F.wave * 14 + (hh - 4)] = kmA;
      if (lane < 32 && (lane & 3) == 0) red[F.wave * 14 + 2 + (lane >> 2)] = kmC;
      asm volatile("s_waitcnt lgkmcnt(0)\n\ts_barrier" ::: "memory");
      if (F.tid < 10) { float m = 0.f;
#pragma unroll
          for (int w = 0; w < 8; ++w) m = fmaxf(m, red[w * 14 + F.tid]);
          atomicMax(F.tid < 2 ? kmaxA + F.tid : kmaxC + (F.tid - 2), __float_as_uint(sqrtf(m))); }
      asm volatile("s_waitcnt lgkmcnt(0)\n\ts_barrier" ::: "memory"); }
}

struct KVLinear {
    const bf16_t* kbase; const bf16_t* vbase;
    __device__ __forceinline__ const bf16_t* tk(int t) const { return kbase + (size_t)(64 * t) * INW; }
    __device__ __forceinline__ const bf16_t* tv(int t) const { return vbase + (size_t)(64 * t) * INW; }
    __device__ __forceinline__ int rmul() const { return 1; }
    __device__ __forceinline__ const bf16_t* kptr(int t, int j) const { return kbase + (size_t)(64 * t + j) * INW; }
    __device__ __forceinline__ const bf16_t* vptr(int t, int j) const { return vbase + (size_t)(64 * t + j) * INW; }
};
struct KVStrided {
    const bf16_t* kbase; const bf16_t* vbase; int d; int ntr;
    __device__ __forceinline__ const bf16_t* tk(int t) const { const int g2 = t >= ntr ? 1 : 0; const int tt = t - g2 * ntr; return kbase + (size_t)(g2 + d * 64 * tt) * INW; }
    __device__ __forceinline__ const bf16_t* tv(int t) const { const int g2 = t >= ntr ? 1 : 0; const int tt = t - g2 * ntr; return vbase + (size_t)(g2 + d * 64 * tt) * INW; }
    __device__ __forceinline__ int rmul() const { return d; }
    __device__ __forceinline__ const bf16_t* kptr(int t, int j) const { const int g2 = t >= ntr ? 1 : 0; const int tt = t - g2 * ntr; return kbase + (size_t)(g2 + d * (64 * tt + j)) * INW; }
    __device__ __forceinline__ const bf16_t* vptr(int t, int j) const { const int g2 = t >= ntr ? 1 : 0; const int tt = t - g2 * ntr; return vbase + (size_t)(g2 + d * (64 * tt + j)) * INW; }
};
struct HookNone { __device__ __forceinline__ bool skip(int) const { return false; } __device__ __forceinline__ float cbias(int) const { return 0.f; } __device__ __forceinline__ void apply(f32x16&, f32x16&, int) const {} };

__device__ __forceinline__ void store_gated(Frame& F, LAS const float* stg, size_t lrow0, size_t grow0, int gate_col, int mix_col, int lane) {
#pragma unroll
    for (int i = 0; i < 4; ++i) { const int row = i * 8 + (lane >> 3), ch = lane & 7;
        const f32x4 a = *(LAS const f32x4*)(stg + row * 64 + ch * 8), b = *(LAS const f32x4*)(stg + row * 64 + ch * 8 + 4);
        const u32x4 gw = *(const u32x4*)(F.PROJ + (lrow0 + row) * INW + gate_col + ch * 8);
        u32x4 w; w.x = pk2(a.x * fa::silu(bflo(gw.x)), a.y * fa::silu(bfhi(gw.x))); w.y = pk2(a.z * fa::silu(bflo(gw.y)), a.w * fa::silu(bfhi(gw.y)));
        w.z = pk2(b.x * fa::silu(bflo(gw.z)), b.y * fa::silu(bfhi(gw.z))); w.w = pk2(b.z * fa::silu(bflo(gw.w)), b.w * fa::silu(bfhi(gw.w)));
        *(u32x4*)(F.XNM + (grow0 + row) * MIXW + mix_col + ch * 8) = w; }
}

__device__ __forceinline__ void unit_A(Frame& F, int s, int layer, int bh, int qb) {
    const int n = s ? 2048 : 8192; const int b = bh >> 2, h = bh & 3;
    int tid_ = F.tid; asm volatile("" : "+v"(tid_)); const int wid = __builtin_amdgcn_readfirstlane(tid_ >> 6);
    const size_t rowbase = (size_t)b * n; const int q0 = qb * 256 + wid * 32;
    const bf16_t* Qw = F.PROJ + (rowbase + q0) * INW + C_AQ + h * 64;
    const bf16_t* Kh = F.PROJ + rowbase * INW + C_AK + (h >> 1) * 64; const bf16_t* Vh = F.PROJ + rowbase * INW + C_AV + (h >> 1) * 64;
    const bf16_t* Gp = F.PROJ + (rowbase + q0) * INW + C_AG + h * 64;
    bf16_t* Ow = F.XNM + ((size_t)s * RS + rowbase + q0) * MIXW + h * 64;
    const float kbA = __uint_as_float(((const unsigned*)(F.ws + WS_CTL))[CW_KMAXA + (layer * 2 + s) * 2 + (h >> 1)]) * 1.01f;
    tb::attn_unit<8, 0, true>(tid_, Qw, Kh, Vh, n / 64, Gp, Ow, (char*)(unsigned char*)F.lds, 0, nullptr, 0, 0.f, 0.f, kbA, 0.f);
}

struct HookC {
    LAS const float* tab;
    int qw;
    int r32, hi; float bl, br;
    __device__ __forceinline__ bool skip(int) const { return false; }
    __device__ __forceinline__ float cbias(int t) const {
        const int maxrel = 64 * t + 63 - qw, minrel = 64 * t - qw - 31;
        return (maxrel <= -91) ? bl : ((minrel >= 91) ? br : 0.f);
    }
    __device__ __forceinline__ void apply(f32x16& p0, f32x16& p1, int t) const {
        const int maxrel = 64 * t + 63 - qw, minrel = 64 * t - qw - 31;
        if (maxrel > -91 && minrel < 91) { LAS const float* tp = tab + (320 + 64 * t - qw - r32 + 4 * hi);
#pragma unroll
            for (int r = 0; r < 16; ++r) { const int kk = (r & 3) + 8 * (r >> 2); p0[r] += tp[kk]; p1[r] += tp[kk + 32]; } }
    }
};
__device__ __forceinline__ void unit_C(Frame& F, int s, int layer, int bh, int qb) {
    const int n = s ? 2048 : 8192; const int b = bh >> 2, h = bh & 3; int tid_ = F.tid; asm volatile("" : "+v"(tid_)); const int lane = tid_ & 63, r32 = lane & 31, hi = lane >> 5, wid = __builtin_amdgcn_readfirstlane(tid_ >> 6);
    const size_t rowbase = (size_t)b * n; const int q0 = qb * 256; const int qw = q0 + wid * 32;
    LAS float* tab = (LAS float*)(F.lds + fa::L_TAB);
    for (int i = tid_; i < 641; i += 512) tab[i] = F.TAB[T_C + h * 641 + i];
    asm volatile("s_waitcnt vmcnt(0) lgkmcnt(0)\n\ts_barrier" ::: "memory");
    const bf16_t* qptr = F.PROJ + (rowbase + qw + r32) * INW + C_CQ + h * 64;
    KVLinear kv{F.PROJ + rowbase * INW + C_CK + h * 64, F.PROJ + rowbase * INW + C_CV + h * 64};
    f32x16 o1[2], o2[2];
    HookC hk{tab, qw, r32, hi, tab[320 - 100], tab[320 + 100]};
    fa::flash_core_dual_sp(F.lds, qptr, kv, n / 64, hk, o1, o2, tid_);
    const float lam = F.TAB[T_LAM + layer]; const float li = layer == 0 ? 0.2f : 0.35550907f; const float* sg = F.in[13] + layer * 64;
#pragma unroll
    for (int r = 0; r < 16; ++r) { o1[0][r] -= lam * o2[0][r]; o1[1][r] -= lam * o2[1][r]; }
    LAS float* stg = (LAS float*)(F.lds + fa::L_OST) + wid * 2048;
    fa::stage_o(stg, o1, r32, hi);
#pragma unroll
    for (int i = 0; i < 4; ++i) { const int row = i * 8 + (lane >> 3), ch = lane & 7;
        const f32x4 a0 = *(LAS const f32x4*)(stg + row * 64 + ch * 8), a1 = *(LAS const f32x4*)(stg + row * 64 + ch * 8 + 4);
        const float v[8] = {a0.x, a0.y, a0.z, a0.w, a1.x, a1.y, a1.z, a1.w};
        float ss = 0.f;
#pragma unroll
        for (int k = 0; k < 8; ++k) ss += v[k] * v[k];
        ss += __shfl_xor(ss, 1); ss += __shfl_xor(ss, 2); ss += __shfl_xor(ss, 4);
        const float sc = (1.f - li) / sqrtf(ss * (1.f / 64.f) + RMS_EPS);
        const size_t lrow = rowbase + qw + row;
        const u32x4 gw = *(const u32x4*)(F.PROJ + lrow * INW + C_CG + h * 64 + ch * 8);
        const float g[8] = {bflo(gw.x), bfhi(gw.x), bflo(gw.y), bfhi(gw.y), bflo(gw.z), bfhi(gw.z), bflo(gw.w), bfhi(gw.w)};
        float y[8];
#pragma unroll
        for (int k = 0; k < 8; ++k) y[k] = v[k] * sc * sg[ch * 8 + k] * fa::silu(g[k]);
        u32x4 w; w.x = pk2(y[0], y[1]); w.y = pk2(y[2], y[3]); w.z = pk2(y[4], y[5]); w.w = pk2(y[6], y[7]);
        *(u32x4*)(F.XNM + ((size_t)s * RS + lrow) * MIXW + 512 + h * 64 + ch * 8) = w; }
    asm volatile("s_waitcnt lgkmcnt(0)\n\ts_barrier" ::: "memory");
}

__device__ __forceinline__ void unit_Cv(Frame& F, int s, int layer, int bh, int qb) {
    const int n = s ? 2048 : 8192; const int b = bh >> 2, h = bh & 3; int tid_ = F.tid; asm volatile("" : "+v"(tid_)); const int lane = tid_ & 63, r32 = lane & 31, hi = lane >> 5, wid = __builtin_amdgcn_readfirstlane(tid_ >> 6);
    const int map = wid >> 2; const size_t rowbase = (size_t)b * n; const int q0 = qb * 128; const int qw = q0 + (wid & 3) * 32;
    LAS float* tab = (LAS float*)(F.lds + fa::L_TAB);
    for (int i = tid_; i < 641; i += 512) tab[i] = F.TAB[T_C + h * 641 + i];
    asm volatile("s_waitcnt vmcnt(0) lgkmcnt(0)\n\ts_barrier" ::: "memory");
    const bf16_t* qptr = F.PROJ + (rowbase + qw + r32) * INW + C_CQ + h * 64 + map * 32;
    KVLinear kv{F.PROJ + rowbase * INW + C_CK + h * 64, F.PROJ + rowbase * INW + C_CV + h * 64};
    f32x16 o[2]; float mh, lt;
    HookC hk{tab, qw, r32, hi, tab[320 - 100], tab[320 + 100]};
    fa::flash_core_sp<2>(F.lds, qptr, kv, n / 64, hk, map * 4096, o, mh, lt, tid_);
    LAS float* stg = (LAS float*)(F.lds + fa::L_OST) + wid * 2048;
    fa::stage_o(stg, o, r32, hi);
    asm volatile("s_waitcnt lgkmcnt(0)\n\ts_barrier" ::: "memory");
    const float lam = F.TAB[T_LAM + layer]; const float li = layer == 0 ? 0.2f : 0.35550907f; const float* sg = F.in[13] + layer * 64;
    LAS const float* S1 = (LAS const float*)(F.lds + fa::L_OST); LAS const float* S2 = S1 + 4 * 2048;
#pragma unroll
    for (int j = 0; j < 2; ++j) { const int row = 16 * wid + 8 * j + (lane >> 3), ch = lane & 7;
        const int off = (row >> 5) * 2048 + (row & 31) * 64 + ch * 8;
        const f32x4 a0 = *(LAS const f32x4*)(S1 + off), a1 = *(LAS const f32x4*)(S1 + off + 4), b0 = *(LAS const f32x4*)(S2 + off), b1 = *(LAS const f32x4*)(S2 + off + 4);
        float v[8] = {a0.x - lam * b0.x, a0.y - lam * b0.y, a0.z - lam * b0.z, a0.w - lam * b0.w, a1.x - lam * b1.x, a1.y - lam * b1.y, a1.z - lam * b1.z, a1.w - lam * b1.w};
        float ss = 0.f;
#pragma unroll
        for (int k = 0; k < 8; ++k) ss += v[k] * v[k];
        ss += __shfl_xor(ss, 1); ss += __shfl_xor(ss, 2); ss += __shfl_xor(ss, 4);
        const float sc = (1.f - li) / sqrtf(ss * (1.f / 64.f) + RMS_EPS);
        const size_t lrow = rowbase + q0 + row;
        const u32x4 gw = *(const u32x4*)(F.PROJ + lrow * INW + C_CG + h * 64 + ch * 8);
        const float g[8] = {bflo(gw.x), bfhi(gw.x), bflo(gw.y), bfhi(gw.y), bflo(gw.z), bfhi(gw.z), bflo(gw.w), bfhi(gw.w)};
        float y[8];
#pragma unroll
        for (int k = 0; k < 8; ++k) y[k] = v[k] * sc * sg[ch * 8 + k] * fa::silu(g[k]);
        u32x4 w; w.x = pk2(y[0], y[1]); w.y = pk2(y[2], y[3]); w.z = pk2(y[4], y[5]); w.w = pk2(y[6], y[7]);
        *(u32x4*)(F.XNM + ((size_t)s * RS + lrow) * MIXW + 512 + h * 64 + ch * 8) = w; }
    asm volatile("s_waitcnt lgkmcnt(0)\n\ts_barrier" ::: "memory");
}

__device__ __forceinline__ void unit_Ct(Frame& F, int s, int layer, int bh, int qb) {
    const int n = s ? 2048 : 8192; const int b = bh >> 2, h = bh & 3;
    int tid_ = F.tid; asm volatile("" : "+v"(tid_)); const int lane = tid_ & 63, wid = __builtin_amdgcn_readfirstlane(tid_ >> 6);
    const int cmap = wid >> 2; const size_t rowbase = (size_t)b * n; const int q0 = qb * 128; const int qw = q0 + (wid & 3) * 32;
    LAS float* tab = (LAS float*)(F.lds + LT_C) + h * 641;
    const bf16_t* Qw = F.PROJ + (rowbase + qw) * INW + C_CQ + h * 64 + cmap * 32;
    const bf16_t* Kh = F.PROJ + rowbase * INW + C_CK + h * 64; const bf16_t* Vh = F.PROJ + rowbase * INW + C_CV + h * 64;
    const float kbC = __uint_as_float(((const unsigned*)(F.ws + WS_CTL))[CW_KMAXC + (layer * 2 + s) * 8 + h * 2 + cmap]) * 1.01f;
    tb::attn_unit<8, 1, true>(tid_, Qw, Kh, Vh, n / 64, nullptr, nullptr, (char*)(unsigned char*)F.lds, cmap, tab, qw, tab[320 - 100], tab[320 + 100], kbC, F.TAB[T_BMAX + h]);
    const float lam = F.TAB[T_LAM + layer]; const float li = layer == 0 ? 0.2f : 0.35550907f; const float* sg = F.in[13] + layer * 64;
    LAS const bf16_t* S1 = (LAS const bf16_t*)(F.lds + tb::LDS_OST); LAS const bf16_t* S2 = S1 + 4 * 2048;
#pragma unroll
    for (int j = 0; j < 2; ++j) { const int row = 16 * wid + 8 * j + (lane >> 3), ch = lane & 7;
        const int off = (row >> 5) * 2048 + (row & 31) * 64 + ch * 8;
        const u32x4 a = *(LAS const u32x4*)(S1 + off), c = *(LAS const u32x4*)(S2 + off);
        float v[8] = {bflo(a.x) - lam * bflo(c.x), bfhi(a.x) - lam * bfhi(c.x), bflo(a.y) - lam * bflo(c.y), bfhi(a.y) - lam * bfhi(c.y),
                      bflo(a.z) - lam * bflo(c.z), bfhi(a.z) - lam * bfhi(c.z), bflo(a.w) - lam * bflo(c.w), bfhi(a.w) - lam * bfhi(c.w)};
        float ss = 0.f;
#pragma unroll
        for (int k = 0; k < 8; ++k) ss += v[k] * v[k];
        ss += __shfl_xor(ss, 1); ss += __shfl_xor(ss, 2); ss += __shfl_xor(ss, 4);
        const float sc = (1.f - li) / sqrtf(ss * (1.f / 64.f) + RMS_EPS);
        const size_t lrow = rowbase + q0 + row;
        const u32x4 gw = *(const u32x4*)(F.PROJ + lrow * INW + C_CG + h * 64 + ch * 8);
        const float g[8] = {bflo(gw.x), bfhi(gw.x), bflo(gw.y), bfhi(gw.y), bflo(gw.z), bfhi(gw.z), bflo(gw.w), bfhi(gw.w)};
        float y[8];
#pragma unroll
        for (int k = 0; k < 8; ++k) y[k] = v[k] * sc * sg[ch * 8 + k] * fa::silu(g[k]);
        u32x4 w; w.x = pk2(y[0], y[1]); w.y = pk2(y[2], y[3]); w.z = pk2(y[4], y[5]); w.w = pk2(y[6], y[7]);
        *(u32x4*)(F.XNM + ((size_t)s * RS + lrow) * MIXW + 512 + h * 64 + ch * 8) = w; }
    asm volatile("s_waitcnt lgkmcnt(0)\n\ts_barrier" ::: "memory");
}

struct HookB {
    LAS const float* tab;
    int qw, L, kb0;
    int r32, hi;
    __device__ __forceinline__ bool skip(int t) const { const int kb = kb0 + 64 * t; return (qw >= L) || (kb + 63 < qw - 64) || (kb > qw + 95); }
    __device__ __forceinline__ void apply(f32x16& p0, f32x16& p1, int t) const {
        LAS const float* tp = tab + (kb0 + 64 * t + 4 * hi - (qw + r32) + 158);
#pragma unroll
        for (int r = 0; r < 16; ++r) { const int kk = (r & 3) + 8 * (r >> 2); p0[r] += tp[kk]; p1[r] += tp[kk + 32]; }
    }
};
__device__ __forceinline__ void unit_B(Frame& F, int s, int layer, int g, int bh, int res, int qblk, int pack) {
    const int n = s ? 2048 : 8192; const int b = bh >> 2, h = bh & 3; int tid_ = F.tid; asm volatile("" : "+v"(tid_)); const int lane = tid_ & 63, r32 = lane & 31, hi = lane >> 5, wid = __builtin_amdgcn_readfirstlane(tid_ >> 6);
    const int d = (g == 0) ? 1 : (g == 1 ? 4 : 16); const int L = n / d; const size_t rowbase = (size_t)b * n;
    const int wg2 = pack ? (wid >> 2) : 0;
    const int q0 = qblk * 256, qw = pack ? (wid & 3) * 32 : q0 + wid * 32;
    int tlo = (q0 - 64) >> 6; if (tlo < 0) tlo = 0; int thi = (q0 + 319) >> 6; const int tmax = (L - 1) >> 6; if (thi > tmax) thi = tmax;
    const int NT = thi - tlo + 1;
    LAS float* tab = (LAS float*)(F.lds + LT_B) + (g * 4 + h) * 320;
    int qidx = qw + r32; const bool active = qw < L; if (qidx >= L) qidx = L - 1;
    const size_t qrow = rowbase + res + wg2 + (size_t)d * qidx;
    const bf16_t* qptr = F.PROJ + qrow * INW + C_BQ + h * 64;
    const size_t krow0 = rowbase + res + (size_t)d * 64 * tlo;
    KVStrided kv{F.PROJ + krow0 * INW + C_BK + h * 64, F.PROJ + krow0 * INW + C_BV + h * 64, d, NT};
    f32x16 o[2]; float mh, lt;
    LAS const float* bk = (LAS const float*)(F.lds + LT_BK);
    fa::flash_core_all3(F.lds, qptr, kv, pack ? 2 * NT : NT, NT, wg2 * NT, tab, qw, 64 * tlo, active, bk[h], bk[4 + h], o, mh, lt, tid_);
    LAS float* stg = (LAS float*)(F.lds + fa::L_AOST) + wid * 2048;
    fa::stage_o(stg, o, r32, hi);
    if (active) {
        bf16_t* BP = F.BPART + (size_t)g * RS * 256;
#pragma unroll
        for (int i = 0; i < 4; ++i) { const int row = i * 8 + (lane >> 3), ch = lane & 7;
            const f32x4 a = *(LAS const f32x4*)(stg + row * 64 + ch * 8), c = *(LAS const f32x4*)(stg + row * 64 + ch * 8 + 4);
            u32x4 w; w.x = pk2(a.x, a.y); w.y = pk2(a.z, a.w); w.z = pk2(c.x, c.y); w.w = pk2(c.z, c.w);
            const size_t orow = rowbase + res + wg2 + (size_t)d * (qw + row);
            *(u32x4*)(BP + orow * 256 + h * 64 + ch * 8) = w; }
        if (hi == 0) F.BLSE[((size_t)g * RS + qrow) * 4 + h] = mh + __log2f(lt);
    }
    asm volatile("s_waitcnt lgkmcnt(0)\n\ts_barrier" ::: "memory");
}
__device__ __forceinline__ void phase_bcomb(Frame& F, int s) {
    const int gw = F.vcu * 8 + F.wave, NGW = F.G * 8; const int lane = F.lane, h = lane >> 4, c4 = (lane & 15) * 4;
    constexpr int NB = 4;
    for (int lr0 = gw; lr0 < RS; lr0 += NB * NGW) {
        float ls[NB][3]; u32x2 pv_[NB][3]; u32x2 gt[NB];
#pragma unroll
        for (int k = 0; k < NB; ++k) { int lr = lr0 + k * NGW; if (lr >= RS) lr = RS - 1;
#pragma unroll
            for (int g = 0; g < 3; ++g) { ls[k][g] = F.BLSE[((size_t)g * RS + lr) * 4 + h]; pv_[k][g] = *(const u32x2*)(F.BPART + ((size_t)g * RS + lr) * 256 + h * 64 + c4); }
            gt[k] = *(const u32x2*)(F.PROJ + (size_t)lr * INW + C_BG + h * 64 + c4); }
#pragma unroll
        for (int k = 0; k < NB; ++k) { const int lr = lr0 + k * NGW; if (lr < RS) {
            const float m = fmaxf(ls[k][0], fmaxf(ls[k][1], ls[k][2]));
            float w[3], ws_ = 0.f;
#pragma unroll
            for (int g = 0; g < 3; ++g) { w[g] = exp2f(ls[k][g] - m); ws_ += w[g]; }
            const float inv = 1.f / ws_; float y[4] = {0.f, 0.f, 0.f, 0.f};
#pragma unroll
            for (int g = 0; g < 3; ++g) { const float wg = w[g] * inv; y[0] += wg * bflo(pv_[k][g].x); y[1] += wg * bfhi(pv_[k][g].x); y[2] += wg * bflo(pv_[k][g].y); y[3] += wg * bfhi(pv_[k][g].y); }
            u32x2 ow; ow.x = pk2(y[0] * fa::silu(bflo(gt[k].x)), y[1] * fa::silu(bfhi(gt[k].x))); ow.y = pk2(y[2] * fa::silu(bflo(gt[k].y)), y[3] * fa::silu(bfhi(gt[k].y)));
            *(u32x2*)(F.XNM + ((size_t)s * RS + lr) * MIXW + 256 + h * 64 + c4) = ow; } }
    }
}

struct HookD {
    LAS const float* tab;
    int R, kr_lo, r0, c, cs, hi;
    __device__ __forceinline__ bool skip(int t) const { const int kr = kr_lo + t; return kr < r0 || kr > r0 + 7; }
    __device__ __forceinline__ void apply(f32x16& p0, f32x16& p1, int t) const {
        const int kr = kr_lo + t; LAS const float* tp = tab + (kr - R + 7) * 31 + 15 - c + 4 * hi;
#pragma unroll
        for (int r = 0; r < 16; ++r) { const int kk = (r & 3) + 8 * (r >> 2);
            { const int kc = kk + 4 * hi; const bool ok = (unsigned)(kc - cs) < 16u; const float bv = tp[ok ? kk : (c - 4 * hi)]; p0[r] = ok ? p0[r] + bv : -INFINITY; }
            { const int kc = kk + 32 + 4 * hi; const bool ok = (unsigned)(kc - cs) < 16u; const float bv = tp[ok ? kk + 32 : (c - 4 * hi)]; p1[r] = ok ? p1[r] + bv : -INFINITY; } }
    }
};
__device__ __forceinline__ int d_r0(int R, int rows) { int v = R - 4; if (v < 0) v = 0; if (v > rows - 8) v = rows - 8; return v; }
__device__ __forceinline__ void unit_D(Frame& F, int s, int layer, int bh, int u4) {
    const int n = s ? 2048 : 8192; const int rows = n >> 6; const int b = bh >> 2, h = bh & 3; int tid_ = F.tid; asm volatile("" : "+v"(tid_)); const int lane = tid_ & 63, r32 = lane & 31, wid = __builtin_amdgcn_readfirstlane(tid_ >> 6);
    const size_t rowbase = (size_t)b * n; const int R0 = 4 * u4;
    const int kr_lo = d_r0(R0, rows), kr_hi = d_r0(R0 + 3, rows) + 7; const int NT = kr_hi - kr_lo + 1;
    const int R = R0 + (wid >> 1), c = 32 * (wid & 1) + r32; const int r0w = d_r0(R, rows);
    const size_t qrow = rowbase + 64 * R + c;
    const bf16_t* qptr = F.PROJ + qrow * INW + C_DQ + h * 64;
    const size_t krow0 = rowbase + (size_t)64 * kr_lo;
    KVLinear kv{F.PROJ + krow0 * INW + C_DK + h * 64, F.PROJ + krow0 * INW + C_DV + h * 64};
    LAS const float* bk = (LAS const float*)(F.lds + LT_BK);
    f32x16 o[2];
    fa::flash_core_d(F.lds, qptr, kv, NT, r0w - kr_lo, r0w + 7 - kr_lo, kr_lo - R + 7, c, bk[8 + h], bk[12 + h], F.in[14] + ((size_t)layer * 4 + h) * 465, o, tid_);
    LAS float* stg = (LAS float*)(F.lds + fa::L_OST) + wid * 2048;
    fa::stage_o(stg, o, r32, lane >> 5);
    const size_t lrow0 = rowbase + 64 * R + 32 * (wid & 1);
    store_gated(F, stg, lrow0, (size_t)s * RS + lrow0, C_DG + h * 64, 768 + h * 64, lane);
    asm volatile("s_waitcnt lgkmcnt(0)\n\ts_barrier" ::: "memory");
}

__device__ __forceinline__ void phase_mixers(Frame& F, int s, int layer) {
    const int G = F.G, v = F.vcu;
    const int sh = s ? 3 : 5;
    unsigned* c_prep = (unsigned*)(F.ws + WS_CTL) + CW_SPLIT + 64 * (2 * (layer * 2 + s));
    unsigned* c_b = c_prep + 64;
    unsigned* c_pb = (unsigned*)(F.ws + WS_CTL) + CW_SPLIT + 64 * 8 + 64 * (layer * 2 + s);
#ifndef UN_MASK
#define UN_MASK 0xF
#endif
    { LAS float* tc = (LAS float*)(F.lds + LT_C); LAS float* tbb = (LAS float*)(F.lds + LT_B);
      { LAS float* tr_ = (LAS float*)(F.lds + LT_ROPE); for (int i = F.tid; i < 128 * 16 * 2; i += 512) tr_[i] = F.TAB[T_ROPE + i]; }
      for (int i = F.tid; i < 12 * 320; i += 512) tbb[i] = F.TAB[T_B + i];
      for (int i = F.tid; i < 4 * 641; i += 512) tc[i] = F.TAB[T_C + i];
      asm volatile("s_waitcnt vmcnt(0) lgkmcnt(0)\n\ts_barrier" ::: "memory"); }
    phase_prepB(F, s, layer);
    split_arrive(c_pb);
    phase_prep(F, s, layer);
    split_arrive(c_prep);
    split_wait(c_pb, (unsigned)G);
    { LAS float* bk = (LAS float*)(F.lds + LT_BK);
      if (F.tid < 4) bk[F.tid] = __uint_as_float(((const unsigned*)(F.ws + WS_CTL))[CW_KMAXB + (layer * 2 + s) * 4 + F.tid]) * 1.01f;
      else if (F.tid < 8) bk[F.tid] = F.TAB[T_BMAXB + F.tid - 4];
      else if (F.tid < 12) bk[F.tid] = __uint_as_float(((const unsigned*)(F.ws + WS_CTL))[CW_KMAXD + (layer * 2 + s) * 4 + F.tid - 8]) * 1.01f;
      else if (F.tid < 16) bk[F.tid] = F.TAB[T_BMAXD + layer * 4 + F.tid - 12];
      asm volatile("s_waitcnt vmcnt(0) lgkmcnt(0)\n\ts_barrier" ::: "memory"); }
    if (UN_MASK & 4) { const int nB = 768;
        for (int u = v; u < nB; u += G) {
            int g, bh, res, qblk, pack = 0;
            if (s == 0) { g = u >> 8; const int rest = u & 255, k = rest & 31; bh = rest >> 5; const int lper = (g == 0) ? 5 : (g == 1 ? 3 : 1); res = k >> lper; qblk = k & ((1 << lper) - 1); }
            else if (u < 256) { g = 0; bh = u >> 3; res = 0; qblk = u & 7; }
            else if (u < 512) { const int r = u - 256; g = 1; bh = r >> 3; res = (r & 7) >> 1; qblk = r & 1; }
            else { const int r = u - 512; g = 2; bh = r >> 3; res = (r & 7) * 2; qblk = 0; pack = 1; }
            unit_B(F, s, layer, g, bh, res, qblk, pack);
        } }
    split_arrive(c_b);
    if (UN_MASK & 8) for (int u = v; u < 256; u += G) unit_D(F, s, layer, u >> sh, u & ((1 << sh) - 1));
    split_wait(c_prep, (unsigned)G);
    if (UN_MASK & 2) for (int u = v; u < 512; u += G) unit_Ct(F, s, layer, u >> (sh + 1), u & ((2 << sh) - 1));
    if (UN_MASK & 1) for (int u = v; u < 256; u += G) unit_A(F, s, layer, u >> sh, u & ((1 << sh) - 1));
    split_wait(c_b, (unsigned)G);
    phase_bcomb(F, s);
}

constexpr int N_PHASES = 11;
#ifndef PH_MASK
#define PH_MASK 0xFF
#endif
#define PH_ON(b) ((PH_MASK >> (b)) & 1)
struct Args { const float* in[15]; float* out; unsigned char* ws; int ph_lo, ph_hi; };
__global__ void __launch_bounds__(512, 2) enc_fwd(Args args) {
    extern __shared__ __attribute__((aligned(16))) unsigned char lds_raw[];
    Frame F;
    F.lds = (LAS unsigned char*)lds_raw;
    F.tid = threadIdx.x; F.lane = F.tid & 63; F.wave = __builtin_amdgcn_readfirstlane(F.tid >> 6);
    F.G = gridDim.x; { const int bx = blockIdx.x; F.vcu = (F.G % 8 == 0) ? (bx % 8) * (F.G / 8) + bx / 8 : bx; }
    typedef __attribute__((address_space(4))) const unsigned char* kaptr_t;
    unsigned char* ws0 = args.ws; const int wave0 = __builtin_amdgcn_readfirstlane((int)threadIdx.x >> 6);
    volatile LAS unsigned* MISC = (volatile LAS unsigned*)(F.lds + MISC_OFF);
    for (int u = F.tid; u < (LDS_BYTES - LDSCTL_OFF) / 4; u += 512) ((LAS unsigned*)(F.lds + LDSCTL_OFF))[u] = 0u;
    __syncthreads();
    const bool multi = (args.ph_hi - args.ph_lo) > 1;
    XcdBarrier bar; bar.bar = (unsigned*)(ws0 + WS_CTL) + CW_BAR; bar.x = 0; bar.st = nullptr;
    if (multi) bar = xcd_barrier_post((unsigned*)(ws0 + WS_CTL) + CW_BAR, MISC + 8);

    for (int p = args.ph_lo; p < args.ph_hi; ++p) {
        { unsigned z_; asm volatile("s_mov_b32 %0, 0" : "=s"(z_)); int t_ = (wave0 << 6) | (int)__builtin_amdgcn_mbcnt_hi(~0u, __builtin_amdgcn_mbcnt_lo(~0u, z_)); asm volatile("" : "+v"(t_)); F.tid = t_; F.lane = t_ & 63; F.wave = __builtin_amdgcn_readfirstlane(t_ >> 6); }
        { kaptr_t ka = (kaptr_t)__builtin_amdgcn_kernarg_segment_ptr(); asm volatile("" : "+s"(ka));
          F.in = (const float* const __attribute__((address_space(4)))*)ka;
          unsigned char* ws_ = *(unsigned char* const __attribute__((address_space(4)))*)(ka + 16 * 8); float* out_ = *(float* const __attribute__((address_space(4)))*)(ka + 15 * 8); F.out = out_; F.ws = ws_;
          F.WIN = (bf16_t*)(ws_ + WS_WIN); F.WOUT = (bf16_t*)(ws_ + WS_WOUT); F.XNM = (bf16_t*)(ws_ + WS_XNM); F.PROJ = (bf16_t*)(ws_ + WS_PROJ);
          F.BPART = (bf16_t*)(ws_ + WS_BPART); F.BLSE = (float*)(ws_ + WS_BLSE); F.TAB = (float*)(ws_ + WS_TAB); }
        int kind, layer = 0, st = 0;
        if (p == 0) kind = 0;
        else { layer = (p - 1) / 5; const int r = (p - 1) % 5; if (r == 4) kind = 4; else { kind = 2 + (r & 1); st = r >> 1; } }
        if (kind == 0) { phase_prologue(F); phase_xn(F, 0); }
        else if (kind == 4) {
            pg8::Gemm g{F.XNM, F.WOUT + (size_t)layer * DMODEL * MIXW, MTOT, DMODEL, MIXW};
            pg8::PanelRms st_{(float*)(F.ws + WS_XSLOT), (unsigned*)(F.ws + WS_CTL) + CW_PANEL + layer * 128 * 64, RMS_EPS};
            for (int rd = 0; rd < 2; ++rd) {
                pg8::RoundOrder S; S.so.init(MTOT, DMODEL, F.G, (int)blockIdx.x); S.round = rd;
                if (layer == 0) { pg8::EpiRmsOut<false> E{F.in[0], F.in[1], RS, F.out, F.XNM, nullptr, DMODEL, st_};
                    pg8::gemm_phase<pg8::EpiRmsOut<false>, pg8::RoundOrder, false, true>(F.lds, g, S, E, F.tid); }
                else { pg8::EpiRmsOut<true> E{F.out, F.out + (size_t)RS * DMODEL, RS, F.out, nullptr, F.in[5], DMODEL, st_};
                    pg8::gemm_phase<pg8::EpiRmsOut<true>, pg8::RoundOrder, false, true>(F.lds, g, S, E, F.tid); }
            }
        } else if (kind == 2) {
            pg8::Gemm g{F.XNM + (size_t)st * RS * DMODEL, F.WIN + (size_t)layer * INW * DMODEL, RS, INW, DMODEL}; pg8::StaticOrder S; S.init(RS, INW, F.G, (int)blockIdx.x);
            pg8::EpiBf16 E{F.PROJ, INW};
            pg8::gemm_phase<pg8::EpiBf16, pg8::StaticOrder, true, true>(F.lds, g, S, E, F.tid);
        } else phase_mixers(F, st, layer);
        if (p + 1 < args.ph_hi) xcd_barrier(bar);
    }
}

extern "C" void kernel_launch(void* const* d_in, const int* in_sizes, int n_in, void* d_out, int out_size, void* d_ws, size_t ws_size, hipStream_t stream) {
    static int grid = 0;
    if (grid == 0) {
        if (n_in != 15 || out_size != MTOT * DMODEL || ws_size < WS_END) { fprintf(stderr, "kernel_launch: unexpected shapes (n_in %d out %d ws %zu)\n", n_in, out_size, ws_size); grid = -1; return; }
        int dev = 0, cus = 0, per_cu = 0;
        if (hipGetDevice(&dev) != hipSuccess || hipDeviceGetAttribute(&cus, hipDeviceAttributeMultiprocessorCount, dev) != hipSuccess) { grid = -1; return; }
        if (hipFuncSetAttribute((const void*)enc_fwd, hipFuncAttributeMaxDynamicSharedMemorySize, LDS_BYTES) != hipSuccess) { fprintf(stderr, "kernel_launch: hipFuncSetAttribute failed\n"); grid = -1; return; }
        if (hipOccupancyMaxActiveBlocksPerMultiprocessor(&per_cu, (const void*)enc_fwd, 512, LDS_BYTES) != hipSuccess || per_cu < 1) { fprintf(stderr, "kernel_launch: occupancy query says %d\n", per_cu); per_cu = 1; }
        (void)hipGetLastError();
        grid = cus;
    }
    if (grid < 0) return;
    (void)hipMemsetAsync((char*)d_ws + WS_CTL, 0, CTL_ZERO_BYTES, stream);
    Args a{};
    for (int i = 0; i < 15; ++i) a.in[i] = (const float*)d_in[i];
    a.out = (float*)d_out; a.ws = (unsigned char*)d_ws;
#if MK_ONE_LAUNCH
    a.ph_lo = 0; a.ph_hi = N_PHASES;
    hipLaunchKernelGGL(enc_fwd, dim3(grid), dim3(512), LDS_BYTES, stream, a);
#else
    for (int p = 0; p < N_PHASES; ++p) { a.ph_lo = p; a.ph_hi = p + 1; hipLaunchKernelGGL(enc_fwd, dim3(grid), dim3(512), LDS_BYTES, stream, a); }
#endif
}
```

```cpp
#include <hip/hip_runtime.h>
#include <hip/hip_bf16.h>
#include <cstdio>
#include <cstdint>

#ifndef MK_ONE_LAUNCH
#define MK_ONE_LAUNCH 1
#endif

#define LAS __attribute__((address_space(3)))
#define GAS __attribute__((address_space(1)))
typedef unsigned short bf16_t;
typedef short bf16x8 __attribute__((ext_vector_type(8)));
typedef short s16x4 __attribute__((ext_vector_type(4)));
typedef short v4i16_t __attribute__((ext_vector_type(4)));
typedef float f32x2 __attribute__((ext_vector_type(2)));
typedef float f32x4 __attribute__((ext_vector_type(4)));
typedef float f32x16 __attribute__((ext_vector_type(16)));
typedef unsigned u32x2 __attribute__((ext_vector_type(2)));
typedef unsigned u32x4 __attribute__((ext_vector_type(4)));

constexpr int DMODEL = 1024, INW = 3840, MIXW = 1024, DEPTH = 2;
constexpr int RS = 16384;
constexpr int MTOT = 2 * RS;
constexpr float RMS_EPS = 1e-6f;
constexpr float LOG2E = 1.4426950408889634f;
constexpr int C_AQ = 0, C_AK = 256, C_AV = 384, C_AG = 512, C_BQ = 768, C_BK = 1024, C_BV = 1280, C_BG = 1536;
constexpr int C_CQ = 1792, C_CK = 2048, C_CV = 2304, C_CG = 2560, C_DQ = 2816, C_DK = 3072, C_DV = 3328, C_DG = 3584;

constexpr size_t MiB = 1u << 20;
constexpr size_t WS_CTL = 0, CTL_ZERO_BYTES = 192 * 1024;
constexpr size_t WS_XSLOT = 1 * MiB + 512 * 1024;
constexpr int CW_KMAXD = 40576;
constexpr int CW_KMAXB = 40512;
constexpr int CW_KMAXA = 40000, CW_KMAXC = 40192;
constexpr int CW_PANEL = 16384;
constexpr size_t WS_TAB = 1 * MiB;
constexpr size_t WS_WIN = 2 * MiB;
constexpr size_t WS_WOUT = 17 * MiB;
constexpr size_t WS_XNM = 22 * MiB;
constexpr size_t WS_PROJ = 86 * MiB;
constexpr size_t WS_BPART = 206 * MiB;
constexpr size_t WS_BLSE = 230 * MiB;
constexpr size_t WS_END = 231 * MiB;
constexpr int T_ROPE = 0;
constexpr int T_C = 4096;
constexpr int T_B = T_C + 4 * 641;
constexpr int T_LAM = T_B + 3 * 4 * 320;
constexpr int T_BMAX = T_LAM + 2;
constexpr int T_BMAXB = T_BMAX + 4;
constexpr int T_BMAXD = T_BMAXB + 4;
constexpr int CW_BAR = 1024;

constexpr int RING_BYTES = 131072;
constexpr int LDSCTL_OFF = RING_BYTES, MISC_OFF = LDSCTL_OFF + 320;
constexpr int LDS_BYTES = 163840;
constexpr int LT_ROPE = 0;
constexpr int LT_B = 143 * 1024;
constexpr int LT_C = 132 * 1024;
constexpr int LT_BK = LT_B + 12 * 320 * 4;
static_assert(LT_C + 4 * 641 * 4 <= LT_B && LT_BK + 64 <= LDS_BYTES, "LDS tables");

__device__ __forceinline__ unsigned f2bf(float f) { unsigned u = __builtin_bit_cast(unsigned, f); return (u + 0x7fffu + ((u >> 16) & 1u)) >> 16; }
typedef __bf16 bf16x2_hw __attribute__((ext_vector_type(2)));
__device__ __forceinline__ unsigned pk2(float lo, float hi) { f32x2 v = {lo, hi}; bf16x2_hw b = __builtin_convertvector(v, bf16x2_hw); return __builtin_bit_cast(unsigned, b); }
__device__ __forceinline__ float bf2f(unsigned short b) { return __builtin_bit_cast(float, (unsigned)b << 16); }
__device__ __forceinline__ float bflo(unsigned w) { return __builtin_bit_cast(float, w << 16); }
__device__ __forceinline__ float bfhi(unsigned w) { return __builtin_bit_cast(float, w & 0xffff0000u); }

namespace pg8 {
constexpr int BM = 256, BK = 64, HALF = 128, HTB = HALF * BK * 2, STAGE_BYTES = 8 * HTB, NXCD = 8, WGM = 8;
__host__ __device__ __forceinline__ int lds_byte(int r, int c) { const int st = (r >> 4) * 2 + (c >> 5), rr = r & 15, cc = c & 31, ob = rr * 64 + cc * 2; return st * 1024 + (ob ^ (((ob >> 9) & 1) << 5)); }
__host__ __device__ __forceinline__ void stage_rc(int b, int& R, int& C) { const int st = b / 1024, sb = b % 1024, swz = sb ^ (((sb >> 9) & 1) << 5); R = (st >> 1) * 16 + swz / 64; C = (st & 1) * 32 + (swz % 64) / 2; }
__host__ __device__ __forceinline__ int perm32(int rho) { const int n = rho >> 4, i = rho & 15; return 8 * (i >> 2) + 4 * n + (i & 3); }
struct Unit { int pm, pn; };
struct Gemm { const bf16_t* A; const bf16_t* Bt; int M, N, K; };
struct StaticOrder {
    int nM, nN, nwg, G, c;
    __host__ __device__ void init(int M, int N, int G_, int c_) { nM = M / BM; nN = N / BM; nwg = nM * nN; G = G_; c = c_; }
    __host__ __device__ bool next(int i, Unit& u) const {
        const long L = (long)i * G + c; if (L >= nwg) return false;
        int wgid = (int)L; { const int q = nwg / NXCD, r = nwg % NXCD, xcd = wgid % NXCD, off = wgid / NXCD; wgid = (xcd < r ? xcd * (q + 1) : r * (q + 1) + (xcd - r) * q) + off; }
        const int nig = WGM * nN, gid = wgid / nig, fm = gid * WGM, gsz = (nM - fm) < WGM ? (nM - fm) : WGM;
        u.pm = fm + ((wgid % nig) % gsz); u.pn = (wgid % nig) / gsz; return true;
    }
    __device__ __forceinline__ void a_ready(const Unit&) const {}
    __device__ __forceinline__ void done(const Unit&) const {}
};
__device__ __forceinline__ unsigned cvt_pk_bf16(float lo, float hi) { unsigned r; asm volatile("v_cvt_pk_bf16_f32 %0, %1, %2" : "=v"(r) : "v"(lo), "v"(hi)); return r; }

struct EpiBf16 {
    static constexpr bool PERM = true, AFTER_DRAIN = false;
    bf16_t* O; int ldc;
    __device__ __forceinline__ void operator()(const f32x4 (&acc)[2][2][4][2], const Unit& u, int wr, int wc, int fr, int fq) const {
        const int row0 = u.pm * BM + wr * 64 + fr; const int col0 = u.pn * BM + wc * 32 + 8 * fq;
#pragma unroll
        for (int ai = 0; ai < 2; ++ai)
#pragma unroll
            for (int m = 0; m < 4; ++m) { bf16_t* rowp = O + (size_t)(row0 + ai * HALF + m * 16) * ldc + col0;
#pragma unroll
                for (int bj = 0; bj < 2; ++bj) { const f32x4 v0 = acc[ai][bj][m][0], v1 = acc[ai][bj][m][1];
                    u32x4 w; w.x = cvt_pk_bf16(v0[0], v0[1]); w.y = cvt_pk_bf16(v0[2], v0[3]); w.z = cvt_pk_bf16(v1[0], v1[1]); w.w = cvt_pk_bf16(v1[2], v1[3]);
                    *(u32x4*)(rowp + bj * HALF) = w; } }
    }
};
struct EpiResF32 {
    static constexpr bool PERM = false, AFTER_DRAIN = false;
    const float* base0; const float* base1; int split_row; float* out; int ldc;
    __device__ __forceinline__ void operator()(const f32x4 (&acc)[2][2][4][2], const Unit& u, int wr, int wc, int fr, int fq) const {
        const int col0 = u.pn * BM + wc * 32 + 4 * fq;
#pragma unroll
        for (int ai = 0; ai < 2; ++ai)
#pragma unroll
            for (int m = 0; m < 4; ++m) { const int r = u.pm * BM + ai * HALF + wr * 64 + m * 16 + fr;
                const float* b = (r < split_row) ? base0 + (size_t)r * ldc : base1 + (size_t)(r - split_row) * ldc;
                float* o = out + (size_t)r * ldc;
#pragma unroll
                for (int bj = 0; bj < 2; ++bj)
#pragma unroll
                    for (int n = 0; n < 2; ++n) { const int off = col0 + bj * HALF + n * 16; const f32x4 bs = *(const f32x4*)(b + off); *(f32x4*)(o + off) = bs + acc[ai][bj][m][n]; } }
    }
};

struct PanelRms {
    float* xbuf; unsigned* cnt; float eps;
    __device__ __forceinline__ void run(const f32x4 (&v)[2][2][4][2], const Unit& u, int wr, int wc, int fr, int fq, LAS unsigned char* lds, int wid, int lane) const {
        LAS float* P = (LAS float*)lds;
        LAS float* S = (LAS float*)(lds + 8192);
        LAS unsigned* flag = (LAS unsigned*)(lds + 8192 + 2048);
#pragma unroll
        for (int ai = 0; ai < 2; ++ai)
#pragma unroll
            for (int m = 0; m < 4; ++m) { float q = 0.f;
#pragma unroll
                for (int bj = 0; bj < 2; ++bj)
#pragma unroll
                    for (int n = 0; n < 2; ++n) { const f32x4 x = v[ai][bj][m][n]; q += (x[0] * x[0] + x[1] * x[1]) + (x[2] * x[2] + x[3] * x[3]); }
                q += __shfl_xor(q, 16); q += __shfl_xor(q, 32);
                if (fq == 0) P[(ai * HALF + wr * 64 + m * 16 + fr) * 4 + wc] = q; }
        asm volatile("s_waitcnt lgkmcnt(0)" ::: "memory"); __builtin_amdgcn_s_barrier(); asm volatile("" ::: "memory");
        const int row = wid * 32 + (lane & 31);
        if (lane < 32) { const float t = (P[row * 4 + 0] + P[row * 4 + 1]) + (P[row * 4 + 2] + P[row * 4 + 3]);
            __hip_atomic_store(xbuf + ((size_t)(u.pm * BM + row) * 4 + u.pn), t, __ATOMIC_RELAXED, __HIP_MEMORY_SCOPE_AGENT); }
        asm volatile("s_waitcnt vmcnt(0)" ::: "memory");
        if (lane == 0) __hip_atomic_fetch_add(cnt + 64 * u.pm, 1u, __ATOMIC_RELAXED, __HIP_MEMORY_SCOPE_AGENT);
        if (wid == 0) {
            unsigned sp = 0u;
            for (;;) { if ((unsigned)__builtin_amdgcn_readfirstlane(__hip_atomic_load(cnt + 64 * u.pm, __ATOMIC_RELAXED, __HIP_MEMORY_SCOPE_AGENT)) >= 32u) break;
                __builtin_amdgcn_s_sleep(2); if (++sp > (1u << 22)) break; }
            __builtin_amdgcn_fence(__ATOMIC_ACQUIRE, "agent");
            if (lane == 0) flag[0] = 1u;
        }
        asm volatile("s_waitcnt vmcnt(0) lgkmcnt(0)" ::: "memory"); __builtin_amdgcn_s_barrier(); asm volatile("" ::: "memory");
        if (lane < 32) { const float* sl = xbuf + (size_t)(u.pm * BM + row) * 4; float t = 0.f;
#pragma unroll
            for (int k = 0; k < 4; ++k) t += __hip_atomic_load(sl + k, __ATOMIC_RELAXED, __HIP_MEMORY_SCOPE_AGENT);
            S[row] = 1.0f / sqrtf(t * (1.0f / 1024.0f) + eps); }
        asm volatile("s_waitcnt lgkmcnt(0)" ::: "memory"); __builtin_amdgcn_s_barrier(); asm volatile("" ::: "memory");
    }
};
template <bool FINAL> struct EpiRmsOut {
    static constexpr bool PERM = false, AFTER_DRAIN = true;
    const float* base0; const float* base1; int split_row; float* out; bf16_t* xn; const float* gain; int ldc; PanelRms st;
    __device__ __forceinline__ void fused(f32x4 (&acc)[2][2][4][2], const Unit& u, int wr, int wc, int fr, int fq, LAS unsigned char* lds, int wid, int lane) const {
        const LAS float* S = (const LAS float*)(lds + 8192);
        const int col0 = u.pn * BM + wc * 32 + 4 * fq;
        f32x4 bq[3][2][2];
#define PG8_LDBASE(buf, g_) do { const int ai_ = (g_) >> 2, m_ = (g_) & 3; const int r = u.pm * BM + ai_ * HALF + wr * 64 + m_ * 16 + fr; \
            const float* b = (r < split_row) ? base0 + (size_t)r * ldc : base1 + (size_t)(r - split_row) * ldc; \
            _Pragma("unroll") for (int bj = 0; bj < 2; ++bj) _Pragma("unroll") for (int n = 0; n < 2; ++n) bq[buf][bj][n] = *(const f32x4*)(b + col0 + bj * HALF + n * 16); } while (0)
#define PG8_ADDBASE(buf, g_) do { const int ai_ = (g_) >> 2, m_ = (g_) & 3; \
            _Pragma("unroll") for (int bj = 0; bj < 2; ++bj) _Pragma("unroll") for (int n = 0; n < 2; ++n) acc[ai_][bj][m_][n] += bq[buf][bj][n]; \
            asm volatile("" : "+v"(acc[ai_][0][m_][0]), "+v"(acc[ai_][0][m_][1]), "+v"(acc[ai_][1][m_][0]), "+v"(acc[ai_][1][m_][1])); } while (0)
        PG8_LDBASE(0, 0); PG8_LDBASE(1, 1); asm volatile("" ::: "memory");
        PG8_LDBASE(2, 2); asm volatile("" ::: "memory"); PG8_ADDBASE(0, 0);
        PG8_LDBASE(0, 3); asm volatile("" ::: "memory"); PG8_ADDBASE(1, 1);
        PG8_LDBASE(1, 4); asm volatile("" ::: "memory"); PG8_ADDBASE(2, 2);
        PG8_LDBASE(2, 5); asm volatile("" ::: "memory"); PG8_ADDBASE(0, 3);
        PG8_LDBASE(0, 6); asm volatile("" ::: "memory"); PG8_ADDBASE(1, 4);
        PG8_LDBASE(1, 7); asm volatile("" ::: "memory"); PG8_ADDBASE(2, 5);
        PG8_ADDBASE(0, 6); PG8_ADDBASE(1, 7);
#undef PG8_LDBASE
#undef PG8_ADDBASE
        st.run(acc, u, wr, wc, fr, fq, lds, wid, lane);
#pragma unroll
        for (int ai = 0; ai < 2; ++ai)
#pragma unroll
            for (int m = 0; m < 4; ++m) { const int rl = ai * HALF + wr * 64 + m * 16 + fr; const float rs = S[rl]; const size_t off = (size_t)(u.pm * BM + rl) * ldc + col0;
#pragma unroll
                for (int bj = 0; bj < 2; ++bj)
#pragma unroll
                    for (int n = 0; n < 2; ++n) { const f32x4 x = acc[ai][bj][m][n]; const size_t o_ = off + bj * HALF + n * 16;
                        if (FINAL) { const f32x4 gg = *(const f32x4*)(gain + col0 + bj * HALF + n * 16); *(f32x4*)(out + o_) = x * rs * gg; }
                        else { *(f32x4*)(out + o_) = x; const f32x4 y = x * rs; u32x2 w; w.x = cvt_pk_bf16(y[0], y[1]); w.y = cvt_pk_bf16(y[2], y[3]); *(u32x2*)(xn + o_) = w; } }
                asm volatile("" ::: "memory"); }
        asm volatile("s_waitcnt lgkmcnt(0)" ::: "memory"); __builtin_amdgcn_s_barrier(); asm volatile("" ::: "memory");
    }
};
struct RoundOrder {
    StaticOrder so; int round;
    __device__ __forceinline__ bool next(int i, Unit& u) const { if (i > 0) return false; return so.next(round, u); }
    __device__ __forceinline__ void a_ready(const Unit&) const {}
    __device__ __forceinline__ void done(const Unit&) const {}
};

template <class Epi, class Sched, bool ALIGN_EPI = false, bool SP2 = false>
__device__ __forceinline__ void gemm_phase(LAS unsigned char* lds, const Gemm g, const Sched& S, const Epi& E, const int tid) {
    const int wid = __builtin_amdgcn_readfirstlane(tid >> 6), lane = tid & 63, wr = wid >> 2, wc = wid & 3, fr = lane & 15, fq = lane >> 4;
    const int K = g.K, nt = K / BK;
    unsigned voffA[2], voffB[2];
#pragma unroll
    for (int i = 0; i < 2; ++i) { int R, C; stage_rc(tid * 16 + i * 8192, R, C); const int Rb = Epi::PERM ? ((R & ~31) + perm32(R & 31)) : R;
        voffA[i] = (unsigned)(R * K + C) * 2u; voffB[i] = (unsigned)(Rb * K + C) * 2u; }
    const size_t kstep = (size_t)(BK * 2);
    const size_t hstep = (size_t)HALF * K * 2;
    const size_t tstep = 2 * hstep;
    const unsigned ldsw = (unsigned)wid * 1024u;
    const int aoff = lds_byte(wr * 64 + fr, fq * 8), boff = lds_byte(wc * 32 + fr, fq * 8);
#define PG8_SA(b, h) (((b) * 2 + (h)) * HTB)
#define PG8_SB(b, h) ((4 + (b) * 2 + (h)) * HTB)
#define PG8_STAGE(bufoff, gbase, voff) do { _Pragma("unroll") for (int _i = 0; _i < 2; ++_i) \
        __builtin_amdgcn_global_load_lds((const unsigned*)((const char*)(gbase) + (voff)[_i]), (LAS unsigned*)(lds + (bufoff) + ldsw + _i * 8192), 16, 0, 0); } while (0)
#define PG8_LDA(dst, b, h) do { _Pragma("unroll") for (int m = 0; m < 4; ++m) _Pragma("unroll") for (int k = 0; k < 2; ++k) dst[m][k] = *(const LAS bf16x8*)(lds + PG8_SA(b, h) + aoff + m * 2048 + k * 1024); } while (0)
#define PG8_LDB(dst, b, h) do { _Pragma("unroll") for (int n = 0; n < 2; ++n) _Pragma("unroll") for (int k = 0; k < 2; ++k) dst[n][k] = *(const LAS bf16x8*)(lds + PG8_SB(b, h) + boff + n * 2048 + k * 1024); } while (0)
#define PG8_MMA(ai, bj, At, Bt) do { __builtin_amdgcn_s_setprio(1); _Pragma("unroll") for (int m = 0; m < 4; ++m) _Pragma("unroll") for (int n = 0; n < 2; ++n) _Pragma("unroll") for (int k = 0; k < 2; ++k) \
        acc[ai][bj][m][n] = __builtin_amdgcn_mfma_f32_16x16x32_bf16(Bt[n][k], At[m][k], acc[ai][bj][m][n], 0, 0, 0); __builtin_amdgcn_s_setprio(0); } while (0)
#define PG8_WAIT_V(n) asm volatile("s_waitcnt vmcnt(" #n ")" ::: "memory")
#define PG8_WAIT_L(n) asm volatile("s_waitcnt lgkmcnt(" #n ")" ::: "memory")
#define PG8_BAR __builtin_amdgcn_s_barrier()
#define PG8_SCHED __builtin_amdgcn_sched_barrier(0)
    Unit cur, nxt; int ui = 0;
    if (!S.next(0, cur)) return;
    f32x4 acc[2][2][4][2];
#pragma unroll
    for (int a = 0; a < 2; ++a)
#pragma unroll
        for (int b = 0; b < 2; ++b)
#pragma unroll
            for (int m = 0; m < 4; ++m)
#pragma unroll
                for (int n = 0; n < 2; ++n) acc[a][b][m][n] = (f32x4){0.f, 0.f, 0.f, 0.f};
    bf16x8 At[4][2], B0[2][2], B1[2][2];
    const char* cA = (const char*)g.A + (size_t)cur.pm * tstep; const char* cB = (const char*)g.Bt + (size_t)cur.pn * tstep;
    S.a_ready(cur);
    if constexpr (SP2) {
        PG8_STAGE(PG8_SB(0, 0), cB, voffB); PG8_STAGE(PG8_SB(0, 1), cB + hstep, voffB); PG8_STAGE(PG8_SA(0, 0), cA, voffA); PG8_STAGE(PG8_SA(0, 1), cA + hstep, voffA);
        if (wr == 1) PG8_BAR;
        PG8_WAIT_V(2); PG8_BAR;
        PG8_STAGE(PG8_SB(1, 0), cB + kstep, voffB); PG8_STAGE(PG8_SA(1, 0), cA + kstep, voffA); PG8_STAGE(PG8_SB(1, 1), cB + hstep + kstep, voffB);
        PG8_WAIT_V(6); PG8_BAR;
    } else {
        PG8_STAGE(PG8_SB(0, 0), cB, voffB); PG8_STAGE(PG8_SA(0, 0), cA, voffA); PG8_STAGE(PG8_SB(0, 1), cB + hstep, voffB); PG8_STAGE(PG8_SA(0, 1), cA + hstep, voffA);
        if (wr == 1) PG8_BAR;
        PG8_WAIT_V(4); PG8_BAR;
        PG8_STAGE(PG8_SB(1, 0), cB + kstep, voffB); PG8_STAGE(PG8_SA(1, 0), cA + kstep, voffA); PG8_STAGE(PG8_SB(1, 1), cB + hstep + kstep, voffB);
        PG8_WAIT_V(6); PG8_BAR;
    }
    for (;;) {
        const bool has_next = S.next(ui + 1, nxt);
        const char* nA = has_next ? (const char*)g.A + (size_t)nxt.pm * tstep : cA; const char* nB = has_next ? (const char*)g.Bt + (size_t)nxt.pn * tstep : cB;
        for (int t = 0; t < nt; t += 2) {
            const bool last = (t == nt - 2);
            const char* a1 = cA + (size_t)(t + 1) * kstep;
            const char* a2 = last ? nA : cA + (size_t)(t + 2) * kstep; const char* b2 = last ? nB : cB + (size_t)(t + 2) * kstep;
            const char* a3 = a2 + kstep; const char* b3 = b2 + kstep;
            if (last && has_next) S.a_ready(nxt);
            if constexpr (SP2) {
            PG8_LDB(B0, 0, 0); PG8_LDB(B1, 0, 1); PG8_SCHED; PG8_LDA(At, 0, 0); PG8_STAGE(PG8_SA(1, 1), a1 + hstep, voffA);
            PG8_WAIT_V(8); PG8_WAIT_L(0); PG8_BAR; PG8_MMA(0, 0, At, B0); PG8_MMA(0, 1, At, B1); PG8_BAR; PG8_SCHED;
            PG8_LDA(At, 0, 1); PG8_STAGE(PG8_SB(0, 0), b2, voffB); PG8_STAGE(PG8_SB(0, 1), b2 + hstep, voffB); PG8_STAGE(PG8_SA(0, 0), a2, voffA);
            PG8_WAIT_V(8); PG8_WAIT_L(0); PG8_BAR; PG8_MMA(1, 0, At, B0); PG8_MMA(1, 1, At, B1); PG8_BAR; PG8_SCHED;
            PG8_LDB(B0, 1, 0); PG8_LDB(B1, 1, 1); PG8_SCHED; PG8_LDA(At, 1, 0); PG8_STAGE(PG8_SA(0, 1), a2 + hstep, voffA);
            PG8_WAIT_V(8); PG8_WAIT_L(0); PG8_BAR; PG8_MMA(0, 0, At, B0); PG8_MMA(0, 1, At, B1); PG8_BAR; PG8_SCHED;
            PG8_LDA(At, 1, 1); PG8_STAGE(PG8_SB(1, 0), b3, voffB); PG8_STAGE(PG8_SB(1, 1), b3 + hstep, voffB); PG8_STAGE(PG8_SA(1, 0), a3, voffA);
            PG8_WAIT_V(8); PG8_WAIT_L(0); PG8_BAR; PG8_MMA(1, 0, At, B0); PG8_MMA(1, 1, At, B1); PG8_BAR; PG8_SCHED;
            } else {
            PG8_LDB(B0, 0, 0); PG8_SCHED; PG8_LDA(At, 0, 0); PG8_STAGE(PG8_SA(1, 1), a1 + hstep, voffA);
            PG8_WAIT_L(8); PG8_BAR; PG8_WAIT_L(0); PG8_MMA(0, 0, At, B0); PG8_BAR; PG8_SCHED;
            PG8_LDB(B1, 0, 1); PG8_STAGE(PG8_SB(0, 0), b2, voffB);
            PG8_BAR; PG8_WAIT_L(0); PG8_MMA(0, 1, At, B1); PG8_BAR;
            PG8_LDA(At, 0, 1); PG8_STAGE(PG8_SA(0, 0), a2, voffA);
            PG8_BAR; PG8_WAIT_L(0); PG8_MMA(1, 0, At, B0); PG8_BAR; PG8_SCHED;
            PG8_STAGE(PG8_SB(0, 1), b2 + hstep, voffB);
            PG8_WAIT_V(6); PG8_BAR; PG8_MMA(1, 1, At, B1); PG8_BAR;
            PG8_LDB(B0, 1, 0); PG8_SCHED; PG8_LDA(At, 1, 0); PG8_STAGE(PG8_SA(0, 1), a2 + hstep, voffA);
            PG8_WAIT_L(8); PG8_BAR; PG8_WAIT_L(0); PG8_MMA(0, 0, At, B0); PG8_BAR; PG8_SCHED;
            PG8_LDB(B1, 1, 1); PG8_STAGE(PG8_SB(1, 0), b3, voffB);
            PG8_BAR; PG8_WAIT_L(0); PG8_MMA(0, 1, At, B1); PG8_BAR;
            PG8_LDA(At, 1, 1); PG8_STAGE(PG8_SA(1, 0), a3, voffA);
            PG8_BAR; PG8_WAIT_L(0); PG8_MMA(1, 0, At, B0); PG8_BAR; PG8_SCHED;
            PG8_STAGE(PG8_SB(1, 1), b3 + hstep, voffB);
            PG8_WAIT_V(6); PG8_BAR; PG8_MMA(1, 1, At, B1); PG8_BAR;
            }
        }
        if constexpr (ALIGN_EPI) { if (wr == 0) PG8_BAR; }
        if constexpr (!Epi::AFTER_DRAIN) { E(acc, cur, wr, wc, fr, fq); S.done(cur); }
        if (!has_next) break;
#pragma unroll
        for (int a = 0; a < 2; ++a)
#pragma unroll
            for (int b = 0; b < 2; ++b)
#pragma unroll
                for (int m = 0; m < 4; ++m)
#pragma unroll
                    for (int n = 0; n < 2; ++n) acc[a][b][m][n] = (f32x4){0.f, 0.f, 0.f, 0.f};
        cur = nxt; cA = nA; cB = nB; ++ui;
        if constexpr (ALIGN_EPI) { if (wr == 1) PG8_BAR; }
    }
    PG8_WAIT_V(0);
    if constexpr (!ALIGN_EPI) { if (wr == 0) PG8_BAR; }
    PG8_BAR;
    if constexpr (Epi::AFTER_DRAIN) { E.fused(acc, cur, wr, wc, fr, fq, lds, wid, lane); S.done(cur); }
#undef PG8_SA
#undef PG8_SB
#undef PG8_STAGE
#undef PG8_LDA
#undef PG8_LDB
#undef PG8_MMA
#undef PG8_WAIT_V
#undef PG8_WAIT_L
#undef PG8_BAR
#undef PG8_SCHED
}
}

namespace fa {
constexpr int SLOTB = 8192;
constexpr int L_K = 0, L_V = 3 * SLOTB, L_OST = 6 * SLOTB, L_QST = L_OST, L_WS = 120 * 1024, L_TAB = L_WS + 2048, L_END = L_TAB + 4096;
constexpr int L_AK = 0, L_AV = 6 * SLOTB, L_AOST = 0;
static_assert(L_END <= RING_BYTES, "attention LDS map");
#define SBAR() __builtin_amdgcn_sched_barrier(0)
__device__ __forceinline__ int crow(int r, int hi) { return (r & 3) + 8 * (r >> 2) + 4 * hi; }
__device__ __forceinline__ void glds16(const void* gsrc, unsigned lds_dst) { unsigned keep;
    asm volatile("s_mov_b32 %0, m0\n\ts_mov_b32 m0, %2\n\ts_nop 0\n\tglobal_load_lds_dwordx4 %1, off\n\ts_mov_b32 m0, %0" : "=&s"(keep) : "v"(gsrc), "s"(lds_dst) : "memory"); }
__device__ __forceinline__ void glds16s(const void* sbase, unsigned voff, unsigned lds_dst) { unsigned keep;
    asm volatile("s_mov_b32 %0, m0\n\ts_mov_b32 m0, %3\n\ts_nop 0\n\tglobal_load_lds_dwordx4 %1, %2\n\ts_mov_b32 m0, %0" : "=&s"(keep) : "v"(voff), "s"(sbase), "s"(lds_dst) : "memory"); }
typedef __bf16 bf16x2_t __attribute__((ext_vector_type(2)));
__device__ __forceinline__ unsigned cvtpk_s(float lo, float hi) { f32x2 v = {lo, hi}; bf16x2_t b = __builtin_convertvector(v, bf16x2_t); return __builtin_bit_cast(unsigned, b); }
#define FA_WAIT_BAR(N) asm volatile("s_waitcnt vmcnt(" #N ") lgkmcnt(0)\n\ts_barrier" ::: "memory")

template <int NDQ>
__device__ __forceinline__ void qkt(f32x16& p0, f32x16& p1, LAS const unsigned char* Kslot, const bf16x8* qr, const f32x16& cin, int r32, int hi) {
    LAS const unsigned char* kb = Kslot + hi * 1024 + r32 * 16;
#pragma unroll
    for (int d0 = 0; d0 < NDQ; ++d0) {
        const bf16x8 b0 = *(LAS const bf16x8*)(kb + d0 * 2048);
        const bf16x8 b1 = *(LAS const bf16x8*)(kb + d0 * 2048 + 512);
        if (d0 == 0) { p0 = __builtin_amdgcn_mfma_f32_32x32x16_bf16(b0, qr[0], cin, 0, 0, 0); p1 = __builtin_amdgcn_mfma_f32_32x32x16_bf16(b1, qr[0], cin, 0, 0, 0); }
        else { p0 = __builtin_amdgcn_mfma_f32_32x32x16_bf16(b0, qr[d0], p0, 0, 0, 0); p1 = __builtin_amdgcn_mfma_f32_32x32x16_bf16(b1, qr[d0], p1, 0, 0, 0); } }
}
__device__ __forceinline__ float max3f(float a, float b, float c) { float r; asm("v_max3_f32 %0, %1, %2, %3" : "=v"(r) : "v"(a), "v"(b), "v"(c)); return r; }
__device__ __forceinline__ float max2f(float a, float b) { float r; asm("v_max_f32_e32 %0, %1, %2" : "=v"(r) : "v"(a), "v"(b)); return r; }
__device__ __forceinline__ float rowmax(const f32x16& p0, const f32x16& p1) {
    float a = max3f(p0[0], p0[1], p1[0]), b = max3f(p0[2], p0[3], p1[1]); a = max3f(a, p1[2], p1[3]);
#pragma unroll
    for (int r = 4; r < 16; r += 4) { a = max3f(a, p0[r], p0[r + 1]); b = max3f(b, p0[r + 2], p0[r + 3]); a = max3f(a, p1[r], p1[r + 1]); b = max3f(b, p1[r + 2], p1[r + 3]); }
    const float m = max2f(a, b);
    auto rr = __builtin_amdgcn_permlane32_swap(__float_as_uint(m), __float_as_uint(m), false, false);
    return max2f(__uint_as_float(rr[0]), __uint_as_float(rr[1]));
}
__device__ __forceinline__ void pv(f32x16* o, int vb, bf16x8 pa0, bf16x8 pa1, bf16x8 pa2, bf16x8 pa3) {
#pragma unroll
    for (int d0 = 0; d0 < 2; ++d0) { s16x4 lo[4], hi[4];
#pragma unroll
        for (int ks = 0; ks < 4; ++ks) {
            asm volatile("ds_read_b64_tr_b16 %0,%1 offset:%c2" : "=&v"(lo[ks]) : "v"(vb), "i"(d0 * 4096 + ks * 1024) : "memory");
            asm volatile("ds_read_b64_tr_b16 %0,%1 offset:%c2" : "=&v"(hi[ks]) : "v"(vb), "i"(d0 * 4096 + ks * 1024 + 512) : "memory"); }
        asm volatile("s_waitcnt lgkmcnt(0)" ::: "memory"); SBAR();
#define FA_PK(k) (bf16x8){lo[k][0], lo[k][1], lo[k][2], lo[k][3], hi[k][0], hi[k][1], hi[k][2], hi[k][3]}
        o[d0] = __builtin_amdgcn_mfma_f32_32x32x16_bf16(pa0, FA_PK(0), o[d0], 0, 0, 0);
        o[d0] = __builtin_amdgcn_mfma_f32_32x32x16_bf16(pa1, FA_PK(1), o[d0], 0, 0, 0);
        o[d0] = __builtin_amdgcn_mfma_f32_32x32x16_bf16(pa2, FA_PK(2), o[d0], 0, 0, 0);
        o[d0] = __builtin_amdgcn_mfma_f32_32x32x16_bf16(pa3, FA_PK(3), o[d0], 0, 0, 0);
#undef FA_PK
    }
}

constexpr float THR = 8.0f;
template <int NDQ, class KV, class Hook>
__device__ __forceinline__ void flash_core(LAS unsigned char* shm, const bf16_t* qptr, const KV& kv, int NT, const Hook& hk, int koff, f32x16 (&o)[2], float& mhat_out, float& l_out, const int tid) {
    const int lane = tid & 63, r32 = lane & 31, hi = lane >> 5; const int wid = __builtin_amdgcn_readfirstlane(tid >> 6);
    const unsigned lds0 = (unsigned)(uintptr_t)shm;
    LAS float* wsf = (LAS float*)(shm + L_WS) + wid * 64;
    const unsigned kdst = lds0 + L_K + wid * 1024, vdst = lds0 + L_V + wid * 1024;
    const int vrow_j = 16 * (wid & 3) + (lane >> 2), vcol = (wid >> 2) * 32 + (lane & 3) * 8;
#define FA_DMA(t, slot) do { glds16(kv.kptr((t), lane) + wid * 8, (unsigned)__builtin_amdgcn_readfirstlane(kdst + (slot) * SLOTB)); \
                             glds16(kv.vptr((t), vrow_j) + vcol, (unsigned)__builtin_amdgcn_readfirstlane(vdst + (slot) * SLOTB)); } while (0)
    FA_DMA(0, 0);
    bf16x8 qr[4];
#pragma unroll
    for (int d0 = 0; d0 < 4; ++d0) { if (d0 < NDQ) qr[d0] = *(const bf16x8*)(qptr + d0 * 16 + hi * 8); else qr[d0] = (bf16x8){0, 0, 0, 0, 0, 0, 0, 0}; }
    asm volatile("" : "+v"(qr[0]), "+v"(qr[1]), "+v"(qr[2]), "+v"(qr[3]));
    float mhat = 0.f, l = 0.f; o[0] = f32x16{}; o[1] = f32x16{}; const f32x16 zero16 = f32x16{};
    bool first = true;
    const int vb0 = (int)(lds0 + L_V) + ((lane >> 4) & 1) * 32 + (lane & 3) * 8 + (4 * hi + ((lane & 15) >> 2)) * 64;
    for (int t = 0; t < NT; ++t) {
        const int slot = t & 1;
        if (t + 1 < NT) { FA_DMA(t + 1, slot ^ 1); FA_WAIT_BAR(2); } else { FA_WAIT_BAR(0); }
        if (!hk.skip(t)) {
            f32x16 p0, p1;
            qkt<NDQ>(p0, p1, shm + L_K + slot * SLOTB + koff, qr, zero16, r32, hi);
            hk.apply(p0, p1, t);
            const float rmr = rowmax(p0, p1); const float rm = rmr - mhat;
            if (first) {
                first = false; mhat = (rmr > -1e29f) ? rmr : 0.f;
            } else if (__any(rm > THR)) {
                const float dl = fmaxf(rm, 0.f); mhat += dl;
                const float f = __builtin_amdgcn_exp2f(-dl); l *= f; if (hi == 0) wsf[r32] = f;
                asm volatile("s_waitcnt lgkmcnt(0)" ::: "memory");
#pragma unroll
                for (int r = 0; r < 16; ++r) { const float fr_ = wsf[crow(r, hi)]; o[0][r] *= fr_; o[1][r] *= fr_; }
            }
            float sacc = 0.f, sacc2 = 0.f;
#pragma unroll
            for (int r = 0; r < 16; ++r) { p0[r] = __builtin_amdgcn_exp2f(p0[r] - mhat); p1[r] = __builtin_amdgcn_exp2f(p1[r] - mhat); sacc += p0[r]; sacc2 += p1[r]; }
            l += sacc + sacc2;
            u32x4 pw0, pw1, pw2, pw3;
            pw0 = (u32x4){cvtpk_s(p0[0], p0[1]), cvtpk_s(p0[2], p0[3]), cvtpk_s(p0[4], p0[5]), cvtpk_s(p0[6], p0[7])};
            pw1 = (u32x4){cvtpk_s(p0[8], p0[9]), cvtpk_s(p0[10], p0[11]), cvtpk_s(p0[12], p0[13]), cvtpk_s(p0[14], p0[15])};
            pw2 = (u32x4){cvtpk_s(p1[0], p1[1]), cvtpk_s(p1[2], p1[3]), cvtpk_s(p1[4], p1[5]), cvtpk_s(p1[6], p1[7])};
            pw3 = (u32x4){cvtpk_s(p1[8], p1[9]), cvtpk_s(p1[10], p1[11]), cvtpk_s(p1[12], p1[13]), cvtpk_s(p1[14], p1[15])};
            SBAR();
            pv(o, vb0 + slot * SLOTB, __builtin_bit_cast(bf16x8, pw0), __builtin_bit_cast(bf16x8, pw1), __builtin_bit_cast(bf16x8, pw2), __builtin_bit_cast(bf16x8, pw3));
        }
        asm volatile("s_waitcnt lgkmcnt(0)\n\ts_barrier" ::: "memory");
    }
#undef FA_DMA
    { auto rr = __builtin_amdgcn_permlane32_swap(__float_as_uint(l), __float_as_uint(l), false, false); l = __uint_as_float(rr[0]) + __uint_as_float(rr[1]); }
    if (hi == 0) wsf[32 + r32] = l;
    asm volatile("s_waitcnt lgkmcnt(0)" ::: "memory");
#pragma unroll
    for (int r = 0; r < 16; ++r) { const float rl = __builtin_amdgcn_rcpf(wsf[32 + crow(r, hi)]); o[0][r] *= rl; o[1][r] *= rl; }
    mhat_out = mhat; l_out = l;
}
template <int NDQ, class KV, class Hook>
__device__ __forceinline__ void flash_core_sp(LAS unsigned char* shm, const bf16_t* qptr, const KV& kv, int NT, const Hook& hk, int koff, f32x16 (&o)[2], float& mhat_out, float& l_out, const int tid) {
    const int lane = tid & 63, r32 = lane & 31, hi = lane >> 5; const int wid = __builtin_amdgcn_readfirstlane(tid >> 6);
    const unsigned lds0 = (unsigned)(uintptr_t)shm;
    LAS float* wsf = (LAS float*)(shm + L_WS) + wid * 64;
    const unsigned kdst = lds0 + L_K + wid * 1024, vdst = lds0 + L_V + wid * 1024;
    const int vrow_j = 16 * (wid & 3) + (lane >> 2), vcol = (wid >> 2) * 32 + (lane & 3) * 8;
#define FA_DMAK(t, SL) glds16(kv.kptr((t), lane) + wid * 8, (unsigned)__builtin_amdgcn_readfirstlane(kdst + (SL) * SLOTB))
#define FA_DMAV(t, SL) glds16(kv.vptr((t), vrow_j) + vcol, (unsigned)__builtin_amdgcn_readfirstlane(vdst + (SL) * SLOTB))
    FA_DMAK(0, 0); FA_DMAV(0, 0); FA_DMAK(1, 1); FA_DMAK(2, 2); FA_DMAV(1, 1);
    bf16x8 qr[4];
#pragma unroll
    for (int d0 = 0; d0 < 4; ++d0) { if (d0 < NDQ) qr[d0] = *(const bf16x8*)(qptr + d0 * 16 + hi * 8); else qr[d0] = (bf16x8){0, 0, 0, 0, 0, 0, 0, 0}; }
    asm volatile("" : "+v"(qr[0]), "+v"(qr[1]), "+v"(qr[2]), "+v"(qr[3]));
    float mhat = 0.f, l = 0.f; o[0] = f32x16{}; o[1] = f32x16{}; const f32x16 zero16 = f32x16{};
    bool first = true;
    const int vb0 = (int)(lds0 + L_V) + ((lane >> 4) & 1) * 32 + (lane & 3) * 8 + (4 * hi + ((lane & 15) >> 2)) * 64;
    f32x16 pA0, pA1, pB0, pB1;
    FA_WAIT_BAR(2);
#define FA_ENDW(tt) do { if ((tt) + 3 < NT) { FA_WAIT_BAR(2); } else if ((tt) + 2 < NT) { FA_WAIT_BAR(1); } else { FA_WAIT_BAR(0); } } while (0)
    if (!hk.skip(0)) qkt<NDQ>(pA0, pA1, shm + L_K + koff, qr, zero16, r32, hi);
#define FA_SMPV(P0, P1, tt, SL) do { \
        hk.apply(P0, P1, (tt)); const float curb = hk.cbias(tt); \
        const float rmr = rowmax(P0, P1) + curb; const float rm = rmr - mhat; \
        if (first) { first = false; mhat = (rmr > -1e29f) ? rmr : 0.f; \
        } else if (__any(rm > THR)) { const float dl = fmaxf(rm, 0.f); mhat += dl; \
            const float f = __builtin_amdgcn_exp2f(-dl); l *= f; if (hi == 0) wsf[r32] = f; \
            asm volatile("s_waitcnt lgkmcnt(0)" ::: "memory"); \
            _Pragma("unroll") for (int r = 0; r < 16; ++r) { const float fr_ = wsf[crow(r, hi)]; o[0][r] *= fr_; o[1][r] *= fr_; } } \
        float sacc = 0.f, sacc2 = 0.f; const float mref_ = mhat - curb; \
        _Pragma("unroll") for (int r = 0; r < 16; ++r) { P0[r] = __builtin_amdgcn_exp2f(P0[r] - mref_); P1[r] = __builtin_amdgcn_exp2f(P1[r] - mref_); sacc += P0[r]; sacc2 += P1[r]; } \
        l += sacc + sacc2; \
        u32x4 pw0, pw1, pw2, pw3; \
        pw0 = (u32x4){cvtpk_s(P0[0], P0[1]), cvtpk_s(P0[2], P0[3]), cvtpk_s(P0[4], P0[5]), cvtpk_s(P0[6], P0[7])}; \
        pw1 = (u32x4){cvtpk_s(P0[8], P0[9]), cvtpk_s(P0[10], P0[11]), cvtpk_s(P0[12], P0[13]), cvtpk_s(P0[14], P0[15])}; \
        pw2 = (u32x4){cvtpk_s(P1[0], P1[1]), cvtpk_s(P1[2], P1[3]), cvtpk_s(P1[4], P1[5]), cvtpk_s(P1[6], P1[7])}; \
        pw3 = (u32x4){cvtpk_s(P1[8], P1[9]), cvtpk_s(P1[10], P1[11]), cvtpk_s(P1[12], P1[13]), cvtpk_s(P1[14], P1[15])}; \
        SBAR(); \
        pv(o, vb0 + (SL) * SLOTB, __builtin_bit_cast(bf16x8, pw0), __builtin_bit_cast(bf16x8, pw1), __builtin_bit_cast(bf16x8, pw2), __builtin_bit_cast(bf16x8, pw3)); \
    } while (0)
    bf16x8 kf[8];
#define FA_KLOAD(SL) do { LAS const unsigned char* kb_ = shm + L_K + (SL) * SLOTB + koff + hi * 1024 + r32 * 16; \
        _Pragma("unroll") for (int d0 = 0; d0 < NDQ; ++d0) { kf[2 * d0] = *(LAS const bf16x8*)(kb_ + d0 * 2048); kf[2 * d0 + 1] = *(LAS const bf16x8*)(kb_ + d0 * 2048 + 512); } } while (0)
#define FA_QKM(P0, P1) do { _Pragma("unroll") for (int d0 = 0; d0 < NDQ; ++d0) { \
        if (d0 == 0) { P0 = __builtin_amdgcn_mfma_f32_32x32x16_bf16(kf[0], qr[0], zero16, 0, 0, 0); P1 = __builtin_amdgcn_mfma_f32_32x32x16_bf16(kf[1], qr[0], zero16, 0, 0, 0); } \
        else { P0 = __builtin_amdgcn_mfma_f32_32x32x16_bf16(kf[2 * d0], qr[d0], P0, 0, 0, 0); P1 = __builtin_amdgcn_mfma_f32_32x32x16_bf16(kf[2 * d0 + 1], qr[d0], P1, 0, 0, 0); } } } while (0)
#define FA_STEP(tt, SC, PC0, PC1, PN0, PN1) do { \
        if ((tt) + 3 < NT) FA_DMAK((tt) + 3, (SC)); \
        if ((tt) + 2 < NT) FA_DMAV((tt) + 2, ((SC) + 2) % 3); \
        const bool nx_ = ((tt) + 1 < NT) && !hk.skip((tt) + 1); \
        if (true) { if (nx_) FA_KLOAD(((SC) + 1) % 3); } \
        SBAR(); \
        if (!hk.skip(tt)) { FA_SMPV(PC0, PC1, (tt), (SC)); } \
        SBAR(); \
        if (nx_) { FA_QKM(PN0, PN1); } \
        FA_ENDW(tt); \
    } while (0)
    for (int t = 0; t < NT; t += 6) {
        FA_STEP(t, 0, pA0, pA1, pB0, pB1);
        if (t + 1 < NT) { FA_STEP(t + 1, 1, pB0, pB1, pA0, pA1); }
        if (t + 2 < NT) { FA_STEP(t + 2, 2, pA0, pA1, pB0, pB1); }
        if (t + 3 < NT) { FA_STEP(t + 3, 0, pB0, pB1, pA0, pA1); }
        if (t + 4 < NT) { FA_STEP(t + 4, 1, pA0, pA1, pB0, pB1); }
        if (t + 5 < NT) { FA_STEP(t + 5, 2, pB0, pB1, pA0, pA1); }
    }
#undef FA_STEP
#undef FA_KLOAD
#undef FA_QKM
#undef FA_SMPV
#undef FA_DMAK
#undef FA_ENDW
#undef FA_DMAV
    { auto rr = __builtin_amdgcn_permlane32_swap(__float_as_uint(l), __float_as_uint(l), false, false); l = __uint_as_float(rr[0]) + __uint_as_float(rr[1]); }
    if (hi == 0) wsf[32 + r32] = l;
    asm volatile("s_waitcnt lgkmcnt(0)" ::: "memory");
#pragma unroll
    for (int r = 0; r < 16; ++r) { const float rl = __builtin_amdgcn_rcpf(wsf[32 + crow(r, hi)]); o[0][r] *= rl; o[1][r] *= rl; }
    mhat_out = mhat; l_out = l;
}
template <class KV, class Hook>
__device__ __forceinline__ void flash_core_all(LAS unsigned char* shm, const bf16_t* qptr, const KV& kv, int NT, const Hook& hk, f32x16 (&o)[2], float& mhat_out, float& l_out, const int tid) {
    const int lane = tid & 63, r32 = lane & 31, hi = lane >> 5; const int wid = __builtin_amdgcn_readfirstlane(tid >> 6);
    const unsigned lds0 = (unsigned)(uintptr_t)shm;
    LAS float* wsf = (LAS float*)(shm + L_WS) + wid * 64;
    const unsigned kdst = lds0 + L_AK + wid * 1024, vdst = lds0 + L_AV + wid * 1024;
    const int vrow_j = 16 * (wid & 3) + (lane >> 2), vcol = (wid >> 2) * 32 + (lane & 3) * 8;
    for (int t = 0; t < NT; ++t) {
        glds16(kv.kptr(t, lane) + wid * 8, (unsigned)__builtin_amdgcn_readfirstlane(kdst + t * SLOTB));
        glds16(kv.vptr(t, vrow_j) + vcol, (unsigned)__builtin_amdgcn_readfirstlane(vdst + t * SLOTB)); }
    bf16x8 qr[4];
#pragma unroll
    for (int d0 = 0; d0 < 4; ++d0) qr[d0] = *(const bf16x8*)(qptr + d0 * 16 + hi * 8);
    asm volatile("" : "+v"(qr[0]), "+v"(qr[1]), "+v"(qr[2]), "+v"(qr[3]));
    float mhat = 0.f, l = 0.f; o[0] = f32x16{}; o[1] = f32x16{}; const f32x16 zero16 = f32x16{};
    bool first = true;
    const int vb0 = (int)(lds0 + L_AV) + ((lane >> 4) & 1) * 32 + (lane & 3) * 8 + (4 * hi + ((lane & 15) >> 2)) * 64;
    FA_WAIT_BAR(0);
    for (int t = 0; t < NT; ++t) {
        if (hk.skip(t)) continue;
        f32x16 p0, p1;
        { bf16x8 kf[8]; LAS const unsigned char* kb_ = shm + L_AK + t * SLOTB + hi * 1024 + r32 * 16;
#pragma unroll
          for (int d0 = 0; d0 < 4; ++d0) { kf[2 * d0] = *(LAS const bf16x8*)(kb_ + d0 * 2048); kf[2 * d0 + 1] = *(LAS const bf16x8*)(kb_ + d0 * 2048 + 512); }
#pragma unroll
          for (int d0 = 0; d0 < 4; ++d0) {
              if (d0 == 0) { p0 = __builtin_amdgcn_mfma_f32_32x32x16_bf16(kf[0], qr[0], zero16, 0, 0, 0); p1 = __builtin_amdgcn_mfma_f32_32x32x16_bf16(kf[1], qr[0], zero16, 0, 0, 0); }
              else { p0 = __builtin_amdgcn_mfma_f32_32x32x16_bf16(kf[2 * d0], qr[d0], p0, 0, 0, 0); p1 = __builtin_amdgcn_mfma_f32_32x32x16_bf16(kf[2 * d0 + 1], qr[d0], p1, 0, 0, 0); } } }
        hk.apply(p0, p1, t);
        const float rmr = rowmax(p0, p1); const float rm = rmr - mhat;
        if (first) { first = false; mhat = (rmr > -1e29f) ? rmr : 0.f;
        } else if (__any(rm > THR)) { const float dl = fmaxf(rm, 0.f); mhat += dl;
            const float f = __builtin_amdgcn_exp2f(-dl); l *= f; if (hi == 0) wsf[r32] = f;
            asm volatile("s_waitcnt lgkmcnt(0)" ::: "memory");
#pragma unroll
            for (int r = 0; r < 16; ++r) { const float fr_ = wsf[crow(r, hi)]; o[0][r] *= fr_; o[1][r] *= fr_; } }
        float sacc = 0.f, sacc2 = 0.f;
#pragma unroll
        for (int r = 0; r < 16; ++r) { p0[r] = __builtin_amdgcn_exp2f(p0[r] - mhat); p1[r] = __builtin_amdgcn_exp2f(p1[r] - mhat); sacc += p0[r]; sacc2 += p1[r]; }
        l += sacc + sacc2;
        u32x4 pw0, pw1, pw2, pw3;
        pw0 = (u32x4){cvtpk_s(p0[0], p0[1]), cvtpk_s(p0[2], p0[3]), cvtpk_s(p0[4], p0[5]), cvtpk_s(p0[6], p0[7])};
        pw1 = (u32x4){cvtpk_s(p0[8], p0[9]), cvtpk_s(p0[10], p0[11]), cvtpk_s(p0[12], p0[13]), cvtpk_s(p0[14], p0[15])};
        pw2 = (u32x4){cvtpk_s(p1[0], p1[1]), cvtpk_s(p1[2], p1[3]), cvtpk_s(p1[4], p1[5]), cvtpk_s(p1[6], p1[7])};
        pw3 = (u32x4){cvtpk_s(p1[8], p1[9]), cvtpk_s(p1[10], p1[11]), cvtpk_s(p1[12], p1[13]), cvtpk_s(p1[14], p1[15])};
        SBAR();
        pv(o, vb0 + t * SLOTB, __builtin_bit_cast(bf16x8, pw0), __builtin_bit_cast(bf16x8, pw1), __builtin_bit_cast(bf16x8, pw2), __builtin_bit_cast(bf16x8, pw3));
    }
    asm volatile("s_waitcnt lgkmcnt(0)\n\ts_barrier" ::: "memory");
    { auto rr = __builtin_amdgcn_permlane32_swap(__float_as_uint(l), __float_as_uint(l), false, false); l = __uint_as_float(rr[0]) + __uint_as_float(rr[1]); }
    if (hi == 0) wsf[32 + r32] = l;
    asm volatile("s_waitcnt lgkmcnt(0)" ::: "memory");
#pragma unroll
    for (int r = 0; r < 16; ++r) { const float rl = __builtin_amdgcn_rcpf(wsf[32 + crow(r, hi)]); o[0][r] *= rl; o[1][r] *= rl; }
    mhat_out = mhat; l_out = l;
}
template <class KV>
__device__ __forceinline__ void flash_core_all3(LAS unsigned char* shm, const bf16_t* qptr, const KV& kv, int NTD, int NT, int slot_off, LAS const float* tab, int qw, int kb0, bool active, float kbound, float badd,
                                                f32x16 (&o)[2], float& mrow_out, float& l_out, const int tid) {
    const int lane = tid & 63, r32 = lane & 31, hi = lane >> 5; const int wid = __builtin_amdgcn_readfirstlane(tid >> 6);
    const unsigned lds0 = (unsigned)(uintptr_t)shm;
    LAS float* wsf = (LAS float*)(shm + L_WS) + wid * 64;
    const unsigned kdst = lds0 + L_AK + wid * 1024, vdst = lds0 + L_AV + wid * 1024;
    const int vrow_j = 16 * (wid & 3) + (lane >> 2), vcol = (wid >> 2) * 32 + (lane & 3) * 8;
    const unsigned koffv = (unsigned)(kv.rmul() * lane * INW + wid * 8) * 2u, voffv = (unsigned)(kv.rmul() * vrow_j * INW + vcol) * 2u;
    for (int t = 0; t < NTD; ++t) {
        glds16s(kv.tk(t), koffv, (unsigned)__builtin_amdgcn_readfirstlane(kdst + t * SLOTB));
        glds16s(kv.tv(t), voffv, (unsigned)__builtin_amdgcn_readfirstlane(vdst + t * SLOTB)); }
    bf16x8 qr[4];
#pragma unroll
    for (int d0 = 0; d0 < 4; ++d0) qr[d0] = *(const bf16x8*)(qptr + d0 * 16 + hi * 8);
    float q2 = 0.f;
#pragma unroll
    for (int d0 = 0; d0 < 4; ++d0)
#pragma unroll
        for (int e = 0; e < 8; ++e) { const float x = __builtin_bit_cast(float, (unsigned)(unsigned short)qr[d0][e] << 16); q2 += x * x; }
    { auto rr = __builtin_amdgcn_permlane32_swap(__float_as_uint(q2), __float_as_uint(q2), false, false); q2 = __uint_as_float(rr[0]) + __uint_as_float(rr[1]); }
    const float mrow = sqrtf(q2) * kbound + badd;
    f32x16 negm;
#pragma unroll
    for (int r = 0; r < 16; ++r) negm[r] = -mrow;
    asm volatile("" : "+v"(negm));
    float l = 0.f; o[0] = f32x16{}; o[1] = f32x16{};
    const int tf = (qw - 64 - kb0) >> 6;
    const unsigned kbase = lds0 + L_AK + hi * 1024 + r32 * 16;
    const unsigned vbase = lds0 + L_AV + ((lane >> 4) & 1) * 32 + (lane & 3) * 8 + (4 * hi + ((lane & 15) >> 2)) * 64;
    const unsigned tbase = (unsigned)(uintptr_t)tab + 4u * (unsigned)(kb0 + 4 * hi - (qw + r32) + 158);
    FA_WAIT_BAR(0);
    { int t_lo = tf < 0 ? 0 : tf, t_hi = tf + 2 >= NT ? NT - 1 : tf + 2; if (!active) t_hi = t_lo - 1;
    for (int t = t_lo; t <= t_hi; ++t) {
        {
            const unsigned ka = kbase + (unsigned)(t + slot_off) * SLOTB, va = vbase + (unsigned)(t + slot_off) * SLOTB, ta = tbase + 256u * (unsigned)t;
            bf16x8 kf[8]; f32x2 tv0[8], tv1[8]; s16x4 vlo[8], vhi[8];
#define B3_KRD(j) asm volatile("ds_read_b128 %0, %2 offset:%c3\n\tds_read_b128 %1, %2 offset:%c4" : "=&v"(kf[2 * (j)]), "=&v"(kf[2 * (j) + 1]) : "v"(ka), "i"((j) * 2048), "i"((j) * 2048 + 512) : "memory")
#define B3_TR1(dst, off) asm volatile("ds_read2_b32 %0, %1 offset0:%c2 offset1:%c3" : "=&v"(dst) : "v"(ta), "i"(off), "i"((off) + 1) : "memory")
#define B3_TRD(j2) do { B3_TR1(tv0[j2], 8 * ((j2) >> 1) + 2 * ((j2) & 1)); B3_TR1(tv1[j2], 8 * ((j2) >> 1) + 2 * ((j2) & 1) + 32); } while (0)
#define B3_VRD(ii) asm volatile("ds_read_b64_tr_b16 %0, %2 offset:%c3\n\tds_read_b64_tr_b16 %1, %2 offset:%c4" : "=&v"(vlo[ii]), "=&v"(vhi[ii]) : "v"(va), "i"(((ii) >> 2) * 4096 + ((ii) & 3) * 1024), "i"(((ii) >> 2) * 4096 + ((ii) & 3) * 1024 + 512) : "memory")
            B3_KRD(0); B3_KRD(1); B3_KRD(2); B3_KRD(3);
            B3_TRD(0); B3_TRD(1); B3_TRD(2);
            asm volatile("s_waitcnt lgkmcnt(6)" : "+v"(kf[0]), "+v"(kf[1]), "+v"(kf[2]), "+v"(kf[3]), "+v"(kf[4]), "+v"(kf[5]), "+v"(kf[6]), "+v"(kf[7]));
            SBAR();
            f32x16 p0 = __builtin_amdgcn_mfma_f32_32x32x16_bf16(kf[0], qr[0], negm, 0, 0, 0), p1 = __builtin_amdgcn_mfma_f32_32x32x16_bf16(kf[1], qr[0], negm, 0, 0, 0);
#pragma unroll
            for (int d0 = 1; d0 < 4; ++d0) { p0 = __builtin_amdgcn_mfma_f32_32x32x16_bf16(kf[2 * d0], qr[d0], p0, 0, 0, 0); p1 = __builtin_amdgcn_mfma_f32_32x32x16_bf16(kf[2 * d0 + 1], qr[d0], p1, 0, 0, 0); }
            SBAR();
            asm volatile("s_waitcnt lgkmcnt(5)" ::: "memory");
            B3_TRD(3); B3_TRD(4); B3_TRD(5); B3_TRD(6); B3_TRD(7);
            asm volatile("s_waitcnt lgkmcnt(7)" ::: "memory");
            B3_VRD(0); B3_VRD(1); B3_VRD(2); B3_VRD(3);
            asm volatile("s_waitcnt lgkmcnt(8)" : "+v"(tv0[0]), "+v"(tv0[1]), "+v"(tv0[2]), "+v"(tv0[3]), "+v"(tv0[4]), "+v"(tv0[5]), "+v"(tv0[6]), "+v"(tv0[7]),
                                                  "+v"(tv1[0]), "+v"(tv1[1]), "+v"(tv1[2]), "+v"(tv1[3]), "+v"(tv1[4]), "+v"(tv1[5]), "+v"(tv1[6]), "+v"(tv1[7]));
            SBAR();
            float sacc = 0.f;
#pragma unroll
            for (int r = 0; r < 16; ++r) { const int j2 = (r >> 2) * 2 + ((r & 3) >> 1), e = r & 1;
                p0[r] = __builtin_amdgcn_exp2f(p0[r] + tv0[j2][e]); p1[r] = __builtin_amdgcn_exp2f(p1[r] + tv1[j2][e]); sacc += p0[r]; sacc += p1[r]; }
            l += sacc;
            const u32x4 pw0 = (u32x4){cvtpk_s(p0[0], p0[1]), cvtpk_s(p0[2], p0[3]), cvtpk_s(p0[4], p0[5]), cvtpk_s(p0[6], p0[7])};
            const u32x4 pw1 = (u32x4){cvtpk_s(p0[8], p0[9]), cvtpk_s(p0[10], p0[11]), cvtpk_s(p0[12], p0[13]), cvtpk_s(p0[14], p0[15])};
            const u32x4 pw2 = (u32x4){cvtpk_s(p1[0], p1[1]), cvtpk_s(p1[2], p1[3]), cvtpk_s(p1[4], p1[5]), cvtpk_s(p1[6], p1[7])};
            const u32x4 pw3 = (u32x4){cvtpk_s(p1[8], p1[9]), cvtpk_s(p1[10], p1[11]), cvtpk_s(p1[12], p1[13]), cvtpk_s(p1[14], p1[15])};
            SBAR();
            asm volatile("s_waitcnt lgkmcnt(0)" : "+v"(vlo[0]), "+v"(vlo[1]), "+v"(vlo[2]), "+v"(vlo[3]), "+v"(vhi[0]), "+v"(vhi[1]), "+v"(vhi[2]), "+v"(vhi[3]));
            B3_VRD(4); B3_VRD(5); B3_VRD(6); B3_VRD(7);
            SBAR();
#define B3_VF(ii) (bf16x8){vlo[ii][0], vlo[ii][1], vlo[ii][2], vlo[ii][3], vhi[ii][0], vhi[ii][1], vhi[ii][2], vhi[ii][3]}
            o[0] = __builtin_amdgcn_mfma_f32_32x32x16_bf16(__builtin_bit_cast(bf16x8, pw0), B3_VF(0), o[0], 0, 0, 0);
            o[0] = __builtin_amdgcn_mfma_f32_32x32x16_bf16(__builtin_bit_cast(bf16x8, pw1), B3_VF(1), o[0], 0, 0, 0);
            o[0] = __builtin_amdgcn_mfma_f32_32x32x16_bf16(__builtin_bit_cast(bf16x8, pw2), B3_VF(2), o[0], 0, 0, 0);
            o[0] = __builtin_amdgcn_mfma_f32_32x32x16_bf16(__builtin_bit_cast(bf16x8, pw3), B3_VF(3), o[0], 0, 0, 0);
            SBAR();
            asm volatile("s_waitcnt lgkmcnt(0)" : "+v"(vlo[4]), "+v"(vlo[5]), "+v"(vlo[6]), "+v"(vlo[7]), "+v"(vhi[4]), "+v"(vhi[5]), "+v"(vhi[6]), "+v"(vhi[7]));
            SBAR();
            o[1] = __builtin_amdgcn_mfma_f32_32x32x16_bf16(__builtin_bit_cast(bf16x8, pw0), B3_VF(4), o[1], 0, 0, 0);
            o[1] = __builtin_amdgcn_mfma_f32_32x32x16_bf16(__builtin_bit_cast(bf16x8, pw1), B3_VF(5), o[1], 0, 0, 0);
            o[1] = __builtin_amdgcn_mfma_f32_32x32x16_bf16(__builtin_bit_cast(bf16x8, pw2), B3_VF(6), o[1], 0, 0, 0);
            o[1] = __builtin_amdgcn_mfma_f32_32x32x16_bf16(__builtin_bit_cast(bf16x8, pw3), B3_VF(7), o[1], 0, 0, 0);
            SBAR();
#undef B3_TR1
#undef B3_KRD
#undef B3_TRD
#undef B3_VRD
#undef B3_VF
        }
    } }
    asm volatile("s_waitcnt lgkmcnt(0)\n\ts_barrier" ::: "memory");
    { auto rr = __builtin_amdgcn_permlane32_swap(__float_as_uint(l), __float_as_uint(l), false, false); l = __uint_as_float(rr[0]) + __uint_as_float(rr[1]); }
    if (hi == 0) wsf[32 + r32] = l;
    asm volatile("s_waitcnt lgkmcnt(0)" ::: "memory");
#pragma unroll
    for (int r = 0; r < 16; ++r) { const float rl = __builtin_amdgcn_rcpf(wsf[32 + crow(r, hi)]); o[0][r] *= rl; o[1][r] *= rl; }
    asm volatile("s_waitcnt lgkmcnt(0)" ::: "memory");
    mrow_out = mrow; l_out = l;
}
constexpr int L_DT = L_OST + 8 * SLOTB;
static_assert(L_DT + 15 * 128 * 4 <= L_WS, "D table");
template <class KV>
__device__ __forceinline__ void flash_core_d(LAS unsigned char* shm, const bf16_t* qptr, const KV& kv, int NT, int t_first, int t_last, int dr0, int c, float kbound, float badd,
                                             const float* rpb, f32x16 (&o)[2], const int tid) {
    const int lane = tid & 63, r32 = lane & 31, hi = lane >> 5; const int wid = __builtin_amdgcn_readfirstlane(tid >> 6);
    const unsigned lds0 = (unsigned)(uintptr_t)shm;
    LAS float* wsf = (LAS float*)(shm + L_WS) + wid * 64;
    const unsigned kdst = lds0 + L_K + wid * 1024, vdst = lds0 + L_V + wid * 1024;
    const int vrow_j = 16 * (wid & 3) + (lane >> 2), vcol = (wid >> 2) * 32 + (lane & 3) * 8;
    const unsigned koffv = (unsigned)(kv.rmul() * lane * INW + wid * 8) * 2u, voffv = (unsigned)(kv.rmul() * vrow_j * INW + vcol) * 2u;
#define FD_DMA(t, slot) do { glds16s(kv.tk(t), koffv, (unsigned)__builtin_amdgcn_readfirstlane(kdst + (slot) * SLOTB)); \
                             glds16s(kv.tv(t), voffv, (unsigned)__builtin_amdgcn_readfirstlane(vdst + (slot) * SLOTB)); } while (0)
    FD_DMA(0, 0); FD_DMA(1, 1);
    const float rv = (tid < 465) ? rpb[tid] : 0.f;
    bf16x8 qr[4];
#pragma unroll
    for (int d0 = 0; d0 < 4; ++d0) qr[d0] = *(const bf16x8*)(qptr + d0 * 16 + hi * 8);
    float q2 = 0.f;
#pragma unroll
    for (int d0 = 0; d0 < 4; ++d0)
#pragma unroll
        for (int e = 0; e < 8; ++e) { const float x = __builtin_bit_cast(float, (unsigned)(unsigned short)qr[d0][e] << 16); q2 += x * x; }
    { auto rr = __builtin_amdgcn_permlane32_swap(__float_as_uint(q2), __float_as_uint(q2), false, false); q2 = __uint_as_float(rr[0]) + __uint_as_float(rr[1]); }
    const float mrow = sqrtf(q2) * kbound + badd;
    { LAS float* raw = (LAS float*)(shm + L_TAB); LAS float* dt = (LAS float*)(shm + L_DT);
      if (tid < 465) raw[tid] = rv * 1.4426950408889634f;
      asm volatile("s_waitcnt lgkmcnt(0)\n\ts_barrier" ::: "memory");
#pragma unroll
      for (int j = 0; j < 4; ++j) { const int i = tid + 512 * j; if (i < 15 * 128) { const int dr = i >> 7, dc = (i & 127) - 64; dt[i] = (dc >= -15 && dc <= 15) ? raw[dr * 31 + dc + 15] : 0.f; } } }
    int cs = c - 8; if (cs < 0) cs = 0; if (cs > 48) cs = 48;
    f32x16 cm0, cm1;
#pragma unroll
    for (int r = 0; r < 16; ++r) { const int kc = (r & 3) + 8 * (r >> 2) + 4 * hi;
        cm0[r] = ((unsigned)(kc - cs) < 16u) ? -mrow : -INFINITY; cm1[r] = ((unsigned)(kc + 32 - cs) < 16u) ? -mrow : -INFINITY; }
    asm volatile("" : "+v"(cm0), "+v"(cm1));
    float l = 0.f; o[0] = f32x16{}; o[1] = f32x16{};
    const unsigned kbase = lds0 + L_K + hi * 1024 + r32 * 16;
    const unsigned vbase = lds0 + L_V + ((lane >> 4) & 1) * 32 + (lane & 3) * 8 + (4 * hi + ((lane & 15) >> 2)) * 64;
    const unsigned tbase = lds0 + L_DT + 4u * (unsigned)(64 - c + 4 * hi);
#define B3_KRD(j) asm volatile("ds_read_b128 %0, %2 offset:%c3\n\tds_read_b128 %1, %2 offset:%c4" : "=&v"(kf[2 * (j)]), "=&v"(kf[2 * (j) + 1]) : "v"(ka), "i"((j) * 2048), "i"((j) * 2048 + 512) : "memory")
#define B3_TR1(dst, off) asm volatile("ds_read2_b32 %0, %1 offset0:%c2 offset1:%c3" : "=&v"(dst) : "v"(ta), "i"(off), "i"((off) + 1) : "memory")
#define B3_T0(j2) B3_TR1(tv0[j2], 8 * ((j2) >> 1) + 2 * ((j2) & 1))
#define B3_T1(j2) B3_TR1(tv1[j2], 8 * ((j2) >> 1) + 2 * ((j2) & 1) + 32)
#define B3_VRD(ii) asm volatile("ds_read_b64_tr_b16 %0, %2 offset:%c3\n\tds_read_b64_tr_b16 %1, %2 offset:%c4" : "=&v"(vlo[ii]), "=&v"(vhi[ii]) : "v"(va), "i"(((ii) >> 2) * 4096 + ((ii) & 3) * 1024), "i"(((ii) >> 2) * 4096 + ((ii) & 3) * 1024 + 512) : "memory")
#define B3_VF(ii) (bf16x8){vlo[ii][0], vlo[ii][1], vlo[ii][2], vlo[ii][3], vhi[ii][0], vhi[ii][1], vhi[ii][2], vhi[ii][3]}
#define B3_PV(dd, pw, ii) o[dd] = __builtin_amdgcn_mfma_f32_32x32x16_bf16(__builtin_bit_cast(bf16x8, pw), B3_VF(ii), o[dd], 0, 0, 0)
#define D_TILE(LEFT) do { \
            const unsigned ka = kbase + (unsigned)slot * SLOTB, va = vbase + (unsigned)slot * SLOTB, ta = tbase + 512u * (unsigned)(dr0 + t); \
            bf16x8 kf[8]; f32x2 tv0[8], tv1[8]; s16x4 vlo[8], vhi[8]; \
            B3_KRD(0); B3_KRD(1); B3_KRD(2); B3_KRD(3);                                          \
            if (LEFT) { B3_T0(0); B3_T0(1); B3_T0(2); B3_T0(3); B3_T0(4); B3_T0(5); }            \
            else      { B3_T1(0); B3_T1(1); B3_T1(2); B3_T1(3); B3_T1(4); B3_T1(5); } \
            asm volatile("s_waitcnt lgkmcnt(6)" : "+v"(kf[0]), "+v"(kf[1]), "+v"(kf[2]), "+v"(kf[3]), "+v"(kf[4]), "+v"(kf[5]), "+v"(kf[6]), "+v"(kf[7])); \
            SBAR(); \
            f32x16 p0 = __builtin_amdgcn_mfma_f32_32x32x16_bf16(kf[0], qr[0], cm0, 0, 0, 0), p1 = __builtin_amdgcn_mfma_f32_32x32x16_bf16(kf[1], qr[0], cm1, 0, 0, 0); \
            _Pragma("unroll") for (int d0 = 1; d0 < 4; ++d0) { p0 = __builtin_amdgcn_mfma_f32_32x32x16_bf16(kf[2 * d0], qr[d0], p0, 0, 0, 0); p1 = __builtin_amdgcn_mfma_f32_32x32x16_bf16(kf[2 * d0 + 1], qr[d0], p1, 0, 0, 0); } \
            SBAR(); \
            asm volatile("s_waitcnt lgkmcnt(5)" ::: "memory");                                    \
            if (LEFT) { B3_T0(6); B3_T0(7); B3_T1(0); B3_T1(1); B3_VRD(0); B3_VRD(1); B3_VRD(2); }     \
            else      { B3_T1(6); B3_T1(7); B3_T0(6); B3_T0(7); B3_VRD(1); B3_VRD(2); B3_VRD(3); } \
            if (LEFT) asm volatile("s_waitcnt lgkmcnt(6)" : "+v"(tv0[0]), "+v"(tv0[1]), "+v"(tv0[2]), "+v"(tv0[3]), "+v"(tv0[4]), "+v"(tv0[5]), "+v"(tv0[6]), "+v"(tv0[7]), "+v"(tv1[0]), "+v"(tv1[1])); \
            else      asm volatile("s_waitcnt lgkmcnt(6)" : "+v"(tv1[0]), "+v"(tv1[1]), "+v"(tv1[2]), "+v"(tv1[3]), "+v"(tv1[4]), "+v"(tv1[5]), "+v"(tv1[6]), "+v"(tv1[7]), "+v"(tv0[6]), "+v"(tv0[7])); \
            SBAR(); \
            float sacc = 0.f; u32x4 pw0, pw1, pw2, pw3; \
            if (LEFT) { \
                _Pragma("unroll") for (int r = 0; r < 16; ++r) { const int j2 = (r >> 2) * 2 + ((r & 3) >> 1), e = r & 1; p0[r] = __builtin_amdgcn_exp2f(p0[r] + tv0[j2][e]); sacc += p0[r]; } \
                _Pragma("unroll") for (int r = 0; r < 4; ++r) { const int j2 = (r & 3) >> 1, e = r & 1; p1[r] = __builtin_amdgcn_exp2f(p1[r] + tv1[j2][e]); sacc += p1[r]; } \
                pw0 = (u32x4){cvtpk_s(p0[0], p0[1]), cvtpk_s(p0[2], p0[3]), cvtpk_s(p0[4], p0[5]), cvtpk_s(p0[6], p0[7])}; \
                pw1 = (u32x4){cvtpk_s(p0[8], p0[9]), cvtpk_s(p0[10], p0[11]), cvtpk_s(p0[12], p0[13]), cvtpk_s(p0[14], p0[15])}; \
                pw2 = (u32x4){cvtpk_s(p1[0], p1[1]), cvtpk_s(p1[2], p1[3]), 0u, 0u}; pw3 = pw2; \
            } else { \
                _Pragma("unroll") for (int r = 0; r < 16; ++r) { const int j2 = (r >> 2) * 2 + ((r & 3) >> 1), e = r & 1; p1[r] = __builtin_amdgcn_exp2f(p1[r] + tv1[j2][e]); sacc += p1[r]; } \
                _Pragma("unroll") for (int r = 12; r < 16; ++r) { const int j2 = 6 + ((r & 3) >> 1), e = r & 1; p0[r] = __builtin_amdgcn_exp2f(p0[r] + tv0[j2][e]); sacc += p0[r]; } \
                pw1 = (u32x4){0u, 0u, cvtpk_s(p0[12], p0[13]), cvtpk_s(p0[14], p0[15])}; pw0 = pw1; \
                pw2 = (u32x4){cvtpk_s(p1[0], p1[1]), cvtpk_s(p1[2], p1[3]), cvtpk_s(p1[4], p1[5]), cvtpk_s(p1[6], p1[7])}; \
                pw3 = (u32x4){cvtpk_s(p1[8], p1[9]), cvtpk_s(p1[10], p1[11]), cvtpk_s(p1[12], p1[13]), cvtpk_s(p1[14], p1[15])}; \
            } \
            l += sacc; \
            SBAR(); \
            if (LEFT) { asm volatile("s_waitcnt lgkmcnt(0)" : "+v"(vlo[0]), "+v"(vlo[1]), "+v"(vlo[2]), "+v"(vhi[0]), "+v"(vhi[1]), "+v"(vhi[2])); \
                        B3_VRD(4); B3_VRD(5); B3_VRD(6); SBAR(); \
                        B3_PV(0, pw0, 0); B3_PV(0, pw1, 1); B3_PV(0, pw2, 2); SBAR(); \
                        asm volatile("s_waitcnt lgkmcnt(0)" : "+v"(vlo[4]), "+v"(vlo[5]), "+v"(vlo[6]), "+v"(vhi[4]), "+v"(vhi[5]), "+v"(vhi[6])); SBAR(); \
                        B3_PV(1, pw0, 4); B3_PV(1, pw1, 5); B3_PV(1, pw2, 6); SBAR(); } \
            else      { asm volatile("s_waitcnt lgkmcnt(0)" : "+v"(vlo[1]), "+v"(vlo[2]), "+v"(vlo[3]), "+v"(vhi[1]), "+v"(vhi[2]), "+v"(vhi[3])); \
                        B3_VRD(5); B3_VRD(6); B3_VRD(7); SBAR(); \
                        B3_PV(0, pw1, 1); B3_PV(0, pw2, 2); B3_PV(0, pw3, 3); SBAR(); \
                        asm volatile("s_waitcnt lgkmcnt(0)" : "+v"(vlo[5]), "+v"(vlo[6]), "+v"(vlo[7]), "+v"(vhi[5]), "+v"(vhi[6]), "+v"(vhi[7])); SBAR(); \
                        B3_PV(1, pw1, 5); B3_PV(1, pw2, 6); B3_PV(1, pw3, 7); SBAR(); } \
        } while (0)
#define D_LOOP(LEFT) do { int slot = 0; \
    for (int t = 0; t < NT; ++t) { \
        if (t + 1 < NT) asm volatile("s_waitcnt vmcnt(2) lgkmcnt(0)\n\ts_barrier" ::: "memory"); else asm volatile("s_waitcnt vmcnt(0) lgkmcnt(0)\n\ts_barrier" ::: "memory"); \
          \
        if (t + 2 < NT) { const int s2 = slot == 0 ? 2 : slot - 1; FD_DMA(t + 2, s2); } \
        if (t >= t_first && t <= t_last) D_TILE(LEFT);             \
        slot = slot == 2 ? 0 : slot + 1; } } while (0)
    if ((wid & 1) == 0) D_LOOP(1); else D_LOOP(0);
#undef D_LOOP
#undef D_TILE
#undef B3_TR1
#undef B3_T0
#undef B3_T1
#undef B3_KRD
#undef B3_VRD
#undef B3_VF
#undef B3_PV
#undef FD_DMA
    asm volatile("s_waitcnt lgkmcnt(0)\n\ts_barrier" ::: "memory");
    { auto rr = __builtin_amdgcn_permlane32_swap(__float_as_uint(l), __float_as_uint(l), false, false); l = __uint_as_float(rr[0]) + __uint_as_float(rr[1]); }
    if (hi == 0) wsf[32 + r32] = l;
    asm volatile("s_waitcnt lgkmcnt(0)" ::: "memory");
#pragma unroll
    for (int r = 0; r < 16; ++r) { const float rl = __builtin_amdgcn_rcpf(wsf[32 + crow(r, hi)]); o[0][r] *= rl; o[1][r] *= rl; }
    asm volatile("s_waitcnt lgkmcnt(0)" ::: "memory");
}
template <class KV, class Hook>
__device__ __forceinline__ void flash_core_dual(LAS unsigned char* shm, const bf16_t* qptr, const KV& kv, int NT, const Hook& hk, f32x16 (&o1)[2], f32x16 (&o2)[2], const int tid) {
    const int lane = tid & 63, r32 = lane & 31, hi = lane >> 5; const int wid = __builtin_amdgcn_readfirstlane(tid >> 6);
    const unsigned lds0 = (unsigned)(uintptr_t)shm;
    LAS float* wsf = (LAS float*)(shm + L_WS) + wid * 64;
    const unsigned kdst = lds0 + L_K + wid * 1024, vdst = lds0 + L_V + wid * 1024;
    const int vrow_j = 16 * (wid & 3) + (lane >> 2), vcol = (wid >> 2) * 32 + (lane & 3) * 8;
#define FA_DMA(t, slot) do { glds16(kv.kptr((t), lane) + wid * 8, (unsigned)__builtin_amdgcn_readfirstlane(kdst + (slot) * SLOTB)); \
                             glds16(kv.vptr((t), vrow_j) + vcol, (unsigned)__builtin_amdgcn_readfirstlane(vdst + (slot) * SLOTB)); } while (0)
    FA_DMA(0, 0);
    bf16x8 qr[4];
#pragma unroll
    for (int d0 = 0; d0 < 4; ++d0) qr[d0] = *(const bf16x8*)(qptr + d0 * 16 + hi * 8);
    asm volatile("" : "+v"(qr[0]), "+v"(qr[1]), "+v"(qr[2]), "+v"(qr[3]));
    float mA = 0.f, lA = 0.f, mB = 0.f, lB = 0.f, curb = 0.f;
    o1[0] = f32x16{}; o1[1] = f32x16{}; o2[0] = f32x16{}; o2[1] = f32x16{}; const f32x16 zero16 = f32x16{};
    bool first = true;
    const int vb0 = (int)(lds0 + L_V) + ((lane >> 4) & 1) * 32 + (lane & 3) * 8 + (4 * hi + ((lane & 15) >> 2)) * 64;
#define FA_MAP(MAP, mh, ll, neg, oo, PW0, PW1, PW2, PW3) do { \
        f32x16 p0, p1; \
        { LAS const unsigned char* kb = shm + L_K + slot * SLOTB + (MAP) * 4096 + hi * 1024 + r32 * 16; \
          const bf16x8 b0 = *(LAS const bf16x8*)(kb), b1 = *(LAS const bf16x8*)(kb + 512), b2 = *(LAS const bf16x8*)(kb + 2048), b3 = *(LAS const bf16x8*)(kb + 2048 + 512); \
          p0 = __builtin_amdgcn_mfma_f32_32x32x16_bf16(b0, qr[2 * (MAP)], zero16, 0, 0, 0); p1 = __builtin_amdgcn_mfma_f32_32x32x16_bf16(b1, qr[2 * (MAP)], zero16, 0, 0, 0); \
          p0 = __builtin_amdgcn_mfma_f32_32x32x16_bf16(b2, qr[2 * (MAP) + 1], p0, 0, 0, 0); p1 = __builtin_amdgcn_mfma_f32_32x32x16_bf16(b3, qr[2 * (MAP) + 1], p1, 0, 0, 0); } \
        hk.apply(p0, p1, t); \
        const float rm = rowmax(p0, p1) + curb - mh; \
        if (first) { mh += rm; \
        } else if (__any(rm > THR)) { const float dl = __builtin_fmaxf(rm, 0.f); mh += dl; \
            const float f = __builtin_amdgcn_exp2f(-dl); ll *= f; if (hi == 0) wsf[r32] = f; \
            asm volatile("s_waitcnt lgkmcnt(0)" ::: "memory"); \
            _Pragma("unroll") for (int r = 0; r < 16; ++r) { const float fr_ = wsf[crow(r, hi)]; oo[0][r] *= fr_; oo[1][r] *= fr_; } \
            asm volatile("s_waitcnt lgkmcnt(0)" ::: "memory"); } \
        float sacc = 0.f, sacc2 = 0.f; const float mref_ = mh - curb; \
        _Pragma("unroll") for (int r = 0; r < 16; ++r) { p0[r] = __builtin_amdgcn_exp2f(p0[r] - mref_); p1[r] = __builtin_amdgcn_exp2f(p1[r] - mref_); sacc += p0[r]; sacc2 += p1[r]; } \
        ll += sacc + sacc2; \
        PW0 = (u32x4){cvtpk_s(p0[0], p0[1]), cvtpk_s(p0[2], p0[3]), cvtpk_s(p0[4], p0[5]), cvtpk_s(p0[6], p0[7])}; \
        PW1 = (u32x4){cvtpk_s(p0[8], p0[9]), cvtpk_s(p0[10], p0[11]), cvtpk_s(p0[12], p0[13]), cvtpk_s(p0[14], p0[15])}; \
        PW2 = (u32x4){cvtpk_s(p1[0], p1[1]), cvtpk_s(p1[2], p1[3]), cvtpk_s(p1[4], p1[5]), cvtpk_s(p1[6], p1[7])}; \
        PW3 = (u32x4){cvtpk_s(p1[8], p1[9]), cvtpk_s(p1[10], p1[11]), cvtpk_s(p1[12], p1[13]), cvtpk_s(p1[14], p1[15])}; \
    } while (0)
    for (int t = 0; t < NT; ++t) {
        const int slot = t & 1;
        if (t + 1 < NT) { FA_DMA(t + 1, slot ^ 1); FA_WAIT_BAR(2); } else { FA_WAIT_BAR(0); }
        curb = hk.cbias(t);
        u32x4 a0, a1, a2, a3, b0_, b1_, b2_, b3_;
        FA_MAP(0, mA, lA, zero16, o1, a0, a1, a2, a3);
        SBAR();
        FA_MAP(1, mB, lB, zero16, o2, b0_, b1_, b2_, b3_);
        first = false;
        SBAR();
        { const int vb = vb0 + slot * SLOTB;
#pragma unroll
          for (int d0 = 0; d0 < 2; ++d0) { s16x4 lo[4], hi_[4];
#pragma unroll
              for (int ks = 0; ks < 4; ++ks) {
                  asm volatile("ds_read_b64_tr_b16 %0,%1 offset:%c2" : "=&v"(lo[ks]) : "v"(vb), "i"(d0 * 4096 + ks * 1024) : "memory");
                  asm volatile("ds_read_b64_tr_b16 %0,%1 offset:%c2" : "=&v"(hi_[ks]) : "v"(vb), "i"(d0 * 4096 + ks * 1024 + 512) : "memory"); }
              asm volatile("s_waitcnt lgkmcnt(0)" ::: "memory"); SBAR();
#define FA_PK(k) (bf16x8){lo[k][0], lo[k][1], lo[k][2], lo[k][3], hi_[k][0], hi_[k][1], hi_[k][2], hi_[k][3]}
              o1[d0] = __builtin_amdgcn_mfma_f32_32x32x16_bf16(__builtin_bit_cast(bf16x8, a0), FA_PK(0), o1[d0], 0, 0, 0);
              o2[d0] = __builtin_amdgcn_mfma_f32_32x32x16_bf16(__builtin_bit_cast(bf16x8, b0_), FA_PK(0), o2[d0], 0, 0, 0);
              o1[d0] = __builtin_amdgcn_mfma_f32_32x32x16_bf16(__builtin_bit_cast(bf16x8, a1), FA_PK(1), o1[d0], 0, 0, 0);
              o2[d0] = __builtin_amdgcn_mfma_f32_32x32x16_bf16(__builtin_bit_cast(bf16x8, b1_), FA_PK(1), o2[d0], 0, 0, 0);
              o1[d0] = __builtin_amdgcn_mfma_f32_32x32x16_bf16(__builtin_bit_cast(bf16x8, a2), FA_PK(2), o1[d0], 0, 0, 0);
              o2[d0] = __builtin_amdgcn_mfma_f32_32x32x16_bf16(__builtin_bit_cast(bf16x8, b2_), FA_PK(2), o2[d0], 0, 0, 0);
              o1[d0] = __builtin_amdgcn_mfma_f32_32x32x16_bf16(__builtin_bit_cast(bf16x8, a3), FA_PK(3), o1[d0], 0, 0, 0);
              o2[d0] = __builtin_amdgcn_mfma_f32_32x32x16_bf16(__builtin_bit_cast(bf16x8, b3_), FA_PK(3), o2[d0], 0, 0, 0);
#undef FA_PK
          } }
        asm volatile("s_waitcnt lgkmcnt(0)\n\ts_barrier" ::: "memory");
    }
#undef FA_DMA
#undef FA_MAP
    { auto rr = __builtin_amdgcn_permlane32_swap(__float_as_uint(lA), __float_as_uint(lA), false, false); lA = __uint_as_float(rr[0]) + __uint_as_float(rr[1]); }
    { auto rr = __builtin_amdgcn_permlane32_swap(__float_as_uint(lB), __float_as_uint(lB), false, false); lB = __uint_as_float(rr[0]) + __uint_as_float(rr[1]); }
    if (hi == 0) { wsf[r32] = lA; wsf[32 + r32] = lB; }
    asm volatile("s_waitcnt lgkmcnt(0)" ::: "memory");
#pragma unroll
    for (int r = 0; r < 16; ++r) { const float ra = __builtin_amdgcn_rcpf(wsf[crow(r, hi)]), rb = __builtin_amdgcn_rcpf(wsf[32 + crow(r, hi)]); o1[0][r] *= ra; o1[1][r] *= ra; o2[0][r] *= rb; o2[1][r] *= rb; }
}
template <class KV, class Hook>
__device__ __forceinline__ void flash_core_dual_sp(LAS unsigned char* shm, const bf16_t* qptr, const KV& kv, int NT, const Hook& hk, f32x16 (&o1)[2], f32x16 (&o2)[2], const int tid) {
    const int lane = tid & 63, r32 = lane & 31, hi = lane >> 5; const int wid = __builtin_amdgcn_readfirstlane(tid >> 6);
    const unsigned lds0 = (unsigned)(uintptr_t)shm;
    LAS float* wsf = (LAS float*)(shm + L_WS) + wid * 64;
    const unsigned kdst = lds0 + L_K + wid * 1024, vdst = lds0 + L_V + wid * 1024;
    const int vrow_j = 16 * (wid & 3) + (lane >> 2), vcol = (wid >> 2) * 32 + (lane & 3) * 8;
#define FA_DMAK(t) glds16(kv.kptr((t), lane) + wid * 8, (unsigned)__builtin_amdgcn_readfirstlane(kdst + ((t) & 1) * SLOTB))
#define FA_DMAV(t) glds16(kv.vptr((t), vrow_j) + vcol, (unsigned)__builtin_amdgcn_readfirstlane(vdst + ((t) & 1) * SLOTB))
    FA_DMAK(0); FA_DMAV(0); if (NT > 1) FA_DMAK(1);
    bf16x8 qr[4];
#pragma unroll
    for (int d0 = 0; d0 < 4; ++d0) qr[d0] = *(const bf16x8*)(qptr + d0 * 16 + hi * 8);
    asm volatile("" : "+v"(qr[0]), "+v"(qr[1]), "+v"(qr[2]), "+v"(qr[3]));
    LAS bf16x8* qst = (LAS bf16x8*)(shm + L_QST) + wid * 256 + lane;
    qst[0] = qr[0]; qst[64] = qr[1]; qst[128] = qr[2]; qst[192] = qr[3];
    float mA = 0.f, lA = 0.f, mB = 0.f, lB = 0.f;
    o1[0] = f32x16{}; o1[1] = f32x16{}; o2[0] = f32x16{}; o2[1] = f32x16{}; const f32x16 zero16 = f32x16{};
    const int vb0 = (int)(lds0 + L_V) + ((lane >> 4) & 1) * 32 + (lane & 3) * 8 + (4 * hi + ((lane & 15) >> 2)) * 64;
    bf16x8 kfA[4], kfB[4]; f32x16 pA0, pA1, pB0, pB1;
#define FA_KLOADA(tt) do { LAS const unsigned char* kb_ = shm + L_K + ((tt) & 1) * SLOTB + hi * 1024 + r32 * 16; \
        kfA[0] = *(LAS const bf16x8*)(kb_); kfA[1] = *(LAS const bf16x8*)(kb_ + 512); kfA[2] = *(LAS const bf16x8*)(kb_ + 2048); kfA[3] = *(LAS const bf16x8*)(kb_ + 2560); } while (0)
#define FA_KLOADB(tt) do { LAS const unsigned char* kb_ = shm + L_K + ((tt) & 1) * SLOTB + hi * 1024 + r32 * 16; \
        kfB[0] = *(LAS const bf16x8*)(kb_ + 4096); kfB[1] = *(LAS const bf16x8*)(kb_ + 4608); kfB[2] = *(LAS const bf16x8*)(kb_ + 6144); kfB[3] = *(LAS const bf16x8*)(kb_ + 6656); } while (0)
#define FA_QKA() do { const bf16x8 q0_ = qst[0], q1_ = qst[64]; pA0 = __builtin_amdgcn_mfma_f32_32x32x16_bf16(kfA[0], q0_, zero16, 0, 0, 0); pA1 = __builtin_amdgcn_mfma_f32_32x32x16_bf16(kfA[1], q0_, zero16, 0, 0, 0); \
        pA0 = __builtin_amdgcn_mfma_f32_32x32x16_bf16(kfA[2], q1_, pA0, 0, 0, 0); pA1 = __builtin_amdgcn_mfma_f32_32x32x16_bf16(kfA[3], q1_, pA1, 0, 0, 0); } while (0)
#define FA_QKB() do { const bf16x8 q2_ = qst[128], q3_ = qst[192]; pB0 = __builtin_amdgcn_mfma_f32_32x32x16_bf16(kfB[0], q2_, zero16, 0, 0, 0); pB1 = __builtin_amdgcn_mfma_f32_32x32x16_bf16(kfB[1], q2_, zero16, 0, 0, 0); \
        pB0 = __builtin_amdgcn_mfma_f32_32x32x16_bf16(kfB[2], q3_, pB0, 0, 0, 0); pB1 = __builtin_amdgcn_mfma_f32_32x32x16_bf16(kfB[3], q3_, pB1, 0, 0, 0); } while (0)
#define FA_SM(p0, p1, mh, ll, oo, PW0, PW1, PW2, PW3) do { \
        hk.apply(p0, p1, t); \
        const float rm = rowmax(p0, p1) + curb - mh; \
        if (__any(rm > THR)) { const float dl = __builtin_fmaxf(rm, 0.f); mh += dl; \
            const float f = __builtin_amdgcn_exp2f(-dl); ll *= f; if (hi == 0) wsf[r32] = f; \
            asm volatile("s_waitcnt lgkmcnt(0)" ::: "memory"); \
            _Pragma("unroll") for (int r = 0; r < 16; ++r) { const float fr_ = wsf[crow(r, hi)]; oo[0][r] *= fr_; oo[1][r] *= fr_; } \
            asm volatile("s_waitcnt lgkmcnt(0)" ::: "memory"); } \
        float sacc = 0.f, sacc2 = 0.f; const float mref_ = mh - curb; \
        _Pragma("unroll") for (int r = 0; r < 16; ++r) { p0[r] = __builtin_amdgcn_exp2f(p0[r] - mref_); p1[r] = __builtin_amdgcn_exp2f(p1[r] - mref_); sacc += p0[r]; sacc2 += p1[r]; } \
        ll += sacc + sacc2; \
        PW0 = (u32x4){cvtpk_s(p0[0], p0[1]), cvtpk_s(p0[2], p0[3]), cvtpk_s(p0[4], p0[5]), cvtpk_s(p0[6], p0[7])}; \
        PW1 = (u32x4){cvtpk_s(p0[8], p0[9]), cvtpk_s(p0[10], p0[11]), cvtpk_s(p0[12], p0[13]), cvtpk_s(p0[14], p0[15])}; \
        PW2 = (u32x4){cvtpk_s(p1[0], p1[1]), cvtpk_s(p1[2], p1[3]), cvtpk_s(p1[4], p1[5]), cvtpk_s(p1[6], p1[7])}; \
        PW3 = (u32x4){cvtpk_s(p1[8], p1[9]), cvtpk_s(p1[10], p1[11]), cvtpk_s(p1[12], p1[13]), cvtpk_s(p1[14], p1[15])}; \
    } while (0)
    FA_WAIT_BAR(0);
    FA_KLOADA(0); FA_KLOADB(0);
    FA_QKB();
    { const float cb0 = hk.cbias(0); mB = rowmax(pB0, pB1) + cb0; FA_QKA(); mA = rowmax(pA0, pA1) + cb0; }
#define FA_VTR(off) __builtin_bit_cast(s16x4, __builtin_amdgcn_ds_read_tr16_b64_v4i16((LAS v4i16_t*)(vp_ + (off))))
#define FA_PVM(oo, w0, w1, w2, w3) do { LAS const unsigned char* vp_ = shm + L_V + (t & 1) * SLOTB + vboff; \
        _Pragma("unroll") for (int d0 = 0; d0 < 2; ++d0) { s16x4 lo[4], hi_[4]; \
            _Pragma("unroll") for (int ks = 0; ks < 4; ++ks) { lo[ks] = FA_VTR(d0 * 4096 + ks * 1024); hi_[ks] = FA_VTR(d0 * 4096 + ks * 1024 + 512); } \
            oo[d0] = __builtin_amdgcn_mfma_f32_32x32x16_bf16(__builtin_bit_cast(bf16x8, w0), (bf16x8){lo[0][0], lo[0][1], lo[0][2], lo[0][3], hi_[0][0], hi_[0][1], hi_[0][2], hi_[0][3]}, oo[d0], 0, 0, 0); \
            oo[d0] = __builtin_amdgcn_mfma_f32_32x32x16_bf16(__builtin_bit_cast(bf16x8, w1), (bf16x8){lo[1][0], lo[1][1], lo[1][2], lo[1][3], hi_[1][0], hi_[1][1], hi_[1][2], hi_[1][3]}, oo[d0], 0, 0, 0); \
            oo[d0] = __builtin_amdgcn_mfma_f32_32x32x16_bf16(__builtin_bit_cast(bf16x8, w2), (bf16x8){lo[2][0], lo[2][1], lo[2][2], lo[2][3], hi_[2][0], hi_[2][1], hi_[2][2], hi_[2][3]}, oo[d0], 0, 0, 0); \
            oo[d0] = __builtin_amdgcn_mfma_f32_32x32x16_bf16(__builtin_bit_cast(bf16x8, w3), (bf16x8){lo[3][0], lo[3][1], lo[3][2], lo[3][3], hi_[3][0], hi_[3][1], hi_[3][2], hi_[3][3]}, oo[d0], 0, 0, 0); } } while (0)
    const int vboff = ((lane >> 4) & 1) * 32 + (lane & 3) * 8 + (4 * hi + ((lane & 15) >> 2)) * 64;
    for (int t = 0; t < NT; ++t) {
        if (t + 2 < NT) FA_DMAK(t + 2);
        if (t + 1 < NT) FA_DMAV(t + 1);
        const float curb = hk.cbias(t);
        FA_QKB();
        SBAR();
        if (t + 1 < NT) { FA_KLOADA(t + 1); FA_KLOADB(t + 1); }
        { u32x4 a0, a1, a2, a3;
          FA_SM(pA0, pA1, mA, lA, o1, a0, a1, a2, a3);
          SBAR();
          FA_PVM(o1, a0, a1, a2, a3); }
        SBAR();
        { u32x4 b0_, b1_, b2_, b3_;
          FA_SM(pB0, pB1, mB, lB, o2, b0_, b1_, b2_, b3_);
          SBAR();
          if (t + 1 < NT) FA_QKA();
          SBAR();
          FA_PVM(o2, b0_, b1_, b2_, b3_); }
        FA_WAIT_BAR(0);
    }
#undef FA_PVM
#undef FA_VTR
#undef FA_DMAK
#undef FA_DMAV
#undef FA_KLOADA
#undef FA_KLOADB
#undef FA_QKA
#undef FA_QKB
#undef FA_SM
    { auto rr = __builtin_amdgcn_permlane32_swap(__float_as_uint(lA), __float_as_uint(lA), false, false); lA = __uint_as_float(rr[0]) + __uint_as_float(rr[1]); }
    { auto rr = __builtin_amdgcn_permlane32_swap(__float_as_uint(lB), __float_as_uint(lB), false, false); lB = __uint_as_float(rr[0]) + __uint_as_float(rr[1]); }
    if (hi == 0) { wsf[r32] = lA; wsf[32 + r32] = lB; }
    asm volatile("s_waitcnt lgkmcnt(0)" ::: "memory");
#pragma unroll
    for (int r = 0; r < 16; ++r) { const float ra = __builtin_amdgcn_rcpf(wsf[crow(r, hi)]), rb = __builtin_amdgcn_rcpf(wsf[32 + crow(r, hi)]); o1[0][r] *= ra; o1[1][r] *= ra; o2[0][r] *= rb; o2[1][r] *= rb; }
}
__device__ __forceinline__ void stage_o(LAS float* stg, const f32x16 (&o)[2], int r32, int hi) {
#pragma unroll
    for (int r = 0; r < 16; ++r) { const int orow = crow(r, hi); stg[orow * 64 + r32] = o[0][r]; stg[orow * 64 + 32 + r32] = o[1][r]; }
    asm volatile("s_waitcnt lgkmcnt(0)" ::: "memory");
}
__device__ __forceinline__ float silu(float g) { return g * __builtin_amdgcn_rcpf(1.f + __builtin_amdgcn_exp2f(-1.4426950408889634f * g)); }
}

#undef SBAR
namespace tb {
using bf16=unsigned short;
constexpr int D=64,DM=INW;
constexpr int NW=8,QBLK=32,QB=QBLK*NW,KVBLK=64;
__device__ __forceinline__ int crow(int r,int hi){return (r&3)+8*(r>>2)+4*hi;}
#define SBAR() __builtin_amdgcn_sched_barrier(0)
constexpr int NSLOT=3, SLOTB=8192;
constexpr int LDS_K=0, LDS_V=NSLOT*SLOTB, LDS_WS=2*NSLOT*SLOTB, LDS_OST=LDS_WS+NW*64*4, LDS_BYTES=LDS_OST+NW*4096;
constexpr float C2=0.125f*1.4426950408889634f;
__device__ __forceinline__ void glds16(const void*gsrc,unsigned lds_dst){unsigned keep;
  asm volatile("s_mov_b32 %0, m0\n\ts_mov_b32 m0, %2\n\ts_nop 0\n\tglobal_load_lds_dwordx4 %1, off\n\ts_mov_b32 m0, %0":"=&s"(keep):"v"(gsrc),"s"(lds_dst):"memory");}
__device__ __forceinline__ void glds16s(const void*sbase,unsigned voff,unsigned lds_dst){
  asm volatile("s_mov_b32 m0, %2\n\ts_nop 0\n\tglobal_load_lds_dwordx4 %0, %1"::"v"(voff),"s"(sbase),"s"(lds_dst):"memory");}
__device__ __forceinline__ float max3f(float a,float b,float c){float r;asm("v_max3_f32 %0, %1, %2, %3":"=v"(r):"v"(a),"v"(b),"v"(c));return r;}
__device__ __forceinline__ float max2f(float a,float b){float r;asm("v_max_f32_e32 %0, %1, %2":"=v"(r):"v"(a),"v"(b));return r;}
__device__ __forceinline__ float fadd_s(float a,float b){float r;asm("v_add_f32_e32 %0, %1, %2":"=v"(r):"v"(a),"v"(b));return r;}
__device__ __forceinline__ float fsub_s(float a,float b){float r;asm("v_sub_f32_e32 %0, %1, %2":"=v"(r):"v"(a),"v"(b));return r;}
typedef float f32x2_t __attribute__((ext_vector_type(2))); typedef __bf16 bf16x2_t __attribute__((ext_vector_type(2)));
__device__ __forceinline__ unsigned cvtpk_s(float lo,float hi){f32x2_t v={lo,hi};bf16x2_t b=__builtin_convertvector(v,bf16x2_t);return __builtin_bit_cast(unsigned,b);}
#define LGKM_IMM(N) (0xC07F|((N)<<8))
#define WAIT_BAR(N) do{ asm volatile("s_waitcnt vmcnt(" #N ")":::"memory"); __builtin_amdgcn_s_waitcnt(LGKM_IMM(0)); __builtin_amdgcn_s_barrier(); asm volatile("":::"memory"); }while(0)

__device__ __forceinline__ void qkt(f32x16&p0,f32x16&p1,const char*Kslot,const bf16x8*qr,const f32x16&negm,int r32,int hi){
  const char*kb=Kslot+hi*1024+r32*16;
  #pragma unroll
  for(int d0=0;d0<4;++d0){
    const bf16x8 b0=*reinterpret_cast<const bf16x8*>(kb+d0*2048);
    const bf16x8 b1=*reinterpret_cast<const bf16x8*>(kb+d0*2048+512);
    if(d0==0){p0=__builtin_amdgcn_mfma_f32_32x32x16_bf16(b0,qr[0],negm,0,0,0);p1=__builtin_amdgcn_mfma_f32_32x32x16_bf16(b1,qr[0],negm,0,0,0);}
    else{p0=__builtin_amdgcn_mfma_f32_32x32x16_bf16(b0,qr[d0],p0,0,0,0);p1=__builtin_amdgcn_mfma_f32_32x32x16_bf16(b1,qr[d0],p1,0,0,0);}}
}
typedef __attribute__((address_space(3))) const char* lds_cptr;
__device__ __forceinline__ void kload8(bf16x8*kf,lds_cptr kp){
  kf[0]=*(const __attribute__((address_space(3))) bf16x8*)(kp);      kf[1]=*(const __attribute__((address_space(3))) bf16x8*)(kp+512);
  kf[2]=*(const __attribute__((address_space(3))) bf16x8*)(kp+2048); kf[3]=*(const __attribute__((address_space(3))) bf16x8*)(kp+2560);
  kf[4]=*(const __attribute__((address_space(3))) bf16x8*)(kp+4096); kf[5]=*(const __attribute__((address_space(3))) bf16x8*)(kp+4608);
  kf[6]=*(const __attribute__((address_space(3))) bf16x8*)(kp+6144); kf[7]=*(const __attribute__((address_space(3))) bf16x8*)(kp+6656);
}
__device__ __forceinline__ void kload4(bf16x8*kf,lds_cptr kp){
  kf[0]=*(const __attribute__((address_space(3))) bf16x8*)(kp);      kf[1]=*(const __attribute__((address_space(3))) bf16x8*)(kp+512);
  kf[2]=*(const __attribute__((address_space(3))) bf16x8*)(kp+2048); kf[3]=*(const __attribute__((address_space(3))) bf16x8*)(kp+2560);
}
__device__ __forceinline__ void kload2(bf16x8*kf,lds_cptr kp,int j){ kf[2*j]=*(const __attribute__((address_space(3))) bf16x8*)(kp+j*2048); kf[2*j+1]=*(const __attribute__((address_space(3))) bf16x8*)(kp+j*2048+512); }
__device__ __forceinline__ s16x4 vtr(lds_cptr p){ return __builtin_bit_cast(s16x4,__builtin_amdgcn_ds_read_tr16_b64_v4i16((__attribute__((address_space(3))) v4i16_t*)p)); }
__device__ __forceinline__ float rowmax(const f32x16&p0,const f32x16&p1){
  float a=max3f(p0[0],p0[1],p1[0]),b=max3f(p0[2],p0[3],p1[1]);a=max3f(a,p1[2],p1[3]);
  #pragma unroll
  for(int r=4;r<16;r+=4){a=max3f(a,p0[r],p0[r+1]);b=max3f(b,p0[r+2],p0[r+3]);a=max3f(a,p1[r],p1[r+1]);b=max3f(b,p1[r+2],p1[r+3]);}
  const float m=max2f(a,b);
  auto rr=__builtin_amdgcn_permlane32_swap(__float_as_uint(m),__float_as_uint(m),false,false);
  return max2f(__uint_as_float(rr[0]),__uint_as_float(rr[1]));
}
__device__ __forceinline__ void pv(f32x16*o,int vb,bf16x8 pa0,bf16x8 pa1,bf16x8 pa2,bf16x8 pa3){
  #pragma unroll
  for(int d0=0;d0<2;++d0){s16x4 lo[4],hi[4];
    #pragma unroll
    for(int ks=0;ks<4;++ks){
      asm volatile("ds_read_b64_tr_b16 %0,%1 offset:%c2":"=&v"(lo[ks]):"v"(vb),"i"(d0*4096+ks*1024):"memory");
      asm volatile("ds_read_b64_tr_b16 %0,%1 offset:%c2":"=&v"(hi[ks]):"v"(vb),"i"(d0*4096+ks*1024+512):"memory");}
    asm volatile("s_waitcnt lgkmcnt(0)":::"memory");SBAR();
    #define PK(k) (bf16x8){lo[k][0],lo[k][1],lo[k][2],lo[k][3],hi[k][0],hi[k][1],hi[k][2],hi[k][3]}
    o[d0]=__builtin_amdgcn_mfma_f32_32x32x16_bf16(pa0,PK(0),o[d0],0,0,0);
    o[d0]=__builtin_amdgcn_mfma_f32_32x32x16_bf16(pa1,PK(1),o[d0],0,0,0);
    o[d0]=__builtin_amdgcn_mfma_f32_32x32x16_bf16(pa2,PK(2),o[d0],0,0,0);
    o[d0]=__builtin_amdgcn_mfma_f32_32x32x16_bf16(pa3,PK(3),o[d0],0,0,0);
    #undef PK
  }
}

template<int THRL,int MODE,bool BOUND> __device__ __forceinline__ void attn_unit(const int tid,const bf16*Qw,const bf16*__restrict__ Kh,const bf16*__restrict__ Vh,const int NT,const bf16*Gp,bf16*Ow,char*shm,
                                                                 const int cmap,const __attribute__((address_space(3))) float*tabc,const int qw,const float bl,const float br,const float kbound,const float badd){
  const int lane=tid&63,r32=lane&31,hi=lane>>5; const int wid=__builtin_amdgcn_readfirstlane(tid>>6);
  unsigned m0keep; asm volatile("s_mov_b32 %0, m0":"=s"(m0keep)::"memory");
  const unsigned lds0=(unsigned)(uintptr_t)shm;
  float*wsf=(float*)(shm+LDS_WS)+wid*64;
  const unsigned koff=(unsigned)(lane*DM+wid*8)*2u;
  const unsigned voff=(unsigned)((16*(wid&3)+(lane>>2))*DM+(wid>>2)*32+(lane&3)*8)*2u;
  const unsigned kdst=lds0+LDS_K+wid*1024, vdst=lds0+LDS_V+wid*1024;
  #define DMA_K(t,slot) glds16s(Kh+(long)(t)*KVBLK*DM,koff,(unsigned)__builtin_amdgcn_readfirstlane(kdst+(slot)))
  #define DMA_V(t,slot) glds16s(Vh+(long)(t)*KVBLK*DM,voff,(unsigned)__builtin_amdgcn_readfirstlane(vdst+(slot)))
  const int vb0=(int)(lds0+LDS_V)+((lane>>4)&1)*32+(lane&3)*8+(4*hi+((lane&15)>>2))*64;
  const char*Kbase=shm+LDS_K; bf16x8 kf[8];
  const lds_cptr shm3=(lds_cptr)shm; const lds_cptr kp0=shm3+LDS_K+hi*1024+r32*16; const lds_cptr kpLo=kp0+(MODE==1?cmap*4096:0), kpHi=kp0+(MODE==1?(1-cmap)*4096:4096); const lds_cptr vp0=shm3+LDS_V+((lane>>4)&1)*32+(lane&3)*8+(4*hi+((lane&15)>>2))*64;
  DMA_K(0,0);DMA_V(0,0);DMA_K(1,SLOTB);
  bf16x8 qr[4];
  #pragma unroll
  for(int d0=0;d0<4;++d0){ if(MODE==0||d0<2)qr[d0]=*reinterpret_cast<const bf16x8*>(&Qw[(long)r32*DM+d0*16+hi*8]); else qr[d0]=(bf16x8){0,0,0,0,0,0,0,0}; }
  float mrow=0.f;
  if(BOUND){ float q2=0.f;
    #pragma unroll
    for(int d0=0;d0<(MODE==1?2:4);++d0){
      #pragma unroll
      for(int e=0;e<8;++e){ const float x=__builtin_bit_cast(float,(unsigned)(unsigned short)qr[d0][e]<<16); q2+=x*x; } }
    { auto rr=__builtin_amdgcn_permlane32_swap(__float_as_uint(q2),__float_as_uint(q2),false,false); q2=__uint_as_float(rr[0])+__uint_as_float(rr[1]); }
    mrow=sqrtf(q2)*kbound+badd; }
  float mhat=0.f,l_reg=0.f;f32x16 o[2];o[0]=f32x16{};o[1]=f32x16{};f32x16 negm=f32x16{};asm volatile("":"+v"(negm));
  const unsigned blu=__builtin_amdgcn_readfirstlane(__float_as_uint(bl)), bru=__builtin_amdgcn_readfirstlane(__float_as_uint(br)); unsigned curbu=0u; float curb=0.f;
  #define cbias_(t) ((64*(t)+63-qw<=-91)?blu:((64*(t)-qw-31>=91)?bru:0u))
  #define CBSET(t) do{ if(MODE==1){ const unsigned cb_=cbias_(t); if(cb_!=curbu){ curbu=cb_; curb=__uint_as_float(curbu); _Pragma("unroll") for(int r=0;r<16;++r)negm[r]=curb-mhat; asm volatile("":"+v"(negm)); } } }while(0)
  #define BIASHOOK(P0,P1,t) do{ if(MODE==1){ if(64*(t)+63-qw>-91&&64*(t)-qw-31<91){ const __attribute__((address_space(3))) float*tp_=tabc+(320+64*(t)-qw-r32+4*hi); \
      _Pragma("unroll") for(int r=0;r<16;++r){const int kk_=(r&3)+8*(r>>2);P0[r]+=tp_[kk_];P1[r]+=tp_[kk_+32];} } } }while(0)
  #define CMASK(P0,P1,t) BIASHOOK(P0,P1,t)
  bool resc=false;
  #define START(P0,P1) do{ const float rm=BOUND?mrow:rowmax(P0,P1); resc=false; \
    { const float dl=rm; mhat=fadd_s(mhat,dl); \
      _Pragma("unroll") for(int r=0;r<16;++r){P0[r]=fsub_s(P0[r],dl);P1[r]=fsub_s(P1[r],dl);} \
      _Pragma("unroll") for(int r=0;r<16;++r)negm[r]=curb-mhat; asm volatile("":"+v"(negm)); } \
    _Pragma("unroll") for(int r=0;r<16;++r)P0[r]=__builtin_amdgcn_exp2f(P0[r]); }while(0)
  #define RESC() do{ if(resc){ asm volatile("s_waitcnt lgkmcnt(0)":::"memory"); \
      _Pragma("unroll") for(int d_=0;d_<2;++d_) _Pragma("unroll") for(int r=0;r<16;++r)o[d_][r]*=wsf[crow(r,hi)]; } }while(0)
  f32x16 pA0,pA1,pB0,pB1;
  int sl_prev=0,sl_cur=0,sl_next=SLOTB;
  #define ROT() do{sl_prev=sl_cur;sl_cur=sl_next;sl_next=(sl_next==(NSLOT-1)*SLOTB)?0:sl_next+SLOTB;}while(0)
  DMA_K(2,2*SLOTB);
  WAIT_BAR(3);
  if(MODE==1){ curbu=cbias_(0); curb=__uint_as_float(curbu); _Pragma("unroll") for(int r=0;r<16;++r)negm[r]=curb; asm volatile("":"+v"(negm)); }
  kload4(kf,kpLo);if(MODE==0)kload4(kf+4,kpHi);
  pA0=__builtin_amdgcn_mfma_f32_32x32x16_bf16(kf[0],qr[0],negm,0,0,0);pA1=__builtin_amdgcn_mfma_f32_32x32x16_bf16(kf[1],qr[0],negm,0,0,0);
  _Pragma("unroll") for(int d0=1;d0<(MODE==1?2:4);++d0){pA0=__builtin_amdgcn_mfma_f32_32x32x16_bf16(kf[2*d0],qr[d0],pA0,0,0,0);pA1=__builtin_amdgcn_mfma_f32_32x32x16_bf16(kf[2*d0+1],qr[d0],pA1,0,0,0);}
  asm volatile("s_nop 15\n\ts_nop 7":"+v"(pA0),"+v"(pA1));CMASK(pA0,pA1,0);
  START(pA0,pA1);
  _Pragma("unroll") for(int r=0;r<16;++r)pA1[r]=__builtin_amdgcn_exp2f(pA1[r]);
  WAIT_BAR(0);
  DMA_K(3,0);DMA_V(1,SLOTB);
  ROT();
  kload4(kf,kpLo+sl_cur);if(MODE==0)kload4(kf+4,kpHi+sl_cur);
  WAIT_BAR(2);
  s16x4 vlo[8],vhi[8]; u32x4 pw0,pw1,pw2,pw3;
  #define PKW(P,B) cvtpk_s(P[B],P[B+1])
  #define PAF(k) __builtin_bit_cast(bf16x8,pw##k)
  #define VFR(i) (bf16x8){vlo[i][0],vlo[i][1],vlo[i][2],vlo[i][3],vhi[i][0],vhi[i][1],vhi[i][2],vhi[i][3]}
  #define PIN(x) asm volatile("":"+v"(x))
  #define MX3(a,b,c) __builtin_fmaxf(__builtin_fmaxf((a),(b)),(c))
  #define GAPA(MF,A0,A1,A2,A3,W0,W1,PW) do{ MF; sacc+=A0; sacc+=A1; sacc+=A2; sacc+=A3; PIN(sacc); W0; W1; PIN(PW); SBAR(); }while(0)
  #define EX(v) __builtin_amdgcn_exp2f(v)
  #define GAPB(MF,X,B) do{ MF; X[B]=EX(X[B]); X[B+1]=EX(X[B+1]); X[B+2]=EX(X[B+2]); X[B+3]=EX(X[B+3]); PIN(X); SBAR(); }while(0)
  #define VRD(i) do{ vlo[i]=vtr(vp_+(((i)>>2)*4096+((i)&3)*1024)); vhi[i]=vtr(vp_+(((i)>>2)*4096+((i)&3)*1024+512)); }while(0)
  #define KRD(G,j) do{ if(G){ if((j)<2){kload2(kf,kpLo+sl_next,(j));}else if(MODE==0){kload2(kf+4,kpHi+sl_next,(j)-2);} SBAR(); } }while(0)
  #define STEP(C0,C1,P0,P1,t,GK,GV,GL) do{ SBAR(); \
    const lds_cptr vp_=vp0+sl_prev; \
    VRD(0); SBAR(); float sacc=(P0[0]+P0[1]); \
    GAPA(C0=__builtin_amdgcn_mfma_f32_32x32x16_bf16(kf[0],qr[0],negm,0,0,0), P0[2],P0[3],P0[4],P0[5],     pw0[0]=PKW(P0,0), pw0[1]=PKW(P0,2), pw0); \
    VRD(4); SBAR(); GAPA(C1=__builtin_amdgcn_mfma_f32_32x32x16_bf16(kf[1],qr[0],negm,0,0,0), P0[6],P0[7],P0[8],P0[9],     pw0[2]=PKW(P0,4), pw0[3]=PKW(P0,6), pw0); \
    VRD(1); SBAR(); GAPA(C0=__builtin_amdgcn_mfma_f32_32x32x16_bf16(kf[2],qr[1],C0,0,0,0),   P0[10],P0[11],P0[12],P0[13], pw1[0]=PKW(P0,8), pw1[1]=PKW(P0,10), pw1); \
    VRD(5); SBAR(); GAPA(C1=__builtin_amdgcn_mfma_f32_32x32x16_bf16(kf[3],qr[1],C1,0,0,0),   P0[14],P0[15],P1[0],P1[1],   pw1[2]=PKW(P0,12),pw1[3]=PKW(P0,14), pw1); \
    VRD(2); SBAR(); GAPA(if(MODE==0)C0=__builtin_amdgcn_mfma_f32_32x32x16_bf16(kf[4],qr[2],C0,0,0,0),   P1[2],P1[3],P1[4],P1[5],     pw2[0]=PKW(P1,0), pw2[1]=PKW(P1,2), pw2); \
    VRD(6); SBAR(); GAPA(if(MODE==0)C1=__builtin_amdgcn_mfma_f32_32x32x16_bf16(kf[5],qr[2],C1,0,0,0),   P1[6],P1[7],P1[8],P1[9],     pw2[2]=PKW(P1,4), pw2[3]=PKW(P1,6), pw2); \
    VRD(3); SBAR(); GAPA(if(MODE==0)C0=__builtin_amdgcn_mfma_f32_32x32x16_bf16(kf[6],qr[3],C0,0,0,0),   P1[10],P1[11],P1[12],P1[13], pw3[0]=PKW(P1,8), pw3[1]=PKW(P1,10), pw3); \
    VRD(7); SBAR(); GAPA(if(MODE==0)C1=__builtin_amdgcn_mfma_f32_32x32x16_bf16(kf[7],qr[3],C1,0,0,0),   P1[14],P1[15],0.f,0.f,       pw3[2]=PKW(P1,12),pw3[3]=PKW(P1,14), pw3); \
    l_reg+=sacc; \
    if(GK){DMA_K((t)+3,sl_cur);} if(GV){DMA_V((t)+1,sl_next);} \
    CMASK(C0,C1,t); \
    if(!BOUND){ float a=MX3(C0[0],C0[1],C1[0]),b=MX3(C0[2],C0[3],C1[1]); a=MX3(a,C1[2],C1[3]); \
      _Pragma("unroll") for(int r=4;r<16;r+=4){a=MX3(a,C0[r],C0[r+1]);b=MX3(b,C0[r+2],C0[r+3]);a=MX3(a,C1[r],C1[r+1]);b=MX3(b,C1[r+2],C1[r+3]);} \
      float rm=__builtin_fmaxf(a,b); { auto rr=__builtin_amdgcn_permlane32_swap(__float_as_uint(rm),__float_as_uint(rm),false,false); rm=__builtin_fmaxf(__uint_as_float(rr[0]),__uint_as_float(rr[1])); } \
      resc=false; \
      if(__builtin_expect(__any(rm>(float)THRL),0)){ const float dl=__builtin_fmaxf(rm,0.f); mhat+=dl; \
        _Pragma("unroll") for(int r=0;r<16;++r){C0[r]-=dl;C1[r]-=dl;} \
        _Pragma("unroll") for(int r=0;r<16;++r)negm[r]=curb-mhat; asm volatile("":"+v"(negm)); \
        const float f=__builtin_amdgcn_exp2f(-dl); l_reg*=f; if(hi==0)wsf[r32]=f; resc=true; } } \
    SBAR(); \
    __builtin_amdgcn_s_waitcnt(LGKM_IMM(8)); SBAR();        \
    GAPB(o[0]=__builtin_amdgcn_mfma_f32_32x32x16_bf16(PAF(0),VFR(0),o[0],0,0,0), C0,0); \
    GAPB(o[1]=__builtin_amdgcn_mfma_f32_32x32x16_bf16(PAF(0),VFR(4),o[1],0,0,0), C0,4); \
    KRD(GL,0); GAPB(o[0]=__builtin_amdgcn_mfma_f32_32x32x16_bf16(PAF(1),VFR(1),o[0],0,0,0), C0,8); \
    KRD(GL,1); GAPB(o[1]=__builtin_amdgcn_mfma_f32_32x32x16_bf16(PAF(1),VFR(5),o[1],0,0,0), C0,12); \
    KRD(GL,2); if(GL){ __builtin_amdgcn_s_waitcnt(LGKM_IMM(4+(MODE==0?6:4))); }else{ __builtin_amdgcn_s_waitcnt(LGKM_IMM(4)); } SBAR();     \
    GAPB(o[0]=__builtin_amdgcn_mfma_f32_32x32x16_bf16(PAF(2),VFR(2),o[0],0,0,0), C1,0); \
    KRD(GL,3); GAPB(o[1]=__builtin_amdgcn_mfma_f32_32x32x16_bf16(PAF(2),VFR(6),o[1],0,0,0), C1,4); \
    if(GL){ __builtin_amdgcn_s_waitcnt(LGKM_IMM(MODE==0?8:4)); }else{ __builtin_amdgcn_s_waitcnt(LGKM_IMM(0)); } SBAR();                    \
    GAPB(o[0]=__builtin_amdgcn_mfma_f32_32x32x16_bf16(PAF(3),VFR(3),o[0],0,0,0), C1,8); \
    GAPB(o[1]=__builtin_amdgcn_mfma_f32_32x32x16_bf16(PAF(3),VFR(7),o[1],0,0,0), C1,12); \
    }while(0)
  int t=1;
  #undef CMASK
  #define CMASK(P0,P1,t) BIASHOOK(P0,P1,t)
  #define FARL_(tt) (64*(tt)+63-qw<=-91)
  #define FARR_(tt) (64*(tt)-qw-31>=91)
  #define CBS_(x) do{ if(trip_near){ CBSET(x); } }while(0)
  #undef CMASK
  #define CMASK(P0,P1,t) do{ if(trip_near){ BIASHOOK(P0,P1,t); } }while(0)
  for(;t+9<NT;t+=6){
    const bool trip_near=(MODE==1)&&!(FARL_(t+5)||FARR_(t));
    if(MODE==1&&!trip_near){ CBSET(t); }
    { constexpr int sl_prev=0,sl_cur=SLOTB,sl_next=2*SLOTB; CBS_(t);   STEP(pB0,pB1,pA0,pA1,t,true,true,true);     WAIT_BAR(2); RESC(); }
    { constexpr int sl_prev=SLOTB,sl_cur=2*SLOTB,sl_next=0; CBS_(t+1); STEP(pA0,pA1,pB0,pB1,t+1,true,true,true);   WAIT_BAR(2); RESC(); }
    { constexpr int sl_prev=2*SLOTB,sl_cur=0,sl_next=SLOTB; CBS_(t+2); STEP(pB0,pB1,pA0,pA1,t+2,true,true,true);   WAIT_BAR(2); RESC(); }
    { constexpr int sl_prev=0,sl_cur=SLOTB,sl_next=2*SLOTB; CBS_(t+3); STEP(pA0,pA1,pB0,pB1,t+3,true,true,true);   WAIT_BAR(2); RESC(); }
    { constexpr int sl_prev=SLOTB,sl_cur=2*SLOTB,sl_next=0; CBS_(t+4); STEP(pB0,pB1,pA0,pA1,t+4,true,true,true);   WAIT_BAR(2); RESC(); }
    { constexpr int sl_prev=2*SLOTB,sl_cur=0,sl_next=SLOTB; CBS_(t+5); STEP(pA0,pA1,pB0,pB1,t+5,true,true,true);   WAIT_BAR(2); RESC(); }
  }
  #undef CMASK
  #define CMASK(P0,P1,t) BIASHOOK(P0,P1,t)
  for(;t+5<NT;t+=2){
    CBSET(t);   STEP(pB0,pB1,pA0,pA1,t,true,true,true);     WAIT_BAR(2); RESC(); ROT();
    CBSET(t+1); STEP(pA0,pA1,pB0,pB1,t+1,true,true,true);   WAIT_BAR(2); RESC(); ROT();
  }
  #undef CMASK
  #define CMASK(P0,P1,t) BIASHOOK(P0,P1,t)
  #define ENDW(tt) do{ if((tt)+3<NT){WAIT_BAR(2);} else if((tt)+2<NT){WAIT_BAR(1);} else {WAIT_BAR(0);} }while(0)
  for(;t+1<NT;t+=2){
    CBSET(t);   STEP(pB0,pB1,pA0,pA1,t,(t+3<NT),(t+1<NT),(t+1<NT));       ENDW(t);   RESC(); ROT();
    CBSET(t+1); STEP(pA0,pA1,pB0,pB1,t+1,(t+4<NT),(t+2<NT),(t+2<NT));     ENDW(t+1); RESC(); ROT();
  }
  CBSET(NT-1); STEP(pB0,pB1,pA0,pA1,NT-1,false,false,false); RESC();
  { float sacc=pB0[0]+pB0[1]; _Pragma("unroll") for(int r=2;r<16;++r)sacc+=pB0[r]; _Pragma("unroll") for(int r=0;r<16;++r)sacc+=pB1[r]; l_reg+=sacc;
    pw0=(u32x4){PKW(pB0,0),PKW(pB0,2),PKW(pB0,4),PKW(pB0,6)};pw1=(u32x4){PKW(pB0,8),PKW(pB0,10),PKW(pB0,12),PKW(pB0,14)};pw2=(u32x4){PKW(pB1,0),PKW(pB1,2),PKW(pB1,4),PKW(pB1,6)};pw3=(u32x4){PKW(pB1,8),PKW(pB1,10),PKW(pB1,12),PKW(pB1,14)};
    SBAR(); pv(o,vb0+sl_cur,PAF(0),PAF(1),PAF(2),PAF(3)); }
  #undef PKW
  #undef PAF
  #undef VFR
  #undef PIN
  #undef MX3
  #undef GAPA
  #undef GAPB
  #undef EX
  #undef VRD
  #undef KRD
  #undef STEP
  #undef ENDW
  {auto rr=__builtin_amdgcn_permlane32_swap(__float_as_uint(l_reg),__float_as_uint(l_reg),false,false);l_reg=__uint_as_float(rr[0])+__uint_as_float(rr[1]);}
  if(hi==0)wsf[32+r32]=l_reg;asm volatile("s_waitcnt lgkmcnt(0)":::"memory");
  float rli[16];
  #pragma unroll
  for(int r=0;r<16;++r)rli[r]=__builtin_amdgcn_rcpf(wsf[32+crow(r,hi)]);
  { bf16*stg=(bf16*)(shm+LDS_OST)+wid*2048;
    #pragma unroll
    for(int r=0;r<16;++r){const int orow=crow(r,hi);
      #pragma unroll
      for(int d0=0;d0<2;++d0)stg[orow*64+d0*32+r32]=(bf16)(pk2(o[d0][r]*rli[r],0.f)&0xffffu);}
    asm volatile("s_waitcnt lgkmcnt(0)":::"memory");
    if(MODE==0){
    #pragma unroll
    for(int i=0;i<4;++i){const int row=i*8+(lane>>3),ch=lane&7; const u32x4 v=*(const u32x4*)(stg+row*64+ch*8); const u32x4 g=*(const u32x4*)(Gp+(long)row*DM+ch*8);
      u32x4 w; w.x=pk2(bflo(v.x)*fa::silu(bflo(g.x)),bfhi(v.x)*fa::silu(bfhi(g.x))); w.y=pk2(bflo(v.y)*fa::silu(bflo(g.y)),bfhi(v.y)*fa::silu(bfhi(g.y)));
      w.z=pk2(bflo(v.z)*fa::silu(bflo(g.z)),bfhi(v.z)*fa::silu(bfhi(g.z))); w.w=pk2(bflo(v.w)*fa::silu(bflo(g.w)),bfhi(v.w)*fa::silu(bfhi(g.w)));
      *(u32x4*)(Ow+(long)row*MIXW+ch*8)=w;} } }
  asm volatile("s_waitcnt lgkmcnt(0)\n\ts_barrier\n\ts_mov_b32 m0, %0"::"s"(m0keep):"memory");
  #undef DMA_K
  #undef DMA_V
  #undef CMASK
  #undef cbias_
  #undef CBSET
  #undef BIASHOOK
  #undef START
  #undef RESC
  #undef ROT
}
#undef SBAR
#undef WAIT_BAR
}
#define SBAR() __builtin_amdgcn_sched_barrier(0)

typedef GAS unsigned gu32;
#define XB_TMO      128
#define XB_XCNT(j)  (256  + 64 * (j))
#define XB_XSUB(j)  (1280 + 64 * (j))
#define XB_XGEN(j)  (2304 + 64 * (j))
#define XB_TOP      3328
#define XB_TOPGEN   3392
#define XCD_BAR_WORDS 3456
#define XB_SPIN_CAP (1u << 22)
__device__ __forceinline__ unsigned xb_ld(unsigned* p)              { return __hip_atomic_load(p, __ATOMIC_RELAXED, __HIP_MEMORY_SCOPE_AGENT); }
__device__ __forceinline__ unsigned xb_add(unsigned* p, unsigned v) { return __hip_atomic_fetch_add(p, v, __ATOMIC_RELAXED, __HIP_MEMORY_SCOPE_AGENT); }
__device__ __forceinline__ unsigned xb_xcc_id() { return (unsigned)__builtin_amdgcn_s_getreg((3 << 11) | 20) & 0xFu; }
#define XB_SPIN(cond, bar) do { unsigned _sp = 0; while (cond) { __builtin_amdgcn_s_sleep(1); \
    if ((++_sp & 255u) == 0u) { if (xb_ld(&(bar)[XB_TMO])) break; if (_sp > XB_SPIN_CAP) { atomicAdd(&(bar)[XB_TMO], 1u); break; } } } } while (0)
struct XcdBarrier { unsigned* bar; unsigned x; volatile LAS unsigned* st; };
__device__ __forceinline__ XcdBarrier xcd_barrier_post(unsigned* bar, volatile LAS unsigned* st) {
    XcdBarrier b; b.bar = bar; b.x = xb_xcc_id(); b.st = st;
    if (threadIdx.x == 0) (void)xb_add(&bar[XB_XCNT(b.x)], 1u);
    return b;
}
__device__ __forceinline__ void xcd_barrier_complete(unsigned* bar, unsigned x, unsigned& nloc, unsigned& nx) {
    const unsigned G = gridDim.x * gridDim.y * gridDim.z;
    unsigned sum, cnt, mine, sp = 0u;
    for (;;) {
        sum = 0u; cnt = 0u; mine = 0u;
#pragma unroll
        for (unsigned j = 0; j < 16; ++j) { const unsigned c = xb_ld(&bar[XB_XCNT(j)]); sum += c; cnt += (c > 0u) ? 1u : 0u; mine = (j == x) ? c : mine; }
        if (sum == G) break;
        __builtin_amdgcn_s_sleep(1);
        if ((++sp & 255u) == 0u) { if (xb_ld(&bar[XB_TMO])) break; if (sp > XB_SPIN_CAP) { atomicAdd(&bar[XB_TMO], 1u); break; } }
    }
    nloc = mine > 0u ? mine : 1u; nx = cnt > 0u ? cnt : 1u;
}
__device__ __forceinline__ void xcd_barrier(const XcdBarrier& b) {
    asm volatile("s_waitcnt vmcnt(0)" ::: "memory");
    __syncthreads();
    if (threadIdx.x == 0) {
        unsigned* bar = b.bar;
        __builtin_amdgcn_s_waitcnt(0);
        unsigned nloc = b.st[0], nx = b.st[1];
        if (nloc == 0u) { xcd_barrier_complete(bar, b.x, nloc, nx); b.st[0] = nloc; b.st[1] = nx; }
        const unsigned old = xb_add(&bar[XB_XSUB(b.x)], 1u);
        const unsigned gen = old / nloc;
        if (old + 1u == (gen + 1u) * nloc) {
            __builtin_amdgcn_fence(__ATOMIC_RELEASE, "agent");
            asm volatile("s_waitcnt vmcnt(0)" ::: "memory");
            const unsigned og = xb_add(&bar[XB_TOP], 1u);
            const unsigned tg = og / nx;
            if (og + 1u == (tg + 1u) * nx) xb_add(&bar[XB_TOPGEN], 1u);
            else XB_SPIN(xb_ld(&bar[XB_TOPGEN]) == tg, bar);
            __builtin_amdgcn_fence(__ATOMIC_ACQUIRE, "agent");
            xb_add(&bar[XB_XGEN(b.x)], 1u);
            asm volatile("s_waitcnt vmcnt(0)" ::: "memory");
        } else {
            XB_SPIN(xb_ld(&bar[XB_XGEN(b.x)]) == gen, bar);
            __builtin_amdgcn_fence(__ATOMIC_ACQUIRE, "agent");
            asm volatile("s_waitcnt vmcnt(0)" ::: "memory");
        }
    }
    __syncthreads();
}

constexpr int CW_SPLIT = 8192;
__device__ __forceinline__ void split_arrive(unsigned* cnt) {
    asm volatile("s_waitcnt vmcnt(0)" ::: "memory");
    __syncthreads();
    if (threadIdx.x == 0) {
        __builtin_amdgcn_fence(__ATOMIC_RELEASE, "agent");
        asm volatile("s_waitcnt vmcnt(0)" ::: "memory");
        (void)__hip_atomic_fetch_add(cnt, 1u, __ATOMIC_RELAXED, __HIP_MEMORY_SCOPE_AGENT);
    }
}
__device__ __forceinline__ void split_wait(unsigned* cnt, unsigned want) {
    if (threadIdx.x == 0) {
        unsigned sp = 0u;
        while (__hip_atomic_load(cnt, __ATOMIC_RELAXED, __HIP_MEMORY_SCOPE_AGENT) < want) { __builtin_amdgcn_s_sleep(2); if (++sp > (1u << 24)) break; }
        __builtin_amdgcn_fence(__ATOMIC_ACQUIRE, "agent");
        asm volatile("s_waitcnt vmcnt(0)" ::: "memory");
    }
    __syncthreads();
}

struct Frame {
    LAS unsigned char* lds;
    int tid, lane, wave, vcu, G;
    const float* const __attribute__((address_space(4)))* in; float* out; unsigned char* ws;
    bf16_t *WIN, *WOUT, *XNM, *PROJ, *BPART; float *BLSE, *TAB;
};
__device__ __forceinline__ float wave_sum(float v) {
#pragma unroll
    for (int o = 1; o < 64; o <<= 1) v += __shfl_xor(v, o);
    return v;
}
__device__ __forceinline__ int t5_bucket(int rel) {
    const int dist = rel < 0 ? -rel : rel; int v;
    if (dist < 8) v = dist; else { const unsigned q = (unsigned)(dist * dist) >> 6; const int k = 31 - __builtin_clz(q); v = 8 + k; if (v > 15) v = 15; }
    return v + (rel > 0 ? 16 : 0);
}
__device__ __forceinline__ float in_colscale(int n) {
    if (n >= C_BQ && n < C_BK) return 0.125f * LOG2E;
    if (n >= C_CQ && n < C_CK) return 0.17677669529663687f * LOG2E;
    if (n >= C_DQ && n < C_DK) return 0.125f * LOG2E;
    return 1.f;
}
template <bool IN>
__device__ __forceinline__ void transpose_item(const float* W, const float* g, int K, int N, bf16_t* WT, LAS float* scr, int item, int lane) {
    const int nblk = N / 32, kb = item / nblk, nb = item % nblk, k0 = 64 * kb, n0 = 32 * nb;
#pragma unroll 8
    for (int i = 0; i < 32; ++i) { const int kk = 2 * i + (lane >> 5); float w = W[(size_t)(k0 + kk) * N + n0 + (lane & 31)]; if (IN) w *= g[k0 + kk]; scr[kk * 33 + (lane & 31)] = w; }
    asm volatile("s_waitcnt lgkmcnt(0)" ::: "memory");
    const int c = lane & 7;
#pragma unroll
    for (int j = 0; j < 4; ++j) { const int n = (lane >> 3) + 8 * j; const LAS float* s = scr + (8 * c) * 33 + n; const float cs = IN ? in_colscale(n0 + n) : 1.f;
        u32x4 o; o.x = pk2(s[0 * 33] * cs, s[1 * 33] * cs); o.y = pk2(s[2 * 33] * cs, s[3 * 33] * cs); o.z = pk2(s[4 * 33] * cs, s[5 * 33] * cs); o.w = pk2(s[6 * 33] * cs, s[7 * 33] * cs);
        *(u32x4*)(WT + (size_t)(n0 + n) * K + k0 + 8 * c) = o; }
    asm volatile("s_waitcnt lgkmcnt(0)" ::: "memory");
}
__device__ __forceinline__ void phase_prologue(Frame& F) {
    LAS float* scr = (LAS float*)(F.lds + F.wave * 16384);
    const int gw = F.vcu * 8 + F.wave, NGW = F.G * 8;
    constexpr int I_IN = (DMODEL / 64) * (INW / 32), I_OUT = (MIXW / 64) * (DMODEL / 32);
    constexpr int NITEMS = DEPTH * (I_IN + I_OUT);
    for (int it = gw; it < NITEMS; it += NGW) {
        int r = it;
        if (r < DEPTH * I_IN) { const int l = r / I_IN; r -= l * I_IN; transpose_item<true>(F.in[2] + (size_t)l * DMODEL * INW, F.in[4] + l * DMODEL, DMODEL, INW, F.WIN + (size_t)l * INW * DMODEL, scr, r, F.lane); continue; }
        r -= DEPTH * I_IN; { const int l = r / I_OUT; r -= l * I_OUT; transpose_item<false>(F.in[3] + (size_t)l * MIXW * DMODEL, nullptr, MIXW, DMODEL, F.WOUT + (size_t)l * DMODEL * MIXW, scr, r, F.lane); }
    }
    if (blockIdx.x == 0) {
        float* T = F.TAB; const float* t5 = F.in[8];
        for (int i = F.tid; i < 128 * 16; i += 512) { const int pos = i >> 4, k = i & 15; const float f = exp2f(-(float)k * (13.287712379549449f / 16.f)); const float a = (float)pos * f; T[T_ROPE + 2 * i] = cosf(a); T[T_ROPE + 2 * i + 1] = sinf(a); }
        for (int i = F.tid; i < 4 * 641; i += 512) { const int h = i / 641, rel = i % 641 - 320; T[T_C + i] = t5[t5_bucket(rel) * 8 + 4 + h] * LOG2E; }
        for (int i = F.tid; i < 3 * 4 * 320; i += 512) { const int g = i / (4 * 320), h = (i / 320) & 3, off = i % 320 - 158; const int d = (g == 0) ? 1 : (g == 1 ? 4 : 16); T[T_B + i] = (off < -64 || off > 64) ? -INFINITY : t5[t5_bucket(off * d) * 8 + h] * LOG2E; }
        { const int lh = F.wave; const float* rp = F.in[14] + (size_t)lh * 465; float m = -1e30f;
          for (int i = F.lane; i < 465; i += 64) m = fmaxf(m, rp[i] * LOG2E);
          for (int o_ = 32; o_; o_ >>= 1) m = fmaxf(m, __shfl_xor(m, o_));
          if (F.lane == 0) T[T_BMAXD + lh] = m; }
        if (F.tid >= 68 && F.tid < 72) { const int h = F.tid - 68; float m = -1e30f; for (int bk = 0; bk < 32; ++bk) m = fmaxf(m, t5[bk * 8 + h] * LOG2E); T[T_BMAXB + h] = m; }
        if (F.tid >= 64 && F.tid < 68) { const int h = F.tid - 64; float m = -1e30f; for (int bk = 0; bk < 32; ++bk) m = fmaxf(m, t5[bk * 8 + 4 + h] * LOG2E); T[T_BMAX + h] = m; }
        if (F.tid < DEPTH) { const int l = F.tid; float s1 = 0.f, s2 = 0.f; for (int i = 0; i < 32; ++i) { s1 += F.in[9][l * 32 + i] * F.in[10][l * 32 + i]; s2 += F.in[11][l * 32 + i] * F.in[12][l * 32 + i]; }
            const float li = 0.8f - 0.6f * expf(-0.3f * (float)l); T[T_LAM + l] = expf(s1) - expf(s2) + li; }
    }
}
__device__ __forceinline__ void phase_xn(Frame& F, int layer) {
    const int gw = F.vcu * 8 + F.wave, NGW = F.G * 8;
    for (int m = gw; m < MTOT; m += NGW) {
        const float* src = (layer == 0) ? (m < RS ? F.in[0] + (size_t)m * DMODEL : F.in[1] + (size_t)(m - RS) * DMODEL) : F.out + (size_t)m * DMODEL;
        const f32x4* xr = (const f32x4*)src + F.lane; f32x4 v[4]; float s = 0.f;
#pragma unroll
        for (int j = 0; j < 4; ++j) { v[j] = xr[64 * j]; s += (v[j].x * v[j].x + v[j].y * v[j].y) + (v[j].z * v[j].z + v[j].w * v[j].w); }
        const float r = 1.f / sqrtf(wave_sum(s) * (1.f / DMODEL) + RMS_EPS);
        u32x2* o8 = (u32x2*)(F.XNM + (size_t)m * DMODEL) + F.lane;
#pragma unroll
        for (int j = 0; j < 4; ++j) { u32x2 w; w.x = pk2(v[j].x * r, v[j].y * r); w.y = pk2(v[j].z * r, v[j].w * r); o8[64 * j] = w; }
    }
}
__device__ __forceinline__ void phase_final(Frame& F) {
    const int gw = F.vcu * 8 + F.wave, NGW = F.G * 8; const float* g = F.in[5];
    for (int m = gw; m < MTOT; m += NGW) {
        f32x4* xr = (f32x4*)(F.out + (size_t)m * DMODEL) + F.lane; f32x4 v[4]; float s = 0.f;
#pragma unroll
        for (int j = 0; j < 4; ++j) { v[j] = xr[64 * j]; s += (v[j].x * v[j].x + v[j].y * v[j].y) + (v[j].z * v[j].z + v[j].w * v[j].w); }
        const float r = 1.f / sqrtf(wave_sum(s) * (1.f / DMODEL) + RMS_EPS);
#pragma unroll
        for (int j = 0; j < 4; ++j) { const f32x4 gg = *((const f32x4*)g + F.lane + 64 * j); xr[64 * j] = v[j] * r * gg; }
    }
}
__device__ __forceinline__ void phase_prepB(Frame& F, int s, int layer) {
    const int gw = F.vcu * 8 + F.wave, NGW = F.G * 8; const int lane = F.lane, half = lane >> 5, l32 = lane & 31;
    unsigned* kmaxB = (unsigned*)(F.ws + WS_CTL) + CW_KMAXB + (layer * 2 + s) * 4; unsigned* kmaxD = (unsigned*)(F.ws + WS_CTL) + CW_KMAXD + (layer * 2 + s) * 4;
    float kmB = 0.f, kmD = 0.f;
    for (int i0 = 0; gw + NGW * 2 * i0 < RS; i0 += 4) {
        u32x4 w[4], wd[4];
#pragma unroll
        for (int i = 0; i < 4; ++i) { const int lr = gw + NGW * (2 * (i0 + i) + half);
            w[i] = (lr < RS) ? *(const u32x4*)(F.PROJ + (size_t)lr * INW + C_BK + l32 * 8) : (u32x4){0u, 0u, 0u, 0u};
            wd[i] = (lr < RS) ? *(const u32x4*)(F.PROJ + (size_t)lr * INW + C_DK + l32 * 8) : (u32x4){0u, 0u, 0u, 0u}; }
#pragma unroll
        for (int i = 0; i < 4; ++i) { const float r[8] = {bflo(w[i].x), bfhi(w[i].x), bflo(w[i].y), bfhi(w[i].y), bflo(w[i].z), bfhi(w[i].z), bflo(w[i].w), bfhi(w[i].w)}; float k2 = 0.f;
            const float rd[8] = {bflo(wd[i].x), bfhi(wd[i].x), bflo(wd[i].y), bfhi(wd[i].y), bflo(wd[i].z), bfhi(wd[i].z), bflo(wd[i].w), bfhi(wd[i].w)}; float d2 = 0.f;
#pragma unroll
            for (int j = 0; j < 8; ++j) { k2 += r[j] * r[j]; d2 += rd[j] * rd[j]; }
            k2 += __shfl_xor(k2, 1); k2 += __shfl_xor(k2, 2); k2 += __shfl_xor(k2, 4);
            d2 += __shfl_xor(d2, 1); d2 += __shfl_xor(d2, 2); d2 += __shfl_xor(d2, 4);
            kmB = fmaxf(kmB, k2); kmD = fmaxf(kmD, d2); }
    }
    kmB = fmaxf(kmB, __shfl_xor(kmB, 32)); kmD = fmaxf(kmD, __shfl_xor(kmD, 32));
    { LAS float* red = (LAS float*)(F.lds + fa::L_WS);
      if (lane < 32 && (lane & 7) == 0) { red[F.wave * 8 + (lane >> 3)] = kmB; red[F.wave * 8 + 4 + (lane >> 3)] = kmD; }
      asm volatile("s_waitcnt lgkmcnt(0)\n\ts_barrier" ::: "memory");
      if (F.tid < 8) { float m = 0.f;
#pragma unroll
          for (int w_ = 0; w_ < 8; ++w_) m = fmaxf(m, red[w_ * 8 + F.tid]);
          atomicMax(F.tid < 4 ? kmaxB + F.tid : kmaxD + (F.tid - 4), __float_as_uint(sqrtf(m))); }
      asm volatile("s_waitcnt lgkmcnt(0)\n\ts_barrier" ::: "memory"); }
}
__device__ __forceinline__ void phase_prep(Frame& F, int s, int layer) {
    const int gw = F.vcu * 8 + F.wave, NGW = F.G * 8; const int n = s ? 2048 : 8192;
    const float* gq = F.in[6] + layer * 64; const float* gk = F.in[7] + layer * 64;
    LAS const float* rope = (LAS const float*)(F.lds + LT_ROPE);
    const int lane = F.lane, hh = lane >> 3, c = lane & 7;
    unsigned* kmaxA = (unsigned*)(F.ws + WS_CTL) + CW_KMAXA + (layer * 2 + s) * 2; unsigned* kmaxC = (unsigned*)(F.ws + WS_CTL) + CW_KMAXC + (layer * 2 + s) * 8;
    float kmA = 0.f, kmC = 0.f;
    float gv[8];
#pragma unroll
    for (int j = 0; j < 8; ++j) gv[j] = ((hh < 4 ? gq : gk) + c * 8)[j];
    const float sgn = (c & 2) ? 1.f : -1.f; const float qs = (hh < 4) ? 0.125f * LOG2E : 1.f;
    constexpr int NB = 4;
    for (int lr0 = gw; lr0 < RS; lr0 += NB * NGW) {
        u32x4 wA[NB], wC[NB];
#pragma unroll
        for (int k = 0; k < NB; ++k) { const int lr = lr0 + k * NGW; wA[k] = (u32x4){0u, 0u, 0u, 0u}; wC[k] = wA[k];
            if (lr < RS) { if (lane < 48) wA[k] = *(const u32x4*)(F.PROJ + (size_t)lr * INW + hh * 64 + c * 8);
                           if (lane < 32) wC[k] = *(const u32x4*)(F.PROJ + (size_t)lr * INW + C_CK + lane * 8); } }
#pragma unroll
        for (int k = 0; k < NB; ++k) { const int lr = lr0 + k * NGW; if (lr < RS) {
            const u32x4 w = wA[k]; float v[8] = {bflo(w.x), bfhi(w.x), bflo(w.y), bfhi(w.y), bflo(w.z), bfhi(w.z), bflo(w.w), bfhi(w.w)};
            float ss = 0.f;
#pragma unroll
            for (int j = 0; j < 8; ++j) ss += v[j] * v[j];
            ss += __shfl_xor(ss, 1); ss += __shfl_xor(ss, 2); ss += __shfl_xor(ss, 4);
            const float rinv = 1.f / sqrtf(ss * (1.f / 64.f) + RMS_EPS);
            const int t = lr % n; const int pos = (c < 4) ? (t >> 6) : (t & 63);
            float o[8];
#pragma unroll
            for (int j = 0; j < 8; ++j) { v[j] = v[j] * rinv * gv[j]; }
#pragma unroll
            for (int j = 0; j < 8; ++j) { const float pr = __shfl_xor(v[j], 2); const int i = 8 * (c & 1) + j; const float cs = rope[(pos * 16 + i) * 2], sn = rope[(pos * 16 + i) * 2 + 1];
                o[j] = (v[j] * cs + sgn * pr * sn) * qs; }
            u32x4 ow; ow.x = pk2(o[0], o[1]); ow.y = pk2(o[2], o[3]); ow.z = pk2(o[4], o[5]); ow.w = pk2(o[6], o[7]);
            if (lane < 48) *(u32x4*)(F.PROJ + (size_t)lr * INW + hh * 64 + c * 8) = ow;
            { const float r[8] = {bflo(ow.x), bfhi(ow.x), bflo(ow.y), bfhi(ow.y), bflo(ow.z), bfhi(ow.z), bflo(ow.w), bfhi(ow.w)}; float k2 = 0.f;
#pragma unroll
              for (int j = 0; j < 8; ++j) k2 += r[j] * r[j];
              k2 += __shfl_xor(k2, 1); k2 += __shfl_xor(k2, 2); k2 += __shfl_xor(k2, 4);
              kmA = fmaxf(kmA, k2); }
            { const u32x4 wc = wC[k]; const float r[8] = {bflo(wc.x), bfhi(wc.x), bflo(wc.y), bfhi(wc.y), bflo(wc.z), bfhi(wc.z), bflo(wc.w), bfhi(wc.w)}; float k2 = 0.f;
#pragma unroll
              for (int j = 0; j < 8; ++j) k2 += r[j] * r[j];
              k2 += __shfl_xor(k2, 1); k2 += __shfl_xor(k2, 2);
              kmC = fmaxf(kmC, k2); } } }
    }
    { LAS float* red = (LAS float*)(F.lds + fa::L_WS);
      if (lane == 32 || lane == 40) red[F.wave * 14 + (hh - 4)] = kmA;
      if (lane < 32 && (lane & 3) == 0) red[F.wave * 14 + 2 + (lane >> 2)] = kmC;
      asm volatile("s_waitcnt lgkmcnt(0)\n\ts_barrier" ::: "memory");
      if (F.tid < 10) { float m = 0.f;
#pragma unroll
          for (int w = 0; w < 8; ++w) m = fmaxf(m, red[w * 14 + F.tid]);
          atomicMax(F.tid < 2 ? kmaxA + F.tid : kmaxC + (F.tid - 2), __float_as_uint(sqrtf(m))); }
      asm volatile("s_waitcnt lgkmcnt(0)\n\ts_barrier" ::: "memory"); }
}

struct KVLinear {
    const bf16_t* kbase; const bf16_t* vbase;
    __device__ __forceinline__ const bf16_t* tk(int t) const { return kbase + (size_t)(64 * t) * INW; }
    __device__ __forceinline__ const bf16_t* tv(int t) const { return vbase + (size_t)(64 * t) * INW; }
    __device__ __forceinline__ int rmul() const { return 1; }
    __device__ __forceinline__ const bf16_t* kptr(int t, int j) const { return kbase + (size_t)(64 * t + j) * INW; }
    __device__ __forceinline__ const bf16_t* vptr(int t, int j) const { return vbase + (size_t)(64 * t + j) * INW; }
};
struct KVStrided {
    const bf16_t* kbase; const bf16_t* vbase; int d; int ntr;
    __device__ __forceinline__ const bf16_t* tk(int t) const { const int g2 = t >= ntr ? 1 : 0; const int tt = t - g2 * ntr; return kbase + (size_t)(g2 + d * 64 * tt) * INW; }
    __device__ __forceinline__ const bf16_t* tv(int t) const { const int g2 = t >= ntr ? 1 : 0; const int tt = t - g2 * ntr; return vbase + (size_t)(g2 + d * 64 * tt) * INW; }
    __device__ __forceinline__ int rmul() const { return d; }
    __device__ __forceinline__ const bf16_t* kptr(int t, int j) const { const int g2 = t >= ntr ? 1 : 0; const int tt = t - g2 * ntr; return kbase + (size_t)(g2 + d * (64 * tt + j)) * INW; }
    __device__ __forceinline__ const bf16_t* vptr(int t, int j) const { const int g2 = t >= ntr ? 1 : 0; const int tt = t - g2 * ntr; return vbase + (size_t)(g2 + d * (64 * tt + j)) * INW; }
};
struct HookNone { __device__ __forceinline__ bool skip(int) const { return false; } __device__ __forceinline__ float cbias(int) const { return 0.f; } __device__ __forceinline__ void apply(f32x16&, f32x16&, int) const {} };

__device__ __forceinline__ void store_gated(Frame& F, LAS const float* stg, size_t lrow0, size_t grow0, int gate_col, int mix_col, int lane) {
#pragma unroll
    for (int i = 0; i < 4; ++i) { const int row = i * 8 + (lane >> 3), ch = lane & 7;
        const f32x4 a = *(LAS const f32x4*)(stg + row * 64 + ch * 8), b = *(LAS const f32x4*)(stg + row * 64 + ch * 8 + 4);
        const u32x4 gw = *(const u32x4*)(F.PROJ + (lrow0 + row) * INW + gate_col + ch * 8);
        u32x4 w; w.x = pk2(a.x * fa::silu(bflo(gw.x)), a.y * fa::silu(bfhi(gw.x))); w.y = pk2(a.z * fa::silu(bflo(gw.y)), a.w * fa::silu(bfhi(gw.y)));
        w.z = pk2(b.x * fa::silu(bflo(gw.z)), b.y * fa::silu(bfhi(gw.z))); w.w = pk2(b.z * fa::silu(bflo(gw.w)), b.w * fa::silu(bfhi(gw.w)));
        *(u32x4*)(F.XNM + (grow0 + row) * MIXW + mix_col + ch * 8) = w; }
}

__device__ __forceinline__ void unit_A(Frame& F, int s, int layer, int bh, int qb) {
    const int n = s ? 2048 : 8192; const int b = bh >> 2, h = bh & 3;
    int tid_ = F.tid; asm volatile("" : "+v"(tid_)); const int wid = __builtin_amdgcn_readfirstlane(tid_ >> 6);
    const size_t rowbase = (size_t)b * n; const int q0 = qb * 256 + wid * 32;
    const bf16_t* Qw = F.PROJ + (rowbase + q0) * INW + C_AQ + h * 64;
    const bf16_t* Kh = F.PROJ + rowbase * INW + C_AK + (h >> 1) * 64; const bf16_t* Vh = F.PROJ + rowbase * INW + C_AV + (h >> 1) * 64;
    const bf16_t* Gp = F.PROJ + (rowbase + q0) * INW + C_AG + h * 64;
    bf16_t* Ow = F.XNM + ((size_t)s * RS + rowbase + q0) * MIXW + h * 64;
    const float kbA = __uint_as_float(((const unsigned*)(F.ws + WS_CTL))[CW_KMAXA + (layer * 2 + s) * 2 + (h >> 1)]) * 1.01f;
    tb::attn_unit<8, 0, true>(tid_, Qw, Kh, Vh, n / 64, Gp, Ow, (char*)(unsigned char*)F.lds, 0, nullptr, 0, 0.f, 0.f, kbA, 0.f);
}

struct HookC {
    LAS const float* tab;
    int qw;
    int r32, hi; float bl, br;
    __device__ __forceinline__ bool skip(int) const { return false; }
    __device__ __forceinline__ float cbias(int t) const {
        const int maxrel = 64 * t + 63 - qw, minrel = 64 * t - qw - 31;
        return (maxrel <= -91) ? bl : ((minrel >= 91) ? br : 0.f);
    }
    __device__ __forceinline__ void apply(f32x16& p0, f32x16& p1, int t) const {
        const int maxrel = 64 * t + 63 - qw, minrel = 64 * t - qw - 31;
        if (maxrel > -91 && minrel < 91) { LAS const float* tp = tab + (320 + 64 * t - qw - r32 + 4 * hi);
#pragma unroll
            for (int r = 0; r < 16; ++r) { const int kk = (r & 3) + 8 * (r >> 2); p0[r] += tp[kk]; p1[r] += tp[kk + 32]; } }
    }
};
__device__ __forceinline__ void unit_C(Frame& F, int s, int layer, int bh, int qb) {
    const int n = s ? 2048 : 8192; const int b = bh >> 2, h = bh & 3; int tid_ = F.tid; asm volatile("" : "+v"(tid_)); const int lane = tid_ & 63, r32 = lane & 31, hi = lane >> 5, wid = __builtin_amdgcn_readfirstlane(tid_ >> 6);
    const size_t rowbase = (size_t)b * n; const int q0 = qb * 256; const int qw = q0 + wid * 32;
    LAS float* tab = (LAS float*)(F.lds + fa::L_TAB);
    for (int i = tid_; i < 641; i += 512) tab[i] = F.TAB[T_C + h * 641 + i];
    asm volatile("s_waitcnt vmcnt(0) lgkmcnt(0)\n\ts_barrier" ::: "memory");
    const bf16_t* qptr = F.PROJ + (rowbase + qw + r32) * INW + C_CQ + h * 64;
    KVLinear kv{F.PROJ + rowbase * INW + C_CK + h * 64, F.PROJ + rowbase * INW + C_CV + h * 64};
    f32x16 o1[2], o2[2];
    HookC hk{tab, qw, r32, hi, tab[320 - 100], tab[320 + 100]};
    fa::flash_core_dual_sp(F.lds, qptr, kv, n / 64, hk, o1, o2, tid_);
    const float lam = F.TAB[T_LAM + layer]; const float li = layer == 0 ? 0.2f : 0.35550907f; const float* sg = F.in[13] + layer * 64;
#pragma unroll
    for (int r = 0; r < 16; ++r) { o1[0][r] -= lam * o2[0][r]; o1[1][r] -= lam * o2[1][r]; }
    LAS float* stg = (LAS float*)(F.lds + fa::L_OST) + wid * 2048;
    fa::stage_o(stg, o1, r32, hi);
#pragma unroll
    for (int i = 0; i < 4; ++i) { const int row = i * 8 + (lane >> 3), ch = lane & 7;
        const f32x4 a0 = *(LAS const f32x4*)(stg + row * 64 + ch * 8), a1 = *(LAS const f32x4*)(stg + row * 64 + ch * 8 + 4);
        const float v[8] = {a0.x, a0.y, a0.z, a0.w, a1.x, a1.y, a1.z, a1.w};
        float ss = 0.f;
#pragma unroll
        for (int k = 0; k < 8; ++k) ss += v[k] * v[k];
        ss += __shfl_xor(ss, 1); ss += __shfl_xor(ss, 2); ss += __shfl_xor(ss, 4);
        const float sc = (1.f - li) / sqrtf(ss * (1.f / 64.f) + RMS_EPS);
        const size_t lrow = rowbase + qw + row;
        const u32x4 gw = *(const u32x4*)(F.PROJ + lrow * INW + C_CG + h * 64 + ch * 8);
        const float g[8] = {bflo(gw.x), bfhi(gw.x), bflo(gw.y), bfhi(gw.y), bflo(gw.z), bfhi(gw.z), bflo(gw.w), bfhi(gw.w)};
        float y[8];
#pragma unroll
        for (int k = 0; k < 8; ++k) y[k] = v[k] * sc * sg[ch * 8 + k] * fa::silu(g[k]);
        u32x4 w; w.x = pk2(y[0], y[1]); w.y = pk2(y[2], y[3]); w.z = pk2(y[4], y[5]); w.w = pk2(y[6], y[7]);
        *(u32x4*)(F.XNM + ((size_t)s * RS + lrow) * MIXW + 512 + h * 64 + ch * 8) = w; }
    asm volatile("s_waitcnt lgkmcnt(0)\n\ts_barrier" ::: "memory");
}

__device__ __forceinline__ void unit_Cv(Frame& F, int s, int layer, int bh, int qb) {
    const int n = s ? 2048 : 8192; const int b = bh >> 2, h = bh & 3; int tid_ = F.tid; asm volatile("" : "+v"(tid_)); const int lane = tid_ & 63, r32 = lane & 31, hi = lane >> 5, wid = __builtin_amdgcn_readfirstlane(tid_ >> 6);
    const int map = wid >> 2; const size_t rowbase = (size_t)b * n; const int q0 = qb * 128; const int qw = q0 + (wid & 3) * 32;
    LAS float* tab = (LAS float*)(F.lds + fa::L_TAB);
    for (int i = tid_; i < 641; i += 512) tab[i] = F.TAB[T_C + h * 641 + i];
    asm volatile("s_waitcnt vmcnt(0) lgkmcnt(0)\n\ts_barrier" ::: "memory");
    const bf16_t* qptr = F.PROJ + (rowbase + qw + r32) * INW + C_CQ + h * 64 + map * 32;
    KVLinear kv{F.PROJ + rowbase * INW + C_CK + h * 64, F.PROJ + rowbase * INW + C_CV + h * 64};
    f32x16 o[2]; float mh, lt;
    HookC hk{tab, qw, r32, hi, tab[320 - 100], tab[320 + 100]};
    fa::flash_core_sp<2>(F.lds, qptr, kv, n / 64, hk, map * 4096, o, mh, lt, tid_);
    LAS float* stg = (LAS float*)(F.lds + fa::L_OST) + wid * 2048;
    fa::stage_o(stg, o, r32, hi);
    asm volatile("s_waitcnt lgkmcnt(0)\n\ts_barrier" ::: "memory");
    const float lam = F.TAB[T_LAM + layer]; const float li = layer == 0 ? 0.2f : 0.35550907f; const float* sg = F.in[13] + layer * 64;
    LAS const float* S1 = (LAS const float*)(F.lds + fa::L_OST); LAS const float* S2 = S1 + 4 * 2048;
#pragma unroll
    for (int j = 0; j < 2; ++j) { const int row = 16 * wid + 8 * j + (lane >> 3), ch = lane & 7;
        const int off = (row >> 5) * 2048 + (row & 31) * 64 + ch * 8;
        const f32x4 a0 = *(LAS const f32x4*)(S1 + off), a1 = *(LAS const f32x4*)(S1 + off + 4), b0 = *(LAS const f32x4*)(S2 + off), b1 = *(LAS const f32x4*)(S2 + off + 4);
        float v[8] = {a0.x - lam * b0.x, a0.y - lam * b0.y, a0.z - lam * b0.z, a0.w - lam * b0.w, a1.x - lam * b1.x, a1.y - lam * b1.y, a1.z - lam * b1.z, a1.w - lam * b1.w};
        float ss = 0.f;
#pragma unroll
        for (int k = 0; k < 8; ++k) ss += v[k] * v[k];
        ss += __shfl_xor(ss, 1); ss += __shfl_xor(ss, 2); ss += __shfl_xor(ss, 4);
        const float sc = (1.f - li) / sqrtf(ss * (1.f / 64.f) + RMS_EPS);
        const size_t lrow = rowbase + q0 + row;
        const u32x4 gw = *(const u32x4*)(F.PROJ + lrow * INW + C_CG + h * 64 + ch * 8);
        const float g[8] = {bflo(gw.x), bfhi(gw.x), bflo(gw.y), bfhi(gw.y), bflo(gw.z), bfhi(gw.z), bflo(gw.w), bfhi(gw.w)};
        float y[8];
#pragma unroll
        for (int k = 0; k < 8; ++k) y[k] = v[k] * sc * sg[ch * 8 + k] * fa::silu(g[k]);
        u32x4 w; w.x = pk2(y[0], y[1]); w.y = pk2(y[2], y[3]); w.z = pk2(y[4], y[5]); w.w = pk2(y[6], y[7]);
        *(u32x4*)(F.XNM + ((size_t)s * RS + lrow) * MIXW + 512 + h * 64 + ch * 8) = w; }
    asm volatile("s_waitcnt lgkmcnt(0)\n\ts_barrier" ::: "memory");
}

__device__ __forceinline__ void unit_Ct(Frame& F, int s, int layer, int bh, int qb) {
    const int n = s ? 2048 : 8192; const int b = bh >> 2, h = bh & 3;
    int tid_ = F.tid; asm volatile("" : "+v"(tid_)); const int lane = tid_ & 63, wid = __builtin_amdgcn_readfirstlane(tid_ >> 6);
    const int cmap = wid >> 2; const size_t rowbase = (size_t)b * n; const int q0 = qb * 128; const int qw = q0 + (wid & 3) * 32;
    LAS float* tab = (LAS float*)(F.lds + LT_C) + h * 641;
    const bf16_t* Qw = F.PROJ + (rowbase + qw) * INW + C_CQ + h * 64 + cmap * 32;
    const bf16_t* Kh = F.PROJ + rowbase * INW + C_CK + h * 64; const bf16_t* Vh = F.PROJ + rowbase * INW + C_CV + h * 64;
    const float kbC = __uint_as_float(((const unsigned*)(F.ws + WS_CTL))[CW_KMAXC + (layer * 2 + s) * 8 + h * 2 + cmap]) * 1.01f;
    tb::attn_unit<8, 1, true>(tid_, Qw, Kh, Vh, n / 64, nullptr, nullptr, (char*)(unsigned char*)F.lds, cmap, tab, qw, tab[320 - 100], tab[320 + 100], kbC, F.TAB[T_BMAX + h]);
    const float lam = F.TAB[T_LAM + layer]; const float li = layer == 0 ? 0.2f : 0.35550907f; const float* sg = F.in[13] + layer * 64;
    LAS const bf16_t* S1 = (LAS const bf16_t*)(F.lds + tb::LDS_OST); LAS const bf16_t* S2 = S1 + 4 * 2048;
#pragma unroll
    for (int j = 0; j < 2; ++j) { const int row = 16 * wid + 8 * j + (lane >> 3), ch = lane & 7;
        const int off = (row >> 5) * 2048 + (row & 31) * 64 + ch * 8;
        const u32x4 a = *(LAS const u32x4*)(S1 + off), c = *(LAS const u32x4*)(S2 + off);
        float v[8] = {bflo(a.x) - lam * bflo(c.x), bfhi(a.x) - lam * bfhi(c.x), bflo(a.y) - lam * bflo(c.y), bfhi(a.y) - lam * bfhi(c.y),
                      bflo(a.z) - lam * bflo(c.z), bfhi(a.z) - lam * bfhi(c.z), bflo(a.w) - lam * bflo(c.w), bfhi(a.w) - lam * bfhi(c.w)};
        float ss = 0.f;
#pragma unroll
        for (int k = 0; k < 8; ++k) ss += v[k] * v[k];
        ss += __shfl_xor(ss, 1); ss += __shfl_xor(ss, 2); ss += __shfl_xor(ss, 4);
        const float sc = (1.f - li) / sqrtf(ss * (1.f / 64.f) + RMS_EPS);
        const size_t lrow = rowbase + q0 + row;
        const u32x4 gw = *(const u32x4*)(F.PROJ + lrow * INW + C_CG + h * 64 + ch * 8);
        const float g[8] = {bflo(gw.x), bfhi(gw.x), bflo(gw.y), bfhi(gw.y), bflo(gw.z), bfhi(gw.z), bflo(gw.w), bfhi(gw.w)};
        float y[8];
#pragma unroll
        for (int k = 0; k < 8; ++k) y[k] = v[k] * sc * sg[ch * 8 + k] * fa::silu(g[k]);
        u32x4 w; w.x = pk2(y[0], y[1]); w.y = pk2(y[2], y[3]); w.z = pk2(y[4], y[5]); w.w = pk2(y[6], y[7]);
        *(u32x4*)(F.XNM + ((size_t)s * RS + lrow) * MIXW + 512 + h * 64 + ch * 8) = w; }
    asm volatile("s_waitcnt lgkmcnt(0)\n\ts_barrier" ::: "memory");
}

struct HookB {
    LAS const float* tab;
    int qw, L, kb0;
    int r32, hi;
    __device__ __forceinline__ bool skip(int t) const { const int kb = kb0 + 64 * t; return (qw >= L) || (kb + 63 < qw - 64) || (kb > qw + 95); }
    __device__ __forceinline__ void apply(f32x16& p0, f32x16& p1, int t) const {
        LAS const float* tp = tab + (kb0 + 64 * t + 4 * hi - (qw + r32) + 158);
#pragma unroll
        for (int r = 0; r < 16; ++r) { const int kk = (r & 3) + 8 * (r >> 2); p0[r] += tp[kk]; p1[r] += tp[kk + 32]; }
    }
};
__device__ __forceinline__ void unit_B(Frame& F, int s, int layer, int g, int bh, int res, int qblk, int pack) {
    const int n = s ? 2048 : 8192; const int b = bh >> 2, h = bh & 3; int tid_ = F.tid; asm volatile("" : "+v"(tid_)); const int lane = tid_ & 63, r32 = lane & 31, hi = lane >> 5, wid = __builtin_amdgcn_readfirstlane(tid_ >> 6);
    const int d = (g == 0) ? 1 : (g == 1 ? 4 : 16); const int L = n / d; const size_t rowbase = (size_t)b * n;
    const int wg2 = pack ? (wid >> 2) : 0;
    const int q0 = qblk * 256, qw = pack ? (wid & 3) * 32 : q0 + wid * 32;
    int tlo = (q0 - 64) >> 6; if (tlo < 0) tlo = 0; int thi = (q0 + 319) >> 6; const int tmax = (L - 1) >> 6; if (thi > tmax) thi = tmax;
    const int NT = thi - tlo + 1;
    LAS float* tab = (LAS float*)(F.lds + LT_B) + (g * 4 + h) * 320;
    int qidx = qw + r32; const bool active = qw < L; if (qidx >= L) qidx = L - 1;
    const size_t qrow = rowbase + res + wg2 + (size_t)d * qidx;
    const bf16_t* qptr = F.PROJ + qrow * INW + C_BQ + h * 64;
    const size_t krow0 = rowbase + res + (size_t)d * 64 * tlo;
    KVStrided kv{F.PROJ + krow0 * INW + C_BK + h * 64, F.PROJ + krow0 * INW + C_BV + h * 64, d, NT};
    f32x16 o[2]; float mh, lt;
    LAS const float* bk = (LAS const float*)(F.lds + LT_BK);
    fa::flash_core_all3(F.lds, qptr, kv, pack ? 2 * NT : NT, NT, wg2 * NT, tab, qw, 64 * tlo, active, bk[h], bk[4 + h], o, mh, lt, tid_);
    LAS float* stg = (LAS float*)(F.lds + fa::L_AOST) + wid * 2048;
    fa::stage_o(stg, o, r32, hi);
    if (active) {
        bf16_t* BP = F.BPART + (size_t)g * RS * 256;
#pragma unroll
        for (int i = 0; i < 4; ++i) { const int row = i * 8 + (lane >> 3), ch = lane & 7;
            const f32x4 a = *(LAS const f32x4*)(stg + row * 64 + ch * 8), c = *(LAS const f32x4*)(stg + row * 64 + ch * 8 + 4);
            u32x4 w; w.x = pk2(a.x, a.y); w.y = pk2(a.z, a.w); w.z = pk2(c.x, c.y); w.w = pk2(c.z, c.w);
            const size_t orow = rowbase + res + wg2 + (size_t)d * (qw + row);
            *(u32x4*)(BP + orow * 256 + h * 64 + ch * 8) = w; }
        if (hi == 0) F.BLSE[((size_t)g * RS + qrow) * 4 + h] = mh + __log2f(lt);
    }
    asm volatile("s_waitcnt lgkmcnt(0)\n\ts_barrier" ::: "memory");
}
__device__ __forceinline__ void phase_bcomb(Frame& F, int s) {
    const int gw = F.vcu * 8 + F.wave, NGW = F.G * 8; const int lane = F.lane, h = lane >> 4, c4 = (lane & 15) * 4;
    constexpr int NB = 4;
    for (int lr0 = gw; lr0 < RS; lr0 += NB * NGW) {
        float ls[NB][3]; u32x2 pv_[NB][3]; u32x2 gt[NB];
#pragma unroll
        for (int k = 0; k < NB; ++k) { int lr = lr0 + k * NGW; if (lr >= RS) lr = RS - 1;
#pragma unroll
            for (int g = 0; g < 3; ++g) { ls[k][g] = F.BLSE[((size_t)g * RS + lr) * 4 + h]; pv_[k][g] = *(const u32x2*)(F.BPART + ((size_t)g * RS + lr) * 256 + h * 64 + c4); }
            gt[k] = *(const u32x2*)(F.PROJ + (size_t)lr * INW + C_BG + h * 64 + c4); }
#pragma unroll
        for (int k = 0; k < NB; ++k) { const int lr = lr0 + k * NGW; if (lr < RS) {
            const float m = fmaxf(ls[k][0], fmaxf(ls[k][1], ls[k][2]));
            float w[3], ws_ = 0.f;
#pragma unroll
            for (int g = 0; g < 3; ++g) { w[g] = exp2f(ls[k][g] - m); ws_ += w[g]; }
            const float inv = 1.f / ws_; float y[4] = {0.f, 0.f, 0.f, 0.f};
#pragma unroll
            for (int g = 0; g < 3; ++g) { const float wg = w[g] * inv; y[0] += wg * bflo(pv_[k][g].x); y[1] += wg * bfhi(pv_[k][g].x); y[2] += wg * bflo(pv_[k][g].y); y[3] += wg * bfhi(pv_[k][g].y); }
            u32x2 ow; ow.x = pk2(y[0] * fa::silu(bflo(gt[k].x)), y[1] * fa::silu(bfhi(gt[k].x))); ow.y = pk2(y[2] * fa::silu(bflo(gt[k].y)), y[3] * fa::silu(bfhi(gt[k].y)));
            *(u32x2*)(F.XNM + ((size_t)s * RS + lr) * MIXW + 256 + h * 64 + c4) = ow; } }
    }
}

struct HookD {
    LAS const float* tab;
    int R, kr_lo, r0, c, cs, hi;
    __device__ __forceinline__ bool skip(int t) const { const int kr = kr_lo + t; return kr < r0 || kr > r0 + 7; }
    __device__ __forceinline__ void apply(f32x16& p0, f32x16& p1, int t) const {
        const int kr = kr_lo + t; LAS const float* tp = tab + (kr - R + 7) * 31 + 15 - c + 4 * hi;
#pragma unroll
        for (int r = 0; r < 16; ++r) { const int kk = (r & 3) + 8 * (r >> 2);
            { const int kc = kk + 4 * hi; const bool ok = (unsigned)(kc - cs) < 16u; const float bv = tp[ok ? kk : (c - 4 * hi)]; p0[r] = ok ? p0[r] + bv : -INFINITY; }
            { const int kc = kk + 32 + 4 * hi; const bool ok = (unsigned)(kc - cs) < 16u; const float bv = tp[ok ? kk + 32 : (c - 4 * hi)]; p1[r] = ok ? p1[r] + bv : -INFINITY; } }
    }
};
__device__ __forceinline__ int d_r0(int R, int rows) { int v = R - 4; if (v < 0) v = 0; if (v > rows - 8) v = rows - 8; return v; }
__device__ __forceinline__ void unit_D(Frame& F, int s, int layer, int bh, int u4) {
    const int n = s ? 2048 : 8192; const int rows = n >> 6; const int b = bh >> 2, h = bh & 3; int tid_ = F.tid; asm volatile("" : "+v"(tid_)); const int lane = tid_ & 63, r32 = lane & 31, wid = __builtin_amdgcn_readfirstlane(tid_ >> 6);
    const size_t rowbase = (size_t)b * n; const int R0 = 4 * u4;
    const int kr_lo = d_r0(R0, rows), kr_hi = d_r0(R0 + 3, rows) + 7; const int NT = kr_hi - kr_lo + 1;
    const int R = R0 + (wid >> 1), c = 32 * (wid & 1) + r32; const int r0w = d_r0(R, rows);
    const size_t qrow = rowbase + 64 * R + c;
    const bf16_t* qptr = F.PROJ + qrow * INW + C_DQ + h * 64;
    const size_t krow0 = rowbase + (size_t)64 * kr_lo;
    KVLinear kv{F.PROJ + krow0 * INW + C_DK + h * 64, F.PROJ + krow0 * INW + C_DV + h * 64};
    LAS const float* bk = (LAS const float*)(F.lds + LT_BK);
    f32x16 o[2];
    fa::flash_core_d(F.lds, qptr, kv, NT, r0w - kr_lo, r0w + 7 - kr_lo, kr_lo - R + 7, c, bk[8 + h], bk[12 + h], F.in[14] + ((size_t)layer * 4 + h) * 465, o, tid_);
    LAS float* stg = (LAS float*)(F.lds + fa::L_OST) + wid * 2048;
    fa::stage_o(stg, o, r32, lane >> 5);
    const size_t lrow0 = rowbase + 64 * R + 32 * (wid & 1);
    store_gated(F, stg, lrow0, (size_t)s * RS + lrow0, C_DG + h * 64, 768 + h * 64, lane);
    asm volatile("s_waitcnt lgkmcnt(0)\n\ts_barrier" ::: "memory");
}

__device__ __forceinline__ void phase_mixers(Frame& F, int s, int layer) {
    const int G = F.G, v = F.vcu;
    const int sh = s ? 3 : 5;
    unsigned* c_prep = (unsigned*)(F.ws + WS_CTL) + CW_SPLIT + 64 * (2 * (layer * 2 + s));
    unsigned* c_b = c_prep + 64;
    unsigned* c_pb = (unsigned*)(F.ws + WS_CTL) + CW_SPLIT + 64 * 8 + 64 * (layer * 2 + s);
#ifndef UN_MASK
#define UN_MASK 0xF
#endif
    { LAS float* tc = (LAS float*)(F.lds + LT_C); LAS float* tbb = (LAS float*)(F.lds + LT_B);
      { LAS float* tr_ = (LAS float*)(F.lds + LT_ROPE); for (int i = F.tid; i < 128 * 16 * 2; i += 512) tr_[i] = F.TAB[T_ROPE + i]; }
      for (int i = F.tid; i < 12 * 320; i += 512) tbb[i] = F.TAB[T_B + i];
      for (int i = F.tid; i < 4 * 641; i += 512) tc[i] = F.TAB[T_C + i];
      asm volatile("s_waitcnt vmcnt(0) lgkmcnt(0)\n\ts_barrier" ::: "memory"); }
    phase_prepB(F, s, layer);
    split_arrive(c_pb);
    phase_prep(F, s, layer);
    split_arrive(c_prep);
    split_wait(c_pb, (unsigned)G);
    { LAS float* bk = (LAS float*)(F.lds + LT_BK);
      if (F.tid < 4) bk[F.tid] = __uint_as_float(((const unsigned*)(F.ws + WS_CTL))[CW_KMAXB + (layer * 2 + s) * 4 + F.tid]) * 1.01f;
      else if (F.tid < 8) bk[F.tid] = F.TAB[T_BMAXB + F.tid - 4];
      else if (F.tid < 12) bk[F.tid] = __uint_as_float(((const unsigned*)(F.ws + WS_CTL))[CW_KMAXD + (layer * 2 + s) * 4 + F.tid - 8]) * 1.01f;
      else if (F.tid < 16) bk[F.tid] = F.TAB[T_BMAXD + layer * 4 + F.tid - 12];
      asm volatile("s_waitcnt vmcnt(0) lgkmcnt(0)\n\ts_barrier" ::: "memory"); }
    if (UN_MASK & 4) { const int nB = 768;
        for (int u = v; u < nB; u += G) {
            int g, bh, res, qblk, pack = 0;
            if (s == 0) { g = u >> 8; const int rest = u & 255, k = rest & 31; bh = rest >> 5; const int lper = (g == 0) ? 5 : (g == 1 ? 3 : 1); res = k >> lper; qblk = k & ((1 << lper) - 1); }
            else if (u < 256) { g = 0; bh = u >> 3; res = 0; qblk = u & 7; }
            else if (u < 512) { const int r = u - 256; g = 1; bh = r >> 3; res = (r & 7) >> 1; qblk = r & 1; }
            else { const int r = u - 512; g = 2; bh = r >> 3; res = (r & 7) * 2; qblk = 0; pack = 1; }
            unit_B(F, s, layer, g, bh, res, qblk, pack);
        } }
    split_arrive(c_b);
    if (UN_MASK & 8) for (int u = v; u < 256; u += G) unit_D(F, s, layer, u >> sh, u & ((1 << sh) - 1));
    split_wait(c_prep, (unsigned)G);
    if (UN_MASK & 2) for (int u = v; u < 512; u += G) unit_Ct(F, s, layer, u >> (sh + 1), u & ((2 << sh) - 1));
    if (UN_MASK & 1) for (int u = v; u < 256; u += G) unit_A(F, s, layer, u >> sh, u & ((1 << sh) - 1));
    split_wait(c_b, (unsigned)G);
    phase_bcomb(F, s);
}

constexpr int N_PHASES = 11;
#ifndef PH_MASK
#define PH_MASK 0xFF
#endif
#define PH_ON(b) ((PH_MASK >> (b)) & 1)
struct Args { const float* in[15]; float* out; unsigned char* ws; int ph_lo, ph_hi; };
__global__ void __launch_bounds__(512, 2) enc_fwd(Args args) {
    extern __shared__ __attribute__((aligned(16))) unsigned char lds_raw[];
    Frame F;
    F.lds = (LAS unsigned char*)lds_raw;
    F.tid = threadIdx.x; F.lane = F.tid & 63; F.wave = __builtin_amdgcn_readfirstlane(F.tid >> 6);
    F.G = gridDim.x; { const int bx = blockIdx.x; F.vcu = (F.G % 8 == 0) ? (bx % 8) * (F.G / 8) + bx / 8 : bx; }
    typedef __attribute__((address_space(4))) const unsigned char* kaptr_t;
    unsigned char* ws0 = args.ws; const int wave0 = __builtin_amdgcn_readfirstlane((int)threadIdx.x >> 6);
    volatile LAS unsigned* MISC = (volatile LAS unsigned*)(F.lds + MISC_OFF);
    for (int u = F.tid; u < (LDS_BYTES - LDSCTL_OFF) / 4; u += 512) ((LAS unsigned*)(F.lds + LDSCTL_OFF))[u] = 0u;
    __syncthreads();
    const bool multi = (args.ph_hi - args.ph_lo) > 1;
    XcdBarrier bar; bar.bar = (unsigned*)(ws0 + WS_CTL) + CW_BAR; bar.x = 0; bar.st = nullptr;
    if (multi) bar = xcd_barrier_post((unsigned*)(ws0 + WS_CTL) + CW_BAR, MISC + 8);

    for (int p = args.ph_lo; p < args.ph_hi; ++p) {
        { unsigned z_; asm volatile("s_mov_b32 %0, 0" : "=s"(z_)); int t_ = (wave0 << 6) | (int)__builtin_amdgcn_mbcnt_hi(~0u, __builtin_amdgcn_mbcnt_lo(~0u, z_)); asm volatile("" : "+v"(t_)); F.tid = t_; F.lane = t_ & 63; F.wave = __builtin_amdgcn_readfirstlane(t_ >> 6); }
        { kaptr_t ka = (kaptr_t)__builtin_amdgcn_kernarg_segment_ptr(); asm volatile("" : "+s"(ka));
          F.in = (const float* const __attribute__((address_space(4)))*)ka;
          unsigned char* ws_ = *(unsigned char* const __attribute__((address_space(4)))*)(ka + 16 * 8); float* out_ = *(float* const __attribute__((address_space(4)))*)(ka + 15 * 8); F.out = out_; F.ws = ws_;
          F.WIN = (bf16_t*)(ws_ + WS_WIN); F.WOUT = (bf16_t*)(ws_ + WS_WOUT); F.XNM = (bf16_t*)(ws_ + WS_XNM); F.PROJ = (bf16_t*)(ws_ + WS_PROJ);
          F.BPART = (bf16_t*)(ws_ + WS_BPART); F.BLSE = (float*)(ws_ + WS_BLSE); F.TAB = (float*)(ws_ + WS_TAB); }
        int kind, layer = 0, st = 0;
        if (p == 0) kind = 0;
        else { layer = (p - 1) / 5; const int r = (p - 1) % 5; if (r == 4) kind = 4; else { kind = 2 + (r & 1); st = r >> 1; } }
        if (kind == 0) { phase_prologue(F); phase_xn(F, 0); }
        else if (kind == 4) {
            pg8::Gemm g{F.XNM, F.WOUT + (size_t)layer * DMODEL * MIXW, MTOT, DMODEL, MIXW};
            pg8::PanelRms st_{(float*)(F.ws + WS_XSLOT), (unsigned*)(F.ws + WS_CTL) + CW_PANEL + layer * 128 * 64, RMS_EPS};
            for (int rd = 0; rd < 2; ++rd) {
                pg8::RoundOrder S; S.so.init(MTOT, DMODEL, F.G, (int)blockIdx.x); S.round = rd;
                if (layer == 0) { pg8::EpiRmsOut<false> E{F.in[0], F.in[1], RS, F.out, F.XNM, nullptr, DMODEL, st_};
                    pg8::gemm_phase<pg8::EpiRmsOut<false>, pg8::RoundOrder, false, true>(F.lds, g, S, E, F.tid); }
                else { pg8::EpiRmsOut<true> E{F.out, F.out + (size_t)RS * DMODEL, RS, F.out, nullptr, F.in[5], DMODEL, st_};
                    pg8::gemm_phase<pg8::EpiRmsOut<true>, pg8::RoundOrder, false, true>(F.lds, g, S, E, F.tid); }
            }
        } else if (kind == 2) {
            pg8::Gemm g{F.XNM + (size_t)st * RS * DMODEL, F.WIN + (size_t)layer * INW * DMODEL, RS, INW, DMODEL}; pg8::StaticOrder S; S.init(RS, INW, F.G, (int)blockIdx.x);
            pg8::EpiBf16 E{F.PROJ, INW};
            pg8::gemm_phase<pg8::EpiBf16, pg8::StaticOrder, true, true>(F.lds, g, S, E, F.tid);
        } else phase_mixers(F, st, layer);
        if (p + 1 < args.ph_hi) xcd_barrier(bar);
    }
}

extern "C" void kernel_launch(void* const* d_in, const int* in_sizes, int n_in, void* d_out, int out_size, void* d_ws, size_t ws_size, hipStream_t stream) {
    static int grid = 0;
    if (grid == 0) {
        if (n_in != 15 || out_size != MTOT * DMODEL || ws_size < WS_END) { fprintf(stderr, "kernel_launch: unexpected shapes (n_in %d out %d ws %zu)\n", n_in, out_size, ws_size); grid = -1; return; }
        int dev = 0, cus = 0, per_cu = 0;
        if (hipGetDevice(&dev) != hipSuccess || hipDeviceGetAttribute(&cus, hipDeviceAttributeMultiprocessorCount, dev) != hipSuccess) { grid = -1; return; }
        if (hipFuncSetAttribute((const void*)enc_fwd, hipFuncAttributeMaxDynamicSharedMemorySize, LDS_BYTES) != hipSuccess) { fprintf(stderr, "kernel_launch: hipFuncSetAttribute failed\n"); grid = -1; return; }
        if (hipOccupancyMaxActiveBlocksPerMultiprocessor(&per_cu, (const void*)enc_fwd, 512, LDS_BYTES) != hipSuccess || per_cu < 1) { fprintf(stderr, "kernel_launch: occupancy query says %d\n", per_cu); per_cu = 1; }
        (void)hipGetLastError();
        grid = cus;
    }
    if (grid < 0) return;
    (void)hipMemsetAsync((char*)d_ws + WS_CTL, 0, CTL_ZERO_BYTES, stream);
    Args a{};
    for (int i = 0; i < 15; ++i) a.in[i] = (const float*)d_in[i];
    a.out = (float*)d_out; a.ws = (unsigned char*)d_ws;
#if MK_ONE_LAUNCH
    a.ph_lo = 0; a.ph_hi = N_PHASES;
    hipLaunchKernelGGL(enc_fwd, dim3(grid), dim3(512), LDS_BYTES, stream, a);
#else
    for (int p = 0; p < N_PHASES; ++p) { a.ph_lo = p; a.ph_hi = p + 1; hipLaunchKernelGGL(enc_fwd, dim3(grid), dim3(512), LDS_BYTES, stream, a); }
#endif
}
```

```cpp
#include <hip/hip_runtime.h>
#include <hip/hip_bf16.h>
#include <cstdio>
#include <cstdint>

#ifndef MK_ONE_LAUNCH
#define MK_ONE_LAUNCH 1
#endif

#define LAS __attribute__((address_space(3)))
#define GAS __attribute__((address_space(1)))
typedef unsigned short bf16_t;
typedef short bf16x8 __attribute__((ext_vector_type(8)));
typedef short s16x4 __attribute__((ext_vector_type(4)));
typedef short v4i16_t __attribute__((ext_vector_type(4)));
typedef float f32x2 __attribute__((ext_vector_type(2)));
typedef float f32x4 __attribute__((ext_vector_type(4)));
typedef float f32x16 __attribute__((ext_vector_type(16)));
typedef unsigned u32x2 __attribute__((ext_vector_type(2)));
typedef unsigned u32x4 __attribute__((ext_vector_type(4)));

constexpr int DMODEL = 1024, INW = 3840, MIXW = 1024, DEPTH = 2;
constexpr int RS = 16384;
constexpr int MTOT = 2 * RS;
constexpr float RMS_EPS = 1e-6f;
constexpr float LOG2E = 1.4426950408889634f;
constexpr int C_AQ = 0, C_AK = 256, C_AV = 384, C_AG = 512, C_BQ = 768, C_BK = 1024, C_BV = 1280, C_BG = 1536;
constexpr int C_CQ = 1792, C_CK = 2048, C_CV = 2304, C_CG = 2560, C_DQ = 2816, C_DK = 3072, C_DV = 3328, C_DG = 3584;

constexpr size_t MiB = 1u << 20;
constexpr size_t WS_CTL = 0, CTL_ZERO_BYTES = 192 * 1024;
constexpr size_t WS_XSLOT = 1 * MiB + 512 * 1024;
constexpr int CW_KMAXD = 40576;
constexpr int CW_KMAXB = 40512;
constexpr int CW_KMAXA = 40000, CW_KMAXC = 40192;
constexpr int CW_PANEL = 16384;
constexpr size_t WS_TAB = 1 * MiB;
constexpr size_t WS_WIN = 2 * MiB;
constexpr size_t WS_WOUT = 17 * MiB;
constexpr size_t WS_XNM = 22 * MiB;
constexpr size_t WS_PROJ = 86 * MiB;
constexpr size_t WS_BPART = 206 * MiB;
constexpr size_t WS_BLSE = 230 * MiB;
constexpr size_t WS_END = 231 * MiB;
constexpr int T_ROPE = 0;
constexpr int T_C = 4096;
constexpr int T_B = T_C + 4 * 641;
constexpr int T_LAM = T_B + 3 * 4 * 320;
constexpr int T_BMAX = T_LAM + 2;
constexpr int T_BMAXB = T_BMAX + 4;
constexpr int T_BMAXD = T_BMAXB + 4;
constexpr int CW_BAR = 1024;

constexpr int RING_BYTES = 131072;
constexpr int LDSCTL_OFF = RING_BYTES, MISC_OFF = LDSCTL_OFF + 320;
constexpr int LDS_BYTES = 163840;
constexpr int LT_ROPE = 0;
constexpr int LT_B = 143 * 1024;
constexpr int LT_C = 132 * 1024;
constexpr int LT_BK = LT_B + 12 * 320 * 4;
static_assert(LT_C + 4 * 641 * 4 <= LT_B && LT_BK + 64 <= LDS_BYTES, "LDS tables");

__device__ __forceinline__ unsigned f2bf(float f) { unsigned u = __builtin_bit_cast(unsigned, f); return (u + 0x7fffu + ((u >> 16) & 1u)) >> 16; }
typedef __bf16 bf16x2_hw __attribute__((ext_vector_type(2)));
__device__ __forceinline__ unsigned pk2(float lo, float hi) { f32x2 v = {lo, hi}; bf16x2_hw b = __builtin_convertvector(v, bf16x2_hw); return __builtin_bit_cast(unsigned, b); }
__device__ __forceinline__ float bf2f(unsigned short b) { return __builtin_bit_cast(float, (unsigned)b << 16); }
__device__ __forceinline__ float bflo(unsigned w) { return __builtin_bit_cast(float, w << 16); }
__device__ __forceinline__ float bfhi(unsigned w) { return __builtin_bit_cast(float, w & 0xffff0000u); }

namespace pg8 {
constexpr int BM = 256, BK = 64, HALF = 128, HTB = HALF * BK * 2, STAGE_BYTES = 8 * HTB, NXCD = 8, WGM = 8;
__host__ __device__ __forceinline__ int lds_byte(int r, int c) { const int st = (r >> 4) * 2 + (c >> 5), rr = r & 15, cc = c & 31, ob = rr * 64 + cc * 2; return st * 1024 + (ob ^ (((ob >> 9) & 1) << 5)); }
__host__ __device__ __forceinline__ void stage_rc(int b, int& R, int& C) { const int st = b / 1024, sb = b % 1024, swz = sb ^ (((sb >> 9) & 1) << 5); R = (st >> 1) * 16 + swz / 64; C = (st & 1) * 32 + (swz % 64) / 2; }
__host__ __device__ __forceinline__ int perm32(int rho) { const int n = rho >> 4, i = rho & 15; return 8 * (i >> 2) + 4 * n + (i & 3); }
struct Unit { int pm, pn; };
struct Gemm { const bf16_t* A; const bf16_t* Bt; int M, N, K; };
struct StaticOrder {
    int nM, nN, nwg, G, c;
    __host__ __device__ void init(int M, int N, int G_, int c_) { nM = M / BM; nN = N / BM; nwg = nM * nN; G = G_; c = c_; }
    __host__ __device__ bool next(int i, Unit& u) const {
        const long L = (long)i * G + c; if (L >= nwg) return false;
        int wgid = (int)L; { const int q = nwg / NXCD, r = nwg % NXCD, xcd = wgid % NXCD, off = wgid / NXCD; wgid = (xcd < r ? xcd * (q + 1) : r * (q + 1) + (xcd - r) * q) + off; }
        const int nig = WGM * nN, gid = wgid / nig, fm = gid * WGM, gsz = (nM - fm) < WGM ? (nM - fm) : WGM;
        u.pm = fm + ((wgid % nig) % gsz); u.pn = (wgid % nig) / gsz; return true;
    }
    __device__ __forceinline__ void a_ready(const Unit&) const {}
    __device__ __forceinline__ void done(const Unit&) const {}
};
__device__ __forceinline__ unsigned cvt_pk_bf16(float lo, float hi) { unsigned r; asm volatile("v_cvt_pk_bf16_f32 %0, %1, %2" : "=v"(r) : "v"(lo), "v"(hi)); return r; }

struct EpiBf16 {
    static constexpr bool PERM = true, AFTER_DRAIN = false;
    bf16_t* O; int ldc;
    __device__ __forceinline__ void operator()(const f32x4 (&acc)[2][2][4][2], const Unit& u, int wr, int wc, int fr, int fq) const {
        const int row0 = u.pm * BM + wr * 64 + fr; const int col0 = u.pn * BM + wc * 32 + 8 * fq;
#pragma unroll
        for (int ai = 0; ai < 2; ++ai)
#pragma unroll
            for (int m = 0; m < 4; ++m) { bf16_t* rowp = O + (size_t)(row0 + ai * HALF + m * 16) * ldc + col0;
#pragma unroll
                for (int bj = 0; bj < 2; ++bj) { const f32x4 v0 = acc[ai][bj][m][0], v1 = acc[ai][bj][m][1];
                    u32x4 w; w.x = cvt_pk_bf16(v0[0], v0[1]); w.y = cvt_pk_bf16(v0[2], v0[3]); w.z = cvt_pk_bf16(v1[0], v1[1]); w.w = cvt_pk_bf16(v1[2], v1[3]);
                    *(u32x4*)(rowp + bj * HALF) = w; } }
    }
};
struct EpiResF32 {
    static constexpr bool PERM = false, AFTER_DRAIN = false;
    const float* base0; const float* base1; int split_row; float* out; int ldc;
    __device__ __forceinline__ void operator()(const f32x4 (&acc)[2][2][4][2], const Unit& u, int wr, int wc, int fr, int fq) const {
        const int col0 = u.pn * BM + wc * 32 + 4 * fq;
#pragma unroll
        for (int ai = 0; ai < 2; ++ai)
#pragma unroll
            for (int m = 0; m < 4; ++m) { const int r = u.pm * BM + ai * HALF + wr * 64 + m * 16 + fr;
                const float* b = (r < split_row) ? base0 + (size_t)r * ldc : base1 + (size_t)(r - split_row) * ldc;
                float* o = out + (size_t)r * ldc;
#pragma unroll
                for (int bj = 0; bj < 2; ++bj)
#pragma unroll
                    for (int n = 0; n < 2; ++n) { const int off = col0 + bj * HALF + n * 16; const f32x4 bs = *(const f32x4*)(b + off); *(f32x4*)(o + off) = bs + acc[ai][bj][m][n]; } }
    }
};

struct PanelRms {
    float* xbuf; unsigned* cnt; float eps;
    __device__ __forceinline__ void run(const f32x4 (&v)[2][2][4][2], const Unit& u, int wr, int wc, int fr, int fq, LAS unsigned char* lds, int wid, int lane) const {
        LAS float* P = (LAS float*)lds;
        LAS float* S = (LAS float*)(lds + 8192);
        LAS unsigned* flag = (LAS unsigned*)(lds + 8192 + 2048);
#pragma unroll
        for (int ai = 0; ai < 2; ++ai)
#pragma unroll
            for (int m = 0; m < 4; ++m) { float q = 0.f;
#pragma unroll
                for (int bj = 0; bj < 2; ++bj)
#pragma unroll
                    for (int n = 0; n < 2; ++n) { const f32x4 x = v[ai][bj][m][n]; q += (x[0] * x[0] + x[1] * x[1]) + (x[2] * x[2] + x[3] * x[3]); }
                q += __shfl_xor(q, 16); q += __shfl_xor(q, 32);
                if (fq == 0) P[(ai * HALF + wr * 64 + m * 16 + fr) * 4 + wc] = q; }
        asm volatile("s_waitcnt lgkmcnt(0)" ::: "memory"); __builtin_amdgcn_s_barrier(); asm volatile("" ::: "memory");
        const int row = wid * 32 + (lane & 31);
        if (lane < 32) { const float t = (P[row * 4 + 0] + P[row * 4 + 1]) + (P[row * 4 + 2] + P[row * 4 + 3]);
            __hip_atomic_store(xbuf + ((size_t)(u.pm * BM + row) * 4 + u.pn), t, __ATOMIC_RELAXED, __HIP_MEMORY_SCOPE_AGENT); }
        asm volatile("s_waitcnt vmcnt(0)" ::: "memory");
        if (lane == 0) __hip_atomic_fetch_add(cnt + 64 * u.pm, 1u, __ATOMIC_RELAXED, __HIP_MEMORY_SCOPE_AGENT);
        if (wid == 0) {
            unsigned sp = 0u;
            for (;;) { if ((unsigned)__builtin_amdgcn_readfirstlane(__hip_atomic_load(cnt + 64 * u.pm, __ATOMIC_RELAXED, __HIP_MEMORY_SCOPE_AGENT)) >= 32u) break;
                __builtin_amdgcn_s_sleep(2); if (++sp > (1u << 22)) break; }
            __builtin_amdgcn_fence(__ATOMIC_ACQUIRE, "agent");
            if (lane == 0) flag[0] = 1u;
        }
        asm volatile("s_waitcnt vmcnt(0) lgkmcnt(0)" ::: "memory"); __builtin_amdgcn_s_barrier(); asm volatile("" ::: "memory");
        if (lane < 32) { const float* sl = xbuf + (size_t)(u.pm * BM + row) * 4; float t = 0.f;
#pragma unroll
            for (int k = 0; k < 4; ++k) t += __hip_atomic_load(sl + k, __ATOMIC_RELAXED, __HIP_MEMORY_SCOPE_AGENT);
            S[row] = 1.0f / sqrtf(t * (1.0f / 1024.0f) + eps); }
        asm volatile("s_waitcnt lgkmcnt(0)" ::: "memory"); __builtin_amdgcn_s_barrier(); asm volatile("" ::: "memory");
    }
};
template <bool FINAL> struct EpiRmsOut {
    static constexpr bool PERM = false, AFTER_DRAIN = true;
    const float* base0; const float* base1; int split_row; float* out; bf16_t* xn; const float* gain; int ldc; PanelRms st;
    __device__ __forceinline__ void fused(f32x4 (&acc)[2][2][4][2], const Unit& u, int wr, int wc, int fr, int fq, LAS unsigned char* lds, int wid, int lane) const {
        const LAS float* S = (const LAS float*)(lds + 8192);
        const int col0 = u.pn * BM + wc * 32 + 4 * fq;
        f32x4 bq[3][2][2];
#define PG8_LDBASE(buf, g_) do { const int ai_ = (g_) >> 2, m_ = (g_) & 3; const int r = u.pm * BM + ai_ * HALF + wr * 64 + m_ * 16 + fr; \
            const float* b = (r < split_row) ? base0 + (size_t)r * ldc : base1 + (size_t)(r - split_row) * ldc; \
            _Pragma("unroll") for (int bj = 0; bj < 2; ++bj) _Pragma("unroll") for (int n = 0; n < 2; ++n) bq[buf][bj][n] = *(const f32x4*)(b + col0 + bj * HALF + n * 16); } while (0)
#define PG8_ADDBASE(buf, g_) do { const int ai_ = (g_) >> 2, m_ = (g_) & 3; \
            _Pragma("unroll") for (int bj = 0; bj < 2; ++bj) _Pragma("unroll") for (int n = 0; n < 2; ++n) acc[ai_][bj][m_][n] += bq[buf][bj][n]; \
            asm volatile("" : "+v"(acc[ai_][0][m_][0]), "+v"(acc[ai_][0][m_][1]), "+v"(acc[ai_][1][m_][0]), "+v"(acc[ai_][1][m_][1])); } while (0)
        PG8_LDBASE(0, 0); PG8_LDBASE(1, 1); asm volatile("" ::: "memory");
        PG8_LDBASE(2, 2); asm volatile("" ::: "memory"); PG8_ADDBASE(0, 0);
        PG8_LDBASE(0, 3); asm volatile("" ::: "memory"); PG8_ADDBASE(1, 1);
        PG8_LDBASE(1, 4); asm volatile("" ::: "memory"); PG8_ADDBASE(2, 2);
        PG8_LDBASE(2, 5); asm volatile("" ::: "memory"); PG8_ADDBASE(0, 3);
        PG8_LDBASE(0, 6); asm volatile("" ::: "memory"); PG8_ADDBASE(1, 4);
        PG8_LDBASE(1, 7); asm volatile("" ::: "memory"); PG8_ADDBASE(2, 5);
        PG8_ADDBASE(0, 6); PG8_ADDBASE(1, 7);
#undef PG8_LDBASE
#undef PG8_ADDBASE
        st.run(acc, u, wr, wc, fr, fq, lds, wid, lane);
#pragma unroll
        for (int ai = 0; ai < 2; ++ai)
#pragma unroll
            for (int m = 0; m < 4; ++m) { const int rl = ai * HALF + wr * 64 + m * 16 + fr; const float rs = S[rl]; const size_t off = (size_t)(u.pm * BM + rl) * ldc + col0;
#pragma unroll
                for (int bj = 0; bj < 2; ++bj)
#pragma unroll
                    for (int n = 0; n < 2; ++n) { const f32x4 x = acc[ai][bj][m][n]; const size_t o_ = off + bj * HALF + n * 16;
                        if (FINAL) { const f32x4 gg = *(const f32x4*)(gain + col0 + bj * HALF + n * 16); *(f32x4*)(out + o_) = x * rs * gg; }
                        else { *(f32x4*)(out + o_) = x; const f32x4 y = x * rs; u32x2 w; w.x = cvt_pk_bf16(y[0], y[1]); w.y = cvt_pk_bf16(y[2], y[3]); *(u32x2*)(xn + o_) = w; } }
                asm volatile("" ::: "memory"); }
        asm volatile("s_waitcnt lgkmcnt(0)" ::: "memory"); __builtin_amdgcn_s_barrier(); asm volatile("" ::: "memory");
    }
};
struct RoundOrder {
    StaticOrder so; int round;
    __device__ __forceinline__ bool next(int i, Unit& u) const { if (i > 0) return false; return so.next(round, u); }
    __device__ __forceinline__ void a_ready(const Unit&) const {}
    __device__ __forceinline__ void done(const Unit&) const {}
};

template <class Epi, class Sched, bool ALIGN_EPI = false, bool SP2 = false>
__device__ __forceinline__ void gemm_phase(LAS unsigned char* lds, const Gemm g, const Sched& S, const Epi& E, const int tid) {
    const int wid = __builtin_amdgcn_readfirstlane(tid >> 6), lane = tid & 63, wr = wid >> 2, wc = wid & 3, fr = lane & 15, fq = lane >> 4;
    const int K = g.K, nt = K / BK;
    unsigned voffA[2], voffB[2];
#pragma unroll
    for (int i = 0; i < 2; ++i) { int R, C; stage_rc(tid * 16 + i * 8192, R, C); const int Rb = Epi::PERM ? ((R & ~31) + perm32(R & 31)) : R;
        voffA[i] = (unsigned)(R * K + C) * 2u; voffB[i] = (unsigned)(Rb * K + C) * 2u; }
    const size_t kstep = (size_t)(BK * 2);
    const size_t hstep = (size_t)HALF * K * 2;
    const size_t tstep = 2 * hstep;
    const unsigned ldsw = (unsigned)wid * 1024u;
    const int aoff = lds_byte(wr * 64 + fr, fq * 8), boff = lds_byte(wc * 32 + fr, fq * 8);
#define PG8_SA(b, h) (((b) * 2 + (h)) * HTB)
#define PG8_SB(b, h) ((4 + (b) * 2 + (h)) * HTB)
#define PG8_STAGE(bufoff, gbase, voff) do { _Pragma("unroll") for (int _i = 0; _i < 2; ++_i) \
        __builtin_amdgcn_global_load_lds((const unsigned*)((const char*)(gbase) + (voff)[_i]), (LAS unsigned*)(lds + (bufoff) + ldsw + _i * 8192), 16, 0, 0); } while (0)
#define PG8_LDA(dst, b, h) do { _Pragma("unroll") for (int m = 0; m < 4; ++m) _Pragma("unroll") for (int k = 0; k < 2; ++k) dst[m][k] = *(const LAS bf16x8*)(lds + PG8_SA(b, h) + aoff + m * 2048 + k * 1024); } while (0)
#define PG8_LDB(dst, b, h) do { _Pragma("unroll") for (int n = 0; n < 2; ++n) _Pragma("unroll") for (int k = 0; k < 2; ++k) dst[n][k] = *(const LAS bf16x8*)(lds + PG8_SB(b, h) + boff + n * 2048 + k * 1024); } while (0)
#define PG8_MMA(ai, bj, At, Bt) do { __builtin_amdgcn_s_setprio(1); _Pragma("unroll") for (int m = 0; m < 4; ++m) _Pragma("unroll") for (int n = 0; n < 2; ++n) _Pragma("unroll") for (int k = 0; k < 2; ++k) \
        acc[ai][bj][m][n] = __builtin_amdgcn_mfma_f32_16x16x32_bf16(Bt[n][k], At[m][k], acc[ai][bj][m][n], 0, 0, 0); __builtin_amdgcn_s_setprio(0); } while (0)
#define PG8_WAIT_V(n) asm volatile("s_waitcnt vmcnt(" #n ")" ::: "memory")
#define PG8_WAIT_L(n) asm volatile("s_waitcnt lgkmcnt(" #n ")" ::: "memory")
#define PG8_BAR __builtin_amdgcn_s_barrier()
#define PG8_SCHED __builtin_amdgcn_sched_barrier(0)
    Unit cur, nxt; int ui = 0;
    if (!S.next(0, cur)) return;
    f32x4 acc[2][2][4][2];
#pragma unroll
    for (int a = 0; a < 2; ++a)
#pragma unroll
        for (int b = 0; b < 2; ++b)
#pragma unroll
            for (int m = 0; m < 4; ++m)
#pragma unroll
                for (int n = 0; n < 2; ++n) acc[a][b][m][n] = (f32x4){0.f, 0.f, 0.f, 0.f};
    bf16x8 At[4][2], B0[2][2], B1[2][2];
    const char* cA = (const char*)g.A + (size_t)cur.pm * tstep; const char* cB = (const char*)g.Bt + (size_t)cur.pn * tstep;
    S.a_ready(cur);
    if constexpr (SP2) {
        PG8_STAGE(PG8_SB(0, 0), cB, voffB); PG8_STAGE(PG8_SB(0, 1), cB + hstep, voffB); PG8_STAGE(PG8_SA(0, 0), cA, voffA); PG8_STAGE(PG8_SA(0, 1), cA + hstep, voffA);
        if (wr == 1) PG8_BAR;
        PG8_WAIT_V(2); PG8_BAR;
        PG8_STAGE(PG8_SB(1, 0), cB + kstep, voffB); PG8_STAGE(PG8_SA(1, 0), cA + kstep, voffA); PG8_STAGE(PG8_SB(1, 1), cB + hstep + kstep, voffB);
        PG8_WAIT_V(6); PG8_BAR;
    } else {
        PG8_STAGE(PG8_SB(0, 0), cB, voffB); PG8_STAGE(PG8_SA(0, 0), cA, voffA); PG8_STAGE(PG8_SB(0, 1), cB + hstep, voffB); PG8_STAGE(PG8_SA(0, 1), cA + hstep, voffA);
        if (wr == 1) PG8_BAR;
        PG8_WAIT_V(4); PG8_BAR;
        PG8_STAGE(PG8_SB(1, 0), cB + kstep, voffB); PG8_STAGE(PG8_SA(1, 0), cA + kstep, voffA); PG8_STAGE(PG8_SB(1, 1), cB + hstep + kstep, voffB);
        PG8_WAIT_V(6); PG8_BAR;
    }
    for (;;) {
        const bool has_next = S.next(ui + 1, nxt);
        const char* nA = has_next ? (const char*)g.A + (size_t)nxt.pm * tstep : cA; const char* nB = has_next ? (const char*)g.Bt + (size_t)nxt.pn * tstep : cB;
        for (int t = 0; t < nt; t += 2) {
            const bool last = (t == nt - 2);
            const char* a1 = cA + (size_t)(t + 1) * kstep;
            const char* a2 = last ? nA : cA + (size_t)(t + 2) * kstep; const char* b2 = last ? nB : cB + (size_t)(t + 2) * kstep;
            const char* a3 = a2 + kstep; const char* b3 = b2 + kstep;
            if (last && has_next) S.a_ready(nxt);
            if constexpr (SP2) {
            PG8_LDB(B0, 0, 0); PG8_LDB(B1, 0, 1); PG8_SCHED; PG8_LDA(At, 0, 0); PG8_STAGE(PG8_SA(1, 1), a1 + hstep, voffA);
            PG8_WAIT_V(8); PG8_WAIT_L(0); PG8_BAR; PG8_MMA(0, 0, At, B0); PG8_MMA(0, 1, At, B1); PG8_BAR; PG8_SCHED;
            PG8_LDA(At, 0, 1); PG8_STAGE(PG8_SB(0, 0), b2, voffB); PG8_STAGE(PG8_SB(0, 1), b2 + hstep, voffB); PG8_STAGE(PG8_SA(0, 0), a2, voffA);
            PG8_WAIT_V(8); PG8_WAIT_L(0); PG8_BAR; PG8_MMA(1, 0, At, B0); PG8_MMA(1, 1, At, B1); PG8_BAR; PG8_SCHED;
            PG8_LDB(B0, 1, 0); PG8_LDB(B1, 1, 1); PG8_SCHED; PG8_LDA(At, 1, 0); PG8_STAGE(PG8_SA(0, 1), a2 + hstep, voffA);
            PG8_WAIT_V(8); PG8_WAIT_L(0); PG8_BAR; PG8_MMA(0, 0, At, B0); PG8_MMA(0, 1, At, B1); PG8_BAR; PG8_SCHED;
            PG8_LDA(At, 1, 1); PG8_STAGE(PG8_SB(1, 0), b3, voffB); PG8_STAGE(PG8_SB(1, 1), b3 + hstep, voffB); PG8_STAGE(PG8_SA(1, 0), a3, voffA);
            PG8_WAIT_V(8); PG8_WAIT_L(0); PG8_BAR; PG8_MMA(1, 0, At, B0); PG8_MMA(1, 1, At, B1); PG8_BAR; PG8_SCHED;
            } else {
            PG8_LDB(B0, 0, 0); PG8_SCHED; PG8_LDA(At, 0, 0); PG8_STAGE(PG8_SA(1, 1), a1 + hstep, voffA);
            PG8_WAIT_L(8); PG8_BAR; PG8_WAIT_L(0); PG8_MMA(0, 0, At, B0); PG8_BAR; PG8_SCHED;
            PG8_LDB(B1, 0, 1); PG8_STAGE(PG8_SB(0, 0), b2, voffB);
            PG8_BAR; PG8_WAIT_L(0); PG8_MMA(0, 1, At, B1); PG8_BAR;
            PG8_LDA(At, 0, 1); PG8_STAGE(PG8_SA(0, 0), a2, voffA);
            PG8_BAR; PG8_WAIT_L(0); PG8_MMA(1, 0, At, B0); PG8_BAR; PG8_SCHED;
            PG8_STAGE(PG8_SB(0, 1), b2 + hstep, voffB);
            PG8_WAIT_V(6); PG8_BAR; PG8_MMA(1, 1, At, B1); PG8_BAR;
            PG8_LDB(B0, 1, 0); PG8_SCHED; PG8_LDA(At, 1, 0); PG8_STAGE(PG8_SA(0, 1), a2 + hstep, voffA);
            PG8_WAIT_L(8); PG8_BAR; PG8_WAIT_L(0); PG8_MMA(0, 0, At, B0); PG8_BAR; PG8_SCHED;
            PG8_LDB(B1, 1, 1); PG8_STAGE(PG8_SB(1, 0), b3, voffB);
            PG8_BAR; PG8_WAIT_L(0); PG8_MMA(0, 1, At, B1); PG8_BAR;
            PG8_LDA(At, 1, 1); PG8_STAGE(PG8_SA(1, 0), a3, voffA);
            PG8_BAR; PG8_WAIT_L(0); PG8_MMA(1, 0, At, B0); PG8_BAR; PG8_SCHED;
            PG8_STAGE(PG8_SB(1, 1), b3 + hstep, voffB);
            PG8_WAIT_V(6); PG8_BAR; PG8_MMA(1, 1, At, B1); PG8_BAR;
            }
        }
        if constexpr (ALIGN_EPI) { if (wr == 0) PG8_BAR; }
        if constexpr (!Epi::AFTER_DRAIN) { E(acc, cur, wr, wc, fr, fq); S.done(cur); }
        if (!has_next) break;
#pragma unroll
        for (int a = 0; a < 2; ++a)
#pragma unroll
            for (int b = 0; b < 2; ++b)
#pragma unroll
                for (int m = 0; m < 4; ++m)
#pragma unroll
                    for (int n = 0; n < 2; ++n) acc[a][b][m][n] = (f32x4){0.f, 0.f, 0.f, 0.f};
        cur = nxt; cA = nA; cB = nB; ++ui;
        if constexpr (ALIGN_EPI) { if (wr == 1) PG8_BAR; }
    }
    PG8_WAIT_V(0);
    if constexpr (!ALIGN_EPI) { if (wr == 0) PG8_BAR; }
    PG8_BAR;
    if constexpr (Epi::AFTER_DRAIN) { E.fused(acc, cur, wr, wc, fr, fq, lds, wid, lane); S.done(cur); }
#undef PG8_SA
#undef PG8_SB
#undef PG8_STAGE
#undef PG8_LDA
#undef PG8_LDB
#undef PG8_MMA
#undef PG8_WAIT_V
#undef PG8_WAIT_L
#undef PG8_BAR
#undef PG8_SCHED
}
}

namespace fa {
constexpr int SLOTB = 8192;
constexpr int L_K = 0, L_V = 3 * SLOTB, L_OST = 6 * SLOTB, L_QST = L_OST, L_WS = 120 * 1024, L_TAB = L_WS + 2048, L_END = L_TAB + 4096;
constexpr int L_AK = 0, L_AV = 6 * SLOTB, L_AOST = 0;
static_assert(L_END <= RING_BYTES, "attention LDS map");
#define SBAR() __builtin_amdgcn_sched_barrier(0)
__device__ __forceinline__ int crow(int r, int hi) { return (r & 3) + 8 * (r >> 2) + 4 * hi; }
__device__ __forceinline__ void glds16(const void* gsrc, unsigned lds_dst) { unsigned keep;
    asm volatile("s_mov_b32 %0, m0\n\ts_mov_b32 m0, %2\n\ts_nop 0\n\tglobal_load_lds_dwordx4 %1, off\n\ts_mov_b32 m0, %0" : "=&s"(keep) : "v"(gsrc), "s"(lds_dst) : "memory"); }
__device__ __forceinline__ void glds16s(const void* sbase, unsigned voff, unsigned lds_dst) { unsigned keep;
    asm volatile("s_mov_b32 %0, m0\n\ts_mov_b32 m0, %3\n\ts_nop 0\n\tglobal_load_lds_dwordx4 %1, %2\n\ts_mov_b32 m0, %0" : "=&s"(keep) : "v"(voff), "s"(sbase), "s"(lds_dst) : "memory"); }
typedef __bf16 bf16x2_t __attribute__((ext_vector_type(2)));
__device__ __forceinline__ unsigned cvtpk_s(float lo, float hi) { f32x2 v = {lo, hi}; bf16x2_t b = __builtin_convertvector(v, bf16x2_t); return __builtin_bit_cast(unsigned, b); }
#define FA_WAIT_BAR(N) asm volatile("s_waitcnt vmcnt(" #N ") lgkmcnt(0)\n\ts_barrier" ::: "memory")

template <int NDQ>
__device__ __forceinline__ void qkt(f32x16& p0, f32x16& p1, LAS const unsigned char* Kslot, const bf16x8* qr, const f32x16& cin, int r32, int hi) {
    LAS const unsigned char* kb = Kslot + hi * 1024 + r32 * 16;
#pragma unroll
    for (int d0 = 0; d0 < NDQ; ++d0) {
        const bf16x8 b0 = *(LAS const bf16x8*)(kb + d0 * 2048);
        const bf16x8 b1 = *(LAS const bf16x8*)(kb + d0 * 2048 + 512);
        if (d0 == 0) { p0 = __builtin_amdgcn_mfma_f32_32x32x16_bf16(b0, qr[0], cin, 0, 0, 0); p1 = __builtin_amdgcn_mfma_f32_32x32x16_bf16(b1, qr[0], cin, 0, 0, 0); }
        else { p0 = __builtin_amdgcn_mfma_f32_32x32x16_bf16(b0, qr[d0], p0, 0, 0, 0); p1 = __builtin_amdgcn_mfma_f32_32x32x16_bf16(b1, qr[d0], p1, 0, 0, 0); } }
}
__device__ __forceinline__ float max3f(float a, float b, float c) { float r; asm("v_max3_f32 %0, %1, %2, %3" : "=v"(r) : "v"(a), "v"(b), "v"(c)); return r; }
__device__ __forceinline__ float max2f(float a, float b) { float r; asm("v_max_f32_e32 %0, %1, %2" : "=v"(r) : "v"(a), "v"(b)); return r; }
__device__ __forceinline__ float rowmax(const f32x16& p0, const f32x16& p1) {
    float a = max3f(p0[0], p0[1], p1[0]), b = max3f(p0[2], p0[3], p1[1]); a = max3f(a, p1[2], p1[3]);
#pragma unroll
    for (int r = 4; r < 16; r += 4) { a = max3f(a, p0[r], p0[r + 1]); b = max3f(b, p0[r + 2], p0[r + 3]); a = max3f(a, p1[r], p1[r + 1]); b = max3f(b, p1[r + 2], p1[r + 3]); }
    const float m = max2f(a, b);
    auto rr = __builtin_amdgcn_permlane32_swap(__float_as_uint(m), __float_as_uint(m), false, false);
    return max2f(__uint_as_float(rr[0]), __uint_as_float(rr[1]));
}
__device__ __forceinline__ void pv(f32x16* o, int vb, bf16x8 pa0, bf16x8 pa1, bf16x8 pa2, bf16x8 pa3) {
#pragma unroll
    for (int d0 = 0; d0 < 2; ++d0) { s16x4 lo[4], hi[4];
#pragma unroll
        for (int ks = 0; ks < 4; ++ks) {
            asm volatile("ds_read_b64_tr_b16 %0,%1 offset:%c2" : "=&v"(lo[ks]) : "v"(vb), "i"(d0 * 4096 + ks * 1024) : "memory");
            asm volatile("ds_read_b64_tr_b16 %0,%1 offset:%c2" : "=&v"(hi[ks]) : "v"(vb), "i"(d0 * 4096 + ks * 1024 + 512) : "memory"); }
        asm volatile("s_waitcnt lgkmcnt(0)" ::: "memory"); SBAR();
#define FA_PK(k) (bf16x8){lo[k][0], lo[k][1], lo[k][2], lo[k][3], hi[k][0], hi[k][1], hi[k][2], hi[k][3]}
        o[d0] = __builtin_amdgcn_mfma_f32_32x32x16_bf16(pa0, FA_PK(0), o[d0], 0, 0, 0);
        o[d0] = __builtin_amdgcn_mfma_f32_32x32x16_bf16(pa1, FA_PK(1), o[d0], 0, 0, 0);
        o[d0] = __builtin_amdgcn_mfma_f32_32x32x16_bf16(pa2, FA_PK(2), o[d0], 0, 0, 0);
        o[d0] = __builtin_amdgcn_mfma_f32_32x32x16_bf16(pa3, FA_PK(3), o[d0], 0, 0, 0);
#undef FA_PK
    }
}

constexpr float THR = 8.0f;
template <int NDQ, class KV, class Hook>
__device__ __forceinline__ void flash_core(LAS unsigned char* shm, const bf16_t* qptr, const KV& kv, int NT, const Hook& hk, int koff, f32x16 (&o)[2], float& mhat_out, float& l_out, const int tid) {
    const int lane = tid & 63, r32 = lane & 31, hi = lane >> 5; const int wid = __builtin_amdgcn_readfirstlane(tid >> 6);
    const unsigned lds0 = (unsigned)(uintptr_t)shm;
    LAS float* wsf = (LAS float*)(shm + L_WS) + wid * 64;
    const unsigned kdst = lds0 + L_K + wid * 1024, vdst = lds0 + L_V + wid * 1024;
    const int vrow_j = 16 * (wid & 3) + (lane >> 2), vcol = (wid >> 2) * 32 + (lane & 3) * 8;
#define FA_DMA(t, slot) do { glds16(kv.kptr((t), lane) + wid * 8, (unsigned)__builtin_amdgcn_readfirstlane(kdst + (slot) * SLOTB)); \
                             glds16(kv.vptr((t), vrow_j) + vcol, (unsigned)__builtin_amdgcn_readfirstlane(vdst + (slot) * SLOTB)); } while (0)
    FA_DMA(0, 0);
    bf16x8 qr[4];
#pragma unroll
    for (int d0 = 0; d0 < 4; ++d0) { if (d0 < NDQ) qr[d0] = *(const bf16x8*)(qptr + d0 * 16 + hi * 8); else qr[d0] = (bf16x8){0, 0, 0, 0, 0, 0, 0, 0}; }
    asm volatile("" : "+v"(qr[0]), "+v"(qr[1]), "+v"(qr[2]), "+v"(qr[3]));
    float mhat = 0.f, l = 0.f; o[0] = f32x16{}; o[1] = f32x16{}; const f32x16 zero16 = f32x16{};
    bool first = true;
    const int vb0 = (int)(lds0 + L_V) + ((lane >> 4) & 1) * 32 + (lane & 3) * 8 + (4 * hi + ((lane & 15) >> 2)) * 64;
    for (int t = 0; t < NT; ++t) {
        const int slot = t & 1;
        if (t + 1 < NT) { FA_DMA(t + 1, slot ^ 1); FA_WAIT_BAR(2); } else { FA_WAIT_BAR(0); }
        if (!hk.skip(t)) {
            f32x16 p0, p1;
            qkt<NDQ>(p0, p1, shm + L_K + slot * SLOTB + koff, qr, zero16, r32, hi);
            hk.apply(p0, p1, t);
            const float rmr = rowmax(p0, p1); const float rm = rmr - mhat;
            if (first) {
                first = false; mhat = (rmr > -1e29f) ? rmr : 0.f;
            } else if (__any(rm > THR)) {
                const float dl = fmaxf(rm, 0.f); mhat += dl;
                const float f = __builtin_amdgcn_exp2f(-dl); l *= f; if (hi == 0) wsf[r32] = f;
                asm volatile("s_waitcnt lgkmcnt(0)" ::: "memory");
#pragma unroll
                for (int r = 0; r < 16; ++r) { const float fr_ = wsf[crow(r, hi)]; o[0][r] *= fr_; o[1][r] *= fr_; }
            }
            float sacc = 0.f, sacc2 = 0.f;
#pragma unroll
            for (int r = 0; r < 16; ++r) { p0[r] = __builtin_amdgcn_exp2f(p0[r] - mhat); p1[r] = __builtin_amdgcn_exp2f(p1[r] - mhat); sacc += p0[r]; sacc2 += p1[r]; }
            l += sacc + sacc2;
            u32x4 pw0, pw1, pw2, pw3;
            pw0 = (u32x4){cvtpk_s(p0[0], p0[1]), cvtpk_s(p0[2], p0[3]), cvtpk_s(p0[4], p0[5]), cvtpk_s(p0[6], p0[7])};
            pw1 = (u32x4){cvtpk_s(p0[8], p0[9]), cvtpk_s(p0[10], p0[11]), cvtpk_s(p0[12], p0[13]), cvtpk_s(p0[14], p0[15])};
            pw2 = (u32x4){cvtpk_s(p1[0], p1[1]), cvtpk_s(p1[2], p1[3]), cvtpk_s(p1[4], p1[5]), cvtpk_s(p1[6], p1[7])};
            pw3 = (u32x4){cvtpk_s(p1[8], p1[9]), cvtpk_s(p1[10], p1[11]), cvtpk_s(p1[12], p1[13]), cvtpk_s(p1[14], p1[15])};
            SBAR();
            pv(o, vb0 + slot * SLOTB, __builtin_bit_cast(bf16x8, pw0), __builtin_bit_cast(bf16x8, pw1), __builtin_bit_cast(bf16x8, pw2), __builtin_bit_cast(bf16x8, pw3));
        }
        asm volatile("s_waitcnt lgkmcnt(0)\n\ts_barrier" ::: "memory");
    }
#undef FA_DMA
    { auto rr = __builtin_amdgcn_permlane32_swap(__float_as_uint(l), __float_as_uint(l), false, false); l = __uint_as_float(rr[0]) + __uint_as_float(rr[1]); }
    if (hi == 0) wsf[32 + r32] = l;
    asm volatile("s_waitcnt lgkmcnt(0)" ::: "memory");
#pragma unroll
    for (int r = 0; r < 16; ++r) { const float rl = __builtin_amdgcn_rcpf(wsf[32 + crow(r, hi)]); o[0][r] *= rl; o[1][r] *= rl; }
    mhat_out = mhat; l_out = l;
}
template <int NDQ, class KV, class Hook>
__device__ __forceinline__ void flash_core_sp(LAS unsigned char* shm, const bf16_t* qptr, const KV& kv, int NT, const Hook& hk, int koff, f32x16 (&o)[2], float& mhat_out, float& l_out, const int tid) {
    const int lane = tid & 63, r32 = lane & 31, hi = lane >> 5; const int wid = __builtin_amdgcn_readfirstlane(tid >> 6);
    const unsigned lds0 = (unsigned)(uintptr_t)shm;
    LAS float* wsf = (LAS float*)(shm + L_WS) + wid * 64;
    const unsigned kdst = lds0 + L_K + wid * 1024, vdst = lds0 + L_V + wid * 1024;
    const int vrow_j = 16 * (wid & 3) + (lane >> 2), vcol = (wid >> 2) * 32 + (lane & 3) * 8;
#define FA_DMAK(t, SL) glds16(kv.kptr((t), lane) + wid * 8, (unsigned)__builtin_amdgcn_readfirstlane(kdst + (SL) * SLOTB))
#define FA_DMAV(t, SL) glds16(kv.vptr((t), vrow_j) + vcol, (unsigned)__builtin_amdgcn_readfirstlane(vdst + (SL) * SLOTB))
    FA_DMAK(0, 0); FA_DMAV(0, 0); FA_DMAK(1, 1); FA_DMAK(2, 2); FA_DMAV(1, 1);
    bf16x8 qr[4];
#pragma unroll
    for (int d0 = 0; d0 < 4; ++d0) { if (d0 < NDQ) qr[d0] = *(const bf16x8*)(qptr + d0 * 16 + hi * 8); else qr[d0] = (bf16x8){0, 0, 0, 0, 0, 0, 0, 0}; }
    asm volatile("" : "+v"(qr[0]), "+v"(qr[1]), "+v"(qr[2]), "+v"(qr[3]));
    float mhat = 0.f, l = 0.f; o[0] = f32x16{}; o[1] = f32x16{}; const f32x16 zero16 = f32x16{};
    bool first = true;
    const int vb0 = (int)(lds0 + L_V) + ((lane >> 4) & 1) * 32 + (lane & 3) * 8 + (4 * hi + ((lane & 15) >> 2)) * 64;
    f32x16 pA0, pA1, pB0, pB1;
    FA_WAIT_BAR(2);
#define FA_ENDW(tt) do { if ((tt) + 3 < NT) { FA_WAIT_BAR(2); } else if ((tt) + 2 < NT) { FA_WAIT_BAR(1); } else { FA_WAIT_BAR(0); } } while (0)
    if (!hk.skip(0)) qkt<NDQ>(pA0, pA1, shm + L_K + koff, qr, zero16, r32, hi);
#define FA_SMPV(P0, P1, tt, SL) do { \
        hk.apply(P0, P1, (tt)); const float curb = hk.cbias(tt); \
        const float rmr = rowmax(P0, P1) + curb; const float rm = rmr - mhat; \
        if (first) { first = false; mhat = (rmr > -1e29f) ? rmr : 0.f; \
        } else if (__any(rm > THR)) { const float dl = fmaxf(rm, 0.f); mhat += dl; \
            const float f = __builtin_amdgcn_exp2f(-dl); l *= f; if (hi == 0) wsf[r32] = f; \
            asm volatile("s_waitcnt lgkmcnt(0)" ::: "memory"); \
            _Pragma("unroll") for (int r = 0; r < 16; ++r) { const float fr_ = wsf[crow(r, hi)]; o[0][r] *= fr_; o[1][r] *= fr_; } } \
        float sacc = 0.f, sacc2 = 0.f; const float mref_ = mhat - curb; \
        _Pragma("unroll") for (int r = 0; r < 16; ++r) { P0[r] = __builtin_amdgcn_exp2f(P0[r] - mref_); P1[r] = __builtin_amdgcn_exp2f(P1[r] - mref_); sacc += P0[r]; sacc2 += P1[r]; } \
        l += sacc + sacc2; \
        u32x4 pw0, pw1, pw2, pw3; \
        pw0 = (u32x4){cvtpk_s(P0[0], P0[1]), cvtpk_s(P0[2], P0[3]), cvtpk_s(P0[4], P0[5]), cvtpk_s(P0[6], P0[7])}; \
        pw1 = (u32x4){cvtpk_s(P0[8], P0[9]), cvtpk_s(P0[10], P0[11]), cvtpk_s(P0[12], P0[13]), cvtpk_s(P0[14], P0[15])}; \
        pw2 = (u32x4){cvtpk_s(P1[0], P1[1]), cvtpk_s(P1[2], P1[3]), cvtpk_s(P1[4], P1[5]), cvtpk_s(P1[6], P1[7])}; \
        pw3 = (u32x4){cvtpk_s(P1[8], P1[9]), cvtpk_s(P1[10], P1[11]), cvtpk_s(P1[12], P1[13]), cvtpk_s(P1[14], P1[15])}; \
        SBAR(); \
        pv(o, vb0 + (SL) * SLOTB, __builtin_bit_cast(bf16x8, pw0), __builtin_bit_cast(bf16x8, pw1), __builtin_bit_cast(bf16x8, pw2), __builtin_bit_cast(bf16x8, pw3)); \
    } while (0)
    bf16x8 kf[8];
#define FA_KLOAD(SL) do { LAS const unsigned char* kb_ = shm + L_K + (SL) * SLOTB + koff + hi * 1024 + r32 * 16; \
        _Pragma("unroll") for (int d0 = 0; d0 < NDQ; ++d0) { kf[2 * d0] = *(LAS const bf16x8*)(kb_ + d0 * 2048); kf[2 * d0 + 1] = *(LAS const bf16x8*)(kb_ + d0 * 2048 + 512); } } while (0)
#define FA_QKM(P0, P1) do { _Pragma("unroll") for (int d0 = 0; d0 < NDQ; ++d0) { \
        if (d0 == 0) { P0 = __builtin_amdgcn_mfma_f32_32x32x16_bf16(kf[0], qr[0], zero16, 0, 0, 0); P1 = __builtin_amdgcn_mfma_f32_32x32x16_bf16(kf[1], qr[0], zero16, 0, 0, 0); } \
        else { P0 = __builtin_amdgcn_mfma_f32_32x32x16_bf16(kf[2 * d0], qr[d0], P0, 0, 0, 0); P1 = __builtin_amdgcn_mfma_f32_32x32x16_bf16(kf[2 * d0 + 1], qr[d0], P1, 0, 0, 0); } } } while (0)
#define FA_STEP(tt, SC, PC0, PC1, PN0, PN1) do { \
        if ((tt) + 3 < NT) FA_DMAK((tt) + 3, (SC)); \
        if ((tt) + 2 < NT) FA_DMAV((tt) + 2, ((SC) + 2) % 3); \
        const bool nx_ = ((tt) + 1 < NT) && !hk.skip((tt) + 1); \
        if (true) { if (nx_) FA_KLOAD(((SC) + 1) % 3); } \
        SBAR(); \
        if (!hk.skip(tt)) { FA_SMPV(PC0, PC1, (tt), (SC)); } \
        SBAR(); \
        if (nx_) { FA_QKM(PN0, PN1); } \
        FA_ENDW(tt); \
    } while (0)
    for (int t = 0; t < NT; t += 6) {
        FA_STEP(t, 0, pA0, pA1, pB0, pB1);
        if (t + 1 < NT) { FA_STEP(t + 1, 1, pB0, pB1, pA0, pA1); }
        if (t + 2 < NT) { FA_STEP(t + 2, 2, pA0, pA1, pB0, pB1); }
        if (t + 3 < NT) { FA_STEP(t + 3, 0, pB0, pB1, pA0, pA1); }
        if (t + 4 < NT) { FA_STEP(t + 4, 1, pA0, pA1, pB0, pB1); }
        if (t + 5 < NT) { FA_STEP(t + 5, 2, pB0, pB1, pA0, pA1); }
    }
#undef FA_STEP
#undef FA_KLOAD
#undef FA_QKM
#undef FA_SMPV
#undef FA_DMAK
#undef FA_ENDW
#undef FA_DMAV
    { auto rr = __builtin_amdgcn_permlane32_swap(__float_as_uint(l), __float_as_uint(l), false, false); l = __uint_as_float(rr[0]) + __uint_as_float(rr[1]); }
    if (hi == 0) wsf[32 + r32] = l;
    asm volatile("s_waitcnt lgkmcnt(0)" ::: "memory");
#pragma unroll
    for (int r = 0; r < 16; ++r) { const float rl = __builtin_amdgcn_rcpf(wsf[32 + crow(r, hi)]); o[0][r] *= rl; o[1][r] *= rl; }
    mhat_out = mhat; l_out = l;
}
template <class KV, class Hook>
__device__ __forceinline__ void flash_core_all(LAS unsigned char* shm, const bf16_t* qptr, const KV& kv, int NT, const Hook& hk, f32x16 (&o)[2], float& mhat_out, float& l_out, const int tid) {
    const int lane = tid & 63, r32 = lane & 31, hi = lane >> 5; const int wid = __builtin_amdgcn_readfirstlane(tid >> 6);
    const unsigned lds0 = (unsigned)(uintptr_t)shm;
    LAS float* wsf = (LAS float*)(shm + L_WS) + wid * 64;
    const unsigned kdst = lds0 + L_AK + wid * 1024, vdst = lds0 + L_AV + wid * 1024;
    const int vrow_j = 16 * (wid & 3) + (lane >> 2), vcol = (wid >> 2) * 32 + (lane & 3) * 8;
    for (int t = 0; t < NT; ++t) {
        glds16(kv.kptr(t, lane) + wid * 8, (unsigned)__builtin_amdgcn_readfirstlane(kdst + t * SLOTB));
        glds16(kv.vptr(t, vrow_j) + vcol, (unsigned)__builtin_amdgcn_readfirstlane(vdst + t * SLOTB)); }
    bf16x8 qr[4];
#pragma unroll
    for (int d0 = 0; d0 < 4; ++d0) qr[d0] = *(const bf16x8*)(qptr + d0 * 16 + hi * 8);
    asm volatile("" : "+v"(qr[0]), "+v"(qr[1]), "+v"(qr[2]), "+v"(qr[3]));
    float mhat = 0.f, l = 0.f; o[0] = f32x16{}; o[1] = f32x16{}; const f32x16 zero16 = f32x16{};
    bool first = true;
    const int vb0 = (int)(lds0 + L_AV) + ((lane >> 4) & 1) * 32 + (lane & 3) * 8 + (4 * hi + ((lane & 15) >> 2)) * 64;
    FA_WAIT_BAR(0);
    for (int t = 0; t < NT; ++t) {
        if (hk.skip(t)) continue;
        f32x16 p0, p1;
        { bf16x8 kf[8]; LAS const unsigned char* kb_ = shm + L_AK + t * SLOTB + hi * 1024 + r32 * 16;
#pragma unroll
          for (int d0 = 0; d0 < 4; ++d0) { kf[2 * d0] = *(LAS const bf16x8*)(kb_ + d0 * 2048); kf[2 * d0 + 1] = *(LAS const bf16x8*)(kb_ + d0 * 2048 + 512); }
#pragma unroll
          for (int d0 = 0; d0 < 4; ++d0) {
              if (d0 == 0) { p0 = __builtin_amdgcn_mfma_f32_32x32x16_bf16(kf[0], qr[0], zero16, 0, 0, 0); p1 = __builtin_amdgcn_mfma_f32_32x32x16_bf16(kf[1], qr[0], zero16, 0, 0, 0); }
              else { p0 = __builtin_amdgcn_mfma_f32_32x32x16_bf16(kf[2 * d0], qr[d0], p0, 0, 0, 0); p1 = __builtin_amdgcn_mfma_f32_32x32x16_bf16(kf[2 * d0 + 1], qr[d0], p1, 0, 0, 0); } } }
        hk.apply(p0, p1, t);
        const float rmr = rowmax(p0, p1); const float rm = rmr - mhat;
        if (first) { first = false; mhat = (rmr > -1e29f) ? rmr : 0.f;
        } else if (__any(rm > THR)) { const float dl = fmaxf(rm, 0.f); mhat += dl;
            const float f = __builtin_amdgcn_exp2f(-dl); l *= f; if (hi == 0) wsf[r32] = f;
            asm volatile("s_waitcnt lgkmcnt(0)" ::: "memory");
#pragma unroll
            for (int r = 0; r < 16; ++r) { const float fr_ = wsf[crow(r, hi)]; o[0][r] *= fr_; o[1][r] *= fr_; } }
        float sacc = 0.f, sacc2 = 0.f;
#pragma unroll
        for (int r = 0; r < 16; ++r) { p0[r] = __builtin_amdgcn_exp2f(p0[r] - mhat); p1[r] = __builtin_amdgcn_exp2f(p1[r] - mhat); sacc += p0[r]; sacc2 += p1[r]; }
        l += sacc + sacc2;
        u32x4 pw0, pw1, pw2, pw3;
        pw0 = (u32x4){cvtpk_s(p0[0], p0[1]), cvtpk_s(p0[2], p0[3]), cvtpk_s(p0[4], p0[5]), cvtpk_s(p0[6], p0[7])};
        pw1 = (u32x4){cvtpk_s(p0[8], p0[9]), cvtpk_s(p0[10], p0[11]), cvtpk_s(p0[12], p0[13]), cvtpk_s(p0[14], p0[15])};
        pw2 = (u32x4){cvtpk_s(p1[0], p1[1]), cvtpk_s(p1[2], p1[3]), cvtpk_s(p1[4], p1[5]), cvtpk_s(p1[6], p1[7])};
        pw3 = (u32x4){cvtpk_s(p1[8], p1[9]), cvtpk_s(p1[10], p1[11]), cvtpk_s(p1[12], p1[13]), cvtpk_s(p1[14], p1[15])};
        SBAR();
        pv(o, vb0 + t * SLOTB, __builtin_bit_cast(bf16x8, pw0), __builtin_bit_cast(bf16x8, pw1), __builtin_bit_cast(bf16x8, pw2), __builtin_bit_cast(bf16x8, pw3));
    }
    asm volatile("s_waitcnt lgkmcnt(0)\n\ts_barrier" ::: "memory");
    { auto rr = __builtin_amdgcn_permlane32_swap(__float_as_uint(l), __float_as_uint(l), false, false); l = __uint_as_float(rr[0]) + __uint_as_float(rr[1]); }
    if (hi == 0) wsf[32 + r32] = l;
    asm volatile("s_waitcnt lgkmcnt(0)" ::: "memory");
#pragma unroll
    for (int r = 0; r < 16; ++r) { const float rl = __builtin_amdgcn_rcpf(wsf[32 + crow(r, hi)]); o[0][r] *= rl; o[1][r] *= rl; }
    mhat_out = mhat; l_out = l;
}
template <int DUMMY = 0>
__device__ __forceinline__ void b3_compute(LAS unsigned char* shm, const bf16x8 (&qr)[4], int NT, int slot_off, LAS const float* tab, int qw, int kb0, bool active, float kbound, float badd,
                                           f32x16 (&o)[2], float& mrow_out, float& l_out, const int tid) {
    const int lane = tid & 63, r32 = lane & 31, hi = lane >> 5;
    const unsigned lds0 = (unsigned)(uintptr_t)shm;
    float q2 = 0.f;
#pragma unroll
    for (int d0 = 0; d0 < 4; ++d0)
#pragma unroll
        for (int e = 0; e < 8; ++e) { const float x = __builtin_bit_cast(float, (unsigned)(unsigned short)qr[d0][e] << 16); q2 += x * x; }
    { auto rr = __builtin_amdgcn_permlane32_swap(__float_as_uint(q2), __float_as_uint(q2), false, false); q2 = __uint_as_float(rr[0]) + __uint_as_float(rr[1]); }
    const float mrow = sqrtf(q2) * kbound + badd;
    f32x16 negm;
#pragma unroll
    for (int r = 0; r < 16; ++r) negm[r] = -mrow;
    asm volatile("" : "+v"(negm));
    float l = 0.f; o[0] = f32x16{}; o[1] = f32x16{};
    const int tf = (qw - 64 - kb0) >> 6;
    const unsigned kbase = lds0 + L_AK + hi * 1024 + r32 * 16;
    const unsigned vbase = lds0 + L_AV + ((lane >> 4) & 1) * 32 + (lane & 3) * 8 + (4 * hi + ((lane & 15) >> 2)) * 64;
    const unsigned tbase = (unsigned)(uintptr_t)tab + 4u * (unsigned)(kb0 + 4 * hi - (qw + r32) + 158);
    FA_WAIT_BAR(0);
    { int t_lo = tf < 0 ? 0 : tf, t_hi = tf + 2 >= NT ? NT - 1 : tf + 2; if (!active) t_hi = t_lo - 1;
    for (int t = t_lo; t <= t_hi; ++t) {
        {
            const unsigned ka = kbase + (unsigned)(t + slot_off) * SLOTB, va = vbase + (unsigned)(t + slot_off) * SLOTB, ta = tbase + 256u * (unsigned)t;
            bf16x8 kf[8]; f32x2 tv0[8], tv1[8]; s16x4 vlo[8], vhi[8];
#define B3_KRD(j) asm volatile("ds_read_b128 %0, %2 offset:%c3\n\tds_read_b128 %1, %2 offset:%c4" : "=&v"(kf[2 * (j)]), "=&v"(kf[2 * (j) + 1]) : "v"(ka), "i"((j) * 2048), "i"((j) * 2048 + 512) : "memory")
#define B3_TR1(dst, off) asm volatile("ds_read2_b32 %0, %1 offset0:%c2 offset1:%c3" : "=&v"(dst) : "v"(ta), "i"(off), "i"((off) + 1) : "memory")
#define B3_TRD(j2) do { B3_TR1(tv0[j2], 8 * ((j2) >> 1) + 2 * ((j2) & 1)); B3_TR1(tv1[j2], 8 * ((j2) >> 1) + 2 * ((j2) & 1) + 32); } while (0)
#define B3_VRD(ii) asm volatile("ds_read_b64_tr_b16 %0, %2 offset:%c3\n\tds_read_b64_tr_b16 %1, %2 offset:%c4" : "=&v"(vlo[ii]), "=&v"(vhi[ii]) : "v"(va), "i"(((ii) >> 2) * 4096 + ((ii) & 3) * 1024), "i"(((ii) >> 2) * 4096 + ((ii) & 3) * 1024 + 512) : "memory")
            B3_KRD(0); B3_KRD(1); B3_KRD(2); B3_KRD(3);
            B3_TRD(0); B3_TRD(1); B3_TRD(2);
            asm volatile("s_waitcnt lgkmcnt(6)" : "+v"(kf[0]), "+v"(kf[1]), "+v"(kf[2]), "+v"(kf[3]), "+v"(kf[4]), "+v"(kf[5]), "+v"(kf[6]), "+v"(kf[7]));
            SBAR();
            f32x16 p0 = __builtin_amdgcn_mfma_f32_32x32x16_bf16(kf[0], qr[0], negm, 0, 0, 0), p1 = __builtin_amdgcn_mfma_f32_32x32x16_bf16(kf[1], qr[0], negm, 0, 0, 0);
#pragma unroll
            for (int d0 = 1; d0 < 4; ++d0) { p0 = __builtin_amdgcn_mfma_f32_32x32x16_bf16(kf[2 * d0], qr[d0], p0, 0, 0, 0); p1 = __builtin_amdgcn_mfma_f32_32x32x16_bf16(kf[2 * d0 + 1], qr[d0], p1, 0, 0, 0); }
            SBAR();
            asm volatile("s_waitcnt lgkmcnt(5)" ::: "memory");
            B3_TRD(3); B3_TRD(4); B3_TRD(5); B3_TRD(6); B3_TRD(7);
            asm volatile("s_waitcnt lgkmcnt(7)" ::: "memory");
            B3_VRD(0); B3_VRD(1); B3_VRD(2); B3_VRD(3);
            asm volatile("s_waitcnt lgkmcnt(8)" : "+v"(tv0[0]), "+v"(tv0[1]), "+v"(tv0[2]), "+v"(tv0[3]), "+v"(tv0[4]), "+v"(tv0[5]), "+v"(tv0[6]), "+v"(tv0[7]),
                                                  "+v"(tv1[0]), "+v"(tv1[1]), "+v"(tv1[2]), "+v"(tv1[3]), "+v"(tv1[4]), "+v"(tv1[5]), "+v"(tv1[6]), "+v"(tv1[7]));
            SBAR();
            float sacc = 0.f;
#pragma unroll
            for (int r = 0; r < 16; ++r) { const int j2 = (r >> 2) * 2 + ((r & 3) >> 1), e = r & 1;
                p0[r] = __builtin_amdgcn_exp2f(p0[r] + tv0[j2][e]); p1[r] = __builtin_amdgcn_exp2f(p1[r] + tv1[j2][e]); sacc += p0[r]; sacc += p1[r]; }
            l += sacc;
            const u32x4 pw0 = (u32x4){cvtpk_s(p0[0], p0[1]), cvtpk_s(p0[2], p0[3]), cvtpk_s(p0[4], p0[5]), cvtpk_s(p0[6], p0[7])};
            const u32x4 pw1 = (u32x4){cvtpk_s(p0[8], p0[9]), cvtpk_s(p0[10], p0[11]), cvtpk_s(p0[12], p0[13]), cvtpk_s(p0[14], p0[15])};
            const u32x4 pw2 = (u32x4){cvtpk_s(p1[0], p1[1]), cvtpk_s(p1[2], p1[3]), cvtpk_s(p1[4], p1[5]), cvtpk_s(p1[6], p1[7])};
            const u32x4 pw3 = (u32x4){cvtpk_s(p1[8], p1[9]), cvtpk_s(p1[10], p1[11]), cvtpk_s(p1[12], p1[13]), cvtpk_s(p1[14], p1[15])};
            SBAR();
            asm volatile("s_waitcnt lgkmcnt(0)" : "+v"(vlo[0]), "+v"(vlo[1]), "+v"(vlo[2]), "+v"(vlo[3]), "+v"(vhi[0]), "+v"(vhi[1]), "+v"(vhi[2]), "+v"(vhi[3]));
            B3_VRD(4); B3_VRD(5); B3_VRD(6); B3_VRD(7);
            SBAR();
#define B3_VF(ii) (bf16x8){vlo[ii][0], vlo[ii][1], vlo[ii][2], vlo[ii][3], vhi[ii][0], vhi[ii][1], vhi[ii][2], vhi[ii][3]}
            o[0] = __builtin_amdgcn_mfma_f32_32x32x16_bf16(__builtin_bit_cast(bf16x8, pw0), B3_VF(0), o[0], 0, 0, 0);
            o[0] = __builtin_amdgcn_mfma_f32_32x32x16_bf16(__builtin_bit_cast(bf16x8, pw1), B3_VF(1), o[0], 0, 0, 0);
            o[0] = __builtin_amdgcn_mfma_f32_32x32x16_bf16(__builtin_bit_cast(bf16x8, pw2), B3_VF(2), o[0], 0, 0, 0);
            o[0] = __builtin_amdgcn_mfma_f32_32x32x16_bf16(__builtin_bit_cast(bf16x8, pw3), B3_VF(3), o[0], 0, 0, 0);
            SBAR();
            asm volatile("s_waitcnt lgkmcnt(0)" : "+v"(vlo[4]), "+v"(vlo[5]), "+v"(vlo[6]), "+v"(vlo[7]), "+v"(vhi[4]), "+v"(vhi[5]), "+v"(vhi[6]), "+v"(vhi[7]));
            SBAR();
            o[1] = __builtin_amdgcn_mfma_f32_32x32x16_bf16(__builtin_bit_cast(bf16x8, pw0), B3_VF(4), o[1], 0, 0, 0);
            o[1] = __builtin_amdgcn_mfma_f32_32x32x16_bf16(__builtin_bit_cast(bf16x8, pw1), B3_VF(5), o[1], 0, 0, 0);
            o[1] = __builtin_amdgcn_mfma_f32_32x32x16_bf16(__builtin_bit_cast(bf16x8, pw2), B3_VF(6), o[1], 0, 0, 0);
            o[1] = __builtin_amdgcn_mfma_f32_32x32x16_bf16(__builtin_bit_cast(bf16x8, pw3), B3_VF(7), o[1], 0, 0, 0);
            SBAR();
#undef B3_TR1
#undef B3_KRD
#undef B3_TRD
#undef B3_VRD
#undef B3_VF
        }
    } }
    asm volatile("s_waitcnt lgkmcnt(0)\n\ts_barrier" ::: "memory");
    mrow_out = mrow; l_out = l;
}
constexpr int L_DT = L_OST + 8 * SLOTB;
static_assert(L_DT + 15 * 128 * 4 <= L_WS, "D table");
template <class KV>
__device__ __forceinline__ void flash_core_d(LAS unsigned char* shm, const bf16_t* qptr, const KV& kv, int NT, int t_first, int t_last, int dr0, int c, float kbound, float badd,
                                             const float* rpb, f32x16 (&o)[2], const int tid) {
    const int lane = tid & 63, r32 = lane & 31, hi = lane >> 5; const int wid = __builtin_amdgcn_readfirstlane(tid >> 6);
    const unsigned lds0 = (unsigned)(uintptr_t)shm;
    LAS float* wsf = (LAS float*)(shm + L_WS) + wid * 64;
    const unsigned kdst = lds0 + L_K + wid * 1024, vdst = lds0 + L_V + wid * 1024;
    const int vrow_j = 16 * (wid & 3) + (lane >> 2), vcol = (wid >> 2) * 32 + (lane & 3) * 8;
    const unsigned koffv = (unsigned)(kv.rmul() * lane * INW + wid * 8) * 2u, voffv = (unsigned)(kv.rmul() * vrow_j * INW + vcol) * 2u;
#define FD_DMA(t, slot) do { glds16s(kv.tk(t), koffv, (unsigned)__builtin_amdgcn_readfirstlane(kdst + (slot) * SLOTB)); \
                             glds16s(kv.tv(t), voffv, (unsigned)__builtin_amdgcn_readfirstlane(vdst + (slot) * SLOTB)); } while (0)
    FD_DMA(0, 0); FD_DMA(1, 1);
    const float rv = (tid < 465) ? rpb[tid] : 0.f;
    bf16x8 qr[4];
#pragma unroll
    for (int d0 = 0; d0 < 4; ++d0) qr[d0] = *(const bf16x8*)(qptr + d0 * 16 + hi * 8);
    float q2 = 0.f;
#pragma unroll
    for (int d0 = 0; d0 < 4; ++d0)
#pragma unroll
        for (int e = 0; e < 8; ++e) { const float x = __builtin_bit_cast(float, (unsigned)(unsigned short)qr[d0][e] << 16); q2 += x * x; }
    { auto rr = __builtin_amdgcn_permlane32_swap(__float_as_uint(q2), __float_as_uint(q2), false, false); q2 = __uint_as_float(rr[0]) + __uint_as_float(rr[1]); }
    const float mrow = sqrtf(q2) * kbound + badd;
    { LAS float* raw = (LAS float*)(shm + L_TAB); LAS float* dt = (LAS float*)(shm + L_DT);
      if (tid < 465) raw[tid] = rv * 1.4426950408889634f;
      asm volatile("s_waitcnt lgkmcnt(0)\n\ts_barrier" ::: "memory");
#pragma unroll
      for (int j = 0; j < 4; ++j) { const int i = tid + 512 * j; if (i < 15 * 128) { const int dr = i >> 7, dc = (i & 127) - 64; dt[i] = (dc >= -15 && dc <= 15) ? raw[dr * 31 + dc + 15] : 0.f; } } }
    int cs = c - 8; if (cs < 0) cs = 0; if (cs > 48) cs = 48;
    f32x16 cm0, cm1;
#pragma unroll
    for (int r = 0; r < 16; ++r) { const int kc = (r & 3) + 8 * (r >> 2) + 4 * hi;
        cm0[r] = ((unsigned)(kc - cs) < 16u) ? -mrow : -INFINITY; cm1[r] = ((unsigned)(kc + 32 - cs) < 16u) ? -mrow : -INFINITY; }
    asm volatile("" : "+v"(cm0), "+v"(cm1));
    float l = 0.f; o[0] = f32x16{}; o[1] = f32x16{};
    const unsigned kbase = lds0 + L_K + hi * 1024 + r32 * 16;
    const unsigned vbase = lds0 + L_V + ((lane >> 4) & 1) * 32 + (lane & 3) * 8 + (4 * hi + ((lane & 15) >> 2)) * 64;
    const unsigned tbase = lds0 + L_DT + 4u * (unsigned)(64 - c + 4 * hi);
#define B3_KRD(j) asm volatile("ds_read_b128 %0, %2 offset:%c3\n\tds_read_b128 %1, %2 offset:%c4" : "=&v"(kf[2 * (j)]), "=&v"(kf[2 * (j) + 1]) : "v"(ka), "i"((j) * 2048), "i"((j) * 2048 + 512) : "memory")
#define B3_TR1(dst, off) asm volatile("ds_read2_b32 %0, %1 offset0:%c2 offset1:%c3" : "=&v"(dst) : "v"(ta), "i"(off), "i"((off) + 1) : "memory")
#define B3_T0(j2) B3_TR1(tv0[j2], 8 * ((j2) >> 1) + 2 * ((j2) & 1))
#define B3_T1(j2) B3_TR1(tv1[j2], 8 * ((j2) >> 1) + 2 * ((j2) & 1) + 32)
#define B3_VRD(ii) asm volatile("ds_read_b64_tr_b16 %0, %2 offset:%c3\n\tds_read_b64_tr_b16 %1, %2 offset:%c4" : "=&v"(vlo[ii]), "=&v"(vhi[ii]) : "v"(va), "i"(((ii) >> 2) * 4096 + ((ii) & 3) * 1024), "i"(((ii) >> 2) * 4096 + ((ii) & 3) * 1024 + 512) : "memory")
#define B3_VF(ii) (bf16x8){vlo[ii][0], vlo[ii][1], vlo[ii][2], vlo[ii][3], vhi[ii][0], vhi[ii][1], vhi[ii][2], vhi[ii][3]}
#define B3_PV(dd, pw, ii) o[dd] = __builtin_amdgcn_mfma_f32_32x32x16_bf16(__builtin_bit_cast(bf16x8, pw), B3_VF(ii), o[dd], 0, 0, 0)
#define D_TILE(LEFT) do { \
            const unsigned ka = kbase + (unsigned)slot * SLOTB, va = vbase + (unsigned)slot * SLOTB, ta = tbase + 512u * (unsigned)(dr0 + t); \
            bf16x8 kf[8]; f32x2 tv0[8], tv1[8]; s16x4 vlo[8], vhi[8]; \
            B3_KRD(0); B3_KRD(1); B3_KRD(2); B3_KRD(3);                                          \
            if (LEFT) { B3_T0(0); B3_T0(1); B3_T0(2); B3_T0(3); B3_T0(4); B3_T0(5); }            \
            else      { B3_T1(0); B3_T1(1); B3_T1(2); B3_T1(3); B3_T1(4); B3_T1(5); } \
            asm volatile("s_waitcnt lgkmcnt(6)" : "+v"(kf[0]), "+v"(kf[1]), "+v"(kf[2]), "+v"(kf[3]), "+v"(kf[4]), "+v"(kf[5]), "+v"(kf[6]), "+v"(kf[7])); \
            SBAR(); \
            f32x16 p0 = __builtin_amdgcn_mfma_f32_32x32x16_bf16(kf[0], qr[0], cm0, 0, 0, 0), p1 = __builtin_amdgcn_mfma_f32_32x32x16_bf16(kf[1], qr[0], cm1, 0, 0, 0); \
            _Pragma("unroll") for (int d0 = 1; d0 < 4; ++d0) { p0 = __builtin_amdgcn_mfma_f32_32x32x16_bf16(kf[2 * d0], qr[d0], p0, 0, 0, 0); p1 = __builtin_amdgcn_mfma_f32_32x32x16_bf16(kf[2 * d0 + 1], qr[d0], p1, 0, 0, 0); } \
            SBAR(); \
            asm volatile("s_waitcnt lgkmcnt(5)" ::: "memory");                                    \
            if (LEFT) { B3_T0(6); B3_T0(7); B3_T1(0); B3_T1(1); B3_VRD(0); B3_VRD(1); B3_VRD(2); }     \
            else      { B3_T1(6); B3_T1(7); B3_T0(6); B3_T0(7); B3_VRD(1); B3_VRD(2); B3_VRD(3); } \
            if (LEFT) asm volatile("s_waitcnt lgkmcnt(6)" : "+v"(tv0[0]), "+v"(tv0[1]), "+v"(tv0[2]), "+v"(tv0[3]), "+v"(tv0[4]), "+v"(tv0[5]), "+v"(tv0[6]), "+v"(tv0[7]), "+v"(tv1[0]), "+v"(tv1[1])); \
            else      asm volatile("s_waitcnt lgkmcnt(6)" : "+v"(tv1[0]), "+v"(tv1[1]), "+v"(tv1[2]), "+v"(tv1[3]), "+v"(tv1[4]), "+v"(tv1[5]), "+v"(tv1[6]), "+v"(tv1[7]), "+v"(tv0[6]), "+v"(tv0[7])); \
            SBAR(); \
            float sacc = 0.f; u32x4 pw0, pw1, pw2, pw3; \
            if (LEFT) { \
                _Pragma("unroll") for (int r = 0; r < 16; ++r) { const int j2 = (r >> 2) * 2 + ((r & 3) >> 1), e = r & 1; p0[r] = __builtin_amdgcn_exp2f(p0[r] + tv0[j2][e]); sacc += p0[r]; } \
                _Pragma("unroll") for (int r = 0; r < 4; ++r) { const int j2 = (r & 3) >> 1, e = r & 1; p1[r] = __builtin_amdgcn_exp2f(p1[r] + tv1[j2][e]); sacc += p1[r]; } \
                pw0 = (u32x4){cvtpk_s(p0[0], p0[1]), cvtpk_s(p0[2], p0[3]), cvtpk_s(p0[4], p0[5]), cvtpk_s(p0[6], p0[7])}; \
                pw1 = (u32x4){cvtpk_s(p0[8], p0[9]), cvtpk_s(p0[10], p0[11]), cvtpk_s(p0[12], p0[13]), cvtpk_s(p0[14], p0[15])}; \
                pw2 = (u32x4){cvtpk_s(p1[0], p1[1]), cvtpk_s(p1[2], p1[3]), 0u, 0u}; pw3 = pw2; \
            } else { \
                _Pragma("unroll") for (int r = 0; r < 16; ++r) { const int j2 = (r >> 2) * 2 + ((r & 3) >> 1), e = r & 1; p1[r] = __builtin_amdgcn_exp2f(p1[r] + tv1[j2][e]); sacc += p1[r]; } \
                _Pragma("unroll") for (int r = 12; r < 16; ++r) { const int j2 = 6 + ((r & 3) >> 1), e = r & 1; p0[r] = __builtin_amdgcn_exp2f(p0[r] + tv0[j2][e]); sacc += p0[r]; } \
                pw1 = (u32x4){0u, 0u, cvtpk_s(p0[12], p0[13]), cvtpk_s(p0[14], p0[15])}; pw0 = pw1; \
                pw2 = (u32x4){cvtpk_s(p1[0], p1[1]), cvtpk_s(p1[2], p1[3]), cvtpk_s(p1[4], p1[5]), cvtpk_s(p1[6], p1[7])}; \
                pw3 = (u32x4){cvtpk_s(p1[8], p1[9]), cvtpk_s(p1[10], p1[11]), cvtpk_s(p1[12], p1[13]), cvtpk_s(p1[14], p1[15])}; \
            } \
            l += sacc; \
            SBAR(); \
            if (LEFT) { asm volatile("s_waitcnt lgkmcnt(0)" : "+v"(vlo[0]), "+v"(vlo[1]), "+v"(vlo[2]), "+v"(vhi[0]), "+v"(vhi[1]), "+v"(vhi[2])); \
                        B3_VRD(4); B3_VRD(5); B3_VRD(6); SBAR(); \
                        B3_PV(0, pw0, 0); B3_PV(0, pw1, 1); B3_PV(0, pw2, 2); SBAR(); \
                        asm volatile("s_waitcnt lgkmcnt(0)" : "+v"(vlo[4]), "+v"(vlo[5]), "+v"(vlo[6]), "+v"(vhi[4]), "+v"(vhi[5]), "+v"(vhi[6])); SBAR(); \
                        B3_PV(1, pw0, 4); B3_PV(1, pw1, 5); B3_PV(1, pw2, 6); SBAR(); } \
            else      { asm volatile("s_waitcnt lgkmcnt(0)" : "+v"(vlo[1]), "+v"(vlo[2]), "+v"(vlo[3]), "+v"(vhi[1]), "+v"(vhi[2]), "+v"(vhi[3])); \
                        B3_VRD(5); B3_VRD(6); B3_VRD(7); SBAR(); \
                        B3_PV(0, pw1, 1); B3_PV(0, pw2, 2); B3_PV(0, pw3, 3); SBAR(); \
                        asm volatile("s_waitcnt lgkmcnt(0)" : "+v"(vlo[5]), "+v"(vlo[6]), "+v"(vlo[7]), "+v"(vhi[5]), "+v"(vhi[6]), "+v"(vhi[7])); SBAR(); \
                        B3_PV(1, pw1, 5); B3_PV(1, pw2, 6); B3_PV(1, pw3, 7); SBAR(); } \
        } while (0)
#define D_LOOP(LEFT) do { int slot = 0; \
    for (int t = 0; t < NT; ++t) { \
        if (t + 1 < NT) asm volatile("s_waitcnt vmcnt(2) lgkmcnt(0)\n\ts_barrier" ::: "memory"); else asm volatile("s_waitcnt vmcnt(0) lgkmcnt(0)\n\ts_barrier" ::: "memory"); \
          \
        if (t + 2 < NT) { const int s2 = slot == 0 ? 2 : slot - 1; FD_DMA(t + 2, s2); } \
        if (t >= t_first && t <= t_last) D_TILE(LEFT);             \
        slot = slot == 2 ? 0 : slot + 1; } } while (0)
    if ((wid & 1) == 0) D_LOOP(1); else D_LOOP(0);
#undef D_LOOP
#undef D_TILE
#undef B3_TR1
#undef B3_T0
#undef B3_T1
#undef B3_KRD
#undef B3_VRD
#undef B3_VF
#undef B3_PV
#undef FD_DMA
    asm volatile("s_waitcnt lgkmcnt(0)\n\ts_barrier" ::: "memory");
    { auto rr = __builtin_amdgcn_permlane32_swap(__float_as_uint(l), __float_as_uint(l), false, false); l = __uint_as_float(rr[0]) + __uint_as_float(rr[1]); }
    if (hi == 0) wsf[32 + r32] = l;
    asm volatile("s_waitcnt lgkmcnt(0)" ::: "memory");
#pragma unroll
    for (int r = 0; r < 16; ++r) { const float rl = __builtin_amdgcn_rcpf(wsf[32 + crow(r, hi)]); o[0][r] *= rl; o[1][r] *= rl; }
    asm volatile("s_waitcnt lgkmcnt(0)" ::: "memory");
}
template <class KV, class Hook>
__device__ __forceinline__ void flash_core_dual(LAS unsigned char* shm, const bf16_t* qptr, const KV& kv, int NT, const Hook& hk, f32x16 (&o1)[2], f32x16 (&o2)[2], const int tid) {
    const int lane = tid & 63, r32 = lane & 31, hi = lane >> 5; const int wid = __builtin_amdgcn_readfirstlane(tid >> 6);
    const unsigned lds0 = (unsigned)(uintptr_t)shm;
    LAS float* wsf = (LAS float*)(shm + L_WS) + wid * 64;
    const unsigned kdst = lds0 + L_K + wid * 1024, vdst = lds0 + L_V + wid * 1024;
    const int vrow_j = 16 * (wid & 3) + (lane >> 2), vcol = (wid >> 2) * 32 + (lane & 3) * 8;
#define FA_DMA(t, slot) do { glds16(kv.kptr((t), lane) + wid * 8, (unsigned)__builtin_amdgcn_readfirstlane(kdst + (slot) * SLOTB)); \
                             glds16(kv.vptr((t), vrow_j) + vcol, (unsigned)__builtin_amdgcn_readfirstlane(vdst + (slot) * SLOTB)); } while (0)
    FA_DMA(0, 0);
    bf16x8 qr[4];
#pragma unroll
    for (int d0 = 0; d0 < 4; ++d0) qr[d0] = *(const bf16x8*)(qptr + d0 * 16 + hi * 8);
    asm volatile("" : "+v"(qr[0]), "+v"(qr[1]), "+v"(qr[2]), "+v"(qr[3]));
    float mA = 0.f, lA = 0.f, mB = 0.f, lB = 0.f, curb = 0.f;
    o1[0] = f32x16{}; o1[1] = f32x16{}; o2[0] = f32x16{}; o2[1] = f32x16{}; const f32x16 zero16 = f32x16{};
    bool first = true;
    const int vb0 = (int)(lds0 + L_V) + ((lane >> 4) & 1) * 32 + (lane & 3) * 8 + (4 * hi + ((lane & 15) >> 2)) * 64;
#define FA_MAP(MAP, mh, ll, neg, oo, PW0, PW1, PW2, PW3) do { \
        f32x16 p0, p1; \
        { LAS const unsigned char* kb = shm + L_K + slot * SLOTB + (MAP) * 4096 + hi * 1024 + r32 * 16; \
          const bf16x8 b0 = *(LAS const bf16x8*)(kb), b1 = *(LAS const bf16x8*)(kb + 512), b2 = *(LAS const bf16x8*)(kb + 2048), b3 = *(LAS const bf16x8*)(kb + 2048 + 512); \
          p0 = __builtin_amdgcn_mfma_f32_32x32x16_bf16(b0, qr[2 * (MAP)], zero16, 0, 0, 0); p1 = __builtin_amdgcn_mfma_f32_32x32x16_bf16(b1, qr[2 * (MAP)], zero16, 0, 0, 0); \
          p0 = __builtin_amdgcn_mfma_f32_32x32x16_bf16(b2, qr[2 * (MAP) + 1], p0, 0, 0, 0); p1 = __builtin_amdgcn_mfma_f32_32x32x16_bf16(b3, qr[2 * (MAP) + 1], p1, 0, 0, 0); } \
        hk.apply(p0, p1, t); \
        const float rm = rowmax(p0, p1) + curb - mh; \
        if (first) { mh += rm; \
        } else if (__any(rm > THR)) { const float dl = __builtin_fmaxf(rm, 0.f); mh += dl; \
            const float f = __builtin_amdgcn_exp2f(-dl); ll *= f; if (hi == 0) wsf[r32] = f; \
            asm volatile("s_waitcnt lgkmcnt(0)" ::: "memory"); \
            _Pragma("unroll") for (int r = 0; r < 16; ++r) { const float fr_ = wsf[crow(r, hi)]; oo[0][r] *= fr_; oo[1][r] *= fr_; } \
            asm volatile("s_waitcnt lgkmcnt(0)" ::: "memory"); } \
        float sacc = 0.f, sacc2 = 0.f; const float mref_ = mh - curb; \
        _Pragma("unroll") for (int r = 0; r < 16; ++r) { p0[r] = __builtin_amdgcn_exp2f(p0[r] - mref_); p1[r] = __builtin_amdgcn_exp2f(p1[r] - mref_); sacc += p0[r]; sacc2 += p1[r]; } \
        ll += sacc + sacc2; \
        PW0 = (u32x4){cvtpk_s(p0[0], p0[1]), cvtpk_s(p0[2], p0[3]), cvtpk_s(p0[4], p0[5]), cvtpk_s(p0[6], p0[7])}; \
        PW1 = (u32x4){cvtpk_s(p0[8], p0[9]), cvtpk_s(p0[10], p0[11]), cvtpk_s(p0[12], p0[13]), cvtpk_s(p0[14], p0[15])}; \
        PW2 = (u32x4){cvtpk_s(p1[0], p1[1]), cvtpk_s(p1[2], p1[3]), cvtpk_s(p1[4], p1[5]), cvtpk_s(p1[6], p1[7])}; \
        PW3 = (u32x4){cvtpk_s(p1[8], p1[9]), cvtpk_s(p1[10], p1[11]), cvtpk_s(p1[12], p1[13]), cvtpk_s(p1[14], p1[15])}; \
    } while (0)
    for (int t = 0; t < NT; ++t) {
        const int slot = t & 1;
        if (t + 1 < NT) { FA_DMA(t + 1, slot ^ 1); FA_WAIT_BAR(2); } else { FA_WAIT_BAR(0); }
        curb = hk.cbias(t);
        u32x4 a0, a1, a2, a3, b0_, b1_, b2_, b3_;
        FA_MAP(0, mA, lA, zero16, o1, a0, a1, a2, a3);
        SBAR();
        FA_MAP(1, mB, lB, zero16, o2, b0_, b1_, b2_, b3_);
        first = false;
        SBAR();
        { const int vb = vb0 + slot * SLOTB;
#pragma unroll
          for (int d0 = 0; d0 < 2; ++d0) { s16x4 lo[4], hi_[4];
#pragma unroll
              for (int ks = 0; ks < 4; ++ks) {
                  asm volatile("ds_read_b64_tr_b16 %0,%1 offset:%c2" : "=&v"(lo[ks]) : "v"(vb), "i"(d0 * 4096 + ks * 1024) : "memory");
                  asm volatile("ds_read_b64_tr_b16 %0,%1 offset:%c2" : "=&v"(hi_[ks]) : "v"(vb), "i"(d0 * 4096 + ks * 1024 + 512) : "memory"); }
              asm volatile("s_waitcnt lgkmcnt(0)" ::: "memory"); SBAR();
#define FA_PK(k) (bf16x8){lo[k][0], lo[k][1], lo[k][2], lo[k][3], hi_[k][0], hi_[k][1], hi_[k][2], hi_[k][3]}
              o1[d0] = __builtin_amdgcn_mfma_f32_32x32x16_bf16(__builtin_bit_cast(bf16x8, a0), FA_PK(0), o1[d0], 0, 0, 0);
              o2[d0] = __builtin_amdgcn_mfma_f32_32x32x16_bf16(__builtin_bit_cast(bf16x8, b0_), FA_PK(0), o2[d0], 0, 0, 0);
              o1[d0] = __builtin_amdgcn_mfma_f32_32x32x16_bf16(__builtin_bit_cast(bf16x8, a1), FA_PK(1), o1[d0], 0, 0, 0);
              o2[d0] = __builtin_amdgcn_mfma_f32_32x32x16_bf16(__builtin_bit_cast(bf16x8, b1_), FA_PK(1), o2[d0], 0, 0, 0);
              o1[d0] = __builtin_amdgcn_mfma_f32_32x32x16_bf16(__builtin_bit_cast(bf16x8, a2), FA_PK(2), o1[d0], 0, 0, 0);
              o2[d0] = __builtin_amdgcn_mfma_f32_32x32x16_bf16(__builtin_bit_cast(bf16x8, b2_), FA_PK(2), o2[d0], 0, 0, 0);
              o1[d0] = __builtin_amdgcn_mfma_f32_32x32x16_bf16(__builtin_bit_cast(bf16x8, a3), FA_PK(3), o1[d0], 0, 0, 0);
              o2[d0] = __builtin_amdgcn_mfma_f32_32x32x16_bf16(__builtin_bit_cast(bf16x8, b3_), FA_PK(3), o2[d0], 0, 0, 0);
#undef FA_PK
          } }
        asm volatile("s_waitcnt lgkmcnt(0)\n\ts_barrier" ::: "memory");
    }
#undef FA_DMA
#undef FA_MAP
    { auto rr = __builtin_amdgcn_permlane32_swap(__float_as_uint(lA), __float_as_uint(lA), false, false); lA = __uint_as_float(rr[0]) + __uint_as_float(rr[1]); }
    { auto rr = __builtin_amdgcn_permlane32_swap(__float_as_uint(lB), __float_as_uint(lB), false, false); lB = __uint_as_float(rr[0]) + __uint_as_float(rr[1]); }
    if (hi == 0) { wsf[r32] = lA; wsf[32 + r32] = lB; }
    asm volatile("s_waitcnt lgkmcnt(0)" ::: "memory");
#pragma unroll
    for (int r = 0; r < 16; ++r) { const float ra = __builtin_amdgcn_rcpf(wsf[crow(r, hi)]), rb = __builtin_amdgcn_rcpf(wsf[32 + crow(r, hi)]); o1[0][r] *= ra; o1[1][r] *= ra; o2[0][r] *= rb; o2[1][r] *= rb; }
}
template <class KV, class Hook>
__device__ __forceinline__ void flash_core_dual_sp(LAS unsigned char* shm, const bf16_t* qptr, const KV& kv, int NT, const Hook& hk, f32x16 (&o1)[2], f32x16 (&o2)[2], const int tid) {
    const int lane = tid & 63, r32 = lane & 31, hi = lane >> 5; const int wid = __builtin_amdgcn_readfirstlane(tid >> 6);
    const unsigned lds0 = (unsigned)(uintptr_t)shm;
    LAS float* wsf = (LAS float*)(shm + L_WS) + wid * 64;
    const unsigned kdst = lds0 + L_K + wid * 1024, vdst = lds0 + L_V + wid * 1024;
    const int vrow_j = 16 * (wid & 3) + (lane >> 2), vcol = (wid >> 2) * 32 + (lane & 3) * 8;
#define FA_DMAK(t) glds16(kv.kptr((t), lane) + wid * 8, (unsigned)__builtin_amdgcn_readfirstlane(kdst + ((t) & 1) * SLOTB))
#define FA_DMAV(t) glds16(kv.vptr((t), vrow_j) + vcol, (unsigned)__builtin_amdgcn_readfirstlane(vdst + ((t) & 1) * SLOTB))
    FA_DMAK(0); FA_DMAV(0); if (NT > 1) FA_DMAK(1);
    bf16x8 qr[4];
#pragma unroll
    for (int d0 = 0; d0 < 4; ++d0) qr[d0] = *(const bf16x8*)(qptr + d0 * 16 + hi * 8);
    asm volatile("" : "+v"(qr[0]), "+v"(qr[1]), "+v"(qr[2]), "+v"(qr[3]));
    LAS bf16x8* qst = (LAS bf16x8*)(shm + L_QST) + wid * 256 + lane;
    qst[0] = qr[0]; qst[64] = qr[1]; qst[128] = qr[2]; qst[192] = qr[3];
    float mA = 0.f, lA = 0.f, mB = 0.f, lB = 0.f;
    o1[0] = f32x16{}; o1[1] = f32x16{}; o2[0] = f32x16{}; o2[1] = f32x16{}; const f32x16 zero16 = f32x16{};
    const int vb0 = (int)(lds0 + L_V) + ((lane >> 4) & 1) * 32 + (lane & 3) * 8 + (4 * hi + ((lane & 15) >> 2)) * 64;
    bf16x8 kfA[4], kfB[4]; f32x16 pA0, pA1, pB0, pB1;
#define FA_KLOADA(tt) do { LAS const unsigned char* kb_ = shm + L_K + ((tt) & 1) * SLOTB + hi * 1024 + r32 * 16; \
        kfA[0] = *(LAS const bf16x8*)(kb_); kfA[1] = *(LAS const bf16x8*)(kb_ + 512); kfA[2] = *(LAS const bf16x8*)(kb_ + 2048); kfA[3] = *(LAS const bf16x8*)(kb_ + 2560); } while (0)
#define FA_KLOADB(tt) do { LAS const unsigned char* kb_ = shm + L_K + ((tt) & 1) * SLOTB + hi * 1024 + r32 * 16; \
        kfB[0] = *(LAS const bf16x8*)(kb_ + 4096); kfB[1] = *(LAS const bf16x8*)(kb_ + 4608); kfB[2] = *(LAS const bf16x8*)(kb_ + 6144); kfB[3] = *(LAS const bf16x8*)(kb_ + 6656); } while (0)
#define FA_QKA() do { const bf16x8 q0_ = qst[0], q1_ = qst[64]; pA0 = __builtin_amdgcn_mfma_f32_32x32x16_bf16(kfA[0], q0_, zero16, 0, 0, 0); pA1 = __builtin_amdgcn_mfma_f32_32x32x16_bf16(kfA[1], q0_, zero16, 0, 0, 0); \
        pA0 = __builtin_amdgcn_mfma_f32_32x32x16_bf16(kfA[2], q1_, pA0, 0, 0, 0); pA1 = __builtin_amdgcn_mfma_f32_32x32x16_bf16(kfA[3], q1_, pA1, 0, 0, 0); } while (0)
#define FA_QKB() do { const bf16x8 q2_ = qst[128], q3_ = qst[192]; pB0 = __builtin_amdgcn_mfma_f32_32x32x16_bf16(kfB[0], q2_, zero16, 0, 0, 0); pB1 = __builtin_amdgcn_mfma_f32_32x32x16_bf16(kfB[1], q2_, zero16, 0, 0, 0); \
        pB0 = __builtin_amdgcn_mfma_f32_32x32x16_bf16(kfB[2], q3_, pB0, 0, 0, 0); pB1 = __builtin_amdgcn_mfma_f32_32x32x16_bf16(kfB[3], q3_, pB1, 0, 0, 0); } while (0)
#define FA_SM(p0, p1, mh, ll, oo, PW0, PW1, PW2, PW3) do { \
        hk.apply(p0, p1, t); \
        const float rm = rowmax(p0, p1) + curb - mh; \
        if (__any(rm > THR)) { const float dl = __builtin_fmaxf(rm, 0.f); mh += dl; \
            const float f = __builtin_amdgcn_exp2f(-dl); ll *= f; if (hi == 0) wsf[r32] = f; \
            asm volatile("s_waitcnt lgkmcnt(0)" ::: "memory"); \
            _Pragma("unroll") for (int r = 0; r < 16; ++r) { const float fr_ = wsf[crow(r, hi)]; oo[0][r] *= fr_; oo[1][r] *= fr_; } \
            asm volatile("s_waitcnt lgkmcnt(0)" ::: "memory"); } \
        float sacc = 0.f, sacc2 = 0.f; const float mref_ = mh - curb; \
        _Pragma("unroll") for (int r = 0; r < 16; ++r) { p0[r] = __builtin_amdgcn_exp2f(p0[r] - mref_); p1[r] = __builtin_amdgcn_exp2f(p1[r] - mref_); sacc += p0[r]; sacc2 += p1[r]; } \
        ll += sacc + sacc2; \
        PW0 = (u32x4){cvtpk_s(p0[0], p0[1]), cvtpk_s(p0[2], p0[3]), cvtpk_s(p0[4], p0[5]), cvtpk_s(p0[6], p0[7])}; \
        PW1 = (u32x4){cvtpk_s(p0[8], p0[9]), cvtpk_s(p0[10], p0[11]), cvtpk_s(p0[12], p0[13]), cvtpk_s(p0[14], p0[15])}; \
        PW2 = (u32x4){cvtpk_s(p1[0], p1[1]), cvtpk_s(p1[2], p1[3]), cvtpk_s(p1[4], p1[5]), cvtpk_s(p1[6], p1[7])}; \
        PW3 = (u32x4){cvtpk_s(p1[8], p1[9]), cvtpk_s(p1[10], p1[11]), cvtpk_s(p1[12], p1[13]), cvtpk_s(p1[14], p1[15])}; \
    } while (0)
    FA_WAIT_BAR(0);
    FA_KLOADA(0); FA_KLOADB(0);
    FA_QKB();
    { const float cb0 = hk.cbias(0); mB = rowmax(pB0, pB1) + cb0; FA_QKA(); mA = rowmax(pA0, pA1) + cb0; }
#define FA_VTR(off) __builtin_bit_cast(s16x4, __builtin_amdgcn_ds_read_tr16_b64_v4i16((LAS v4i16_t*)(vp_ + (off))))
#define FA_PVM(oo, w0, w1, w2, w3) do { LAS const unsigned char* vp_ = shm + L_V + (t & 1) * SLOTB + vboff; \
        _Pragma("unroll") for (int d0 = 0; d0 < 2; ++d0) { s16x4 lo[4], hi_[4]; \
            _Pragma("unroll") for (int ks = 0; ks < 4; ++ks) { lo[ks] = FA_VTR(d0 * 4096 + ks * 1024); hi_[ks] = FA_VTR(d0 * 4096 + ks * 1024 + 512); } \
            oo[d0] = __builtin_amdgcn_mfma_f32_32x32x16_bf16(__builtin_bit_cast(bf16x8, w0), (bf16x8){lo[0][0], lo[0][1], lo[0][2], lo[0][3], hi_[0][0], hi_[0][1], hi_[0][2], hi_[0][3]}, oo[d0], 0, 0, 0); \
            oo[d0] = __builtin_amdgcn_mfma_f32_32x32x16_bf16(__builtin_bit_cast(bf16x8, w1), (bf16x8){lo[1][0], lo[1][1], lo[1][2], lo[1][3], hi_[1][0], hi_[1][1], hi_[1][2], hi_[1][3]}, oo[d0], 0, 0, 0); \
            oo[d0] = __builtin_amdgcn_mfma_f32_32x32x16_bf16(__builtin_bit_cast(bf16x8, w2), (bf16x8){lo[2][0], lo[2][1], lo[2][2], lo[2][3], hi_[2][0], hi_[2][1], hi_[2][2], hi_[2][3]}, oo[d0], 0, 0, 0); \
            oo[d0] = __builtin_amdgcn_mfma_f32_32x32x16_bf16(__builtin_bit_cast(bf16x8, w3), (bf16x8){lo[3][0], lo[3][1], lo[3][2], lo[3][3], hi_[3][0], hi_[3][1], hi_[3][2], hi_[3][3]}, oo[d0], 0, 0, 0); } } while (0)
    const int vboff = ((lane >> 4) & 1) * 32 + (lane & 3) * 8 + (4 * hi + ((lane & 15) >> 2)) * 64;
    for (int t = 0; t < NT; ++t) {
        if (t + 2 < NT) FA_DMAK(t + 2);
        if (t + 1 < NT) FA_DMAV(t + 1);
        const float curb = hk.cbias(t);
        FA_QKB();
        SBAR();
        if (t + 1 < NT) { FA_KLOADA(t + 1); FA_KLOADB(t + 1); }
        { u32x4 a0, a1, a2, a3;
          FA_SM(pA0, pA1, mA, lA, o1, a0, a1, a2, a3);
          SBAR();
          FA_PVM(o1, a0, a1, a2, a3); }
        SBAR();
        { u32x4 b0_, b1_, b2_, b3_;
          FA_SM(pB0, pB1, mB, lB, o2, b0_, b1_, b2_, b3_);
          SBAR();
          if (t + 1 < NT) FA_QKA();
          SBAR();
          FA_PVM(o2, b0_, b1_, b2_, b3_); }
        FA_WAIT_BAR(0);
    }
#undef FA_PVM
#undef FA_VTR
#undef FA_DMAK
#undef FA_DMAV
#undef FA_KLOADA
#undef FA_KLOADB
#undef FA_QKA
#undef FA_QKB
#undef FA_SM
    { auto rr = __builtin_amdgcn_permlane32_swap(__float_as_uint(lA), __float_as_uint(lA), false, false); lA = __uint_as_float(rr[0]) + __uint_as_float(rr[1]); }
    { auto rr = __builtin_amdgcn_permlane32_swap(__float_as_uint(lB), __float_as_uint(lB), false, false); lB = __uint_as_float(rr[0]) + __uint_as_float(rr[1]); }
    if (hi == 0) { wsf[r32] = lA; wsf[32 + r32] = lB; }
    asm volatile("s_waitcnt lgkmcnt(0)" ::: "memory");
#pragma unroll
    for (int r = 0; r < 16; ++r) { const float ra = __builtin_amdgcn_rcpf(wsf[crow(r, hi)]), rb = __builtin_amdgcn_rcpf(wsf[32 + crow(r, hi)]); o1[0][r] *= ra; o1[1][r] *= ra; o2[0][r] *= rb; o2[1][r] *= rb; }
}
__device__ __forceinline__ void stage_o(LAS float* stg, const f32x16 (&o)[2], int r32, int hi) {
#pragma unroll
    for (int r = 0; r < 16; ++r) { const int orow = crow(r, hi); stg[orow * 64 + r32] = o[0][r]; stg[orow * 64 + 32 + r32] = o[1][r]; }
    asm volatile("s_waitcnt lgkmcnt(0)" ::: "memory");
}
__device__ __forceinline__ float silu(float g) { return g * __builtin_amdgcn_rcpf(1.f + __builtin_amdgcn_exp2f(-1.4426950408889634f * g)); }
}

#undef SBAR
namespace tb {
using bf16=unsigned short;
constexpr int D=64,DM=INW;
constexpr int NW=8,QBLK=32,QB=QBLK*NW,KVBLK=64;
__device__ __forceinline__ int crow(int r,int hi){return (r&3)+8*(r>>2)+4*hi;}
#define SBAR() __builtin_amdgcn_sched_barrier(0)
constexpr int NSLOT=3, SLOTB=8192;
constexpr int LDS_K=0, LDS_V=NSLOT*SLOTB, LDS_WS=2*NSLOT*SLOTB, LDS_OST=LDS_WS+NW*64*4, LDS_BYTES=LDS_OST+NW*4096;
constexpr float C2=0.125f*1.4426950408889634f;
__device__ __forceinline__ void glds16(const void*gsrc,unsigned lds_dst){unsigned keep;
  asm volatile("s_mov_b32 %0, m0\n\ts_mov_b32 m0, %2\n\ts_nop 0\n\tglobal_load_lds_dwordx4 %1, off\n\ts_mov_b32 m0, %0":"=&s"(keep):"v"(gsrc),"s"(lds_dst):"memory");}
__device__ __forceinline__ void glds16s(const void*sbase,unsigned voff,unsigned lds_dst){unsigned keep;
  asm volatile("s_mov_b32 %0, m0\n\ts_mov_b32 m0, %3\n\ts_nop 0\n\tglobal_load_lds_dwordx4 %1, %2\n\ts_mov_b32 m0, %0":"=&s"(keep):"v"(voff),"s"(sbase),"s"(lds_dst):"memory");}
__device__ __forceinline__ float max3f(float a,float b,float c){float r;asm("v_max3_f32 %0, %1, %2, %3":"=v"(r):"v"(a),"v"(b),"v"(c));return r;}
__device__ __forceinline__ float max2f(float a,float b){float r;asm("v_max_f32_e32 %0, %1, %2":"=v"(r):"v"(a),"v"(b));return r;}
__device__ __forceinline__ float fadd_s(float a,float b){float r;asm("v_add_f32_e32 %0, %1, %2":"=v"(r):"v"(a),"v"(b));return r;}
__device__ __forceinline__ float fsub_s(float a,float b){float r;asm("v_sub_f32_e32 %0, %1, %2":"=v"(r):"v"(a),"v"(b));return r;}
typedef float f32x2_t __attribute__((ext_vector_type(2))); typedef __bf16 bf16x2_t __attribute__((ext_vector_type(2)));
__device__ __forceinline__ unsigned cvtpk_s(float lo,float hi){f32x2_t v={lo,hi};bf16x2_t b=__builtin_convertvector(v,bf16x2_t);return __builtin_bit_cast(unsigned,b);}
#define WAIT_BAR(N) asm volatile("s_waitcnt vmcnt(" #N ") lgkmcnt(0)\n\ts_barrier":::"memory")

__device__ __forceinline__ void qkt(f32x16&p0,f32x16&p1,const char*Kslot,const bf16x8*qr,const f32x16&negm,int r32,int hi){
  const char*kb=Kslot+hi*1024+r32*16;
  #pragma unroll
  for(int d0=0;d0<4;++d0){
    const bf16x8 b0=*reinterpret_cast<const bf16x8*>(kb+d0*2048);
    const bf16x8 b1=*reinterpret_cast<const bf16x8*>(kb+d0*2048+512);
    if(d0==0){p0=__builtin_amdgcn_mfma_f32_32x32x16_bf16(b0,qr[0],negm,0,0,0);p1=__builtin_amdgcn_mfma_f32_32x32x16_bf16(b1,qr[0],negm,0,0,0);}
    else{p0=__builtin_amdgcn_mfma_f32_32x32x16_bf16(b0,qr[d0],p0,0,0,0);p1=__builtin_amdgcn_mfma_f32_32x32x16_bf16(b1,qr[d0],p1,0,0,0);}}
}
typedef __attribute__((address_space(3))) const char* lds_cptr;
__device__ __forceinline__ void kload8(bf16x8*kf,lds_cptr kp){
  kf[0]=*(const __attribute__((address_space(3))) bf16x8*)(kp);      kf[1]=*(const __attribute__((address_space(3))) bf16x8*)(kp+512);
  kf[2]=*(const __attribute__((address_space(3))) bf16x8*)(kp+2048); kf[3]=*(const __attribute__((address_space(3))) bf16x8*)(kp+2560);
  kf[4]=*(const __attribute__((address_space(3))) bf16x8*)(kp+4096); kf[5]=*(const __attribute__((address_space(3))) bf16x8*)(kp+4608);
  kf[6]=*(const __attribute__((address_space(3))) bf16x8*)(kp+6144); kf[7]=*(const __attribute__((address_space(3))) bf16x8*)(kp+6656);
}
__device__ __forceinline__ void kload4(bf16x8*kf,lds_cptr kp){
  kf[0]=*(const __attribute__((address_space(3))) bf16x8*)(kp);      kf[1]=*(const __attribute__((address_space(3))) bf16x8*)(kp+512);
  kf[2]=*(const __attribute__((address_space(3))) bf16x8*)(kp+2048); kf[3]=*(const __attribute__((address_space(3))) bf16x8*)(kp+2560);
}
__device__ __forceinline__ void kload2(bf16x8*kf,lds_cptr kp,int j){ kf[2*j]=*(const __attribute__((address_space(3))) bf16x8*)(kp+j*2048); kf[2*j+1]=*(const __attribute__((address_space(3))) bf16x8*)(kp+j*2048+512); }
__device__ __forceinline__ s16x4 vtr(lds_cptr p){ return __builtin_bit_cast(s16x4,__builtin_amdgcn_ds_read_tr16_b64_v4i16((__attribute__((address_space(3))) v4i16_t*)p)); }
__device__ __forceinline__ float rowmax(const f32x16&p0,const f32x16&p1){
  float a=max3f(p0[0],p0[1],p1[0]),b=max3f(p0[2],p0[3],p1[1]);a=max3f(a,p1[2],p1[3]);
  #pragma unroll
  for(int r=4;r<16;r+=4){a=max3f(a,p0[r],p0[r+1]);b=max3f(b,p0[r+2],p0[r+3]);a=max3f(a,p1[r],p1[r+1]);b=max3f(b,p1[r+2],p1[r+3]);}
  const float m=max2f(a,b);
  auto rr=__builtin_amdgcn_permlane32_swap(__float_as_uint(m),__float_as_uint(m),false,false);
  return max2f(__uint_as_float(rr[0]),__uint_as_float(rr[1]));
}
__device__ __forceinline__ void pv(f32x16*o,int vb,bf16x8 pa0,bf16x8 pa1,bf16x8 pa2,bf16x8 pa3){
  #pragma unroll
  for(int d0=0;d0<2;++d0){s16x4 lo[4],hi[4];
    #pragma unroll
    for(int ks=0;ks<4;++ks){
      asm volatile("ds_read_b64_tr_b16 %0,%1 offset:%c2":"=&v"(lo[ks]):"v"(vb),"i"(d0*4096+ks*1024):"memory");
      asm volatile("ds_read_b64_tr_b16 %0,%1 offset:%c2":"=&v"(hi[ks]):"v"(vb),"i"(d0*4096+ks*1024+512):"memory");}
    asm volatile("s_waitcnt lgkmcnt(0)":::"memory");SBAR();
    #define PK(k) (bf16x8){lo[k][0],lo[k][1],lo[k][2],lo[k][3],hi[k][0],hi[k][1],hi[k][2],hi[k][3]}
    o[d0]=__builtin_amdgcn_mfma_f32_32x32x16_bf16(pa0,PK(0),o[d0],0,0,0);
    o[d0]=__builtin_amdgcn_mfma_f32_32x32x16_bf16(pa1,PK(1),o[d0],0,0,0);
    o[d0]=__builtin_amdgcn_mfma_f32_32x32x16_bf16(pa2,PK(2),o[d0],0,0,0);
    o[d0]=__builtin_amdgcn_mfma_f32_32x32x16_bf16(pa3,PK(3),o[d0],0,0,0);
    #undef PK
  }
}

template<int THRL,int MODE,bool BOUND> __device__ __forceinline__ void attn_unit(const int tid,const bf16*Qw,const bf16*__restrict__ Kh,const bf16*__restrict__ Vh,const int NT,const bf16*Gp,bf16*Ow,char*shm,
                                                                 const int cmap,const __attribute__((address_space(3))) float*tabc,const int qw,const float bl,const float br,const float kbound,const float badd){
  const int lane=tid&63,r32=lane&31,hi=lane>>5; const int wid=__builtin_amdgcn_readfirstlane(tid>>6);
  const unsigned lds0=(unsigned)(uintptr_t)shm;
  float*wsf=(float*)(shm+LDS_WS)+wid*64;
  const unsigned koff=(unsigned)(lane*DM+wid*8)*2u;
  const unsigned voff=(unsigned)((16*(wid&3)+(lane>>2))*DM+(wid>>2)*32+(lane&3)*8)*2u;
  const unsigned kdst=lds0+LDS_K+wid*1024, vdst=lds0+LDS_V+wid*1024;
  #define DMA_K(t,slot) glds16s(Kh+(long)(t)*KVBLK*DM,koff,(unsigned)__builtin_amdgcn_readfirstlane(kdst+(slot)))
  #define DMA_V(t,slot) glds16s(Vh+(long)(t)*KVBLK*DM,voff,(unsigned)__builtin_amdgcn_readfirstlane(vdst+(slot)))
  const int vb0=(int)(lds0+LDS_V)+((lane>>4)&1)*32+(lane&3)*8+(4*hi+((lane&15)>>2))*64;
  const char*Kbase=shm+LDS_K; bf16x8 kf[8];
  const lds_cptr shm3=(lds_cptr)shm; const lds_cptr kp0=shm3+LDS_K+hi*1024+r32*16; const lds_cptr kpLo=kp0+(MODE==1?cmap*4096:0), kpHi=kp0+(MODE==1?(1-cmap)*4096:4096); const lds_cptr vp0=shm3+LDS_V+((lane>>4)&1)*32+(lane&3)*8+(4*hi+((lane&15)>>2))*64;
  DMA_K(0,0);DMA_V(0,0);DMA_K(1,SLOTB);
  bf16x8 qr[4];
  #pragma unroll
  for(int d0=0;d0<4;++d0){ if(MODE==0||d0<2)qr[d0]=*reinterpret_cast<const bf16x8*>(&Qw[(long)r32*DM+d0*16+hi*8]); else qr[d0]=(bf16x8){0,0,0,0,0,0,0,0}; }
  float mrow=0.f;
  if(BOUND){ float q2=0.f;
    #pragma unroll
    for(int d0=0;d0<(MODE==1?2:4);++d0){
      #pragma unroll
      for(int e=0;e<8;++e){ const float x=__builtin_bit_cast(float,(unsigned)(unsigned short)qr[d0][e]<<16); q2+=x*x; } }
    { auto rr=__builtin_amdgcn_permlane32_swap(__float_as_uint(q2),__float_as_uint(q2),false,false); q2=__uint_as_float(rr[0])+__uint_as_float(rr[1]); }
    mrow=sqrtf(q2)*kbound+badd; }
  float mhat=0.f,l_reg=0.f;f32x16 o[2];o[0]=f32x16{};o[1]=f32x16{};f32x16 negm=f32x16{};asm volatile("":"+v"(negm));
  const unsigned blu=__builtin_amdgcn_readfirstlane(__float_as_uint(bl)), bru=__builtin_amdgcn_readfirstlane(__float_as_uint(br)); unsigned curbu=0u; float curb=0.f;
  #define cbias_(t) ((64*(t)+63-qw<=-91)?blu:((64*(t)-qw-31>=91)?bru:0u))
  #define CBSET(t) do{ if(MODE==1){ const unsigned cb_=cbias_(t); if(cb_!=curbu){ curbu=cb_; curb=__uint_as_float(curbu); _Pragma("unroll") for(int r=0;r<16;++r)negm[r]=curb-mhat; asm volatile("":"+v"(negm)); } } }while(0)
  #define BIASHOOK(P0,P1,t) do{ if(MODE==1){ if(64*(t)+63-qw>-91&&64*(t)-qw-31<91){ const __attribute__((address_space(3))) float*tp_=tabc+(320+64*(t)-qw-r32+4*hi); \
      _Pragma("unroll") for(int r=0;r<16;++r){const int kk_=(r&3)+8*(r>>2);P0[r]+=tp_[kk_];P1[r]+=tp_[kk_+32];} } } }while(0)
  #define CMASK(P0,P1,t) BIASHOOK(P0,P1,t)
  bool resc=false;
  #define START(P0,P1) do{ const float rm=BOUND?mrow:rowmax(P0,P1); resc=false; \
    { const float dl=rm; mhat=fadd_s(mhat,dl); \
      _Pragma("unroll") for(int r=0;r<16;++r){P0[r]=fsub_s(P0[r],dl);P1[r]=fsub_s(P1[r],dl);} \
      _Pragma("unroll") for(int r=0;r<16;++r)negm[r]=curb-mhat; asm volatile("":"+v"(negm)); } \
    _Pragma("unroll") for(int r=0;r<16;++r)P0[r]=__builtin_amdgcn_exp2f(P0[r]); }while(0)
  #define RESC() do{ if(resc){ asm volatile("s_waitcnt lgkmcnt(0)":::"memory"); \
      _Pragma("unroll") for(int d_=0;d_<2;++d_) _Pragma("unroll") for(int r=0;r<16;++r)o[d_][r]*=wsf[crow(r,hi)]; } }while(0)
  f32x16 pA0,pA1,pB0,pB1;
  int sl_prev=0,sl_cur=0,sl_next=SLOTB;
  #define ROT() do{sl_prev=sl_cur;sl_cur=sl_next;sl_next=(sl_next==(NSLOT-1)*SLOTB)?0:sl_next+SLOTB;}while(0)
  DMA_K(2,2*SLOTB);
  WAIT_BAR(3);
  if(MODE==1){ curbu=cbias_(0); curb=__uint_as_float(curbu); _Pragma("unroll") for(int r=0;r<16;++r)negm[r]=curb; asm volatile("":"+v"(negm)); }
  kload4(kf,kpLo);if(MODE==0)kload4(kf+4,kpHi);
  pA0=__builtin_amdgcn_mfma_f32_32x32x16_bf16(kf[0],qr[0],negm,0,0,0);pA1=__builtin_amdgcn_mfma_f32_32x32x16_bf16(kf[1],qr[0],negm,0,0,0);
  _Pragma("unroll") for(int d0=1;d0<(MODE==1?2:4);++d0){pA0=__builtin_amdgcn_mfma_f32_32x32x16_bf16(kf[2*d0],qr[d0],pA0,0,0,0);pA1=__builtin_amdgcn_mfma_f32_32x32x16_bf16(kf[2*d0+1],qr[d0],pA1,0,0,0);}
  asm volatile("s_nop 15\n\ts_nop 7":"+v"(pA0),"+v"(pA1));CMASK(pA0,pA1,0);
  START(pA0,pA1);
  _Pragma("unroll") for(int r=0;r<16;++r)pA1[r]=__builtin_amdgcn_exp2f(pA1[r]);
  WAIT_BAR(0);
  DMA_K(3,0);DMA_V(1,SLOTB);
  ROT();
  kload4(kf,kpLo+sl_cur);if(MODE==0)kload4(kf+4,kpHi+sl_cur);
  WAIT_BAR(2);
  s16x4 vlo[8],vhi[8]; u32x4 pw0,pw1,pw2,pw3;
  #define PKW(P,B) cvtpk_s(P[B],P[B+1])
  #define PAF(k) __builtin_bit_cast(bf16x8,pw##k)
  #define VFR(i) (bf16x8){vlo[i][0],vlo[i][1],vlo[i][2],vlo[i][3],vhi[i][0],vhi[i][1],vhi[i][2],vhi[i][3]}
  #define PIN(x) asm volatile("":"+v"(x))
  #define MX3(a,b,c) __builtin_fmaxf(__builtin_fmaxf((a),(b)),(c))
  #define GAPA(MF,A0,A1,A2,A3,W0,W1,PW) do{ MF; sacc+=A0; sacc+=A1; sacc+=A2; sacc+=A3; PIN(sacc); W0; W1; PIN(PW); SBAR(); }while(0)
  #define EX(v) __builtin_amdgcn_exp2f(v)
  #define GAPB(MF,X,B) do{ MF; X[B]=EX(X[B]); X[B+1]=EX(X[B+1]); X[B+2]=EX(X[B+2]); X[B+3]=EX(X[B+3]); PIN(X); SBAR(); }while(0)
  #define VRD(i) do{ vlo[i]=vtr(vp_+(((i)>>2)*4096+((i)&3)*1024)); vhi[i]=vtr(vp_+(((i)>>2)*4096+((i)&3)*1024+512)); }while(0)
  #define KRD(G,j) do{ if(G){ if((j)<2){kload2(kf,kpLo+sl_next,(j));}else if(MODE==0){kload2(kf+4,kpHi+sl_next,(j)-2);} SBAR(); } }while(0)
  #define STEP(C0,C1,P0,P1,t,GK,GV,GL) do{ SBAR(); \
    const lds_cptr vp_=vp0+sl_prev; \
    VRD(0); SBAR(); float sacc=(P0[0]+P0[1]); \
    GAPA(C0=__builtin_amdgcn_mfma_f32_32x32x16_bf16(kf[0],qr[0],negm,0,0,0), P0[2],P0[3],P0[4],P0[5],     pw0[0]=PKW(P0,0), pw0[1]=PKW(P0,2), pw0); \
    VRD(4); SBAR(); GAPA(C1=__builtin_amdgcn_mfma_f32_32x32x16_bf16(kf[1],qr[0],negm,0,0,0), P0[6],P0[7],P0[8],P0[9],     pw0[2]=PKW(P0,4), pw0[3]=PKW(P0,6), pw0); \
    VRD(1); SBAR(); GAPA(C0=__builtin_amdgcn_mfma_f32_32x32x16_bf16(kf[2],qr[1],C0,0,0,0),   P0[10],P0[11],P0[12],P0[13], pw1[0]=PKW(P0,8), pw1[1]=PKW(P0,10), pw1); \
    VRD(5); SBAR(); GAPA(C1=__builtin_amdgcn_mfma_f32_32x32x16_bf16(kf[3],qr[1],C1,0,0,0),   P0[14],P0[15],P1[0],P1[1],   pw1[2]=PKW(P0,12),pw1[3]=PKW(P0,14), pw1); \
    VRD(2); SBAR(); GAPA(if(MODE==0)C0=__builtin_amdgcn_mfma_f32_32x32x16_bf16(kf[4],qr[2],C0,0,0,0),   P1[2],P1[3],P1[4],P1[5],     pw2[0]=PKW(P1,0), pw2[1]=PKW(P1,2), pw2); \
    VRD(6); SBAR(); GAPA(if(MODE==0)C1=__builtin_amdgcn_mfma_f32_32x32x16_bf16(kf[5],qr[2],C1,0,0,0),   P1[6],P1[7],P1[8],P1[9],     pw2[2]=PKW(P1,4), pw2[3]=PKW(P1,6), pw2); \
    VRD(3); SBAR(); GAPA(if(MODE==0)C0=__builtin_amdgcn_mfma_f32_32x32x16_bf16(kf[6],qr[3],C0,0,0,0),   P1[10],P1[11],P1[12],P1[13], pw3[0]=PKW(P1,8), pw3[1]=PKW(P1,10), pw3); \
    VRD(7); SBAR(); GAPA(if(MODE==0)C1=__builtin_amdgcn_mfma_f32_32x32x16_bf16(kf[7],qr[3],C1,0,0,0),   P1[14],P1[15],0.f,0.f,       pw3[2]=PKW(P1,12),pw3[3]=PKW(P1,14), pw3); \
    l_reg+=sacc; \
    if(GK){DMA_K((t)+3,sl_cur);} if(GV){DMA_V((t)+1,sl_next);} \
    CMASK(C0,C1,t); \
    if(!BOUND){ float a=MX3(C0[0],C0[1],C1[0]),b=MX3(C0[2],C0[3],C1[1]); a=MX3(a,C1[2],C1[3]); \
      _Pragma("unroll") for(int r=4;r<16;r+=4){a=MX3(a,C0[r],C0[r+1]);b=MX3(b,C0[r+2],C0[r+3]);a=MX3(a,C1[r],C1[r+1]);b=MX3(b,C1[r+2],C1[r+3]);} \
      float rm=__builtin_fmaxf(a,b); { auto rr=__builtin_amdgcn_permlane32_swap(__float_as_uint(rm),__float_as_uint(rm),false,false); rm=__builtin_fmaxf(__uint_as_float(rr[0]),__uint_as_float(rr[1])); } \
      resc=false; \
      if(__builtin_expect(__any(rm>(float)THRL),0)){ const float dl=__builtin_fmaxf(rm,0.f); mhat+=dl; \
        _Pragma("unroll") for(int r=0;r<16;++r){C0[r]-=dl;C1[r]-=dl;} \
        _Pragma("unroll") for(int r=0;r<16;++r)negm[r]=curb-mhat; asm volatile("":"+v"(negm)); \
        const float f=__builtin_amdgcn_exp2f(-dl); l_reg*=f; if(hi==0)wsf[r32]=f; resc=true; } } \
    SBAR(); \
    GAPB(o[0]=__builtin_amdgcn_mfma_f32_32x32x16_bf16(PAF(0),VFR(0),o[0],0,0,0), C0,0); \
    GAPB(o[1]=__builtin_amdgcn_mfma_f32_32x32x16_bf16(PAF(0),VFR(4),o[1],0,0,0), C0,4); \
    KRD(GL,0); GAPB(o[0]=__builtin_amdgcn_mfma_f32_32x32x16_bf16(PAF(1),VFR(1),o[0],0,0,0), C0,8); \
    KRD(GL,1); GAPB(o[1]=__builtin_amdgcn_mfma_f32_32x32x16_bf16(PAF(1),VFR(5),o[1],0,0,0), C0,12); \
    KRD(GL,2); GAPB(o[0]=__builtin_amdgcn_mfma_f32_32x32x16_bf16(PAF(2),VFR(2),o[0],0,0,0), C1,0); \
    KRD(GL,3); GAPB(o[1]=__builtin_amdgcn_mfma_f32_32x32x16_bf16(PAF(2),VFR(6),o[1],0,0,0), C1,4); \
    GAPB(o[0]=__builtin_amdgcn_mfma_f32_32x32x16_bf16(PAF(3),VFR(3),o[0],0,0,0), C1,8); \
    GAPB(o[1]=__builtin_amdgcn_mfma_f32_32x32x16_bf16(PAF(3),VFR(7),o[1],0,0,0), C1,12); \
    }while(0)
  int t=1;
  #undef CMASK
  #define CMASK(P0,P1,t) BIASHOOK(P0,P1,t)
  for(;t+9<NT;t+=6){
    { constexpr int sl_prev=0,sl_cur=SLOTB,sl_next=2*SLOTB; CBSET(t);   STEP(pB0,pB1,pA0,pA1,t,true,true,true);     WAIT_BAR(2); RESC(); }
    { constexpr int sl_prev=SLOTB,sl_cur=2*SLOTB,sl_next=0; CBSET(t+1); STEP(pA0,pA1,pB0,pB1,t+1,true,true,true);   WAIT_BAR(2); RESC(); }
    { constexpr int sl_prev=2*SLOTB,sl_cur=0,sl_next=SLOTB; CBSET(t+2); STEP(pB0,pB1,pA0,pA1,t+2,true,true,true);   WAIT_BAR(2); RESC(); }
    { constexpr int sl_prev=0,sl_cur=SLOTB,sl_next=2*SLOTB; CBSET(t+3); STEP(pA0,pA1,pB0,pB1,t+3,true,true,true);   WAIT_BAR(2); RESC(); }
    { constexpr int sl_prev=SLOTB,sl_cur=2*SLOTB,sl_next=0; CBSET(t+4); STEP(pB0,pB1,pA0,pA1,t+4,true,true,true);   WAIT_BAR(2); RESC(); }
    { constexpr int sl_prev=2*SLOTB,sl_cur=0,sl_next=SLOTB; CBSET(t+5); STEP(pA0,pA1,pB0,pB1,t+5,true,true,true);   WAIT_BAR(2); RESC(); }
  }
  for(;t+5<NT;t+=2){
    CBSET(t);   STEP(pB0,pB1,pA0,pA1,t,true,true,true);     WAIT_BAR(2); RESC(); ROT();
    CBSET(t+1); STEP(pA0,pA1,pB0,pB1,t+1,true,true,true);   WAIT_BAR(2); RESC(); ROT();
  }
  #undef CMASK
  #define CMASK(P0,P1,t) BIASHOOK(P0,P1,t)
  #define ENDW(tt) do{ if((tt)+3<NT){WAIT_BAR(2);} else if((tt)+2<NT){WAIT_BAR(1);} else {WAIT_BAR(0);} }while(0)
  for(;t+1<NT;t+=2){
    CBSET(t);   STEP(pB0,pB1,pA0,pA1,t,(t+3<NT),(t+1<NT),(t+1<NT));       ENDW(t);   RESC(); ROT();
    CBSET(t+1); STEP(pA0,pA1,pB0,pB1,t+1,(t+4<NT),(t+2<NT),(t+2<NT));     ENDW(t+1); RESC(); ROT();
  }
  CBSET(NT-1); STEP(pB0,pB1,pA0,pA1,NT-1,false,false,false); RESC();
  { float sacc=pB0[0]+pB0[1]; _Pragma("unroll") for(int r=2;r<16;++r)sacc+=pB0[r]; _Pragma("unroll") for(int r=0;r<16;++r)sacc+=pB1[r]; l_reg+=sacc;
    pw0=(u32x4){PKW(pB0,0),PKW(pB0,2),PKW(pB0,4),PKW(pB0,6)};pw1=(u32x4){PKW(pB0,8),PKW(pB0,10),PKW(pB0,12),PKW(pB0,14)};pw2=(u32x4){PKW(pB1,0),PKW(pB1,2),PKW(pB1,4),PKW(pB1,6)};pw3=(u32x4){PKW(pB1,8),PKW(pB1,10),PKW(pB1,12),PKW(pB1,14)};
    SBAR(); pv(o,vb0+sl_cur,PAF(0),PAF(1),PAF(2),PAF(3)); }
  #undef PKW
  #undef PAF
  #undef VFR
  #undef PIN
  #undef MX3
  #undef GAPA
  #undef GAPB
  #undef EX
  #undef VRD
  #undef KRD
  #undef STEP
  #undef ENDW
  {auto rr=__builtin_amdgcn_permlane32_swap(__float_as_uint(l_reg),__float_as_uint(l_reg),false,false);l_reg=__uint_as_float(rr[0])+__uint_as_float(rr[1]);}
  if(hi==0)wsf[32+r32]=l_reg;asm volatile("s_waitcnt lgkmcnt(0)":::"memory");
  float rli[16];
  #pragma unroll
  for(int r=0;r<16;++r)rli[r]=__builtin_amdgcn_rcpf(wsf[32+crow(r,hi)]);
  { bf16*stg=(bf16*)(shm+LDS_OST)+wid*2048;
    #pragma unroll
    for(int r=0;r<16;++r){const int orow=crow(r,hi);
      #pragma unroll
      for(int d0=0;d0<2;++d0)stg[orow*64+d0*32+r32]=(bf16)(pk2(o[d0][r]*rli[r],0.f)&0xffffu);}
    asm volatile("s_waitcnt lgkmcnt(0)":::"memory");
    if(MODE==0){
    #pragma unroll
    for(int i=0;i<4;++i){const int row=i*8+(lane>>3),ch=lane&7; const u32x4 v=*(const u32x4*)(stg+row*64+ch*8); const u32x4 g=*(const u32x4*)(Gp+(long)row*DM+ch*8);
      u32x4 w; w.x=pk2(bflo(v.x)*fa::silu(bflo(g.x)),bfhi(v.x)*fa::silu(bfhi(g.x))); w.y=pk2(bflo(v.y)*fa::silu(bflo(g.y)),bfhi(v.y)*fa::silu(bfhi(g.y)));
      w.z=pk2(bflo(v.z)*fa::silu(bflo(g.z)),bfhi(v.z)*fa::silu(bfhi(g.z))); w.w=pk2(bflo(v.w)*fa::silu(bflo(g.w)),bfhi(v.w)*fa::silu(bfhi(g.w)));
      *(u32x4*)(Ow+(long)row*MIXW+ch*8)=w;} } }
  asm volatile("s_waitcnt lgkmcnt(0)\n\ts_barrier":::"memory");
  #undef DMA_K
  #undef DMA_V
  #undef CMASK
  #undef cbias_
  #undef CBSET
  #undef BIASHOOK
  #undef START
  #undef RESC
  #undef ROT
}
#undef SBAR
#undef WAIT_BAR
}
#define SBAR() __builtin_amdgcn_sched_barrier(0)

typedef GAS unsigned gu32;
#define XB_TMO      128
#define XB_XCNT(j)  (256  + 64 * (j))
#define XB_XSUB(j)  (1280 + 64 * (j))
#define XB_XGEN(j)  (2304 + 64 * (j))
#define XB_TOP      3328
#define XB_TOPGEN   3392
#define XCD_BAR_WORDS 3456
#define XB_SPIN_CAP (1u << 22)
__device__ __forceinline__ unsigned xb_ld(unsigned* p)              { return __hip_atomic_load(p, __ATOMIC_RELAXED, __HIP_MEMORY_SCOPE_AGENT); }
__device__ __forceinline__ unsigned xb_add(unsigned* p, unsigned v) { return __hip_atomic_fetch_add(p, v, __ATOMIC_RELAXED, __HIP_MEMORY_SCOPE_AGENT); }
__device__ __forceinline__ unsigned xb_xcc_id() { return (unsigned)__builtin_amdgcn_s_getreg((3 << 11) | 20) & 0xFu; }
#define XB_SPIN(cond, bar) do { unsigned _sp = 0; while (cond) { __builtin_amdgcn_s_sleep(1); \
    if ((++_sp & 255u) == 0u) { if (xb_ld(&(bar)[XB_TMO])) break; if (_sp > XB_SPIN_CAP) { atomicAdd(&(bar)[XB_TMO], 1u); break; } } } } while (0)
__device__ __forceinline__ bool is_thread0() { unsigned t_ = threadIdx.x; asm volatile("" : "+v"(t_)); return t_ == 0u; }
struct XcdBarrier { unsigned* bar; unsigned x; volatile LAS unsigned* st; };
__device__ __forceinline__ XcdBarrier xcd_barrier_post(unsigned* bar, volatile LAS unsigned* st) {
    XcdBarrier b; b.bar = bar; b.x = xb_xcc_id(); b.st = st;
    if (threadIdx.x == 0) (void)xb_add(&bar[XB_XCNT(b.x)], 1u);
    return b;
}
__device__ __forceinline__ void xcd_barrier_complete(unsigned* bar, unsigned x, unsigned& nloc, unsigned& nx) {
    const unsigned G = gridDim.x * gridDim.y * gridDim.z;
    unsigned sum, cnt, mine, sp = 0u;
    for (;;) {
        sum = 0u; cnt = 0u; mine = 0u;
#pragma unroll
        for (unsigned j = 0; j < 16; ++j) { const unsigned c = xb_ld(&bar[XB_XCNT(j)]); sum += c; cnt += (c > 0u) ? 1u : 0u; mine = (j == x) ? c : mine; }
        if (sum == G) break;
        __builtin_amdgcn_s_sleep(1);
        if ((++sp & 255u) == 0u) { if (xb_ld(&bar[XB_TMO])) break; if (sp > XB_SPIN_CAP) { atomicAdd(&bar[XB_TMO], 1u); break; } }
    }
    nloc = mine > 0u ? mine : 1u; nx = cnt > 0u ? cnt : 1u;
}
__device__ __forceinline__ void xcd_barrier(const XcdBarrier& b) {
    asm volatile("s_waitcnt vmcnt(0)" ::: "memory");
    __syncthreads();
    if (is_thread0()) {
        unsigned* bar = b.bar;
        __builtin_amdgcn_s_waitcnt(0);
        unsigned nloc = b.st[0], nx = b.st[1];
        if (nloc == 0u) { xcd_barrier_complete(bar, b.x, nloc, nx); b.st[0] = nloc; b.st[1] = nx; }
        const unsigned old = xb_add(&bar[XB_XSUB(b.x)], 1u);
        const unsigned gen = old / nloc;
        if (old + 1u == (gen + 1u) * nloc) {
            __builtin_amdgcn_fence(__ATOMIC_RELEASE, "agent");
            asm volatile("s_waitcnt vmcnt(0)" ::: "memory");
            const unsigned og = xb_add(&bar[XB_TOP], 1u);
            const unsigned tg = og / nx;
            if (og + 1u == (tg + 1u) * nx) xb_add(&bar[XB_TOPGEN], 1u);
            else XB_SPIN(xb_ld(&bar[XB_TOPGEN]) == tg, bar);
            __builtin_amdgcn_fence(__ATOMIC_ACQUIRE, "agent");
            xb_add(&bar[XB_XGEN(b.x)], 1u);
            asm volatile("s_waitcnt vmcnt(0)" ::: "memory");
        } else {
            XB_SPIN(xb_ld(&bar[XB_XGEN(b.x)]) == gen, bar);
            __builtin_amdgcn_fence(__ATOMIC_ACQUIRE, "agent");
            asm volatile("s_waitcnt vmcnt(0)" ::: "memory");
        }
    }
    __syncthreads();
}

constexpr int CW_SPLIT = 8192;
__device__ __forceinline__ void split_arrive(unsigned* cnt) {
    asm volatile("s_waitcnt vmcnt(0)" ::: "memory");
    __syncthreads();
    if (is_thread0()) {
        __builtin_amdgcn_fence(__ATOMIC_RELEASE, "agent");
        asm volatile("s_waitcnt vmcnt(0)" ::: "memory");
        (void)__hip_atomic_fetch_add(cnt, 1u, __ATOMIC_RELAXED, __HIP_MEMORY_SCOPE_AGENT);
    }
}
__device__ __forceinline__ void split_wait(unsigned* cnt, unsigned want) {
    if (is_thread0()) {
        unsigned sp = 0u;
        while (__hip_atomic_load(cnt, __ATOMIC_RELAXED, __HIP_MEMORY_SCOPE_AGENT) < want) { __builtin_amdgcn_s_sleep(2); if (++sp > (1u << 24)) break; }
        __builtin_amdgcn_fence(__ATOMIC_ACQUIRE, "agent");
        asm volatile("s_waitcnt vmcnt(0)" ::: "memory");
    }
    __syncthreads();
}

struct Frame {
    LAS unsigned char* lds;
    int tid, lane, wave, vcu, G;
    const float* const __attribute__((address_space(4)))* in; float* out; unsigned char* ws;
    bf16_t *WIN, *WOUT, *XNM, *PROJ, *BPART; float *BLSE, *TAB;
};
__device__ __forceinline__ float wave_sum(float v) {
#pragma unroll
    for (int o = 1; o < 64; o <<= 1) v += __shfl_xor(v, o);
    return v;
}
__device__ __forceinline__ int t5_bucket(int rel) {
    const int dist = rel < 0 ? -rel : rel; int v;
    if (dist < 8) v = dist; else { const unsigned q = (unsigned)(dist * dist) >> 6; const int k = 31 - __builtin_clz(q); v = 8 + k; if (v > 15) v = 15; }
    return v + (rel > 0 ? 16 : 0);
}
__device__ __forceinline__ float in_colscale(int n) {
    if (n >= C_BQ && n < C_BK) return 0.125f * LOG2E;
    if (n >= C_CQ && n < C_CK) return 0.17677669529663687f * LOG2E;
    if (n >= C_DQ && n < C_DK) return 0.125f * LOG2E;
    return 1.f;
}
template <bool IN>
__device__ __forceinline__ void transpose_item(const float* W, const float* g, int K, int N, bf16_t* WT, LAS float* scr, int item, int lane) {
    const int nblk = N / 32, kb = item / nblk, nb = item % nblk, k0 = 64 * kb, n0 = 32 * nb;
#pragma unroll 8
    for (int i = 0; i < 32; ++i) { const int kk = 2 * i + (lane >> 5); float w = W[(size_t)(k0 + kk) * N + n0 + (lane & 31)]; if (IN) w *= g[k0 + kk]; scr[kk * 33 + (lane & 31)] = w; }
    asm volatile("s_waitcnt lgkmcnt(0)" ::: "memory");
    const int c = lane & 7;
#pragma unroll
    for (int j = 0; j < 4; ++j) { const int n = (lane >> 3) + 8 * j; const LAS float* s = scr + (8 * c) * 33 + n; const float cs = IN ? in_colscale(n0 + n) : 1.f;
        u32x4 o; o.x = pk2(s[0 * 33] * cs, s[1 * 33] * cs); o.y = pk2(s[2 * 33] * cs, s[3 * 33] * cs); o.z = pk2(s[4 * 33] * cs, s[5 * 33] * cs); o.w = pk2(s[6 * 33] * cs, s[7 * 33] * cs);
        *(u32x4*)(WT + (size_t)(n0 + n) * K + k0 + 8 * c) = o; }
    asm volatile("s_waitcnt lgkmcnt(0)" ::: "memory");
}
__device__ __forceinline__ void phase_prologue(Frame& F) {
    LAS float* scr = (LAS float*)(F.lds + F.wave * 16384);
    const int gw = F.vcu * 8 + F.wave, NGW = F.G * 8;
    constexpr int I_IN = (DMODEL / 64) * (INW / 32), I_OUT = (MIXW / 64) * (DMODEL / 32);
    constexpr int NITEMS = DEPTH * (I_IN + I_OUT);
    for (int it = gw; it < NITEMS; it += NGW) {
        int r = it;
        if (r < DEPTH * I_IN) { const int l = r / I_IN; r -= l * I_IN; transpose_item<true>(F.in[2] + (size_t)l * DMODEL * INW, F.in[4] + l * DMODEL, DMODEL, INW, F.WIN + (size_t)l * INW * DMODEL, scr, r, F.lane); continue; }
        r -= DEPTH * I_IN; { const int l = r / I_OUT; r -= l * I_OUT; transpose_item<false>(F.in[3] + (size_t)l * MIXW * DMODEL, nullptr, MIXW, DMODEL, F.WOUT + (size_t)l * DMODEL * MIXW, scr, r, F.lane); }
    }
    if (blockIdx.x == 0) {
        float* T = F.TAB; const float* t5 = F.in[8];
        for (int i = F.tid; i < 128 * 16; i += 512) { const int pos = i >> 4, k = i & 15; const float f = exp2f(-(float)k * (13.287712379549449f / 16.f)); const float a = (float)pos * f; T[T_ROPE + 2 * i] = cosf(a); T[T_ROPE + 2 * i + 1] = sinf(a); }
        for (int i = F.tid; i < 4 * 641; i += 512) { const int h = i / 641, rel = i % 641 - 320; T[T_C + i] = t5[t5_bucket(rel) * 8 + 4 + h] * LOG2E; }
        for (int i = F.tid; i < 3 * 4 * 320; i += 512) { const int g = i / (4 * 320), h = (i / 320) & 3, off = i % 320 - 158; const int d = (g == 0) ? 1 : (g == 1 ? 4 : 16); T[T_B + i] = (off < -64 || off > 64) ? -INFINITY : t5[t5_bucket(off * d) * 8 + h] * LOG2E; }
        { const int lh = F.wave; const float* rp = F.in[14] + (size_t)lh * 465; float m = -1e30f;
          for (int i = F.lane; i < 465; i += 64) m = fmaxf(m, rp[i] * LOG2E);
          for (int o_ = 32; o_; o_ >>= 1) m = fmaxf(m, __shfl_xor(m, o_));
          if (F.lane == 0) T[T_BMAXD + lh] = m; }
        if (F.tid >= 68 && F.tid < 72) { const int h = F.tid - 68; float m = -1e30f; for (int bk = 0; bk < 32; ++bk) m = fmaxf(m, t5[bk * 8 + h] * LOG2E); T[T_BMAXB + h] = m; }
        if (F.tid >= 64 && F.tid < 68) { const int h = F.tid - 64; float m = -1e30f; for (int bk = 0; bk < 32; ++bk) m = fmaxf(m, t5[bk * 8 + 4 + h] * LOG2E); T[T_BMAX + h] = m; }
        if (F.tid < DEPTH) { const int l = F.tid; float s1 = 0.f, s2 = 0.f; for (int i = 0; i < 32; ++i) { s1 += F.in[9][l * 32 + i] * F.in[10][l * 32 + i]; s2 += F.in[11][l * 32 + i] * F.in[12][l * 32 + i]; }
            const float li = 0.8f - 0.6f * expf(-0.3f * (float)l); T[T_LAM + l] = expf(s1) - expf(s2) + li; }
    }
}
__device__ __forceinline__ void phase_xn(Frame& F, int layer) {
    const int gw = F.vcu * 8 + F.wave, NGW = F.G * 8;
    for (int m = gw; m < MTOT; m += NGW) {
        const float* src = (layer == 0) ? (m < RS ? F.in[0] + (size_t)m * DMODEL : F.in[1] + (size_t)(m - RS) * DMODEL) : F.out + (size_t)m * DMODEL;
        const f32x4* xr = (const f32x4*)src + F.lane; f32x4 v[4]; float s = 0.f;
#pragma unroll
        for (int j = 0; j < 4; ++j) { v[j] = xr[64 * j]; s += (v[j].x * v[j].x + v[j].y * v[j].y) + (v[j].z * v[j].z + v[j].w * v[j].w); }
        const float r = 1.f / sqrtf(wave_sum(s) * (1.f / DMODEL) + RMS_EPS);
        u32x2* o8 = (u32x2*)(F.XNM + (size_t)m * DMODEL) + F.lane;
#pragma unroll
        for (int j = 0; j < 4; ++j) { u32x2 w; w.x = pk2(v[j].x * r, v[j].y * r); w.y = pk2(v[j].z * r, v[j].w * r); o8[64 * j] = w; }
    }
}
__device__ __forceinline__ void phase_final(Frame& F) {
    const int gw = F.vcu * 8 + F.wave, NGW = F.G * 8; const float* g = F.in[5];
    for (int m = gw; m < MTOT; m += NGW) {
        f32x4* xr = (f32x4*)(F.out + (size_t)m * DMODEL) + F.lane; f32x4 v[4]; float s = 0.f;
#pragma unroll
        for (int j = 0; j < 4; ++j) { v[j] = xr[64 * j]; s += (v[j].x * v[j].x + v[j].y * v[j].y) + (v[j].z * v[j].z + v[j].w * v[j].w); }
        const float r = 1.f / sqrtf(wave_sum(s) * (1.f / DMODEL) + RMS_EPS);
#pragma unroll
        for (int j = 0; j < 4; ++j) { const f32x4 gg = *((const f32x4*)g + F.lane + 64 * j); xr[64 * j] = v[j] * r * gg; }
    }
}
__device__ __forceinline__ void phase_prepB(Frame& F, int s, int layer) {
    const int gw = F.vcu * 8 + F.wave, NGW = F.G * 8; const int lane = F.lane, half = lane >> 5, l32 = lane & 31;
    unsigned* kmaxB = (unsigned*)(F.ws + WS_CTL) + CW_KMAXB + (layer * 2 + s) * 4; unsigned* kmaxD = (unsigned*)(F.ws + WS_CTL) + CW_KMAXD + (layer * 2 + s) * 4;
    float kmB = 0.f, kmD = 0.f;
    for (int i0 = 0; gw + NGW * 2 * i0 < RS; i0 += 4) {
        u32x4 w[4], wd[4];
#pragma unroll
        for (int i = 0; i < 4; ++i) { const int lr = gw + NGW * (2 * (i0 + i) + half);
            w[i] = (lr < RS) ? *(const u32x4*)(F.PROJ + (size_t)lr * INW + C_BK + l32 * 8) : (u32x4){0u, 0u, 0u, 0u};
            wd[i] = (lr < RS) ? *(const u32x4*)(F.PROJ + (size_t)lr * INW + C_DK + l32 * 8) : (u32x4){0u, 0u, 0u, 0u}; }
#pragma unroll
        for (int i = 0; i < 4; ++i) { const float r[8] = {bflo(w[i].x), bfhi(w[i].x), bflo(w[i].y), bfhi(w[i].y), bflo(w[i].z), bfhi(w[i].z), bflo(w[i].w), bfhi(w[i].w)}; float k2 = 0.f;
            const float rd[8] = {bflo(wd[i].x), bfhi(wd[i].x), bflo(wd[i].y), bfhi(wd[i].y), bflo(wd[i].z), bfhi(wd[i].z), bflo(wd[i].w), bfhi(wd[i].w)}; float d2 = 0.f;
#pragma unroll
            for (int j = 0; j < 8; ++j) { k2 += r[j] * r[j]; d2 += rd[j] * rd[j]; }
            k2 += __shfl_xor(k2, 1); k2 += __shfl_xor(k2, 2); k2 += __shfl_xor(k2, 4);
            d2 += __shfl_xor(d2, 1); d2 += __shfl_xor(d2, 2); d2 += __shfl_xor(d2, 4);
            kmB = fmaxf(kmB, k2); kmD = fmaxf(kmD, d2); }
    }
    kmB = fmaxf(kmB, __shfl_xor(kmB, 32)); kmD = fmaxf(kmD, __shfl_xor(kmD, 32));
    { LAS float* red = (LAS float*)(F.lds + fa::L_WS);
      if (lane < 32 && (lane & 7) == 0) { red[F.wave * 8 + (lane >> 3)] = kmB; red[F.wave * 8 + 4 + (lane >> 3)] = kmD; }
      asm volatile("s_waitcnt lgkmcnt(0)\n\ts_barrier" ::: "memory");
      if (F.tid < 8) { float m = 0.f;
#pragma unroll
          for (int w_ = 0; w_ < 8; ++w_) m = fmaxf(m, red[w_ * 8 + F.tid]);
          atomicMax(F.tid < 4 ? kmaxB + F.tid : kmaxD + (F.tid - 4), __float_as_uint(sqrtf(m))); }
      asm volatile("s_waitcnt lgkmcnt(0)\n\ts_barrier" ::: "memory"); }
}
__device__ __forceinline__ void phase_prep(Frame& F, int s, int layer) {
    const int gw = F.vcu * 8 + F.wave, NGW = F.G * 8; const int n = s ? 2048 : 8192;
    const float* gq = F.in[6] + layer * 64; const float* gk = F.in[7] + layer * 64;
    LAS const float* rope = (LAS const float*)(F.lds + LT_ROPE);
    const int lane = F.lane, hh = lane >> 3, c = lane & 7;
    unsigned* kmaxA = (unsigned*)(F.ws + WS_CTL) + CW_KMAXA + (layer * 2 + s) * 2; unsigned* kmaxC = (unsigned*)(F.ws + WS_CTL) + CW_KMAXC + (layer * 2 + s) * 8;
    float kmA = 0.f, kmC = 0.f;
    float gv[8];
#pragma unroll
    for (int j = 0; j < 8; ++j) gv[j] = ((hh < 4 ? gq : gk) + c * 8)[j];
    const float sgn = (c & 2) ? 1.f : -1.f; const float qs = (hh < 4) ? 0.125f * LOG2E : 1.f;
    constexpr int NB = 4;
    for (int lr0 = gw; lr0 < RS; lr0 += NB * NGW) {
        u32x4 wA[NB], wC[NB];
#pragma unroll
        for (int k = 0; k < NB; ++k) { const int lr = lr0 + k * NGW; wA[k] = (u32x4){0u, 0u, 0u, 0u}; wC[k] = wA[k];
            if (lr < RS) { if (lane < 48) wA[k] = *(const u32x4*)(F.PROJ + (size_t)lr * INW + hh * 64 + c * 8);
                           if (lane < 32) wC[k] = *(const u32x4*)(F.PROJ + (size_t)lr * INW + C_CK + lane * 8); } }
#pragma unroll
        for (int k = 0; k < NB; ++k) { const int lr = lr0 + k * NGW; if (lr < RS) {
            const u32x4 w = wA[k]; float v[8] = {bflo(w.x), bfhi(w.x), bflo(w.y), bfhi(w.y), bflo(w.z), bfhi(w.z), bflo(w.w), bfhi(w.w)};
            float ss = 0.f;
#pragma unroll
            for (int j = 0; j < 8; ++j) ss += v[j] * v[j];
            ss += __shfl_xor(ss, 1); ss += __shfl_xor(ss, 2); ss += __shfl_xor(ss, 4);
            const float rinv = 1.f / sqrtf(ss * (1.f / 64.f) + RMS_EPS);
            const int t = lr % n; const int pos = (c < 4) ? (t >> 6) : (t & 63);
            float o[8];
#pragma unroll
            for (int j = 0; j < 8; ++j) { v[j] = v[j] * rinv * gv[j]; }
#pragma unroll
            for (int j = 0; j < 8; ++j) { const float pr = __shfl_xor(v[j], 2); const int i = 8 * (c & 1) + j; const float cs = rope[(pos * 16 + i) * 2], sn = rope[(pos * 16 + i) * 2 + 1];
                o[j] = (v[j] * cs + sgn * pr * sn) * qs; }
            u32x4 ow; ow.x = pk2(o[0], o[1]); ow.y = pk2(o[2], o[3]); ow.z = pk2(o[4], o[5]); ow.w = pk2(o[6], o[7]);
            if (lane < 48) *(u32x4*)(F.PROJ + (size_t)lr * INW + hh * 64 + c * 8) = ow;
            { const float r[8] = {bflo(ow.x), bfhi(ow.x), bflo(ow.y), bfhi(ow.y), bflo(ow.z), bfhi(ow.z), bflo(ow.w), bfhi(ow.w)}; float k2 = 0.f;
#pragma unroll
              for (int j = 0; j < 8; ++j) k2 += r[j] * r[j];
              k2 += __shfl_xor(k2, 1); k2 += __shfl_xor(k2, 2); k2 += __shfl_xor(k2, 4);
              kmA = fmaxf(kmA, k2); }
            { const u32x4 wc = wC[k]; const float r[8] = {bflo(wc.x), bfhi(wc.x), bflo(wc.y), bfhi(wc.y), bflo(wc.z), bfhi(wc.z), bflo(wc.w), bfhi(wc.w)}; float k2 = 0.f;
#pragma unroll
              for (int j = 0; j < 8; ++j) k2 += r[j] * r[j];
              k2 += __shfl_xor(k2, 1); k2 += __shfl_xor(k2, 2);
              kmC = fmaxf(kmC, k2); } } }
    }
    { LAS float* red = (LAS float*)(F.lds + fa::L_WS);
      if (lane == 32 || lane == 40) red[F.wave * 14 + (hh - 4)] = kmA;
      if (lane < 32 && (lane & 3) == 0) red[F.wave * 14 + 2 + (lane >> 2)] = kmC;
      asm volatile("s_waitcnt lgkmcnt(0)\n\ts_barrier" ::: "memory");
      if (F.tid < 10) { float m = 0.f;
#pragma unroll
          for (int w = 0; w < 8; ++w) m = fmaxf(m, red[w * 14 + F.tid]);
          atomicMax(F.tid < 2 ? kmaxA + F.tid : kmaxC + (F.tid - 2), __float_as_uint(sqrtf(m))); }
      asm volatile("s_waitcnt lgkmcnt(0)\n\ts_barrier" ::: "memory"); }
}

struct KVLinear {
    const bf16_t* kbase; const bf16_t* vbase;
    __device__ __forceinline__ const bf16_t* tk(int t) const { return kbase + (size_t)(64 * t) * INW; }
    __device__ __forceinline__ const bf16_t* tv(int t) const { return vbase + (size_t)(64 * t) * INW; }
    __device__ __forceinline__ int rmul() const { return 1; }
    __device__ __forceinline__ const bf16_t* kptr(int t, int j) const { return kbase + (size_t)(64 * t + j) * INW; }
    __device__ __forceinline__ const bf16_t* vptr(int t, int j) const { return vbase + (size_t)(64 * t + j) * INW; }
};
struct KVStrided {
    const bf16_t* kbase; const bf16_t* vbase; int d; int ntr;
    __device__ __forceinline__ const bf16_t* tk(int t) const { const int g2 = t >= ntr ? 1 : 0; const int tt = t - g2 * ntr; return kbase + (size_t)(g2 + d * 64 * tt) * INW; }
    __device__ __forceinline__ const bf16_t* tv(int t) const { const int g2 = t >= ntr ? 1 : 0; const int tt = t - g2 * ntr; return vbase + (size_t)(g2 + d * 64 * tt) * INW; }
    __device__ __forceinline__ int rmul() const { return d; }
    __device__ __forceinline__ const bf16_t* kptr(int t, int j) const { const int g2 = t >= ntr ? 1 : 0; const int tt = t - g2 * ntr; return kbase + (size_t)(g2 + d * (64 * tt + j)) * INW; }
    __device__ __forceinline__ const bf16_t* vptr(int t, int j) const { const int g2 = t >= ntr ? 1 : 0; const int tt = t - g2 * ntr; return vbase + (size_t)(g2 + d * (64 * tt + j)) * INW; }
};
struct HookNone { __device__ __forceinline__ bool skip(int) const { return false; } __device__ __forceinline__ float cbias(int) const { return 0.f; } __device__ __forceinline__ void apply(f32x16&, f32x16&, int) const {} };

__device__ __forceinline__ void store_gated(Frame& F, LAS const float* stg, size_t lrow0, size_t grow0, int gate_col, int mix_col, int lane) {
#pragma unroll
    for (int i = 0; i < 4; ++i) { const int row = i * 8 + (lane >> 3), ch = lane & 7;
        const f32x4 a = *(LAS const f32x4*)(stg + row * 64 + ch * 8), b = *(LAS const f32x4*)(stg + row * 64 + ch * 8 + 4);
        const u32x4 gw = *(const u32x4*)(F.PROJ + (lrow0 + row) * INW + gate_col + ch * 8);
        u32x4 w; w.x = pk2(a.x * fa::silu(bflo(gw.x)), a.y * fa::silu(bfhi(gw.x))); w.y = pk2(a.z * fa::silu(bflo(gw.y)), a.w * fa::silu(bfhi(gw.y)));
        w.z = pk2(b.x * fa::silu(bflo(gw.z)), b.y * fa::silu(bfhi(gw.z))); w.w = pk2(b.z * fa::silu(bflo(gw.w)), b.w * fa::silu(bfhi(gw.w)));
        *(u32x4*)(F.XNM + (grow0 + row) * MIXW + mix_col + ch * 8) = w; }
}

__device__ __forceinline__ void unit_A(Frame& F, int s, int layer, int bh, int qb) {
    const int n = s ? 2048 : 8192; const int b = bh >> 2, h = bh & 3;
    int tid_ = F.tid; asm volatile("" : "+v"(tid_)); const int wid = __builtin_amdgcn_readfirstlane(tid_ >> 6);
    const size_t rowbase = (size_t)b * n; const int q0 = qb * 256 + wid * 32;
    const bf16_t* Qw = F.PROJ + (rowbase + q0) * INW + C_AQ + h * 64;
    const bf16_t* Kh = F.PROJ + rowbase * INW + C_AK + (h >> 1) * 64; const bf16_t* Vh = F.PROJ + rowbase * INW + C_AV + (h >> 1) * 64;
    const bf16_t* Gp = F.PROJ + (rowbase + q0) * INW + C_AG + h * 64;
    bf16_t* Ow = F.XNM + ((size_t)s * RS + rowbase + q0) * MIXW + h * 64;
    const float kbA = __uint_as_float(((const unsigned*)(F.ws + WS_CTL))[CW_KMAXA + (layer * 2 + s) * 2 + (h >> 1)]) * 1.01f;
    tb::attn_unit<8, 0, true>(tid_, Qw, Kh, Vh, n / 64, Gp, Ow, (char*)(unsigned char*)F.lds, 0, nullptr, 0, 0.f, 0.f, kbA, 0.f);
}

struct HookC {
    LAS const float* tab;
    int qw;
    int r32, hi; float bl, br;
    __device__ __forceinline__ bool skip(int) const { return false; }
    __device__ __forceinline__ float cbias(int t) const {
        const int maxrel = 64 * t + 63 - qw, minrel = 64 * t - qw - 31;
        return (maxrel <= -91) ? bl : ((minrel >= 91) ? br : 0.f);
    }
    __device__ __forceinline__ void apply(f32x16& p0, f32x16& p1, int t) const {
        const int maxrel = 64 * t + 63 - qw, minrel = 64 * t - qw - 31;
        if (maxrel > -91 && minrel < 91) { LAS const float* tp = tab + (320 + 64 * t - qw - r32 + 4 * hi);
#pragma unroll
            for (int r = 0; r < 16; ++r) { const int kk = (r & 3) + 8 * (r >> 2); p0[r] += tp[kk]; p1[r] += tp[kk + 32]; } }
    }
};
__device__ __forceinline__ void unit_C(Frame& F, int s, int layer, int bh, int qb) {
    const int n = s ? 2048 : 8192; const int b = bh >> 2, h = bh & 3; int tid_ = F.tid; asm volatile("" : "+v"(tid_)); const int lane = tid_ & 63, r32 = lane & 31, hi = lane >> 5, wid = __builtin_amdgcn_readfirstlane(tid_ >> 6);
    const size_t rowbase = (size_t)b * n; const int q0 = qb * 256; const int qw = q0 + wid * 32;
    LAS float* tab = (LAS float*)(F.lds + fa::L_TAB);
    for (int i = tid_; i < 641; i += 512) tab[i] = F.TAB[T_C + h * 641 + i];
    asm volatile("s_waitcnt vmcnt(0) lgkmcnt(0)\n\ts_barrier" ::: "memory");
    const bf16_t* qptr = F.PROJ + (rowbase + qw + r32) * INW + C_CQ + h * 64;
    KVLinear kv{F.PROJ + rowbase * INW + C_CK + h * 64, F.PROJ + rowbase * INW + C_CV + h * 64};
    f32x16 o1[2], o2[2];
    HookC hk{tab, qw, r32, hi, tab[320 - 100], tab[320 + 100]};
    fa::flash_core_dual_sp(F.lds, qptr, kv, n / 64, hk, o1, o2, tid_);
    const float lam = F.TAB[T_LAM + layer]; const float li = layer == 0 ? 0.2f : 0.35550907f; const float* sg = F.in[13] + layer * 64;
#pragma unroll
    for (int r = 0; r < 16; ++r) { o1[0][r] -= lam * o2[0][r]; o1[1][r] -= lam * o2[1][r]; }
    LAS float* stg = (LAS float*)(F.lds + fa::L_OST) + wid * 2048;
    fa::stage_o(stg, o1, r32, hi);
#pragma unroll
    for (int i = 0; i < 4; ++i) { const int row = i * 8 + (lane >> 3), ch = lane & 7;
        const f32x4 a0 = *(LAS const f32x4*)(stg + row * 64 + ch * 8), a1 = *(LAS const f32x4*)(stg + row * 64 + ch * 8 + 4);
        const float v[8] = {a0.x, a0.y, a0.z, a0.w, a1.x, a1.y, a1.z, a1.w};
        float ss = 0.f;
#pragma unroll
        for (int k = 0; k < 8; ++k) ss += v[k] * v[k];
        ss += __shfl_xor(ss, 1); ss += __shfl_xor(ss, 2); ss += __shfl_xor(ss, 4);
        const float sc = (1.f - li) / sqrtf(ss * (1.f / 64.f) + RMS_EPS);
        const size_t lrow = rowbase + qw + row;
        const u32x4 gw = *(const u32x4*)(F.PROJ + lrow * INW + C_CG + h * 64 + ch * 8);
        const float g[8] = {bflo(gw.x), bfhi(gw.x), bflo(gw.y), bfhi(gw.y), bflo(gw.z), bfhi(gw.z), bflo(gw.w), bfhi(gw.w)};
        float y[8];
#pragma unroll
        for (int k = 0; k < 8; ++k) y[k] = v[k] * sc * sg[ch * 8 + k] * fa::silu(g[k]);
        u32x4 w; w.x = pk2(y[0], y[1]); w.y = pk2(y[2], y[3]); w.z = pk2(y[4], y[5]); w.w = pk2(y[6], y[7]);
        *(u32x4*)(F.XNM + ((size_t)s * RS + lrow) * MIXW + 512 + h * 64 + ch * 8) = w; }
    asm volatile("s_waitcnt lgkmcnt(0)\n\ts_barrier" ::: "memory");
}

__device__ __forceinline__ void unit_Cv(Frame& F, int s, int layer, int bh, int qb) {
    const int n = s ? 2048 : 8192; const int b = bh >> 2, h = bh & 3; int tid_ = F.tid; asm volatile("" : "+v"(tid_)); const int lane = tid_ & 63, r32 = lane & 31, hi = lane >> 5, wid = __builtin_amdgcn_readfirstlane(tid_ >> 6);
    const int map = wid >> 2; const size_t rowbase = (size_t)b * n; const int q0 = qb * 128; const int qw = q0 + (wid & 3) * 32;
    LAS float* tab = (LAS float*)(F.lds + fa::L_TAB);
    for (int i = tid_; i < 641; i += 512) tab[i] = F.TAB[T_C + h * 641 + i];
    asm volatile("s_waitcnt vmcnt(0) lgkmcnt(0)\n\ts_barrier" ::: "memory");
    const bf16_t* qptr = F.PROJ + (rowbase + qw + r32) * INW + C_CQ + h * 64 + map * 32;
    KVLinear kv{F.PROJ + rowbase * INW + C_CK + h * 64, F.PROJ + rowbase * INW + C_CV + h * 64};
    f32x16 o[2]; float mh, lt;
    HookC hk{tab, qw, r32, hi, tab[320 - 100], tab[320 + 100]};
    fa::flash_core_sp<2>(F.lds, qptr, kv, n / 64, hk, map * 4096, o, mh, lt, tid_);
    LAS float* stg = (LAS float*)(F.lds + fa::L_OST) + wid * 2048;
    fa::stage_o(stg, o, r32, hi);
    asm volatile("s_waitcnt lgkmcnt(0)\n\ts_barrier" ::: "memory");
    const float lam = F.TAB[T_LAM + layer]; const float li = layer == 0 ? 0.2f : 0.35550907f; const float* sg = F.in[13] + layer * 64;
    LAS const float* S1 = (LAS const float*)(F.lds + fa::L_OST); LAS const float* S2 = S1 + 4 * 2048;
#pragma unroll
    for (int j = 0; j < 2; ++j) { const int row = 16 * wid + 8 * j + (lane >> 3), ch = lane & 7;
        const int off = (row >> 5) * 2048 + (row & 31) * 64 + ch * 8;
        const f32x4 a0 = *(LAS const f32x4*)(S1 + off), a1 = *(LAS const f32x4*)(S1 + off + 4), b0 = *(LAS const f32x4*)(S2 + off), b1 = *(LAS const f32x4*)(S2 + off + 4);
        float v[8] = {a0.x - lam * b0.x, a0.y - lam * b0.y, a0.z - lam * b0.z, a0.w - lam * b0.w, a1.x - lam * b1.x, a1.y - lam * b1.y, a1.z - lam * b1.z, a1.w - lam * b1.w};
        float ss = 0.f;
#pragma unroll
        for (int k = 0; k < 8; ++k) ss += v[k] * v[k];
        ss += __shfl_xor(ss, 1); ss += __shfl_xor(ss, 2); ss += __shfl_xor(ss, 4);
        const float sc = (1.f - li) / sqrtf(ss * (1.f / 64.f) + RMS_EPS);
        const size_t lrow = rowbase + q0 + row;
        const u32x4 gw = *(const u32x4*)(F.PROJ + lrow * INW + C_CG + h * 64 + ch * 8);
        const float g[8] = {bflo(gw.x), bfhi(gw.x), bflo(gw.y), bfhi(gw.y), bflo(gw.z), bfhi(gw.z), bflo(gw.w), bfhi(gw.w)};
        float y[8];
#pragma unroll
        for (int k = 0; k < 8; ++k) y[k] = v[k] * sc * sg[ch * 8 + k] * fa::silu(g[k]);
        u32x4 w; w.x = pk2(y[0], y[1]); w.y = pk2(y[2], y[3]); w.z = pk2(y[4], y[5]); w.w = pk2(y[6], y[7]);
        *(u32x4*)(F.XNM + ((size_t)s * RS + lrow) * MIXW + 512 + h * 64 + ch * 8) = w; }
    asm volatile("s_waitcnt lgkmcnt(0)\n\ts_barrier" ::: "memory");
}

__device__ __forceinline__ void unit_Ct(Frame& F, int s, int layer, int bh, int qb) {
    const int n = s ? 2048 : 8192; const int b = bh >> 2, h = bh & 3;
    int tid_ = F.tid; asm volatile("" : "+v"(tid_)); const int lane = tid_ & 63, wid = __builtin_amdgcn_readfirstlane(tid_ >> 6);
    const int cmap = wid >> 2; const size_t rowbase = (size_t)b * n; const int q0 = qb * 128; const int qw = q0 + (wid & 3) * 32;
    LAS float* tab = (LAS float*)(F.lds + LT_C) + h * 641;
    const bf16_t* Qw = F.PROJ + (rowbase + qw) * INW + C_CQ + h * 64 + cmap * 32;
    const bf16_t* Kh = F.PROJ + rowbase * INW + C_CK + h * 64; const bf16_t* Vh = F.PROJ + rowbase * INW + C_CV + h * 64;
    const float kbC = __uint_as_float(((const unsigned*)(F.ws + WS_CTL))[CW_KMAXC + (layer * 2 + s) * 8 + h * 2 + cmap]) * 1.01f;
    tb::attn_unit<8, 1, true>(tid_, Qw, Kh, Vh, n / 64, nullptr, nullptr, (char*)(unsigned char*)F.lds, cmap, tab, qw, tab[320 - 100], tab[320 + 100], kbC, F.TAB[T_BMAX + h]);
    const float lam = F.TAB[T_LAM + layer]; const float li = layer == 0 ? 0.2f : 0.35550907f; const float* sg = F.in[13] + layer * 64;
    LAS const bf16_t* S1 = (LAS const bf16_t*)(F.lds + tb::LDS_OST); LAS const bf16_t* S2 = S1 + 4 * 2048;
#pragma unroll
    for (int j = 0; j < 2; ++j) { const int row = 16 * wid + 8 * j + (lane >> 3), ch = lane & 7;
        const int off = (row >> 5) * 2048 + (row & 31) * 64 + ch * 8;
        const u32x4 a = *(LAS const u32x4*)(S1 + off), c = *(LAS const u32x4*)(S2 + off);
        float v[8] = {bflo(a.x) - lam * bflo(c.x), bfhi(a.x) - lam * bfhi(c.x), bflo(a.y) - lam * bflo(c.y), bfhi(a.y) - lam * bfhi(c.y),
                      bflo(a.z) - lam * bflo(c.z), bfhi(a.z) - lam * bfhi(c.z), bflo(a.w) - lam * bflo(c.w), bfhi(a.w) - lam * bfhi(c.w)};
        float ss = 0.f;
#pragma unroll
        for (int k = 0; k < 8; ++k) ss += v[k] * v[k];
        ss += __shfl_xor(ss, 1); ss += __shfl_xor(ss, 2); ss += __shfl_xor(ss, 4);
        const float sc = (1.f - li) / sqrtf(ss * (1.f / 64.f) + RMS_EPS);
        const size_t lrow = rowbase + q0 + row;
        const u32x4 gw = *(const u32x4*)(F.PROJ + lrow * INW + C_CG + h * 64 + ch * 8);
        const float g[8] = {bflo(gw.x), bfhi(gw.x), bflo(gw.y), bfhi(gw.y), bflo(gw.z), bfhi(gw.z), bflo(gw.w), bfhi(gw.w)};
        float y[8];
#pragma unroll
        for (int k = 0; k < 8; ++k) y[k] = v[k] * sc * sg[ch * 8 + k] * fa::silu(g[k]);
        u32x4 w; w.x = pk2(y[0], y[1]); w.y = pk2(y[2], y[3]); w.z = pk2(y[4], y[5]); w.w = pk2(y[6], y[7]);
        *(u32x4*)(F.XNM + ((size_t)s * RS + lrow) * MIXW + 512 + h * 64 + ch * 8) = w; }
    asm volatile("s_waitcnt lgkmcnt(0)\n\ts_barrier" ::: "memory");
}

struct HookB {
    LAS const float* tab;
    int qw, L, kb0;
    int r32, hi;
    __device__ __forceinline__ bool skip(int t) const { const int kb = kb0 + 64 * t; return (qw >= L) || (kb + 63 < qw - 64) || (kb > qw + 95); }
    __device__ __forceinline__ void apply(f32x16& p0, f32x16& p1, int t) const {
        LAS const float* tp = tab + (kb0 + 64 * t + 4 * hi - (qw + r32) + 158);
#pragma unroll
        for (int r = 0; r < 16; ++r) { const int kk = (r & 3) + 8 * (r >> 2); p0[r] += tp[kk]; p1[r] += tp[kk + 32]; }
    }
};
struct BPar { int g, h, d, L, NT, tlo, q0, pack, res; size_t rowbase; };
__device__ __forceinline__ BPar b_decode(int s_in, int u_in) {
    int u = u_in; asm volatile("" : "+s"(u));
    int s = s_in; asm volatile("" : "+s"(s));
    int g, bh, res, qblk, pack = 0;
    if (s == 0) { g = u >> 8; const int rest = u & 255, k = rest & 31; bh = rest >> 5; const int lper = (g == 0) ? 5 : (g == 1 ? 3 : 1); res = k >> lper; qblk = k & ((1 << lper) - 1); }
    else if (u < 256) { g = 0; bh = u >> 3; res = 0; qblk = u & 7; }
    else if (u < 512) { const int r = u - 256; g = 1; bh = r >> 3; res = (r & 7) >> 1; qblk = r & 1; }
    else { const int r = u - 512; g = 2; bh = r >> 3; res = (r & 7) * 2; qblk = 0; pack = 1; }
    BPar P; const int n = 8192 >> (s << 1); P.g = g; P.h = bh & 3; P.d = (g == 0) ? 1 : (g == 1 ? 4 : 16); P.L = n / P.d; P.rowbase = (size_t)(bh >> 2) * n; P.res = res; P.q0 = qblk * 256; P.pack = pack;
    int tlo = (P.q0 - 64) >> 6; if (tlo < 0) tlo = 0; int thi = (P.q0 + 319) >> 6; const int tmax = (P.L - 1) >> 6; if (thi > tmax) thi = tmax;
    P.tlo = tlo; P.NT = thi - tlo + 1; return P;
}
__device__ __forceinline__ void b_dma(Frame& F, const BPar& P, const int tid) {
    const int lane = tid & 63; const int wid = __builtin_amdgcn_readfirstlane(tid >> 6);
    const unsigned lds0 = (unsigned)(uintptr_t)F.lds;
    const unsigned kdst = lds0 + fa::L_AK + wid * 1024, vdst = lds0 + fa::L_AV + wid * 1024;
    const int vrow_j = 16 * (wid & 3) + (lane >> 2), vcol = (wid >> 2) * 32 + (lane & 3) * 8;
    const size_t krow0 = P.rowbase + P.res + (size_t)P.d * 64 * P.tlo;
    KVStrided kv{F.PROJ + krow0 * INW + C_BK + P.h * 64, F.PROJ + krow0 * INW + C_BV + P.h * 64, P.d, P.NT};
    const unsigned koffv = (unsigned)(kv.rmul() * lane * INW + wid * 8) * 2u, voffv = (unsigned)(kv.rmul() * vrow_j * INW + vcol) * 2u;
    const int NTD = P.pack ? 2 * P.NT : P.NT;
    for (int t = 0; t < NTD; ++t) {
        fa::glds16s(kv.tk(t), koffv, (unsigned)__builtin_amdgcn_readfirstlane(kdst + t * fa::SLOTB));
        fa::glds16s(kv.tv(t), voffv, (unsigned)__builtin_amdgcn_readfirstlane(vdst + t * fa::SLOTB)); }
}
__device__ __forceinline__ void b_qload(Frame& F, const BPar& P, const int tid, bf16x8 (&qr)[4]) {
    const int lane = tid & 63, r32 = lane & 31, hi = lane >> 5; const int wid = __builtin_amdgcn_readfirstlane(tid >> 6);
    const int wg2 = P.pack ? (wid >> 2) : 0; const int qw = P.pack ? (wid & 3) * 32 : P.q0 + wid * 32;
    int qidx = qw + r32; if (qidx >= P.L) qidx = P.L - 1;
    const bf16_t* qptr = F.PROJ + (P.rowbase + P.res + wg2 + (size_t)P.d * qidx) * INW + C_BQ + P.h * 64;
#pragma unroll
    for (int d0 = 0; d0 < 4; ++d0) qr[d0] = *(const bf16x8*)(qptr + d0 * 16 + hi * 8);
}
constexpr int L_BST = 96 * 1024;
__device__ __forceinline__ void epilogue_B(Frame& F, int s, int u_in, f32x16 (&o)[2], float mh, float lt) {
    int u = u_in; asm volatile("" : "+s"(u));
    const BPar P = b_decode(s, u);
    int tid_ = F.tid; asm volatile("" : "+v"(tid_)); const int lane = tid_ & 63, r32 = lane & 31, hi = lane >> 5, wid = __builtin_amdgcn_readfirstlane(tid_ >> 6);
    const int g = P.g, h = P.h, d = P.d, L = P.L; const size_t rowbase = P.rowbase; const int res = P.res;
    const int wg2 = P.pack ? (wid >> 2) : 0; const int qw = P.pack ? (wid & 3) * 32 : P.q0 + wid * 32;
    int qidx = qw + r32; const bool active = qw < L; if (qidx >= L) qidx = L - 1;
    const size_t qrow = rowbase + res + wg2 + (size_t)d * qidx;
    { auto rr = __builtin_amdgcn_permlane32_swap(__float_as_uint(lt), __float_as_uint(lt), false, false); lt = __uint_as_float(rr[0]) + __uint_as_float(rr[1]); }
    LAS float* wsf = (LAS float*)(F.lds + fa::L_WS) + wid * 64;
    if (hi == 0) wsf[32 + r32] = lt;
    asm volatile("s_waitcnt lgkmcnt(0)" ::: "memory");
    float rli[16];
#pragma unroll
    for (int r = 0; r < 16; ++r) rli[r] = __builtin_amdgcn_rcpf(wsf[32 + fa::crow(r, hi)]);
    LAS bf16_t* stg = (LAS bf16_t*)(F.lds + L_BST) + wid * 1024;
    bf16_t* BP = F.BPART + (size_t)g * RS * 256;
#pragma unroll
    for (int half = 0; half < 2; ++half) {
#pragma unroll
        for (int rr_ = 0; rr_ < 8; ++rr_) { const int r = half * 8 + rr_; const int lrow = fa::crow(r, hi) - 16 * half;
#pragma unroll
            for (int d0 = 0; d0 < 2; ++d0) stg[lrow * 64 + d0 * 32 + r32] = (bf16_t)(pk2(o[d0][r] * rli[r], 0.f) & 0xffffu); }
        asm volatile("s_waitcnt lgkmcnt(0)" ::: "memory");
        if (active) {
#pragma unroll
            for (int i = 0; i < 2; ++i) { const int row = i * 8 + (lane >> 3), ch = lane & 7;
                const u32x4 w = *(LAS const u32x4*)(stg + row * 64 + ch * 8);
                const size_t orow = rowbase + res + wg2 + (size_t)d * (qw + 16 * half + row);
                *(u32x4*)(BP + orow * 256 + h * 64 + ch * 8) = w; } }
        asm volatile("s_waitcnt lgkmcnt(0)" ::: "memory");
    }
    if (active && hi == 0) F.BLSE[((size_t)g * RS + qrow) * 4 + h] = mh + __log2f(lt);
}
__device__ __forceinline__ void unit_B(Frame& F, int s, int layer, int u, int un, bf16x8 (&qr)[4]) {
    const BPar P = b_decode(s, u);
    int tid_ = F.tid; asm volatile("" : "+v"(tid_)); const int lane = tid_ & 63, r32 = lane & 31, hi = lane >> 5, wid = __builtin_amdgcn_readfirstlane(tid_ >> 6);
    const int g = P.g, h = P.h, d = P.d, L = P.L; const size_t rowbase = P.rowbase; const int res = P.res;
    const int wg2 = P.pack ? (wid >> 2) : 0; const int qw = P.pack ? (wid & 3) * 32 : P.q0 + wid * 32;
    LAS float* tab = (LAS float*)(F.lds + LT_B) + (g * 4 + h) * 320;
    int qidx = qw + r32; const bool active = qw < L; if (qidx >= L) qidx = L - 1;
    const size_t qrow = rowbase + res + wg2 + (size_t)d * qidx;
    f32x16 o[2]; float mh, lt;
    LAS const float* bk = (LAS const float*)(F.lds + LT_BK);
    fa::b3_compute(F.lds, qr, P.NT, wg2 * P.NT, tab, qw, 64 * P.tlo, active, bk[h], bk[4 + h], o, mh, lt, tid_);
    if (un >= 0) { const BPar PN = b_decode(s, un); b_dma(F, PN, tid_); b_qload(F, PN, tid_, qr); }
    epilogue_B(F, s, u, o, mh, lt);
}
__device__ __forceinline__ void phase_bcomb(Frame& F, int s) {
    const int gw = F.vcu * 8 + F.wave, NGW = F.G * 8; const int lane = F.lane, h = lane >> 4, c4 = (lane & 15) * 4;
    constexpr int NB = 4;
    for (int lr0 = gw; lr0 < RS; lr0 += NB * NGW) {
        float ls[NB][3]; u32x2 pv_[NB][3]; u32x2 gt[NB];
#pragma unroll
        for (int k = 0; k < NB; ++k) { int lr = lr0 + k * NGW; if (lr >= RS) lr = RS - 1;
#pragma unroll
            for (int g = 0; g < 3; ++g) { ls[k][g] = F.BLSE[((size_t)g * RS + lr) * 4 + h]; pv_[k][g] = *(const u32x2*)(F.BPART + ((size_t)g * RS + lr) * 256 + h * 64 + c4); }
            gt[k] = *(const u32x2*)(F.PROJ + (size_t)lr * INW + C_BG + h * 64 + c4); }
#pragma unroll
        for (int k = 0; k < NB; ++k) { const int lr = lr0 + k * NGW; if (lr < RS) {
            const float m = fmaxf(ls[k][0], fmaxf(ls[k][1], ls[k][2]));
            float w[3], ws_ = 0.f;
#pragma unroll
            for (int g = 0; g < 3; ++g) { w[g] = exp2f(ls[k][g] - m); ws_ += w[g]; }
            const float inv = 1.f / ws_; float y[4] = {0.f, 0.f, 0.f, 0.f};
#pragma unroll
            for (int g = 0; g < 3; ++g) { const float wg = w[g] * inv; y[0] += wg * bflo(pv_[k][g].x); y[1] += wg * bfhi(pv_[k][g].x); y[2] += wg * bflo(pv_[k][g].y); y[3] += wg * bfhi(pv_[k][g].y); }
            u32x2 ow; ow.x = pk2(y[0] * fa::silu(bflo(gt[k].x)), y[1] * fa::silu(bfhi(gt[k].x))); ow.y = pk2(y[2] * fa::silu(bflo(gt[k].y)), y[3] * fa::silu(bfhi(gt[k].y)));
            *(u32x2*)(F.XNM + ((size_t)s * RS + lr) * MIXW + 256 + h * 64 + c4) = ow; } }
    }
}

struct HookD {
    LAS const float* tab;
    int R, kr_lo, r0, c, cs, hi;
    __device__ __forceinline__ bool skip(int t) const { const int kr = kr_lo + t; return kr < r0 || kr > r0 + 7; }
    __device__ __forceinline__ void apply(f32x16& p0, f32x16& p1, int t) const {
        const int kr = kr_lo + t; LAS const float* tp = tab + (kr - R + 7) * 31 + 15 - c + 4 * hi;
#pragma unroll
        for (int r = 0; r < 16; ++r) { const int kk = (r & 3) + 8 * (r >> 2);
            { const int kc = kk + 4 * hi; const bool ok = (unsigned)(kc - cs) < 16u; const float bv = tp[ok ? kk : (c - 4 * hi)]; p0[r] = ok ? p0[r] + bv : -INFINITY; }
            { const int kc = kk + 32 + 4 * hi; const bool ok = (unsigned)(kc - cs) < 16u; const float bv = tp[ok ? kk + 32 : (c - 4 * hi)]; p1[r] = ok ? p1[r] + bv : -INFINITY; } }
    }
};
__device__ __forceinline__ int d_r0(int R, int rows) { int v = R - 4; if (v < 0) v = 0; if (v > rows - 8) v = rows - 8; return v; }
__device__ __forceinline__ void unit_D(Frame& F, int s, int layer, int bh, int u4) {
    const int n = s ? 2048 : 8192; const int rows = n >> 6; const int b = bh >> 2, h = bh & 3; int tid_ = F.tid; asm volatile("" : "+v"(tid_)); const int lane = tid_ & 63, r32 = lane & 31, wid = __builtin_amdgcn_readfirstlane(tid_ >> 6);
    const size_t rowbase = (size_t)b * n; const int R0 = 4 * u4;
    const int kr_lo = d_r0(R0, rows), kr_hi = d_r0(R0 + 3, rows) + 7; const int NT = kr_hi - kr_lo + 1;
    const int R = R0 + (wid >> 1), c = 32 * (wid & 1) + r32; const int r0w = d_r0(R, rows);
    const size_t qrow = rowbase + 64 * R + c;
    const bf16_t* qptr = F.PROJ + qrow * INW + C_DQ + h * 64;
    const size_t krow0 = rowbase + (size_t)64 * kr_lo;
    KVLinear kv{F.PROJ + krow0 * INW + C_DK + h * 64, F.PROJ + krow0 * INW + C_DV + h * 64};
    LAS const float* bk = (LAS const float*)(F.lds + LT_BK);
    f32x16 o[2];
    fa::flash_core_d(F.lds, qptr, kv, NT, r0w - kr_lo, r0w + 7 - kr_lo, kr_lo - R + 7, c, bk[8 + h], bk[12 + h], F.in[14] + ((size_t)layer * 4 + h) * 465, o, tid_);
    LAS float* stg = (LAS float*)(F.lds + fa::L_OST) + wid * 2048;
    fa::stage_o(stg, o, r32, lane >> 5);
    const size_t lrow0 = rowbase + 64 * R + 32 * (wid & 1);
    store_gated(F, stg, lrow0, (size_t)s * RS + lrow0, C_DG + h * 64, 768 + h * 64, lane);
    asm volatile("s_waitcnt lgkmcnt(0)\n\ts_barrier" ::: "memory");
}

__device__ __forceinline__ void phase_mixers(Frame& F, int s, int layer) {
    const int G = F.G, v = F.vcu;
    const int sh = s ? 3 : 5;
    unsigned* c_prep = (unsigned*)(F.ws + WS_CTL) + CW_SPLIT + 64 * (2 * (layer * 2 + s));
    unsigned* c_b = c_prep + 64;
    unsigned* c_pb = (unsigned*)(F.ws + WS_CTL) + CW_SPLIT + 64 * 8 + 64 * (layer * 2 + s);
#ifndef UN_MASK
#define UN_MASK 0xF
#endif
    { LAS float* tc = (LAS float*)(F.lds + LT_C); LAS float* tbb = (LAS float*)(F.lds + LT_B);
      { LAS float* tr_ = (LAS float*)(F.lds + LT_ROPE); for (int i = F.tid; i < 128 * 16 * 2; i += 512) tr_[i] = F.TAB[T_ROPE + i]; }
      for (int i = F.tid; i < 12 * 320; i += 512) tbb[i] = F.TAB[T_B + i];
      for (int i = F.tid; i < 4 * 641; i += 512) tc[i] = F.TAB[T_C + i];
      asm volatile("s_waitcnt vmcnt(0) lgkmcnt(0)\n\ts_barrier" ::: "memory"); }
    phase_prepB(F, s, layer);
    split_arrive(c_pb);
    phase_prep(F, s, layer);
    split_arrive(c_prep);
    split_wait(c_pb, (unsigned)G);
    { LAS float* bk = (LAS float*)(F.lds + LT_BK);
      { int t_ = F.tid; asm volatile("" : "+v"(t_));
        if (t_ < 16) { const int grp = t_ >> 2, j = t_ & 3; float val;
          if (grp == 0) val = __uint_as_float(((const unsigned*)(F.ws + WS_CTL))[CW_KMAXB + (layer * 2 + s) * 4 + j]) * 1.01f;
          else if (grp == 1) val = F.TAB[T_BMAXB + j];
          else if (grp == 2) val = __uint_as_float(((const unsigned*)(F.ws + WS_CTL))[CW_KMAXD + (layer * 2 + s) * 4 + j]) * 1.01f;
          else val = F.TAB[T_BMAXD + layer * 4 + j];
          bk[t_] = val; } }
      asm volatile("s_waitcnt vmcnt(0) lgkmcnt(0)\n\ts_barrier" ::: "memory"); }
    if (UN_MASK & 4) { const int nB = 768; bf16x8 qrB[4];
        if (v < nB) { const BPar P0 = b_decode(s, v); int tid_ = F.tid; asm volatile("" : "+v"(tid_)); b_dma(F, P0, tid_); b_qload(F, P0, tid_, qrB); }
        for (int u = v; u < nB; u += G) unit_B(F, s, layer, u, (u + G < nB) ? u + G : -1, qrB);
        asm volatile("s_waitcnt vmcnt(0) lgkmcnt(0)\n\ts_barrier" ::: "memory"); }
    split_arrive(c_b);
    if (UN_MASK & 8) for (int u = v; u < 256; u += G) unit_D(F, s, layer, u >> sh, u & ((1 << sh) - 1));
    split_wait(c_prep, (unsigned)G);
    if (UN_MASK & 2) for (int u = v; u < 512; u += G) unit_Ct(F, s, layer, u >> (sh + 1), u & ((2 << sh) - 1));
    if (UN_MASK & 1) for (int u = v; u < 256; u += G) unit_A(F, s, layer, u >> sh, u & ((1 << sh) - 1));
    split_wait(c_b, (unsigned)G);
    phase_bcomb(F, s);
}

constexpr int N_PHASES = 11;
#ifndef PH_MASK
#define PH_MASK 0xFF
#endif
#define PH_ON(b) ((PH_MASK >> (b)) & 1)
struct Args { const float* in[15]; float* out; unsigned char* ws; int ph_lo, ph_hi; };
__global__ void __launch_bounds__(512, 2) enc_fwd(Args args) {
    extern __shared__ __attribute__((aligned(16))) unsigned char lds_raw[];
    Frame F;
    F.lds = (LAS unsigned char*)lds_raw;
    F.tid = threadIdx.x; F.lane = F.tid & 63; F.wave = __builtin_amdgcn_readfirstlane(F.tid >> 6);
    F.G = gridDim.x; { const int bx = blockIdx.x; F.vcu = (F.G % 8 == 0) ? (bx % 8) * (F.G / 8) + bx / 8 : bx; }
    typedef __attribute__((address_space(4))) const unsigned char* kaptr_t;
    unsigned char* ws0 = args.ws; const int wave0 = __builtin_amdgcn_readfirstlane((int)threadIdx.x >> 6);
    volatile LAS unsigned* MISC = (volatile LAS unsigned*)(F.lds + MISC_OFF);
    for (int u = F.tid; u < (LDS_BYTES - LDSCTL_OFF) / 4; u += 512) ((LAS unsigned*)(F.lds + LDSCTL_OFF))[u] = 0u;
    __syncthreads();
    const bool multi = (args.ph_hi - args.ph_lo) > 1;
    XcdBarrier bar; bar.bar = (unsigned*)(ws0 + WS_CTL) + CW_BAR; bar.x = 0; bar.st = nullptr;
    if (multi) bar = xcd_barrier_post((unsigned*)(ws0 + WS_CTL) + CW_BAR, MISC + 8);

    for (int p = args.ph_lo; p < args.ph_hi; ++p) {
        { unsigned z_; asm volatile("s_mov_b32 %0, 0" : "=s"(z_)); int t_ = (wave0 << 6) | (int)__builtin_amdgcn_mbcnt_hi(~0u, __builtin_amdgcn_mbcnt_lo(~0u, z_)); asm volatile("" : "+v"(t_)); F.tid = t_; F.lane = t_ & 63; F.wave = __builtin_amdgcn_readfirstlane(t_ >> 6); }
        { kaptr_t ka = (kaptr_t)__builtin_amdgcn_kernarg_segment_ptr(); asm volatile("" : "+s"(ka));
          F.in = (const float* const __attribute__((address_space(4)))*)ka;
          unsigned char* ws_ = *(unsigned char* const __attribute__((address_space(4)))*)(ka + 16 * 8); float* out_ = *(float* const __attribute__((address_space(4)))*)(ka + 15 * 8); F.out = out_; F.ws = ws_;
          F.WIN = (bf16_t*)(ws_ + WS_WIN); F.WOUT = (bf16_t*)(ws_ + WS_WOUT); F.XNM = (bf16_t*)(ws_ + WS_XNM); F.PROJ = (bf16_t*)(ws_ + WS_PROJ);
          F.BPART = (bf16_t*)(ws_ + WS_BPART); F.BLSE = (float*)(ws_ + WS_BLSE); F.TAB = (float*)(ws_ + WS_TAB); }
        int kind, layer = 0, st = 0;
        if (p == 0) kind = 0;
        else { layer = (p - 1) / 5; const int r = (p - 1) % 5; if (r == 4) kind = 4; else { kind = 2 + (r & 1); st = r >> 1; } }
        if (kind == 0) { phase_prologue(F); phase_xn(F, 0); }
        else if (kind == 4) {
            pg8::Gemm g{F.XNM, F.WOUT + (size_t)layer * DMODEL * MIXW, MTOT, DMODEL, MIXW};
            pg8::PanelRms st_{(float*)(F.ws + WS_XSLOT), (unsigned*)(F.ws + WS_CTL) + CW_PANEL + layer * 128 * 64, RMS_EPS};
            for (int rd = 0; rd < 2; ++rd) {
                pg8::RoundOrder S; S.so.init(MTOT, DMODEL, F.G, (int)blockIdx.x); S.round = rd;
                if (layer == 0) { pg8::EpiRmsOut<false> E{F.in[0], F.in[1], RS, F.out, F.XNM, nullptr, DMODEL, st_};
                    pg8::gemm_phase<pg8::EpiRmsOut<false>, pg8::RoundOrder, false, true>(F.lds, g, S, E, F.tid); }
                else { pg8::EpiRmsOut<true> E{F.out, F.out + (size_t)RS * DMODEL, RS, F.out, nullptr, F.in[5], DMODEL, st_};
                    pg8::gemm_phase<pg8::EpiRmsOut<true>, pg8::RoundOrder, false, true>(F.lds, g, S, E, F.tid); }
            }
        } else if (kind == 2) {
            pg8::Gemm g{F.XNM + (size_t)st * RS * DMODEL, F.WIN + (size_t)layer * INW * DMODEL, RS, INW, DMODEL}; pg8::StaticOrder S; S.init(RS, INW, F.G, (int)blockIdx.x);
            pg8::EpiBf16 E{F.PROJ, INW};
            pg8::gemm_phase<pg8::EpiBf16, pg8::StaticOrder, true, true>(F.lds, g, S, E, F.tid);
        } else phase_mixers(F, st, layer);
        if (p + 1 < args.ph_hi) xcd_barrier(bar);
    }
}

extern "C" void kernel_launch(void* const* d_in, const int* in_sizes, int n_in, void* d_out, int out_size, void* d_ws, size_t ws_size, hipStream_t stream) {
    static int grid = 0;
    if (grid == 0) {
        if (n_in != 15 || out_size != MTOT * DMODEL || ws_size < WS_END) { fprintf(stderr, "kernel_launch: unexpected shapes (n_in %d out %d ws %zu)\n", n_in, out_size, ws_size); grid = -1; return; }
        int dev = 0, cus = 0, per_cu = 0;
        if (hipGetDevice(&dev) != hipSuccess || hipDeviceGetAttribute(&cus, hipDeviceAttributeMultiprocessorCount, dev) != hipSuccess) { grid = -1; return; }
        if (hipFuncSetAttribute((const void*)enc_fwd, hipFuncAttributeMaxDynamicSharedMemorySize, LDS_BYTES) != hipSuccess) { fprintf(stderr, "kernel_launch: hipFuncSetAttribute failed\n"); grid = -1; return; }
        if (hipOccupancyMaxActiveBlocksPerMultiprocessor(&per_cu, (const void*)enc_fwd, 512, LDS_BYTES) != hipSuccess || per_cu < 1) { fprintf(stderr, "kernel_launch: occupancy query says %d\n", per_cu); per_cu = 1; }
        (void)hipGetLastError();
        grid = cus;
    }
    if (grid < 0) return;
    (void)hipMemsetAsync((char*)d_ws + WS_CTL, 0, CTL_ZERO_BYTES, stream);
    Args a{};
    for (int i = 0; i < 15; ++i) a.in[i] = (const float*)d_in[i];
    a.out = (float*)d_out; a.ws = (unsigned char*)d_ws;
#if MK_ONE_LAUNCH
    a.ph_lo = 0; a.ph_hi = N_PHASES;
    hipLaunchKernelGGL(enc_fwd, dim3(grid), dim3(512), LDS_BYTES, stream, a);
#else
    for (int p = 0; p < N_PHASES; ++p) { a.ph_lo = p; a.ph_hi = p + 1; hipLaunchKernelGGL(enc_fwd, dim3(grid), dim3(512), LDS_BYTES, stream, a); }
#endif
}
```

```cpp
#include <hip/hip_runtime.h>
#include <hip/hip_bf16.h>
#include <cstdio>
#include <cstdint>

#ifndef MK_ONE_LAUNCH
#define MK_ONE_LAUNCH 1
#endif

#define LAS __attribute__((address_space(3)))
#define GAS __attribute__((address_space(1)))
typedef unsigned short bf16_t;
typedef short bf16x8 __attribute__((ext_vector_type(8)));
typedef short s16x4 __attribute__((ext_vector_type(4)));
typedef short v4i16_t __attribute__((ext_vector_type(4)));
typedef float f32x2 __attribute__((ext_vector_type(2)));
typedef float f32x4 __attribute__((ext_vector_type(4)));
typedef float f32x16 __attribute__((ext_vector_type(16)));
typedef unsigned u32x2 __attribute__((ext_vector_type(2)));
typedef unsigned u32x4 __attribute__((ext_vector_type(4)));

constexpr int DMODEL = 1024, INW = 3840, MIXW = 1024, DEPTH = 2;
constexpr int RS = 16384;
constexpr int MTOT = 2 * RS;
constexpr float RMS_EPS = 1e-6f;
constexpr float LOG2E = 1.4426950408889634f;
constexpr int C_AQ = 0, C_AK = 256, C_AV = 384, C_AG = 512, C_BQ = 768, C_BK = 1024, C_BV = 1280, C_BG = 1536;
constexpr int C_CQ = 1792, C_CK = 2048, C_CV = 2304, C_CG = 2560, C_DQ = 2816, C_DK = 3072, C_DV = 3328, C_DG = 3584;

constexpr size_t MiB = 1u << 20;
constexpr size_t WS_CTL = 0, CTL_ZERO_BYTES = 192 * 1024;
constexpr size_t WS_XSLOT = 1 * MiB + 512 * 1024;
constexpr int CW_KMAXD = 40576;
constexpr int CW_KMAXB = 40512;
constexpr int CW_KMAXA = 40000, CW_KMAXC = 40192;
constexpr int CW_PANEL = 16384;
constexpr size_t WS_TAB = 1 * MiB;
constexpr size_t WS_WIN = 2 * MiB;
constexpr size_t WS_WOUT = 17 * MiB;
constexpr size_t WS_XNM = 22 * MiB;
constexpr size_t WS_PROJ = 86 * MiB;
constexpr size_t WS_BPART = 206 * MiB;
constexpr size_t WS_BLSE = 230 * MiB;
constexpr size_t WS_END = 231 * MiB;
constexpr size_t WS_X1 = 232 * MiB;
constexpr size_t WS_END_X1 = WS_X1 + 64 * MiB;
constexpr int T_ROPE = 0;
constexpr int T_C = 4096;
constexpr int T_B = T_C + 4 * 641;
constexpr int T_LAM = T_B + 3 * 4 * 320;
constexpr int T_BMAX = T_LAM + 2;
constexpr int T_BMAXB = T_BMAX + 4;
constexpr int T_BMAXD = T_BMAXB + 4;
constexpr int CW_BAR = 1024;

constexpr int RING_BYTES = 131072;
constexpr int LDSCTL_OFF = RING_BYTES, MISC_OFF = LDSCTL_OFF + 320;
constexpr int LDS_BYTES = 163840;
constexpr int LT_ROPE = 0;
constexpr int LT_B = 143 * 1024;
constexpr int LT_C = 132 * 1024;
constexpr int LT_BK = LT_B + 12 * 320 * 4;
static_assert(LT_C + 4 * 641 * 4 <= LT_B && LT_BK + 64 <= LDS_BYTES, "LDS tables");

__device__ __forceinline__ unsigned f2bf(float f) { unsigned u = __builtin_bit_cast(unsigned, f); return (u + 0x7fffu + ((u >> 16) & 1u)) >> 16; }
typedef __bf16 bf16x2_hw __attribute__((ext_vector_type(2)));
__device__ __forceinline__ unsigned pk2(float lo, float hi) { f32x2 v = {lo, hi}; bf16x2_hw b = __builtin_convertvector(v, bf16x2_hw); return __builtin_bit_cast(unsigned, b); }
__device__ __forceinline__ float bf2f(unsigned short b) { return __builtin_bit_cast(float, (unsigned)b << 16); }
__device__ __forceinline__ float bflo(unsigned w) { return __builtin_bit_cast(float, w << 16); }
__device__ __forceinline__ float bfhi(unsigned w) { return __builtin_bit_cast(float, w & 0xffff0000u); }

namespace pg8 {
constexpr int BM = 256, BK = 64, HALF = 128, HTB = HALF * BK * 2, STAGE_BYTES = 8 * HTB, NXCD = 8, WGM = 8;
__host__ __device__ __forceinline__ int lds_byte(int r, int c) { const int st = (r >> 4) * 2 + (c >> 5), rr = r & 15, cc = c & 31, ob = rr * 64 + cc * 2; return st * 1024 + (ob ^ (((ob >> 9) & 1) << 5)); }
__host__ __device__ __forceinline__ void stage_rc(int b, int& R, int& C) { const int st = b / 1024, sb = b % 1024, swz = sb ^ (((sb >> 9) & 1) << 5); R = (st >> 1) * 16 + swz / 64; C = (st & 1) * 32 + (swz % 64) / 2; }
__host__ __device__ __forceinline__ int perm32(int rho) { const int n = rho >> 4, i = rho & 15; return 8 * (i >> 2) + 4 * n + (i & 3); }
struct Unit { int pm, pn; };
struct Gemm { const bf16_t* A; const bf16_t* Bt; int M, N, K; };
struct StaticOrder {
    int nM, nN, nwg, G, c; unsigned* gate;
    __host__ __device__ void init(int M, int N, int G_, int c_) { nM = M / BM; nN = N / BM; nwg = nM * nN; G = G_; c = c_; gate = nullptr; }
    __device__ __forceinline__ void pre_store(int ui) const {
        if (ui == 0 && gate != nullptr) {
            unsigned t_ = threadIdx.x; asm volatile("" : "+v"(t_));
            if (t_ == 0u) { unsigned sp = 0u; while (__hip_atomic_load(gate, __ATOMIC_RELAXED, __HIP_MEMORY_SCOPE_AGENT) < (unsigned)G) { __builtin_amdgcn_s_sleep(2); if (++sp > (1u << 24)) break; } }
            __builtin_amdgcn_s_barrier();
        }
    }
    __host__ __device__ bool next(int i, Unit& u) const {
        const long L = (long)i * G + c; if (L >= nwg) return false;
        int wgid = (int)L; { const int q = nwg / NXCD, r = nwg % NXCD, xcd = wgid % NXCD, off = wgid / NXCD; wgid = (xcd < r ? xcd * (q + 1) : r * (q + 1) + (xcd - r) * q) + off; }
        const int nig = WGM * nN, gid = wgid / nig, fm = gid * WGM, gsz = (nM - fm) < WGM ? (nM - fm) : WGM;
        u.pm = fm + ((wgid % nig) % gsz); u.pn = (wgid % nig) / gsz; return true;
    }
    __device__ __forceinline__ void a_ready(const Unit&) const {}
    __device__ __forceinline__ void done(const Unit&) const {}
};
__device__ __forceinline__ unsigned cvt_pk_bf16(float lo, float hi) { unsigned r; asm volatile("v_cvt_pk_bf16_f32 %0, %1, %2" : "=v"(r) : "v"(lo), "v"(hi)); return r; }

struct EpiBf16 {
    static constexpr bool PERM = true, AFTER_DRAIN = false;
    bf16_t* O; int ldc; const float* rsx; float eps;
    __device__ __forceinline__ void operator()(const f32x4 (&acc)[2][2][4][2], const Unit& u, int wr, int wc, int fr, int fq) const {
        const int row0 = u.pm * BM + wr * 64 + fr; const int col0 = u.pn * BM + wc * 32 + 8 * fq;
#pragma unroll
        for (int ai = 0; ai < 2; ++ai)
#pragma unroll
            for (int m = 0; m < 4; ++m) { bf16_t* rowp = O + (size_t)(row0 + ai * HALF + m * 16) * ldc + col0;
                float rs = 1.f;
                if (rsx) { const f32x4 sl = *(const f32x4*)(rsx + (size_t)(row0 + ai * HALF + m * 16) * 4); rs = 1.0f / sqrtf(((sl.x + sl.y) + (sl.z + sl.w)) * (1.0f / 1024.0f) + eps); }
#pragma unroll
                for (int bj = 0; bj < 2; ++bj) { const f32x4 v0 = acc[ai][bj][m][0] * rs, v1 = acc[ai][bj][m][1] * rs;
                    u32x4 w; w.x = cvt_pk_bf16(v0[0], v0[1]); w.y = cvt_pk_bf16(v0[2], v0[3]); w.z = cvt_pk_bf16(v1[0], v1[1]); w.w = cvt_pk_bf16(v1[2], v1[3]);
                    *(u32x4*)(rowp + bj * HALF) = w; } }
    }
};
struct EpiResF32 {
    static constexpr bool PERM = false, AFTER_DRAIN = false;
    const float* base0; const float* base1; int split_row; float* out; int ldc;
    __device__ __forceinline__ void operator()(const f32x4 (&acc)[2][2][4][2], const Unit& u, int wr, int wc, int fr, int fq) const {
        const int col0 = u.pn * BM + wc * 32 + 4 * fq;
#pragma unroll
        for (int ai = 0; ai < 2; ++ai)
#pragma unroll
            for (int m = 0; m < 4; ++m) { const int r = u.pm * BM + ai * HALF + wr * 64 + m * 16 + fr;
                const float* b = (r < split_row) ? base0 + (size_t)r * ldc : base1 + (size_t)(r - split_row) * ldc;
                float* o = out + (size_t)r * ldc;
#pragma unroll
                for (int bj = 0; bj < 2; ++bj)
#pragma unroll
                    for (int n = 0; n < 2; ++n) { const int off = col0 + bj * HALF + n * 16; const f32x4 bs = *(const f32x4*)(b + off); *(f32x4*)(o + off) = bs + acc[ai][bj][m][n]; } }
    }
};

struct PanelRms {
    float* xbuf; unsigned* cnt; float eps;
    __device__ __forceinline__ void run(const f32x4 (&v)[2][2][4][2], const Unit& u, int wr, int wc, int fr, int fq, LAS unsigned char* lds, int wid, int lane) const {
        LAS float* P = (LAS float*)lds;
        LAS float* S = (LAS float*)(lds + 8192);
        LAS unsigned* flag = (LAS unsigned*)(lds + 8192 + 2048);
#pragma unroll
        for (int ai = 0; ai < 2; ++ai)
#pragma unroll
            for (int m = 0; m < 4; ++m) { float q = 0.f;
#pragma unroll
                for (int bj = 0; bj < 2; ++bj)
#pragma unroll
                    for (int n = 0; n < 2; ++n) { const f32x4 x = v[ai][bj][m][n]; q += (x[0] * x[0] + x[1] * x[1]) + (x[2] * x[2] + x[3] * x[3]); }
                q += __shfl_xor(q, 16); q += __shfl_xor(q, 32);
                if (fq == 0) P[(ai * HALF + wr * 64 + m * 16 + fr) * 4 + wc] = q; }
        asm volatile("s_waitcnt lgkmcnt(0)" ::: "memory"); __builtin_amdgcn_s_barrier(); asm volatile("" ::: "memory");
        const int row = wid * 32 + (lane & 31);
        if (lane < 32) { const float t = (P[row * 4 + 0] + P[row * 4 + 1]) + (P[row * 4 + 2] + P[row * 4 + 3]);
            __hip_atomic_store(xbuf + ((size_t)(u.pm * BM + row) * 4 + u.pn), t, __ATOMIC_RELAXED, __HIP_MEMORY_SCOPE_AGENT); }
        asm volatile("s_waitcnt vmcnt(0)" ::: "memory");
        if (lane == 0) __hip_atomic_fetch_add(cnt + 64 * u.pm, 1u, __ATOMIC_RELAXED, __HIP_MEMORY_SCOPE_AGENT);
        if (wid == 0) {
            unsigned sp = 0u;
            for (;;) { if ((unsigned)__builtin_amdgcn_readfirstlane(__hip_atomic_load(cnt + 64 * u.pm, __ATOMIC_RELAXED, __HIP_MEMORY_SCOPE_AGENT)) >= 32u) break;
                __builtin_amdgcn_s_sleep(2); if (++sp > (1u << 22)) break; }
            asm volatile("" ::: "memory");
            if (lane == 0) flag[0] = 1u;
        }
        asm volatile("s_waitcnt vmcnt(0) lgkmcnt(0)" ::: "memory"); __builtin_amdgcn_s_barrier(); asm volatile("" ::: "memory");
        if (lane < 32) { const float* sl = xbuf + (size_t)(u.pm * BM + row) * 4; float t = 0.f;
#pragma unroll
            for (int k = 0; k < 4; ++k) t += __hip_atomic_load(sl + k, __ATOMIC_RELAXED, __HIP_MEMORY_SCOPE_AGENT);
            S[row] = 1.0f / sqrtf(t * (1.0f / 1024.0f) + eps); }
        asm volatile("s_waitcnt lgkmcnt(0)" ::: "memory"); __builtin_amdgcn_s_barrier(); asm volatile("" ::: "memory");
    }
};
template <bool FINAL, bool XB = false> struct EpiRmsOut {
    static constexpr bool PERM = false, AFTER_DRAIN = true;
    const float* base0; const float* base1; int split_row; float* out; bf16_t* xn; const float* gain; int ldc; PanelRms st; bf16_t* x1b;
    __device__ __forceinline__ void fused(f32x4 (&acc)[2][2][4][2], const Unit& u, int wr, int wc, int fr, int fq, LAS unsigned char* lds, int wid, int lane) const {
        const LAS float* S = (const LAS float*)(lds + 8192);
        const int col0 = u.pn * BM + wc * 32 + 4 * fq;
        f32x4 bq[3][2][2];
#define PG8_LDBASE(buf, g_) do { const int ai_ = (g_) >> 2, m_ = (g_) & 3; const int r = u.pm * BM + ai_ * HALF + wr * 64 + m_ * 16 + fr; \
            const float* b = (r < split_row) ? base0 + (size_t)r * ldc : base1 + (size_t)(r - split_row) * ldc; \
            if (FINAL && XB) { const bf16_t* bb = x1b + (size_t)r * ldc; \
                _Pragma("unroll") for (int bj = 0; bj < 2; ++bj) _Pragma("unroll") for (int n = 0; n < 2; ++n) { const u32x2 w_ = *(const u32x2*)(bb + col0 + bj * HALF + n * 16); \
                    bq[buf][bj][n] = (f32x4){__uint_as_float(w_.x << 16), __uint_as_float(w_.x & 0xffff0000u), __uint_as_float(w_.y << 16), __uint_as_float(w_.y & 0xffff0000u)}; } } \
            else { _Pragma("unroll") for (int bj = 0; bj < 2; ++bj) _Pragma("unroll") for (int n = 0; n < 2; ++n) bq[buf][bj][n] = *(const f32x4*)(b + col0 + bj * HALF + n * 16); } } while (0)
#define PG8_ADDBASE(buf, g_) do { const int ai_ = (g_) >> 2, m_ = (g_) & 3; \
            _Pragma("unroll") for (int bj = 0; bj < 2; ++bj) _Pragma("unroll") for (int n = 0; n < 2; ++n) acc[ai_][bj][m_][n] += bq[buf][bj][n]; \
            asm volatile("" : "+v"(acc[ai_][0][m_][0]), "+v"(acc[ai_][0][m_][1]), "+v"(acc[ai_][1][m_][0]), "+v"(acc[ai_][1][m_][1])); } while (0)
        PG8_LDBASE(0, 0); PG8_LDBASE(1, 1); asm volatile("" ::: "memory");
        PG8_LDBASE(2, 2); asm volatile("" ::: "memory"); PG8_ADDBASE(0, 0);
        PG8_LDBASE(0, 3); asm volatile("" ::: "memory"); PG8_ADDBASE(1, 1);
        PG8_LDBASE(1, 4); asm volatile("" ::: "memory"); PG8_ADDBASE(2, 2);
        PG8_LDBASE(2, 5); asm volatile("" ::: "memory"); PG8_ADDBASE(0, 3);
        PG8_LDBASE(0, 6); asm volatile("" ::: "memory"); PG8_ADDBASE(1, 4);
        PG8_LDBASE(1, 7); asm volatile("" ::: "memory"); PG8_ADDBASE(2, 5);
        PG8_ADDBASE(0, 6); PG8_ADDBASE(1, 7);
#undef PG8_LDBASE
#undef PG8_ADDBASE
        f32x4 ggv[2][2];
        if (FINAL) {
#pragma unroll
            for (int bj = 0; bj < 2; ++bj)
#pragma unroll
                for (int n = 0; n < 2; ++n) ggv[bj][n] = *(const f32x4*)(gain + col0 + bj * HALF + n * 16); }
        st.run(acc, u, wr, wc, fr, fq, lds, wid, lane);
#pragma unroll
        for (int ai = 0; ai < 2; ++ai)
#pragma unroll
            for (int m = 0; m < 4; ++m) { const int rl = ai * HALF + wr * 64 + m * 16 + fr; const float rs = S[rl]; const size_t off = (size_t)(u.pm * BM + rl) * ldc + col0;
#pragma unroll
                for (int bj = 0; bj < 2; ++bj)
#pragma unroll
                    for (int n = 0; n < 2; ++n) { const f32x4 x = acc[ai][bj][m][n]; const size_t o_ = off + bj * HALF + n * 16;
                        if (FINAL) { *(f32x4*)(out + o_) = x * rs * ggv[bj][n]; }
                        else if (XB) { u32x2 wx; wx.x = cvt_pk_bf16(x[0], x[1]); wx.y = cvt_pk_bf16(x[2], x[3]); *(u32x2*)(x1b + o_) = wx; }
                        else { *(f32x4*)(out + o_) = x; const f32x4 y = x * rs; u32x2 w; w.x = cvt_pk_bf16(y[0], y[1]); w.y = cvt_pk_bf16(y[2], y[3]); *(u32x2*)(xn + o_) = w; } }
                asm volatile("" ::: "memory"); }
        asm volatile("s_waitcnt lgkmcnt(0)" ::: "memory"); __builtin_amdgcn_s_barrier(); asm volatile("" ::: "memory");
    }
};
struct RoundOrder {
    StaticOrder so; int round;
    __device__ __forceinline__ bool next(int i, Unit& u) const { if (i > 0) return false; return so.next(round, u); }
    __device__ __forceinline__ void a_ready(const Unit&) const {}
    __device__ __forceinline__ void done(const Unit&) const {}
    __device__ __forceinline__ void pre_store(int) const {}
};

template <class Epi, class Sched, bool ALIGN_EPI = false, bool SP2 = false>
__device__ __forceinline__ void gemm_phase(LAS unsigned char* lds, const Gemm g, const Sched& S, const Epi& E, const int tid) {
    const int wid = __builtin_amdgcn_readfirstlane(tid >> 6), lane = tid & 63, wr = wid >> 2, wc = wid & 3, fr = lane & 15, fq = lane >> 4;
    const int K = g.K, nt = K / BK;
    unsigned voffA[2], voffB[2];
#pragma unroll
    for (int i = 0; i < 2; ++i) { int R, C; stage_rc(tid * 16 + i * 8192, R, C); const int Rb = Epi::PERM ? ((R & ~31) + perm32(R & 31)) : R;
        voffA[i] = (unsigned)(R * K + C) * 2u; voffB[i] = (unsigned)(Rb * K + C) * 2u; }
    const size_t kstep = (size_t)(BK * 2);
    const size_t hstep = (size_t)HALF * K * 2;
    const size_t tstep = 2 * hstep;
    const unsigned ldsw = (unsigned)wid * 1024u;
    const int aoff = lds_byte(wr * 64 + fr, fq * 8), boff = lds_byte(wc * 32 + fr, fq * 8);
#define PG8_SA(b, h) (((b) * 2 + (h)) * HTB)
#define PG8_SB(b, h) ((4 + (b) * 2 + (h)) * HTB)
#define PG8_STAGE(bufoff, gbase, voff) do { _Pragma("unroll") for (int _i = 0; _i < 2; ++_i) \
        __builtin_amdgcn_global_load_lds((const unsigned*)((const char*)(gbase) + (voff)[_i]), (LAS unsigned*)(lds + (bufoff) + ldsw + _i * 8192), 16, 0, 0); } while (0)
#define PG8_LDA(dst, b, h) do { _Pragma("unroll") for (int m = 0; m < 4; ++m) _Pragma("unroll") for (int k = 0; k < 2; ++k) dst[m][k] = *(const LAS bf16x8*)(lds + PG8_SA(b, h) + aoff + m * 2048 + k * 1024); } while (0)
#define PG8_LDB(dst, b, h) do { _Pragma("unroll") for (int n = 0; n < 2; ++n) _Pragma("unroll") for (int k = 0; k < 2; ++k) dst[n][k] = *(const LAS bf16x8*)(lds + PG8_SB(b, h) + boff + n * 2048 + k * 1024); } while (0)
#define PG8_MMA(ai, bj, At, Bt) do { __builtin_amdgcn_s_setprio(1); _Pragma("unroll") for (int m = 0; m < 4; ++m) _Pragma("unroll") for (int n = 0; n < 2; ++n) _Pragma("unroll") for (int k = 0; k < 2; ++k) \
        acc[ai][bj][m][n] = __builtin_amdgcn_mfma_f32_16x16x32_bf16(Bt[n][k], At[m][k], acc[ai][bj][m][n], 0, 0, 0); __builtin_amdgcn_s_setprio(0); } while (0)
#define PG8_WAIT_V(n) asm volatile("s_waitcnt vmcnt(" #n ")" ::: "memory")
#define PG8_WAIT_L(n) asm volatile("s_waitcnt lgkmcnt(" #n ")" ::: "memory")
#define PG8_BAR __builtin_amdgcn_s_barrier()
#define PG8_SCHED __builtin_amdgcn_sched_barrier(0)
    Unit cur, nxt; int ui = 0;
    if (!S.next(0, cur)) return;
    f32x4 acc[2][2][4][2];
#pragma unroll
    for (int a = 0; a < 2; ++a)
#pragma unroll
        for (int b = 0; b < 2; ++b)
#pragma unroll
            for (int m = 0; m < 4; ++m)
#pragma unroll
                for (int n = 0; n < 2; ++n) acc[a][b][m][n] = (f32x4){0.f, 0.f, 0.f, 0.f};
    bf16x8 At[4][2], B0[2][2], B1[2][2];
    const char* cA = (const char*)g.A + (size_t)cur.pm * tstep; const char* cB = (const char*)g.Bt + (size_t)cur.pn * tstep;
    S.a_ready(cur);
    if constexpr (SP2) {
        PG8_STAGE(PG8_SB(0, 0), cB, voffB); PG8_STAGE(PG8_SB(0, 1), cB + hstep, voffB); PG8_STAGE(PG8_SA(0, 0), cA, voffA); PG8_STAGE(PG8_SA(0, 1), cA + hstep, voffA);
        if (wr == 1) PG8_BAR;
        PG8_WAIT_V(2); PG8_BAR;
        PG8_STAGE(PG8_SB(1, 0), cB + kstep, voffB); PG8_STAGE(PG8_SA(1, 0), cA + kstep, voffA); PG8_STAGE(PG8_SB(1, 1), cB + hstep + kstep, voffB);
        PG8_WAIT_V(6); PG8_BAR;
    } else {
        PG8_STAGE(PG8_SB(0, 0), cB, voffB); PG8_STAGE(PG8_SA(0, 0), cA, voffA); PG8_STAGE(PG8_SB(0, 1), cB + hstep, voffB); PG8_STAGE(PG8_SA(0, 1), cA + hstep, voffA);
        if (wr == 1) PG8_BAR;
        PG8_WAIT_V(4); PG8_BAR;
        PG8_STAGE(PG8_SB(1, 0), cB + kstep, voffB); PG8_STAGE(PG8_SA(1, 0), cA + kstep, voffA); PG8_STAGE(PG8_SB(1, 1), cB + hstep + kstep, voffB);
        PG8_WAIT_V(6); PG8_BAR;
    }
    for (;;) {
        const bool has_next = S.next(ui + 1, nxt);
        const char* nA = has_next ? (const char*)g.A + (size_t)nxt.pm * tstep : cA; const char* nB = has_next ? (const char*)g.Bt + (size_t)nxt.pn * tstep : cB;
        for (int t = 0; t < nt; t += 2) {
            const bool last = (t == nt - 2);
            const char* a1 = cA + (size_t)(t + 1) * kstep;
            const char* a2 = last ? nA : cA + (size_t)(t + 2) * kstep; const char* b2 = last ? nB : cB + (size_t)(t + 2) * kstep;
            const char* a3 = a2 + kstep; const char* b3 = b2 + kstep;
            if (last && has_next) S.a_ready(nxt);
            if constexpr (SP2) {
            PG8_LDB(B0, 0, 0); PG8_LDB(B1, 0, 1); PG8_SCHED; PG8_LDA(At, 0, 0); PG8_STAGE(PG8_SA(1, 1), a1 + hstep, voffA);
            PG8_WAIT_V(8); PG8_WAIT_L(0); PG8_BAR; PG8_MMA(0, 0, At, B0); PG8_MMA(0, 1, At, B1); PG8_BAR; PG8_SCHED;
            PG8_LDA(At, 0, 1); PG8_STAGE(PG8_SB(0, 0), b2, voffB); PG8_STAGE(PG8_SB(0, 1), b2 + hstep, voffB); PG8_STAGE(PG8_SA(0, 0), a2, voffA);
            PG8_WAIT_V(8); PG8_WAIT_L(0); PG8_BAR; PG8_MMA(1, 0, At, B0); PG8_MMA(1, 1, At, B1); PG8_BAR; PG8_SCHED;
            PG8_LDB(B0, 1, 0); PG8_LDB(B1, 1, 1); PG8_SCHED; PG8_LDA(At, 1, 0); PG8_STAGE(PG8_SA(0, 1), a2 + hstep, voffA);
            PG8_WAIT_V(8); PG8_WAIT_L(0); PG8_BAR; PG8_MMA(0, 0, At, B0); PG8_MMA(0, 1, At, B1); PG8_BAR; PG8_SCHED;
            PG8_LDA(At, 1, 1); PG8_STAGE(PG8_SB(1, 0), b3, voffB); PG8_STAGE(PG8_SB(1, 1), b3 + hstep, voffB); PG8_STAGE(PG8_SA(1, 0), a3, voffA);
            PG8_WAIT_V(8); PG8_WAIT_L(0); PG8_BAR; PG8_MMA(1, 0, At, B0); PG8_MMA(1, 1, At, B1); PG8_BAR; PG8_SCHED;
            } else {
            PG8_LDB(B0, 0, 0); PG8_SCHED; PG8_LDA(At, 0, 0); PG8_STAGE(PG8_SA(1, 1), a1 + hstep, voffA);
            PG8_WAIT_L(8); PG8_BAR; PG8_WAIT_L(0); PG8_MMA(0, 0, At, B0); PG8_BAR; PG8_SCHED;
            PG8_LDB(B1, 0, 1); PG8_STAGE(PG8_SB(0, 0), b2, voffB);
            PG8_BAR; PG8_WAIT_L(0); PG8_MMA(0, 1, At, B1); PG8_BAR;
            PG8_LDA(At, 0, 1); PG8_STAGE(PG8_SA(0, 0), a2, voffA);
            PG8_BAR; PG8_WAIT_L(0); PG8_MMA(1, 0, At, B0); PG8_BAR; PG8_SCHED;
            PG8_STAGE(PG8_SB(0, 1), b2 + hstep, voffB);
            PG8_WAIT_V(6); PG8_BAR; PG8_MMA(1, 1, At, B1); PG8_BAR;
            PG8_LDB(B0, 1, 0); PG8_SCHED; PG8_LDA(At, 1, 0); PG8_STAGE(PG8_SA(0, 1), a2 + hstep, voffA);
            PG8_WAIT_L(8); PG8_BAR; PG8_WAIT_L(0); PG8_MMA(0, 0, At, B0); PG8_BAR; PG8_SCHED;
            PG8_LDB(B1, 1, 1); PG8_STAGE(PG8_SB(1, 0), b3, voffB);
            PG8_BAR; PG8_WAIT_L(0); PG8_MMA(0, 1, At, B1); PG8_BAR;
            PG8_LDA(At, 1, 1); PG8_STAGE(PG8_SA(1, 0), a3, voffA);
            PG8_BAR; PG8_WAIT_L(0); PG8_MMA(1, 0, At, B0); PG8_BAR; PG8_SCHED;
            PG8_STAGE(PG8_SB(1, 1), b3 + hstep, voffB);
            PG8_WAIT_V(6); PG8_BAR; PG8_MMA(1, 1, At, B1); PG8_BAR;
            }
        }
        if constexpr (ALIGN_EPI) { if (wr == 0) PG8_BAR; }
        if constexpr (!Epi::AFTER_DRAIN) { S.pre_store(ui); E(acc, cur, wr, wc, fr, fq); S.done(cur); }
        if (!has_next) break;
#pragma unroll
        for (int a = 0; a < 2; ++a)
#pragma unroll
            for (int b = 0; b < 2; ++b)
#pragma unroll
                for (int m = 0; m < 4; ++m)
#pragma unroll
                    for (int n = 0; n < 2; ++n) acc[a][b][m][n] = (f32x4){0.f, 0.f, 0.f, 0.f};
        cur = nxt; cA = nA; cB = nB; ++ui;
        if constexpr (ALIGN_EPI) { if (wr == 1) PG8_BAR; }
    }
    PG8_WAIT_V(0);
    if constexpr (!ALIGN_EPI) { if (wr == 0) PG8_BAR; }
    PG8_BAR;
    if constexpr (Epi::AFTER_DRAIN) { E.fused(acc, cur, wr, wc, fr, fq, lds, wid, lane); S.done(cur); }
#undef PG8_SA
#undef PG8_SB
#undef PG8_STAGE
#undef PG8_LDA
#undef PG8_LDB
#undef PG8_MMA
#undef PG8_WAIT_V
#undef PG8_WAIT_L
#undef PG8_BAR
#undef PG8_SCHED
}
}

namespace fa {
constexpr int SLOTB = 8192;
constexpr int L_K = 0, L_V = 3 * SLOTB, L_OST = 6 * SLOTB, L_QST = L_OST, L_WS = 120 * 1024, L_TAB = L_WS + 2048, L_END = L_TAB + 4096;
constexpr int L_AK = 0, L_AV = 6 * SLOTB, L_AOST = 0;
static_assert(L_END <= RING_BYTES, "attention LDS map");
#define SBAR() __builtin_amdgcn_sched_barrier(0)
__device__ __forceinline__ int crow(int r, int hi) { return (r & 3) + 8 * (r >> 2) + 4 * hi; }
__device__ __forceinline__ void glds16(const void* gsrc, unsigned lds_dst) { unsigned keep;
    asm volatile("s_mov_b32 %0, m0\n\ts_mov_b32 m0, %2\n\ts_nop 0\n\tglobal_load_lds_dwordx4 %1, off\n\ts_mov_b32 m0, %0" : "=&s"(keep) : "v"(gsrc), "s"(lds_dst) : "memory"); }
__device__ __forceinline__ void glds16s(const void* sbase, unsigned voff, unsigned lds_dst) { unsigned keep;
    asm volatile("s_mov_b32 %0, m0\n\ts_mov_b32 m0, %3\n\ts_nop 0\n\tglobal_load_lds_dwordx4 %1, %2\n\ts_mov_b32 m0, %0" : "=&s"(keep) : "v"(voff), "s"(sbase), "s"(lds_dst) : "memory"); }
typedef __bf16 bf16x2_t __attribute__((ext_vector_type(2)));
__device__ __forceinline__ unsigned cvtpk_s(float lo, float hi) { f32x2 v = {lo, hi}; bf16x2_t b = __builtin_convertvector(v, bf16x2_t); return __builtin_bit_cast(unsigned, b); }
#define FA_WAIT_BAR(N) asm volatile("s_waitcnt vmcnt(" #N ") lgkmcnt(0)\n\ts_barrier" ::: "memory")

template <int NDQ>
__device__ __forceinline__ void qkt(f32x16& p0, f32x16& p1, LAS const unsigned char* Kslot, const bf16x8* qr, const f32x16& cin, int r32, int hi) {
    LAS const unsigned char* kb = Kslot + hi * 1024 + r32 * 16;
#pragma unroll
    for (int d0 = 0; d0 < NDQ; ++d0) {
        const bf16x8 b0 = *(LAS const bf16x8*)(kb + d0 * 2048);
        const bf16x8 b1 = *(LAS const bf16x8*)(kb + d0 * 2048 + 512);
        if (d0 == 0) { p0 = __builtin_amdgcn_mfma_f32_32x32x16_bf16(b0, qr[0], cin, 0, 0, 0); p1 = __builtin_amdgcn_mfma_f32_32x32x16_bf16(b1, qr[0], cin, 0, 0, 0); }
        else { p0 = __builtin_amdgcn_mfma_f32_32x32x16_bf16(b0, qr[d0], p0, 0, 0, 0); p1 = __builtin_amdgcn_mfma_f32_32x32x16_bf16(b1, qr[d0], p1, 0, 0, 0); } }
}
__device__ __forceinline__ float max3f(float a, float b, float c) { float r; asm("v_max3_f32 %0, %1, %2, %3" : "=v"(r) : "v"(a), "v"(b), "v"(c)); return r; }
__device__ __forceinline__ float max2f(float a, float b) { float r; asm("v_max_f32_e32 %0, %1, %2" : "=v"(r) : "v"(a), "v"(b)); return r; }
__device__ __forceinline__ float rowmax(const f32x16& p0, const f32x16& p1) {
    float a = max3f(p0[0], p0[1], p1[0]), b = max3f(p0[2], p0[3], p1[1]); a = max3f(a, p1[2], p1[3]);
#pragma unroll
    for (int r = 4; r < 16; r += 4) { a = max3f(a, p0[r], p0[r + 1]); b = max3f(b, p0[r + 2], p0[r + 3]); a = max3f(a, p1[r], p1[r + 1]); b = max3f(b, p1[r + 2], p1[r + 3]); }
    const float m = max2f(a, b);
    auto rr = __builtin_amdgcn_permlane32_swap(__float_as_uint(m), __float_as_uint(m), false, false);
    return max2f(__uint_as_float(rr[0]), __uint_as_float(rr[1]));
}
__device__ __forceinline__ void pv(f32x16* o, int vb, bf16x8 pa0, bf16x8 pa1, bf16x8 pa2, bf16x8 pa3) {
#pragma unroll
    for (int d0 = 0; d0 < 2; ++d0) { s16x4 lo[4], hi[4];
#pragma unroll
        for (int ks = 0; ks < 4; ++ks) {
            asm volatile("ds_read_b64_tr_b16 %0,%1 offset:%c2" : "=&v"(lo[ks]) : "v"(vb), "i"(d0 * 4096 + ks * 1024) : "memory");
            asm volatile("ds_read_b64_tr_b16 %0,%1 offset:%c2" : "=&v"(hi[ks]) : "v"(vb), "i"(d0 * 4096 + ks * 1024 + 512) : "memory"); }
        asm volatile("s_waitcnt lgkmcnt(0)" ::: "memory"); SBAR();
#define FA_PK(k) (bf16x8){lo[k][0], lo[k][1], lo[k][2], lo[k][3], hi[k][0], hi[k][1], hi[k][2], hi[k][3]}
        o[d0] = __builtin_amdgcn_mfma_f32_32x32x16_bf16(pa0, FA_PK(0), o[d0], 0, 0, 0);
        o[d0] = __builtin_amdgcn_mfma_f32_32x32x16_bf16(pa1, FA_PK(1), o[d0], 0, 0, 0);
        o[d0] = __builtin_amdgcn_mfma_f32_32x32x16_bf16(pa2, FA_PK(2), o[d0], 0, 0, 0);
        o[d0] = __builtin_amdgcn_mfma_f32_32x32x16_bf16(pa3, FA_PK(3), o[d0], 0, 0, 0);
#undef FA_PK
    }
}

constexpr float THR = 8.0f;
template <int NDQ, class KV, class Hook>
__device__ __forceinline__ void flash_core(LAS unsigned char* shm, const bf16_t* qptr, const KV& kv, int NT, const Hook& hk, int koff, f32x16 (&o)[2], float& mhat_out, float& l_out, const int tid) {
    const int lane = tid & 63, r32 = lane & 31, hi = lane >> 5; const int wid = __builtin_amdgcn_readfirstlane(tid >> 6);
    const unsigned lds0 = (unsigned)(uintptr_t)shm;
    LAS float* wsf = (LAS float*)(shm + L_WS) + wid * 64;
    const unsigned kdst = lds0 + L_K + wid * 1024, vdst = lds0 + L_V + wid * 1024;
    const int vrow_j = 16 * (wid & 3) + (lane >> 2), vcol = (wid >> 2) * 32 + (lane & 3) * 8;
#define FA_DMA(t, slot) do { glds16(kv.kptr((t), lane) + wid * 8, (unsigned)__builtin_amdgcn_readfirstlane(kdst + (slot) * SLOTB)); \
                             glds16(kv.vptr((t), vrow_j) + vcol, (unsigned)__builtin_amdgcn_readfirstlane(vdst + (slot) * SLOTB)); } while (0)
    FA_DMA(0, 0);
    bf16x8 qr[4];
#pragma unroll
    for (int d0 = 0; d0 < 4; ++d0) { if (d0 < NDQ) qr[d0] = *(const bf16x8*)(qptr + d0 * 16 + hi * 8); else qr[d0] = (bf16x8){0, 0, 0, 0, 0, 0, 0, 0}; }
    asm volatile("" : "+v"(qr[0]), "+v"(qr[1]), "+v"(qr[2]), "+v"(qr[3]));
    float mhat = 0.f, l = 0.f; o[0] = f32x16{}; o[1] = f32x16{}; const f32x16 zero16 = f32x16{};
    bool first = true;
    const int vb0 = (int)(lds0 + L_V) + ((lane >> 4) & 1) * 32 + (lane & 3) * 8 + (4 * hi + ((lane & 15) >> 2)) * 64;
    for (int t = 0; t < NT; ++t) {
        const int slot = t & 1;
        if (t + 1 < NT) { FA_DMA(t + 1, slot ^ 1); FA_WAIT_BAR(2); } else { FA_WAIT_BAR(0); }
        if (!hk.skip(t)) {
            f32x16 p0, p1;
            qkt<NDQ>(p0, p1, shm + L_K + slot * SLOTB + koff, qr, zero16, r32, hi);
            hk.apply(p0, p1, t);
            const float rmr = rowmax(p0, p1); const float rm = rmr - mhat;
            if (first) {
                first = false; mhat = (rmr > -1e29f) ? rmr : 0.f;
            } else if (__any(rm > THR)) {
                const float dl = fmaxf(rm, 0.f); mhat += dl;
                const float f = __builtin_amdgcn_exp2f(-dl); l *= f; if (hi == 0) wsf[r32] = f;
                asm volatile("s_waitcnt lgkmcnt(0)" ::: "memory");
#pragma unroll
                for (int r = 0; r < 16; ++r) { const float fr_ = wsf[crow(r, hi)]; o[0][r] *= fr_; o[1][r] *= fr_; }
            }
            float sacc = 0.f, sacc2 = 0.f;
#pragma unroll
            for (int r = 0; r < 16; ++r) { p0[r] = __builtin_amdgcn_exp2f(p0[r] - mhat); p1[r] = __builtin_amdgcn_exp2f(p1[r] - mhat); sacc += p0[r]; sacc2 += p1[r]; }
            l += sacc + sacc2;
            u32x4 pw0, pw1, pw2, pw3;
            pw0 = (u32x4){cvtpk_s(p0[0], p0[1]), cvtpk_s(p0[2], p0[3]), cvtpk_s(p0[4], p0[5]), cvtpk_s(p0[6], p0[7])};
            pw1 = (u32x4){cvtpk_s(p0[8], p0[9]), cvtpk_s(p0[10], p0[11]), cvtpk_s(p0[12], p0[13]), cvtpk_s(p0[14], p0[15])};
            pw2 = (u32x4){cvtpk_s(p1[0], p1[1]), cvtpk_s(p1[2], p1[3]), cvtpk_s(p1[4], p1[5]), cvtpk_s(p1[6], p1[7])};
            pw3 = (u32x4){cvtpk_s(p1[8], p1[9]), cvtpk_s(p1[10], p1[11]), cvtpk_s(p1[12], p1[13]), cvtpk_s(p1[14], p1[15])};
            SBAR();
            pv(o, vb0 + slot * SLOTB, __builtin_bit_cast(bf16x8, pw0), __builtin_bit_cast(bf16x8, pw1), __builtin_bit_cast(bf16x8, pw2), __builtin_bit_cast(bf16x8, pw3));
        }
        asm volatile("s_waitcnt lgkmcnt(0)\n\ts_barrier" ::: "memory");
    }
#undef FA_DMA
    { auto rr = __builtin_amdgcn_permlane32_swap(__float_as_uint(l), __float_as_uint(l), false, false); l = __uint_as_float(rr[0]) + __uint_as_float(rr[1]); }
    if (hi == 0) wsf[32 + r32] = l;
    asm volatile("s_waitcnt lgkmcnt(0)" ::: "memory");
#pragma unroll
    for (int r = 0; r < 16; ++r) { const float rl = __builtin_amdgcn_rcpf(wsf[32 + crow(r, hi)]); o[0][r] *= rl; o[1][r] *= rl; }
    mhat_out = mhat; l_out = l;
}
template <int NDQ, class KV, class Hook>
__device__ __forceinline__ void flash_core_sp(LAS unsigned char* shm, const bf16_t* qptr, const KV& kv, int NT, const Hook& hk, int koff, f32x16 (&o)[2], float& mhat_out, float& l_out, const int tid) {
    const int lane = tid & 63, r32 = lane & 31, hi = lane >> 5; const int wid = __builtin_amdgcn_readfirstlane(tid >> 6);
    const unsigned lds0 = (unsigned)(uintptr_t)shm;
    LAS float* wsf = (LAS float*)(shm + L_WS) + wid * 64;
    const unsigned kdst = lds0 + L_K + wid * 1024, vdst = lds0 + L_V + wid * 1024;
    const int vrow_j = 16 * (wid & 3) + (lane >> 2), vcol = (wid >> 2) * 32 + (lane & 3) * 8;
#define FA_DMAK(t, SL) glds16(kv.kptr((t), lane) + wid * 8, (unsigned)__builtin_amdgcn_readfirstlane(kdst + (SL) * SLOTB))
#define FA_DMAV(t, SL) glds16(kv.vptr((t), vrow_j) + vcol, (unsigned)__builtin_amdgcn_readfirstlane(vdst + (SL) * SLOTB))
    FA_DMAK(0, 0); FA_DMAV(0, 0); FA_DMAK(1, 1); FA_DMAK(2, 2); FA_DMAV(1, 1);
    bf16x8 qr[4];
#pragma unroll
    for (int d0 = 0; d0 < 4; ++d0) { if (d0 < NDQ) qr[d0] = *(const bf16x8*)(qptr + d0 * 16 + hi * 8); else qr[d0] = (bf16x8){0, 0, 0, 0, 0, 0, 0, 0}; }
    asm volatile("" : "+v"(qr[0]), "+v"(qr[1]), "+v"(qr[2]), "+v"(qr[3]));
    float mhat = 0.f, l = 0.f; o[0] = f32x16{}; o[1] = f32x16{}; const f32x16 zero16 = f32x16{};
    bool first = true;
    const int vb0 = (int)(lds0 + L_V) + ((lane >> 4) & 1) * 32 + (lane & 3) * 8 + (4 * hi + ((lane & 15) >> 2)) * 64;
    f32x16 pA0, pA1, pB0, pB1;
    FA_WAIT_BAR(2);
#define FA_ENDW(tt) do { if ((tt) + 3 < NT) { FA_WAIT_BAR(2); } else if ((tt) + 2 < NT) { FA_WAIT_BAR(1); } else { FA_WAIT_BAR(0); } } while (0)
    if (!hk.skip(0)) qkt<NDQ>(pA0, pA1, shm + L_K + koff, qr, zero16, r32, hi);
#define FA_SMPV(P0, P1, tt, SL) do { \
        hk.apply(P0, P1, (tt)); const float curb = hk.cbias(tt); \
        const float rmr = rowmax(P0, P1) + curb; const float rm = rmr - mhat; \
        if (first) { first = false; mhat = (rmr > -1e29f) ? rmr : 0.f; \
        } else if (__any(rm > THR)) { const float dl = fmaxf(rm, 0.f); mhat += dl; \
            const float f = __builtin_amdgcn_exp2f(-dl); l *= f; if (hi == 0) wsf[r32] = f; \
            asm volatile("s_waitcnt lgkmcnt(0)" ::: "memory"); \
            _Pragma("unroll") for (int r = 0; r < 16; ++r) { const float fr_ = wsf[crow(r, hi)]; o[0][r] *= fr_; o[1][r] *= fr_; } } \
        float sacc = 0.f, sacc2 = 0.f; const float mref_ = mhat - curb; \
        _Pragma("unroll") for (int r = 0; r < 16; ++r) { P0[r] = __builtin_amdgcn_exp2f(P0[r] - mref_); P1[r] = __builtin_amdgcn_exp2f(P1[r] - mref_); sacc += P0[r]; sacc2 += P1[r]; } \
        l += sacc + sacc2; \
        u32x4 pw0, pw1, pw2, pw3; \
        pw0 = (u32x4){cvtpk_s(P0[0], P0[1]), cvtpk_s(P0[2], P0[3]), cvtpk_s(P0[4], P0[5]), cvtpk_s(P0[6], P0[7])}; \
        pw1 = (u32x4){cvtpk_s(P0[8], P0[9]), cvtpk_s(P0[10], P0[11]), cvtpk_s(P0[12], P0[13]), cvtpk_s(P0[14], P0[15])}; \
        pw2 = (u32x4){cvtpk_s(P1[0], P1[1]), cvtpk_s(P1[2], P1[3]), cvtpk_s(P1[4], P1[5]), cvtpk_s(P1[6], P1[7])}; \
        pw3 = (u32x4){cvtpk_s(P1[8], P1[9]), cvtpk_s(P1[10], P1[11]), cvtpk_s(P1[12], P1[13]), cvtpk_s(P1[14], P1[15])}; \
        SBAR(); \
        pv(o, vb0 + (SL) * SLOTB, __builtin_bit_cast(bf16x8, pw0), __builtin_bit_cast(bf16x8, pw1), __builtin_bit_cast(bf16x8, pw2), __builtin_bit_cast(bf16x8, pw3)); \
    } while (0)
    bf16x8 kf[8];
#define FA_KLOAD(SL) do { LAS const unsigned char* kb_ = shm + L_K + (SL) * SLOTB + koff + hi * 1024 + r32 * 16; \
        _Pragma("unroll") for (int d0 = 0; d0 < NDQ; ++d0) { kf[2 * d0] = *(LAS const bf16x8*)(kb_ + d0 * 2048); kf[2 * d0 + 1] = *(LAS const bf16x8*)(kb_ + d0 * 2048 + 512); } } while (0)
#define FA_QKM(P0, P1) do { _Pragma("unroll") for (int d0 = 0; d0 < NDQ; ++d0) { \
        if (d0 == 0) { P0 = __builtin_amdgcn_mfma_f32_32x32x16_bf16(kf[0], qr[0], zero16, 0, 0, 0); P1 = __builtin_amdgcn_mfma_f32_32x32x16_bf16(kf[1], qr[0], zero16, 0, 0, 0); } \
        else { P0 = __builtin_amdgcn_mfma_f32_32x32x16_bf16(kf[2 * d0], qr[d0], P0, 0, 0, 0); P1 = __builtin_amdgcn_mfma_f32_32x32x16_bf16(kf[2 * d0 + 1], qr[d0], P1, 0, 0, 0); } } } while (0)
#define FA_STEP(tt, SC, PC0, PC1, PN0, PN1) do { \
        if ((tt) + 3 < NT) FA_DMAK((tt) + 3, (SC)); \
        if ((tt) + 2 < NT) FA_DMAV((tt) + 2, ((SC) + 2) % 3); \
        const bool nx_ = ((tt) + 1 < NT) && !hk.skip((tt) + 1); \
        if (true) { if (nx_) FA_KLOAD(((SC) + 1) % 3); } \
        SBAR(); \
        if (!hk.skip(tt)) { FA_SMPV(PC0, PC1, (tt), (SC)); } \
        SBAR(); \
        if (nx_) { FA_QKM(PN0, PN1); } \
        FA_ENDW(tt); \
    } while (0)
    for (int t = 0; t < NT; t += 6) {
        FA_STEP(t, 0, pA0, pA1, pB0, pB1);
        if (t + 1 < NT) { FA_STEP(t + 1, 1, pB0, pB1, pA0, pA1); }
        if (t + 2 < NT) { FA_STEP(t + 2, 2, pA0, pA1, pB0, pB1); }
        if (t + 3 < NT) { FA_STEP(t + 3, 0, pB0, pB1, pA0, pA1); }
        if (t + 4 < NT) { FA_STEP(t + 4, 1, pA0, pA1, pB0, pB1); }
        if (t + 5 < NT) { FA_STEP(t + 5, 2, pB0, pB1, pA0, pA1); }
    }
#undef FA_STEP
#undef FA_KLOAD
#undef FA_QKM
#undef FA_SMPV
#undef FA_DMAK
#undef FA_ENDW
#undef FA_DMAV
    { auto rr = __builtin_amdgcn_permlane32_swap(__float_as_uint(l), __float_as_uint(l), false, false); l = __uint_as_float(rr[0]) + __uint_as_float(rr[1]); }
    if (hi == 0) wsf[32 + r32] = l;
    asm volatile("s_waitcnt lgkmcnt(0)" ::: "memory");
#pragma unroll
    for (int r = 0; r < 16; ++r) { const float rl = __builtin_amdgcn_rcpf(wsf[32 + crow(r, hi)]); o[0][r] *= rl; o[1][r] *= rl; }
    mhat_out = mhat; l_out = l;
}
template <class KV, class Hook>
__device__ __forceinline__ void flash_core_all(LAS unsigned char* shm, const bf16_t* qptr, const KV& kv, int NT, const Hook& hk, f32x16 (&o)[2], float& mhat_out, float& l_out, const int tid) {
    const int lane = tid & 63, r32 = lane & 31, hi = lane >> 5; const int wid = __builtin_amdgcn_readfirstlane(tid >> 6);
    const unsigned lds0 = (unsigned)(uintptr_t)shm;
    LAS float* wsf = (LAS float*)(shm + L_WS) + wid * 64;
    const unsigned kdst = lds0 + L_AK + wid * 1024, vdst = lds0 + L_AV + wid * 1024;
    const int vrow_j = 16 * (wid & 3) + (lane >> 2), vcol = (wid >> 2) * 32 + (lane & 3) * 8;
    for (int t = 0; t < NT; ++t) {
        glds16(kv.kptr(t, lane) + wid * 8, (unsigned)__builtin_amdgcn_readfirstlane(kdst + t * SLOTB));
        glds16(kv.vptr(t, vrow_j) + vcol, (unsigned)__builtin_amdgcn_readfirstlane(vdst + t * SLOTB)); }
    bf16x8 qr[4];
#pragma unroll
    for (int d0 = 0; d0 < 4; ++d0) qr[d0] = *(const bf16x8*)(qptr + d0 * 16 + hi * 8);
    asm volatile("" : "+v"(qr[0]), "+v"(qr[1]), "+v"(qr[2]), "+v"(qr[3]));
    float mhat = 0.f, l = 0.f; o[0] = f32x16{}; o[1] = f32x16{}; const f32x16 zero16 = f32x16{};
    bool first = true;
    const int vb0 = (int)(lds0 + L_AV) + ((lane >> 4) & 1) * 32 + (lane & 3) * 8 + (4 * hi + ((lane & 15) >> 2)) * 64;
    FA_WAIT_BAR(0);
    for (int t = 0; t < NT; ++t) {
        if (hk.skip(t)) continue;
        f32x16 p0, p1;
        { bf16x8 kf[8]; LAS const unsigned char* kb_ = shm + L_AK + t * SLOTB + hi * 1024 + r32 * 16;
#pragma unroll
          for (int d0 = 0; d0 < 4; ++d0) { kf[2 * d0] = *(LAS const bf16x8*)(kb_ + d0 * 2048); kf[2 * d0 + 1] = *(LAS const bf16x8*)(kb_ + d0 * 2048 + 512); }
#pragma unroll
          for (int d0 = 0; d0 < 4; ++d0) {
              if (d0 == 0) { p0 = __builtin_amdgcn_mfma_f32_32x32x16_bf16(kf[0], qr[0], zero16, 0, 0, 0); p1 = __builtin_amdgcn_mfma_f32_32x32x16_bf16(kf[1], qr[0], zero16, 0, 0, 0); }
              else { p0 = __builtin_amdgcn_mfma_f32_32x32x16_bf16(kf[2 * d0], qr[d0], p0, 0, 0, 0); p1 = __builtin_amdgcn_mfma_f32_32x32x16_bf16(kf[2 * d0 + 1], qr[d0], p1, 0, 0, 0); } } }
        hk.apply(p0, p1, t);
        const float rmr = rowmax(p0, p1); const float rm = rmr - mhat;
        if (first) { first = false; mhat = (rmr > -1e29f) ? rmr : 0.f;
        } else if (__any(rm > THR)) { const float dl = fmaxf(rm, 0.f); mhat += dl;
            const float f = __builtin_amdgcn_exp2f(-dl); l *= f; if (hi == 0) wsf[r32] = f;
            asm volatile("s_waitcnt lgkmcnt(0)" ::: "memory");
#pragma unroll
            for (int r = 0; r < 16; ++r) { const float fr_ = wsf[crow(r, hi)]; o[0][r] *= fr_; o[1][r] *= fr_; } }
        float sacc = 0.f, sacc2 = 0.f;
#pragma unroll
        for (int r = 0; r < 16; ++r) { p0[r] = __builtin_amdgcn_exp2f(p0[r] - mhat); p1[r] = __builtin_amdgcn_exp2f(p1[r] - mhat); sacc += p0[r]; sacc2 += p1[r]; }
        l += sacc + sacc2;
        u32x4 pw0, pw1, pw2, pw3;
        pw0 = (u32x4){cvtpk_s(p0[0], p0[1]), cvtpk_s(p0[2], p0[3]), cvtpk_s(p0[4], p0[5]), cvtpk_s(p0[6], p0[7])};
        pw1 = (u32x4){cvtpk_s(p0[8], p0[9]), cvtpk_s(p0[10], p0[11]), cvtpk_s(p0[12], p0[13]), cvtpk_s(p0[14], p0[15])};
        pw2 = (u32x4){cvtpk_s(p1[0], p1[1]), cvtpk_s(p1[2], p1[3]), cvtpk_s(p1[4], p1[5]), cvtpk_s(p1[6], p1[7])};
        pw3 = (u32x4){cvtpk_s(p1[8], p1[9]), cvtpk_s(p1[10], p1[11]), cvtpk_s(p1[12], p1[13]), cvtpk_s(p1[14], p1[15])};
        SBAR();
        pv(o, vb0 + t * SLOTB, __builtin_bit_cast(bf16x8, pw0), __builtin_bit_cast(bf16x8, pw1), __builtin_bit_cast(bf16x8, pw2), __builtin_bit_cast(bf16x8, pw3));
    }
    asm volatile("s_waitcnt lgkmcnt(0)\n\ts_barrier" ::: "memory");
    { auto rr = __builtin_amdgcn_permlane32_swap(__float_as_uint(l), __float_as_uint(l), false, false); l = __uint_as_float(rr[0]) + __uint_as_float(rr[1]); }
    if (hi == 0) wsf[32 + r32] = l;
    asm volatile("s_waitcnt lgkmcnt(0)" ::: "memory");
#pragma unroll
    for (int r = 0; r < 16; ++r) { const float rl = __builtin_amdgcn_rcpf(wsf[32 + crow(r, hi)]); o[0][r] *= rl; o[1][r] *= rl; }
    mhat_out = mhat; l_out = l;
}
template <int DUMMY = 0>
__device__ __forceinline__ void b3_compute(LAS unsigned char* shm, const bf16x8 (&qr)[4], int NT, int slot_off, LAS const float* tab, int qw, int kb0, bool active, float kbound, float badd,
                                           f32x16 (&o)[2], float& mrow_out, float& l_out, const int tid) {
    const int lane = tid & 63, r32 = lane & 31, hi = lane >> 5;
    const unsigned lds0 = (unsigned)(uintptr_t)shm;
    float q2 = 0.f;
#pragma unroll
    for (int d0 = 0; d0 < 4; ++d0)
#pragma unroll
        for (int e = 0; e < 8; ++e) { const float x = __builtin_bit_cast(float, (unsigned)(unsigned short)qr[d0][e] << 16); q2 += x * x; }
    { auto rr = __builtin_amdgcn_permlane32_swap(__float_as_uint(q2), __float_as_uint(q2), false, false); q2 = __uint_as_float(rr[0]) + __uint_as_float(rr[1]); }
    const float mrow = sqrtf(q2) * kbound + badd;
    f32x16 negm;
#pragma unroll
    for (int r = 0; r < 16; ++r) negm[r] = -mrow;
    asm volatile("" : "+v"(negm));
    float l = 0.f; o[0] = f32x16{}; o[1] = f32x16{};
    const int tf = (qw - 64 - kb0) >> 6;
    const unsigned kbase = lds0 + L_AK + hi * 1024 + r32 * 16;
    const unsigned vbase = lds0 + L_AV + ((lane >> 4) & 1) * 32 + (lane & 3) * 8 + (4 * hi + ((lane & 15) >> 2)) * 64;
    const unsigned tbase = (unsigned)(uintptr_t)tab + 4u * (unsigned)(kb0 + 4 * hi - (qw + r32) + 158);
    FA_WAIT_BAR(0);
    { int t_lo = tf < 0 ? 0 : tf, t_hi = tf + 2 >= NT ? NT - 1 : tf + 2; if (!active) t_hi = t_lo - 1;
    for (int t = t_lo; t <= t_hi; ++t) {
        {
            const unsigned ka = kbase + (unsigned)(t + slot_off) * SLOTB, va = vbase + (unsigned)(t + slot_off) * SLOTB, ta = tbase + 256u * (unsigned)t;
            bf16x8 kf[8]; f32x2 tv0[8], tv1[8]; s16x4 vlo[8], vhi[8];
#define B3_KRD(j) asm volatile("ds_read_b128 %0, %2 offset:%c3\n\tds_read_b128 %1, %2 offset:%c4" : "=&v"(kf[2 * (j)]), "=&v"(kf[2 * (j) + 1]) : "v"(ka), "i"((j) * 2048), "i"((j) * 2048 + 512) : "memory")
#define B3_TR1(dst, off) asm volatile("ds_read2_b32 %0, %1 offset0:%c2 offset1:%c3" : "=&v"(dst) : "v"(ta), "i"(off), "i"((off) + 1) : "memory")
#define B3_TRD(j2) do { B3_TR1(tv0[j2], 8 * ((j2) >> 1) + 2 * ((j2) & 1)); B3_TR1(tv1[j2], 8 * ((j2) >> 1) + 2 * ((j2) & 1) + 32); } while (0)
#define B3_VRD(ii) asm volatile("ds_read_b64_tr_b16 %0, %2 offset:%c3\n\tds_read_b64_tr_b16 %1, %2 offset:%c4" : "=&v"(vlo[ii]), "=&v"(vhi[ii]) : "v"(va), "i"(((ii) >> 2) * 4096 + ((ii) & 3) * 1024), "i"(((ii) >> 2) * 4096 + ((ii) & 3) * 1024 + 512) : "memory")
            B3_KRD(0); B3_KRD(1); B3_KRD(2); B3_KRD(3);
            B3_TRD(0); B3_TRD(1); B3_TRD(2);
            asm volatile("s_waitcnt lgkmcnt(6)" : "+v"(kf[0]), "+v"(kf[1]), "+v"(kf[2]), "+v"(kf[3]), "+v"(kf[4]), "+v"(kf[5]), "+v"(kf[6]), "+v"(kf[7]));
            SBAR();
            f32x16 p0 = __builtin_amdgcn_mfma_f32_32x32x16_bf16(kf[0], qr[0], negm, 0, 0, 0), p1 = __builtin_amdgcn_mfma_f32_32x32x16_bf16(kf[1], qr[0], negm, 0, 0, 0);
#pragma unroll
            for (int d0 = 1; d0 < 4; ++d0) { p0 = __builtin_amdgcn_mfma_f32_32x32x16_bf16(kf[2 * d0], qr[d0], p0, 0, 0, 0); p1 = __builtin_amdgcn_mfma_f32_32x32x16_bf16(kf[2 * d0 + 1], qr[d0], p1, 0, 0, 0); }
            SBAR();
            asm volatile("s_waitcnt lgkmcnt(5)" ::: "memory");
            B3_TRD(3); B3_TRD(4); B3_TRD(5); B3_TRD(6); B3_TRD(7);
            asm volatile("s_waitcnt lgkmcnt(7)" ::: "memory");
            B3_VRD(0); B3_VRD(1); B3_VRD(2); B3_VRD(3);
            asm volatile("s_waitcnt lgkmcnt(8)" : "+v"(tv0[0]), "+v"(tv0[1]), "+v"(tv0[2]), "+v"(tv0[3]), "+v"(tv0[4]), "+v"(tv0[5]), "+v"(tv0[6]), "+v"(tv0[7]),
                                                  "+v"(tv1[0]), "+v"(tv1[1]), "+v"(tv1[2]), "+v"(tv1[3]), "+v"(tv1[4]), "+v"(tv1[5]), "+v"(tv1[6]), "+v"(tv1[7]));
            SBAR();
            float sacc = 0.f;
#pragma unroll
            for (int r = 0; r < 16; ++r) { const int j2 = (r >> 2) * 2 + ((r & 3) >> 1), e = r & 1;
                p0[r] = __builtin_amdgcn_exp2f(p0[r] + tv0[j2][e]); p1[r] = __builtin_amdgcn_exp2f(p1[r] + tv1[j2][e]); sacc += p0[r]; sacc += p1[r]; }
            l += sacc;
            const u32x4 pw0 = (u32x4){cvtpk_s(p0[0], p0[1]), cvtpk_s(p0[2], p0[3]), cvtpk_s(p0[4], p0[5]), cvtpk_s(p0[6], p0[7])};
            const u32x4 pw1 = (u32x4){cvtpk_s(p0[8], p0[9]), cvtpk_s(p0[10], p0[11]), cvtpk_s(p0[12], p0[13]), cvtpk_s(p0[14], p0[15])};
            const u32x4 pw2 = (u32x4){cvtpk_s(p1[0], p1[1]), cvtpk_s(p1[2], p1[3]), cvtpk_s(p1[4], p1[5]), cvtpk_s(p1[6], p1[7])};
            const u32x4 pw3 = (u32x4){cvtpk_s(p1[8], p1[9]), cvtpk_s(p1[10], p1[11]), cvtpk_s(p1[12], p1[13]), cvtpk_s(p1[14], p1[15])};
            SBAR();
            asm volatile("s_waitcnt lgkmcnt(0)" : "+v"(vlo[0]), "+v"(vlo[1]), "+v"(vlo[2]), "+v"(vlo[3]), "+v"(vhi[0]), "+v"(vhi[1]), "+v"(vhi[2]), "+v"(vhi[3]));
            B3_VRD(4); B3_VRD(5); B3_VRD(6); B3_VRD(7);
            SBAR();
#define B3_VF(ii) (bf16x8){vlo[ii][0], vlo[ii][1], vlo[ii][2], vlo[ii][3], vhi[ii][0], vhi[ii][1], vhi[ii][2], vhi[ii][3]}
            o[0] = __builtin_amdgcn_mfma_f32_32x32x16_bf16(__builtin_bit_cast(bf16x8, pw0), B3_VF(0), o[0], 0, 0, 0);
            o[0] = __builtin_amdgcn_mfma_f32_32x32x16_bf16(__builtin_bit_cast(bf16x8, pw1), B3_VF(1), o[0], 0, 0, 0);
            o[0] = __builtin_amdgcn_mfma_f32_32x32x16_bf16(__builtin_bit_cast(bf16x8, pw2), B3_VF(2), o[0], 0, 0, 0);
            o[0] = __builtin_amdgcn_mfma_f32_32x32x16_bf16(__builtin_bit_cast(bf16x8, pw3), B3_VF(3), o[0], 0, 0, 0);
            SBAR();
            asm volatile("s_waitcnt lgkmcnt(0)" : "+v"(vlo[4]), "+v"(vlo[5]), "+v"(vlo[6]), "+v"(vlo[7]), "+v"(vhi[4]), "+v"(vhi[5]), "+v"(vhi[6]), "+v"(vhi[7]));
            SBAR();
            o[1] = __builtin_amdgcn_mfma_f32_32x32x16_bf16(__builtin_bit_cast(bf16x8, pw0), B3_VF(4), o[1], 0, 0, 0);
            o[1] = __builtin_amdgcn_mfma_f32_32x32x16_bf16(__builtin_bit_cast(bf16x8, pw1), B3_VF(5), o[1], 0, 0, 0);
            o[1] = __builtin_amdgcn_mfma_f32_32x32x16_bf16(__builtin_bit_cast(bf16x8, pw2), B3_VF(6), o[1], 0, 0, 0);
            o[1] = __builtin_amdgcn_mfma_f32_32x32x16_bf16(__builtin_bit_cast(bf16x8, pw3), B3_VF(7), o[1], 0, 0, 0);
            SBAR();
#undef B3_TR1
#undef B3_KRD
#undef B3_TRD
#undef B3_VRD
#undef B3_VF
        }
    } }
    asm volatile("s_waitcnt lgkmcnt(0)\n\ts_barrier" ::: "memory");
    mrow_out = mrow; l_out = l;
}
constexpr int L_DT = L_OST + 8 * SLOTB;
static_assert(L_DT + 15 * 128 * 4 <= L_WS, "D table");
template <class KV>
__device__ __forceinline__ void flash_core_d(LAS unsigned char* shm, const bf16_t* qptr, const KV& kv, int NT, int t_first, int t_last, int dr0, int c, float kbound, float badd,
                                             const float* rpb, f32x16 (&o)[2], const int tid) {
    const int lane = tid & 63, r32 = lane & 31, hi = lane >> 5; const int wid = __builtin_amdgcn_readfirstlane(tid >> 6);
    const unsigned lds0 = (unsigned)(uintptr_t)shm;
    LAS float* wsf = (LAS float*)(shm + L_WS) + wid * 64;
    const unsigned kdst = lds0 + L_K + wid * 1024, vdst = lds0 + L_V + wid * 1024;
    const int vrow_j = 16 * (wid & 3) + (lane >> 2), vcol = (wid >> 2) * 32 + (lane & 3) * 8;
    const unsigned koffv = (unsigned)(kv.rmul() * lane * INW + wid * 8) * 2u, voffv = (unsigned)(kv.rmul() * vrow_j * INW + vcol) * 2u;
#define FD_DMA(t, slot) do { glds16s(kv.tk(t), koffv, (unsigned)__builtin_amdgcn_readfirstlane(kdst + (slot) * SLOTB)); \
                             glds16s(kv.tv(t), voffv, (unsigned)__builtin_amdgcn_readfirstlane(vdst + (slot) * SLOTB)); } while (0)
    FD_DMA(0, 0); FD_DMA(1, 1);
    const float rv = (tid < 465) ? rpb[tid] : 0.f;
    bf16x8 qr[4];
#pragma unroll
    for (int d0 = 0; d0 < 4; ++d0) qr[d0] = *(const bf16x8*)(qptr + d0 * 16 + hi * 8);
    float q2 = 0.f;
#pragma unroll
    for (int d0 = 0; d0 < 4; ++d0)
#pragma unroll
        for (int e = 0; e < 8; ++e) { const float x = __builtin_bit_cast(float, (unsigned)(unsigned short)qr[d0][e] << 16); q2 += x * x; }
    { auto rr = __builtin_amdgcn_permlane32_swap(__float_as_uint(q2), __float_as_uint(q2), false, false); q2 = __uint_as_float(rr[0]) + __uint_as_float(rr[1]); }
    const float mrow = sqrtf(q2) * kbound + badd;
    { LAS float* raw = (LAS float*)(shm + L_TAB); LAS float* dt = (LAS float*)(shm + L_DT);
      if (tid < 465) raw[tid] = rv * 1.4426950408889634f;
      asm volatile("s_waitcnt lgkmcnt(0)\n\ts_barrier" ::: "memory");
#pragma unroll
      for (int j = 0; j < 4; ++j) { const int i = tid + 512 * j; if (i < 15 * 128) { const int dr = i >> 7, dc = (i & 127) - 64; dt[i] = (dc >= -15 && dc <= 15) ? raw[dr * 31 + dc + 15] : 0.f; } } }
    int cs = c - 8; if (cs < 0) cs = 0; if (cs > 48) cs = 48;
    f32x16 cm0, cm1;
#pragma unroll
    for (int r = 0; r < 16; ++r) { const int kc = (r & 3) + 8 * (r >> 2) + 4 * hi;
        cm0[r] = ((unsigned)(kc - cs) < 16u) ? -mrow : -INFINITY; cm1[r] = ((unsigned)(kc + 32 - cs) < 16u) ? -mrow : -INFINITY; }
    asm volatile("" : "+v"(cm0), "+v"(cm1));
    float l = 0.f; o[0] = f32x16{}; o[1] = f32x16{};
    const unsigned kbase = lds0 + L_K + hi * 1024 + r32 * 16;
    const unsigned vbase = lds0 + L_V + ((lane >> 4) & 1) * 32 + (lane & 3) * 8 + (4 * hi + ((lane & 15) >> 2)) * 64;
    const unsigned tbase = lds0 + L_DT + 4u * (unsigned)(64 - c + 4 * hi);
#define B3_KRD(j) asm volatile("ds_read_b128 %0, %2 offset:%c3\n\tds_read_b128 %1, %2 offset:%c4" : "=&v"(kf[2 * (j)]), "=&v"(kf[2 * (j) + 1]) : "v"(ka), "i"((j) * 2048), "i"((j) * 2048 + 512) : "memory")
#define B3_TR1(dst, off) asm volatile("ds_read2_b32 %0, %1 offset0:%c2 offset1:%c3" : "=&v"(dst) : "v"(ta), "i"(off), "i"((off) + 1) : "memory")
#define B3_T0(j2) B3_TR1(tv0[j2], 8 * ((j2) >> 1) + 2 * ((j2) & 1))
#define B3_T1(j2) B3_TR1(tv1[j2], 8 * ((j2) >> 1) + 2 * ((j2) & 1) + 32)
#define B3_VRD(ii) asm volatile("ds_read_b64_tr_b16 %0, %2 offset:%c3\n\tds_read_b64_tr_b16 %1, %2 offset:%c4" : "=&v"(vlo[ii]), "=&v"(vhi[ii]) : "v"(va), "i"(((ii) >> 2) * 4096 + ((ii) & 3) * 1024), "i"(((ii) >> 2) * 4096 + ((ii) & 3) * 1024 + 512) : "memory")
#define B3_VF(ii) (bf16x8){vlo[ii][0], vlo[ii][1], vlo[ii][2], vlo[ii][3], vhi[ii][0], vhi[ii][1], vhi[ii][2], vhi[ii][3]}
#define B3_PV(dd, pw, ii) o[dd] = __builtin_amdgcn_mfma_f32_32x32x16_bf16(__builtin_bit_cast(bf16x8, pw), B3_VF(ii), o[dd], 0, 0, 0)
#define D_TILE(LEFT) do { \
            const unsigned ka = kbase + (unsigned)slot * SLOTB, va = vbase + (unsigned)slot * SLOTB, ta = tbase + 512u * (unsigned)(dr0 + t); \
            bf16x8 kf[8]; f32x2 tv0[8], tv1[8]; s16x4 vlo[8], vhi[8]; \
            B3_KRD(0); B3_KRD(1); B3_KRD(2); B3_KRD(3);                                          \
            if (LEFT) { B3_T0(0); B3_T0(1); B3_T0(2); B3_T0(3); B3_T0(4); B3_T0(5); }            \
            else      { B3_T1(0); B3_T1(1); B3_T1(2); B3_T1(3); B3_T1(4); B3_T1(5); } \
            asm volatile("s_waitcnt lgkmcnt(6)" : "+v"(kf[0]), "+v"(kf[1]), "+v"(kf[2]), "+v"(kf[3]), "+v"(kf[4]), "+v"(kf[5]), "+v"(kf[6]), "+v"(kf[7])); \
            SBAR(); \
            f32x16 p0 = __builtin_amdgcn_mfma_f32_32x32x16_bf16(kf[0], qr[0], cm0, 0, 0, 0), p1 = __builtin_amdgcn_mfma_f32_32x32x16_bf16(kf[1], qr[0], cm1, 0, 0, 0); \
            _Pragma("unroll") for (int d0 = 1; d0 < 4; ++d0) { p0 = __builtin_amdgcn_mfma_f32_32x32x16_bf16(kf[2 * d0], qr[d0], p0, 0, 0, 0); p1 = __builtin_amdgcn_mfma_f32_32x32x16_bf16(kf[2 * d0 + 1], qr[d0], p1, 0, 0, 0); } \
            SBAR(); \
            asm volatile("s_waitcnt lgkmcnt(5)" ::: "memory");                                    \
            if (LEFT) { B3_T0(6); B3_T0(7); B3_T1(0); B3_T1(1); B3_VRD(0); B3_VRD(1); B3_VRD(2); }     \
            else      { B3_T1(6); B3_T1(7); B3_T0(6); B3_T0(7); B3_VRD(1); B3_VRD(2); B3_VRD(3); } \
            if (LEFT) asm volatile("s_waitcnt lgkmcnt(6)" : "+v"(tv0[0]), "+v"(tv0[1]), "+v"(tv0[2]), "+v"(tv0[3]), "+v"(tv0[4]), "+v"(tv0[5]), "+v"(tv0[6]), "+v"(tv0[7]), "+v"(tv1[0]), "+v"(tv1[1])); \
            else      asm volatile("s_waitcnt lgkmcnt(6)" : "+v"(tv1[0]), "+v"(tv1[1]), "+v"(tv1[2]), "+v"(tv1[3]), "+v"(tv1[4]), "+v"(tv1[5]), "+v"(tv1[6]), "+v"(tv1[7]), "+v"(tv0[6]), "+v"(tv0[7])); \
            SBAR(); \
            float sacc = 0.f; u32x4 pw0, pw1, pw2, pw3; \
            if (LEFT) { \
                _Pragma("unroll") for (int r = 0; r < 16; ++r) { const int j2 = (r >> 2) * 2 + ((r & 3) >> 1), e = r & 1; p0[r] = __builtin_amdgcn_exp2f(p0[r] + tv0[j2][e]); sacc += p0[r]; } \
                _Pragma("unroll") for (int r = 0; r < 4; ++r) { const int j2 = (r & 3) >> 1, e = r & 1; p1[r] = __builtin_amdgcn_exp2f(p1[r] + tv1[j2][e]); sacc += p1[r]; } \
                pw0 = (u32x4){cvtpk_s(p0[0], p0[1]), cvtpk_s(p0[2], p0[3]), cvtpk_s(p0[4], p0[5]), cvtpk_s(p0[6], p0[7])}; \
                pw1 = (u32x4){cvtpk_s(p0[8], p0[9]), cvtpk_s(p0[10], p0[11]), cvtpk_s(p0[12], p0[13]), cvtpk_s(p0[14], p0[15])}; \
                pw2 = (u32x4){cvtpk_s(p1[0], p1[1]), cvtpk_s(p1[2], p1[3]), 0u, 0u}; pw3 = pw2; \
            } else { \
                _Pragma("unroll") for (int r = 0; r < 16; ++r) { const int j2 = (r >> 2) * 2 + ((r & 3) >> 1), e = r & 1; p1[r] = __builtin_amdgcn_exp2f(p1[r] + tv1[j2][e]); sacc += p1[r]; } \
                _Pragma("unroll") for (int r = 12; r < 16; ++r) { const int j2 = 6 + ((r & 3) >> 1), e = r & 1; p0[r] = __builtin_amdgcn_exp2f(p0[r] + tv0[j2][e]); sacc += p0[r]; } \
                pw1 = (u32x4){0u, 0u, cvtpk_s(p0[12], p0[13]), cvtpk_s(p0[14], p0[15])}; pw0 = pw1; \
                pw2 = (u32x4){cvtpk_s(p1[0], p1[1]), cvtpk_s(p1[2], p1[3]), cvtpk_s(p1[4], p1[5]), cvtpk_s(p1[6], p1[7])}; \
                pw3 = (u32x4){cvtpk_s(p1[8], p1[9]), cvtpk_s(p1[10], p1[11]), cvtpk_s(p1[12], p1[13]), cvtpk_s(p1[14], p1[15])}; \
            } \
            l += sacc; \
            SBAR(); \
            if (LEFT) { asm volatile("s_waitcnt lgkmcnt(0)" : "+v"(vlo[0]), "+v"(vlo[1]), "+v"(vlo[2]), "+v"(vhi[0]), "+v"(vhi[1]), "+v"(vhi[2])); \
                        B3_VRD(4); B3_VRD(5); B3_VRD(6); SBAR(); \
                        B3_PV(0, pw0, 0); B3_PV(0, pw1, 1); B3_PV(0, pw2, 2); SBAR(); \
                        asm volatile("s_waitcnt lgkmcnt(0)" : "+v"(vlo[4]), "+v"(vlo[5]), "+v"(vlo[6]), "+v"(vhi[4]), "+v"(vhi[5]), "+v"(vhi[6])); SBAR(); \
                        B3_PV(1, pw0, 4); B3_PV(1, pw1, 5); B3_PV(1, pw2, 6); SBAR(); } \
            else      { asm volatile("s_waitcnt lgkmcnt(0)" : "+v"(vlo[1]), "+v"(vlo[2]), "+v"(vlo[3]), "+v"(vhi[1]), "+v"(vhi[2]), "+v"(vhi[3])); \
                        B3_VRD(5); B3_VRD(6); B3_VRD(7); SBAR(); \
                        B3_PV(0, pw1, 1); B3_PV(0, pw2, 2); B3_PV(0, pw3, 3); SBAR(); \
                        asm volatile("s_waitcnt lgkmcnt(0)" : "+v"(vlo[5]), "+v"(vlo[6]), "+v"(vlo[7]), "+v"(vhi[5]), "+v"(vhi[6]), "+v"(vhi[7])); SBAR(); \
                        B3_PV(1, pw1, 5); B3_PV(1, pw2, 6); B3_PV(1, pw3, 7); SBAR(); } \
        } while (0)
#define D_LOOP(LEFT) do { int slot = 0; \
    for (int t = 0; t < NT; ++t) { \
        if (t + 1 < NT) asm volatile("s_waitcnt vmcnt(2) lgkmcnt(0)\n\ts_barrier" ::: "memory"); else asm volatile("s_waitcnt vmcnt(0) lgkmcnt(0)\n\ts_barrier" ::: "memory"); \
          \
        if (t + 2 < NT) { const int s2 = slot == 0 ? 2 : slot - 1; FD_DMA(t + 2, s2); } \
        if (t >= t_first && t <= t_last) D_TILE(LEFT);             \
        slot = slot == 2 ? 0 : slot + 1; } } while (0)
    if ((wid & 1) == 0) D_LOOP(1); else D_LOOP(0);
#undef D_LOOP
#undef D_TILE
#undef B3_TR1
#undef B3_T0
#undef B3_T1
#undef B3_KRD
#undef B3_VRD
#undef B3_VF
#undef B3_PV
#undef FD_DMA
    asm volatile("s_waitcnt lgkmcnt(0)\n\ts_barrier" ::: "memory");
    { auto rr = __builtin_amdgcn_permlane32_swap(__float_as_uint(l), __float_as_uint(l), false, false); l = __uint_as_float(rr[0]) + __uint_as_float(rr[1]); }
    if (hi == 0) wsf[32 + r32] = l;
    asm volatile("s_waitcnt lgkmcnt(0)" ::: "memory");
#pragma unroll
    for (int r = 0; r < 16; ++r) { const float rl = __builtin_amdgcn_rcpf(wsf[32 + crow(r, hi)]); o[0][r] *= rl; o[1][r] *= rl; }
    asm volatile("s_waitcnt lgkmcnt(0)" ::: "memory");
}
template <class KV, class Hook>
__device__ __forceinline__ void flash_core_dual(LAS unsigned char* shm, const bf16_t* qptr, const KV& kv, int NT, const Hook& hk, f32x16 (&o1)[2], f32x16 (&o2)[2], const int tid) {
    const int lane = tid & 63, r32 = lane & 31, hi = lane >> 5; const int wid = __builtin_amdgcn_readfirstlane(tid >> 6);
    const unsigned lds0 = (unsigned)(uintptr_t)shm;
    LAS float* wsf = (LAS float*)(shm + L_WS) + wid * 64;
    const unsigned kdst = lds0 + L_K + wid * 1024, vdst = lds0 + L_V + wid * 1024;
    const int vrow_j = 16 * (wid & 3) + (lane >> 2), vcol = (wid >> 2) * 32 + (lane & 3) * 8;
#define FA_DMA(t, slot) do { glds16(kv.kptr((t), lane) + wid * 8, (unsigned)__builtin_amdgcn_readfirstlane(kdst + (slot) * SLOTB)); \
                             glds16(kv.vptr((t), vrow_j) + vcol, (unsigned)__builtin_amdgcn_readfirstlane(vdst + (slot) * SLOTB)); } while (0)
    FA_DMA(0, 0);
    bf16x8 qr[4];
#pragma unroll
    for (int d0 = 0; d0 < 4; ++d0) qr[d0] = *(const bf16x8*)(qptr + d0 * 16 + hi * 8);
    asm volatile("" : "+v"(qr[0]), "+v"(qr[1]), "+v"(qr[2]), "+v"(qr[3]));
    float mA = 0.f, lA = 0.f, mB = 0.f, lB = 0.f, curb = 0.f;
    o1[0] = f32x16{}; o1[1] = f32x16{}; o2[0] = f32x16{}; o2[1] = f32x16{}; const f32x16 zero16 = f32x16{};
    bool first = true;
    const int vb0 = (int)(lds0 + L_V) + ((lane >> 4) & 1) * 32 + (lane & 3) * 8 + (4 * hi + ((lane & 15) >> 2)) * 64;
#define FA_MAP(MAP, mh, ll, neg, oo, PW0, PW1, PW2, PW3) do { \
        f32x16 p0, p1; \
        { LAS const unsigned char* kb = shm + L_K + slot * SLOTB + (MAP) * 4096 + hi * 1024 + r32 * 16; \
          const bf16x8 b0 = *(LAS const bf16x8*)(kb), b1 = *(LAS const bf16x8*)(kb + 512), b2 = *(LAS const bf16x8*)(kb + 2048), b3 = *(LAS const bf16x8*)(kb + 2048 + 512); \
          p0 = __builtin_amdgcn_mfma_f32_32x32x16_bf16(b0, qr[2 * (MAP)], zero16, 0, 0, 0); p1 = __builtin_amdgcn_mfma_f32_32x32x16_bf16(b1, qr[2 * (MAP)], zero16, 0, 0, 0); \
          p0 = __builtin_amdgcn_mfma_f32_32x32x16_bf16(b2, qr[2 * (MAP) + 1], p0, 0, 0, 0); p1 = __builtin_amdgcn_mfma_f32_32x32x16_bf16(b3, qr[2 * (MAP) + 1], p1, 0, 0, 0); } \
        hk.apply(p0, p1, t); \
        const float rm = rowmax(p0, p1) + curb - mh; \
        if (first) { mh += rm; \
        } else if (__any(rm > THR)) { const float dl = __builtin_fmaxf(rm, 0.f); mh += dl; \
            const float f = __builtin_amdgcn_exp2f(-dl); ll *= f; if (hi == 0) wsf[r32] = f; \
            asm volatile("s_waitcnt lgkmcnt(0)" ::: "memory"); \
            _Pragma("unroll") for (int r = 0; r < 16; ++r) { const float fr_ = wsf[crow(r, hi)]; oo[0][r] *= fr_; oo[1][r] *= fr_; } \
            asm volatile("s_waitcnt lgkmcnt(0)" ::: "memory"); } \
        float sacc = 0.f, sacc2 = 0.f; const float mref_ = mh - curb; \
        _Pragma("unroll") for (int r = 0; r < 16; ++r) { p0[r] = __builtin_amdgcn_exp2f(p0[r] - mref_); p1[r] = __builtin_amdgcn_exp2f(p1[r] - mref_); sacc += p0[r]; sacc2 += p1[r]; } \
        ll += sacc + sacc2; \
        PW0 = (u32x4){cvtpk_s(p0[0], p0[1]), cvtpk_s(p0[2], p0[3]), cvtpk_s(p0[4], p0[5]), cvtpk_s(p0[6], p0[7])}; \
        PW1 = (u32x4){cvtpk_s(p0[8], p0[9]), cvtpk_s(p0[10], p0[11]), cvtpk_s(p0[12], p0[13]), cvtpk_s(p0[14], p0[15])}; \
        PW2 = (u32x4){cvtpk_s(p1[0], p1[1]), cvtpk_s(p1[2], p1[3]), cvtpk_s(p1[4], p1[5]), cvtpk_s(p1[6], p1[7])}; \
        PW3 = (u32x4){cvtpk_s(p1[8], p1[9]), cvtpk_s(p1[10], p1[11]), cvtpk_s(p1[12], p1[13]), cvtpk_s(p1[14], p1[15])}; \
    } while (0)
    for (int t = 0; t < NT; ++t) {
        const int slot = t & 1;
        if (t + 1 < NT) { FA_DMA(t + 1, slot ^ 1); FA_WAIT_BAR(2); } else { FA_WAIT_BAR(0); }
        curb = hk.cbias(t);
        u32x4 a0, a1, a2, a3, b0_, b1_, b2_, b3_;
        FA_MAP(0, mA, lA, zero16, o1, a0, a1, a2, a3);
        SBAR();
        FA_MAP(1, mB, lB, zero16, o2, b0_, b1_, b2_, b3_);
        first = false;
        SBAR();
        { const int vb = vb0 + slot * SLOTB;
#pragma unroll
          for (int d0 = 0; d0 < 2; ++d0) { s16x4 lo[4], hi_[4];
#pragma unroll
              for (int ks = 0; ks < 4; ++ks) {
                  asm volatile("ds_read_b64_tr_b16 %0,%1 offset:%c2" : "=&v"(lo[ks]) : "v"(vb), "i"(d0 * 4096 + ks * 1024) : "memory");
                  asm volatile("ds_read_b64_tr_b16 %0,%1 offset:%c2" : "=&v"(hi_[ks]) : "v"(vb), "i"(d0 * 4096 + ks * 1024 + 512) : "memory"); }
              asm volatile("s_waitcnt lgkmcnt(0)" ::: "memory"); SBAR();
#define FA_PK(k) (bf16x8){lo[k][0], lo[k][1], lo[k][2], lo[k][3], hi_[k][0], hi_[k][1], hi_[k][2], hi_[k][3]}
              o1[d0] = __builtin_amdgcn_mfma_f32_32x32x16_bf16(__builtin_bit_cast(bf16x8, a0), FA_PK(0), o1[d0], 0, 0, 0);
              o2[d0] = __builtin_amdgcn_mfma_f32_32x32x16_bf16(__builtin_bit_cast(bf16x8, b0_), FA_PK(0), o2[d0], 0, 0, 0);
              o1[d0] = __builtin_amdgcn_mfma_f32_32x32x16_bf16(__builtin_bit_cast(bf16x8, a1), FA_PK(1), o1[d0], 0, 0, 0);
              o2[d0] = __builtin_amdgcn_mfma_f32_32x32x16_bf16(__builtin_bit_cast(bf16x8, b1_), FA_PK(1), o2[d0], 0, 0, 0);
              o1[d0] = __builtin_amdgcn_mfma_f32_32x32x16_bf16(__builtin_bit_cast(bf16x8, a2), FA_PK(2), o1[d0], 0, 0, 0);
              o2[d0] = __builtin_amdgcn_mfma_f32_32x32x16_bf16(__builtin_bit_cast(bf16x8, b2_), FA_PK(2), o2[d0], 0, 0, 0);
              o1[d0] = __builtin_amdgcn_mfma_f32_32x32x16_bf16(__builtin_bit_cast(bf16x8, a3), FA_PK(3), o1[d0], 0, 0, 0);
              o2[d0] = __builtin_amdgcn_mfma_f32_32x32x16_bf16(__builtin_bit_cast(bf16x8, b3_), FA_PK(3), o2[d0], 0, 0, 0);
#undef FA_PK
          } }
        asm volatile("s_waitcnt lgkmcnt(0)\n\ts_barrier" ::: "memory");
    }
#undef FA_DMA
#undef FA_MAP
    { auto rr = __builtin_amdgcn_permlane32_swap(__float_as_uint(lA), __float_as_uint(lA), false, false); lA = __uint_as_float(rr[0]) + __uint_as_float(rr[1]); }
    { auto rr = __builtin_amdgcn_permlane32_swap(__float_as_uint(lB), __float_as_uint(lB), false, false); lB = __uint_as_float(rr[0]) + __uint_as_float(rr[1]); }
    if (hi == 0) { wsf[r32] = lA; wsf[32 + r32] = lB; }
    asm volatile("s_waitcnt lgkmcnt(0)" ::: "memory");
#pragma unroll
    for (int r = 0; r < 16; ++r) { const float ra = __builtin_amdgcn_rcpf(wsf[crow(r, hi)]), rb = __builtin_amdgcn_rcpf(wsf[32 + crow(r, hi)]); o1[0][r] *= ra; o1[1][r] *= ra; o2[0][r] *= rb; o2[1][r] *= rb; }
}
template <class KV, class Hook>
__device__ __forceinline__ void flash_core_dual_sp(LAS unsigned char* shm, const bf16_t* qptr, const KV& kv, int NT, const Hook& hk, f32x16 (&o1)[2], f32x16 (&o2)[2], const int tid) {
    const int lane = tid & 63, r32 = lane & 31, hi = lane >> 5; const int wid = __builtin_amdgcn_readfirstlane(tid >> 6);
    const unsigned lds0 = (unsigned)(uintptr_t)shm;
    LAS float* wsf = (LAS float*)(shm + L_WS) + wid * 64;
    const unsigned kdst = lds0 + L_K + wid * 1024, vdst = lds0 + L_V + wid * 1024;
    const int vrow_j = 16 * (wid & 3) + (lane >> 2), vcol = (wid >> 2) * 32 + (lane & 3) * 8;
#define FA_DMAK(t) glds16(kv.kptr((t), lane) + wid * 8, (unsigned)__builtin_amdgcn_readfirstlane(kdst + ((t) & 1) * SLOTB))
#define FA_DMAV(t) glds16(kv.vptr((t), vrow_j) + vcol, (unsigned)__builtin_amdgcn_readfirstlane(vdst + ((t) & 1) * SLOTB))
    FA_DMAK(0); FA_DMAV(0); if (NT > 1) FA_DMAK(1);
    bf16x8 qr[4];
#pragma unroll
    for (int d0 = 0; d0 < 4; ++d0) qr[d0] = *(const bf16x8*)(qptr + d0 * 16 + hi * 8);
    asm volatile("" : "+v"(qr[0]), "+v"(qr[1]), "+v"(qr[2]), "+v"(qr[3]));
    LAS bf16x8* qst = (LAS bf16x8*)(shm + L_QST) + wid * 256 + lane;
    qst[0] = qr[0]; qst[64] = qr[1]; qst[128] = qr[2]; qst[192] = qr[3];
    float mA = 0.f, lA = 0.f, mB = 0.f, lB = 0.f;
    o1[0] = f32x16{}; o1[1] = f32x16{}; o2[0] = f32x16{}; o2[1] = f32x16{}; const f32x16 zero16 = f32x16{};
    const int vb0 = (int)(lds0 + L_V) + ((lane >> 4) & 1) * 32 + (lane & 3) * 8 + (4 * hi + ((lane & 15) >> 2)) * 64;
    bf16x8 kfA[4], kfB[4]; f32x16 pA0, pA1, pB0, pB1;
#define FA_KLOADA(tt) do { LAS const unsigned char* kb_ = shm + L_K + ((tt) & 1) * SLOTB + hi * 1024 + r32 * 16; \
        kfA[0] = *(LAS const bf16x8*)(kb_); kfA[1] = *(LAS const bf16x8*)(kb_ + 512); kfA[2] = *(LAS const bf16x8*)(kb_ + 2048); kfA[3] = *(LAS const bf16x8*)(kb_ + 2560); } while (0)
#define FA_KLOADB(tt) do { LAS const unsigned char* kb_ = shm + L_K + ((tt) & 1) * SLOTB + hi * 1024 + r32 * 16; \
        kfB[0] = *(LAS const bf16x8*)(kb_ + 4096); kfB[1] = *(LAS const bf16x8*)(kb_ + 4608); kfB[2] = *(LAS const bf16x8*)(kb_ + 6144); kfB[3] = *(LAS const bf16x8*)(kb_ + 6656); } while (0)
#define FA_QKA() do { const bf16x8 q0_ = qst[0], q1_ = qst[64]; pA0 = __builtin_amdgcn_mfma_f32_32x32x16_bf16(kfA[0], q0_, zero16, 0, 0, 0); pA1 = __builtin_amdgcn_mfma_f32_32x32x16_bf16(kfA[1], q0_, zero16, 0, 0, 0); \
        pA0 = __builtin_amdgcn_mfma_f32_32x32x16_bf16(kfA[2], q1_, pA0, 0, 0, 0); pA1 = __builtin_amdgcn_mfma_f32_32x32x16_bf16(kfA[3], q1_, pA1, 0, 0, 0); } while (0)
#define FA_QKB() do { const bf16x8 q2_ = qst[128], q3_ = qst[192]; pB0 = __builtin_amdgcn_mfma_f32_32x32x16_bf16(kfB[0], q2_, zero16, 0, 0, 0); pB1 = __builtin_amdgcn_mfma_f32_32x32x16_bf16(kfB[1], q2_, zero16, 0, 0, 0); \
        pB0 = __builtin_amdgcn_mfma_f32_32x32x16_bf16(kfB[2], q3_, pB0, 0, 0, 0); pB1 = __builtin_amdgcn_mfma_f32_32x32x16_bf16(kfB[3], q3_, pB1, 0, 0, 0); } while (0)
#define FA_SM(p0, p1, mh, ll, oo, PW0, PW1, PW2, PW3) do { \
        hk.apply(p0, p1, t); \
        const float rm = rowmax(p0, p1) + curb - mh; \
        if (__any(rm > THR)) { const float dl = __builtin_fmaxf(rm, 0.f); mh += dl; \
            const float f = __builtin_amdgcn_exp2f(-dl); ll *= f; if (hi == 0) wsf[r32] = f; \
            asm volatile("s_waitcnt lgkmcnt(0)" ::: "memory"); \
            _Pragma("unroll") for (int r = 0; r < 16; ++r) { const float fr_ = wsf[crow(r, hi)]; oo[0][r] *= fr_; oo[1][r] *= fr_; } \
            asm volatile("s_waitcnt lgkmcnt(0)" ::: "memory"); } \
        float sacc = 0.f, sacc2 = 0.f; const float mref_ = mh - curb; \
        _Pragma("unroll") for (int r = 0; r < 16; ++r) { p0[r] = __builtin_amdgcn_exp2f(p0[r] - mref_); p1[r] = __builtin_amdgcn_exp2f(p1[r] - mref_); sacc += p0[r]; sacc2 += p1[r]; } \
        ll += sacc + sacc2; \
        PW0 = (u32x4){cvtpk_s(p0[0], p0[1]), cvtpk_s(p0[2], p0[3]), cvtpk_s(p0[4], p0[5]), cvtpk_s(p0[6], p0[7])}; \
        PW1 = (u32x4){cvtpk_s(p0[8], p0[9]), cvtpk_s(p0[10], p0[11]), cvtpk_s(p0[12], p0[13]), cvtpk_s(p0[14], p0[15])}; \
        PW2 = (u32x4){cvtpk_s(p1[0], p1[1]), cvtpk_s(p1[2], p1[3]), cvtpk_s(p1[4], p1[5]), cvtpk_s(p1[6], p1[7])}; \
        PW3 = (u32x4){cvtpk_s(p1[8], p1[9]), cvtpk_s(p1[10], p1[11]), cvtpk_s(p1[12], p1[13]), cvtpk_s(p1[14], p1[15])}; \
    } while (0)
    FA_WAIT_BAR(0);
    FA_KLOADA(0); FA_KLOADB(0);
    FA_QKB();
    { const float cb0 = hk.cbias(0); mB = rowmax(pB0, pB1) + cb0; FA_QKA(); mA = rowmax(pA0, pA1) + cb0; }
#define FA_VTR(off) __builtin_bit_cast(s16x4, __builtin_amdgcn_ds_read_tr16_b64_v4i16((LAS v4i16_t*)(vp_ + (off))))
#define FA_PVM(oo, w0, w1, w2, w3) do { LAS const unsigned char* vp_ = shm + L_V + (t & 1) * SLOTB + vboff; \
        _Pragma("unroll") for (int d0 = 0; d0 < 2; ++d0) { s16x4 lo[4], hi_[4]; \
            _Pragma("unroll") for (int ks = 0; ks < 4; ++ks) { lo[ks] = FA_VTR(d0 * 4096 + ks * 1024); hi_[ks] = FA_VTR(d0 * 4096 + ks * 1024 + 512); } \
            oo[d0] = __builtin_amdgcn_mfma_f32_32x32x16_bf16(__builtin_bit_cast(bf16x8, w0), (bf16x8){lo[0][0], lo[0][1], lo[0][2], lo[0][3], hi_[0][0], hi_[0][1], hi_[0][2], hi_[0][3]}, oo[d0], 0, 0, 0); \
            oo[d0] = __builtin_amdgcn_mfma_f32_32x32x16_bf16(__builtin_bit_cast(bf16x8, w1), (bf16x8){lo[1][0], lo[1][1], lo[1][2], lo[1][3], hi_[1][0], hi_[1][1], hi_[1][2], hi_[1][3]}, oo[d0], 0, 0, 0); \
            oo[d0] = __builtin_amdgcn_mfma_f32_32x32x16_bf16(__builtin_bit_cast(bf16x8, w2), (bf16x8){lo[2][0], lo[2][1], lo[2][2], lo[2][3], hi_[2][0], hi_[2][1], hi_[2][2], hi_[2][3]}, oo[d0], 0, 0, 0); \
            oo[d0] = __builtin_amdgcn_mfma_f32_32x32x16_bf16(__builtin_bit_cast(bf16x8, w3), (bf16x8){lo[3][0], lo[3][1], lo[3][2], lo[3][3], hi_[3][0], hi_[3][1], hi_[3][2], hi_[3][3]}, oo[d0], 0, 0, 0); } } while (0)
    const int vboff = ((lane >> 4) & 1) * 32 + (lane & 3) * 8 + (4 * hi + ((lane & 15) >> 2)) * 64;
    for (int t = 0; t < NT; ++t) {
        if (t + 2 < NT) FA_DMAK(t + 2);
        if (t + 1 < NT) FA_DMAV(t + 1);
        const float curb = hk.cbias(t);
        FA_QKB();
        SBAR();
        if (t + 1 < NT) { FA_KLOADA(t + 1); FA_KLOADB(t + 1); }
        { u32x4 a0, a1, a2, a3;
          FA_SM(pA0, pA1, mA, lA, o1, a0, a1, a2, a3);
          SBAR();
          FA_PVM(o1, a0, a1, a2, a3); }
        SBAR();
        { u32x4 b0_, b1_, b2_, b3_;
          FA_SM(pB0, pB1, mB, lB, o2, b0_, b1_, b2_, b3_);
          SBAR();
          if (t + 1 < NT) FA_QKA();
          SBAR();
          FA_PVM(o2, b0_, b1_, b2_, b3_); }
        FA_WAIT_BAR(0);
    }
#undef FA_PVM
#undef FA_VTR
#undef FA_DMAK
#undef FA_DMAV
#undef FA_KLOADA
#undef FA_KLOADB
#undef FA_QKA
#undef FA_QKB
#undef FA_SM
    { auto rr = __builtin_amdgcn_permlane32_swap(__float_as_uint(lA), __float_as_uint(lA), false, false); lA = __uint_as_float(rr[0]) + __uint_as_float(rr[1]); }
    { auto rr = __builtin_amdgcn_permlane32_swap(__float_as_uint(lB), __float_as_uint(lB), false, false); lB = __uint_as_float(rr[0]) + __uint_as_float(rr[1]); }
    if (hi == 0) { wsf[r32] = lA; wsf[32 + r32] = lB; }
    asm volatile("s_waitcnt lgkmcnt(0)" ::: "memory");
#pragma unroll
    for (int r = 0; r < 16; ++r) { const float ra = __builtin_amdgcn_rcpf(wsf[crow(r, hi)]), rb = __builtin_amdgcn_rcpf(wsf[32 + crow(r, hi)]); o1[0][r] *= ra; o1[1][r] *= ra; o2[0][r] *= rb; o2[1][r] *= rb; }
}
__device__ __forceinline__ void stage_o(LAS float* stg, const f32x16 (&o)[2], int r32, int hi) {
#pragma unroll
    for (int r = 0; r < 16; ++r) { const int orow = crow(r, hi); stg[orow * 64 + r32] = o[0][r]; stg[orow * 64 + 32 + r32] = o[1][r]; }
    asm volatile("s_waitcnt lgkmcnt(0)" ::: "memory");
}
__device__ __forceinline__ float silu(float g) { return g * __builtin_amdgcn_rcpf(1.f + __builtin_amdgcn_exp2f(-1.4426950408889634f * g)); }
}

#undef SBAR
namespace tb {
using bf16=unsigned short;
constexpr int D=64,DM=INW;
constexpr int NW=8,QBLK=32,QB=QBLK*NW,KVBLK=64;
__device__ __forceinline__ int crow(int r,int hi){return (r&3)+8*(r>>2)+4*hi;}
#define SBAR() __builtin_amdgcn_sched_barrier(0)
constexpr int NSLOT=3, SLOTB=8192;
constexpr int LDS_K=0, LDS_V=NSLOT*SLOTB, LDS_WS=2*NSLOT*SLOTB, LDS_OST=LDS_WS+NW*64*4, LDS_BYTES=LDS_OST+NW*4096;
constexpr float C2=0.125f*1.4426950408889634f;
__device__ __forceinline__ void glds16(const void*gsrc,unsigned lds_dst){unsigned keep;
  asm volatile("s_mov_b32 %0, m0\n\ts_mov_b32 m0, %2\n\ts_nop 0\n\tglobal_load_lds_dwordx4 %1, off\n\ts_mov_b32 m0, %0":"=&s"(keep):"v"(gsrc),"s"(lds_dst):"memory");}
__device__ __forceinline__ void glds16s(const void*sbase,unsigned voff,unsigned lds_dst){unsigned keep;
  asm volatile("s_mov_b32 %0, m0\n\ts_mov_b32 m0, %3\n\ts_nop 0\n\tglobal_load_lds_dwordx4 %1, %2\n\ts_mov_b32 m0, %0":"=&s"(keep):"v"(voff),"s"(sbase),"s"(lds_dst):"memory");}
__device__ __forceinline__ float max3f(float a,float b,float c){float r;asm("v_max3_f32 %0, %1, %2, %3":"=v"(r):"v"(a),"v"(b),"v"(c));return r;}
__device__ __forceinline__ float max2f(float a,float b){float r;asm("v_max_f32_e32 %0, %1, %2":"=v"(r):"v"(a),"v"(b));return r;}
__device__ __forceinline__ float fadd_s(float a,float b){float r;asm("v_add_f32_e32 %0, %1, %2":"=v"(r):"v"(a),"v"(b));return r;}
__device__ __forceinline__ float fsub_s(float a,float b){float r;asm("v_sub_f32_e32 %0, %1, %2":"=v"(r):"v"(a),"v"(b));return r;}
typedef float f32x2_t __attribute__((ext_vector_type(2))); typedef __bf16 bf16x2_t __attribute__((ext_vector_type(2)));
__device__ __forceinline__ unsigned cvtpk_s(float lo,float hi){f32x2_t v={lo,hi};bf16x2_t b=__builtin_convertvector(v,bf16x2_t);return __builtin_bit_cast(unsigned,b);}
#define WAIT_BAR(N) asm volatile("s_waitcnt vmcnt(" #N ") lgkmcnt(0)\n\ts_barrier":::"memory")

__device__ __forceinline__ void qkt(f32x16&p0,f32x16&p1,const char*Kslot,const bf16x8*qr,const f32x16&negm,int r32,int hi){
  const char*kb=Kslot+hi*1024+r32*16;
  #pragma unroll
  for(int d0=0;d0<4;++d0){
    const bf16x8 b0=*reinterpret_cast<const bf16x8*>(kb+d0*2048);
    const bf16x8 b1=*reinterpret_cast<const bf16x8*>(kb+d0*2048+512);
    if(d0==0){p0=__builtin_amdgcn_mfma_f32_32x32x16_bf16(b0,qr[0],negm,0,0,0);p1=__builtin_amdgcn_mfma_f32_32x32x16_bf16(b1,qr[0],negm,0,0,0);}
    else{p0=__builtin_amdgcn_mfma_f32_32x32x16_bf16(b0,qr[d0],p0,0,0,0);p1=__builtin_amdgcn_mfma_f32_32x32x16_bf16(b1,qr[d0],p1,0,0,0);}}
}
typedef __attribute__((address_space(3))) const char* lds_cptr;
__device__ __forceinline__ void kload8(bf16x8*kf,lds_cptr kp){
  kf[0]=*(const __attribute__((address_space(3))) bf16x8*)(kp);      kf[1]=*(const __attribute__((address_space(3))) bf16x8*)(kp+512);
  kf[2]=*(const __attribute__((address_space(3))) bf16x8*)(kp+2048); kf[3]=*(const __attribute__((address_space(3))) bf16x8*)(kp+2560);
  kf[4]=*(const __attribute__((address_space(3))) bf16x8*)(kp+4096); kf[5]=*(const __attribute__((address_space(3))) bf16x8*)(kp+4608);
  kf[6]=*(const __attribute__((address_space(3))) bf16x8*)(kp+6144); kf[7]=*(const __attribute__((address_space(3))) bf16x8*)(kp+6656);
}
__device__ __forceinline__ void kload4(bf16x8*kf,lds_cptr kp){
  kf[0]=*(const __attribute__((address_space(3))) bf16x8*)(kp);      kf[1]=*(const __attribute__((address_space(3))) bf16x8*)(kp+512);
  kf[2]=*(const __attribute__((address_space(3))) bf16x8*)(kp+2048); kf[3]=*(const __attribute__((address_space(3))) bf16x8*)(kp+2560);
}
__device__ __forceinline__ void kload2(bf16x8*kf,lds_cptr kp,int j){ kf[2*j]=*(const __attribute__((address_space(3))) bf16x8*)(kp+j*2048); kf[2*j+1]=*(const __attribute__((address_space(3))) bf16x8*)(kp+j*2048+512); }
__device__ __forceinline__ s16x4 vtr(lds_cptr p){ return __builtin_bit_cast(s16x4,__builtin_amdgcn_ds_read_tr16_b64_v4i16((__attribute__((address_space(3))) v4i16_t*)p)); }
__device__ __forceinline__ float rowmax(const f32x16&p0,const f32x16&p1){
  float a=max3f(p0[0],p0[1],p1[0]),b=max3f(p0[2],p0[3],p1[1]);a=max3f(a,p1[2],p1[3]);
  #pragma unroll
  for(int r=4;r<16;r+=4){a=max3f(a,p0[r],p0[r+1]);b=max3f(b,p0[r+2],p0[r+3]);a=max3f(a,p1[r],p1[r+1]);b=max3f(b,p1[r+2],p1[r+3]);}
  const float m=max2f(a,b);
  auto rr=__builtin_amdgcn_permlane32_swap(__float_as_uint(m),__float_as_uint(m),false,false);
  return max2f(__uint_as_float(rr[0]),__uint_as_float(rr[1]));
}
__device__ __forceinline__ void pv(f32x16*o,int vb,bf16x8 pa0,bf16x8 pa1,bf16x8 pa2,bf16x8 pa3){
  #pragma unroll
  for(int d0=0;d0<2;++d0){s16x4 lo[4],hi[4];
    #pragma unroll
    for(int ks=0;ks<4;++ks){
      asm volatile("ds_read_b64_tr_b16 %0,%1 offset:%c2":"=&v"(lo[ks]):"v"(vb),"i"(d0*4096+ks*1024):"memory");
      asm volatile("ds_read_b64_tr_b16 %0,%1 offset:%c2":"=&v"(hi[ks]):"v"(vb),"i"(d0*4096+ks*1024+512):"memory");}
    asm volatile("s_waitcnt lgkmcnt(0)":::"memory");SBAR();
    #define PK(k) (bf16x8){lo[k][0],lo[k][1],lo[k][2],lo[k][3],hi[k][0],hi[k][1],hi[k][2],hi[k][3]}
    o[d0]=__builtin_amdgcn_mfma_f32_32x32x16_bf16(pa0,PK(0),o[d0],0,0,0);
    o[d0]=__builtin_amdgcn_mfma_f32_32x32x16_bf16(pa1,PK(1),o[d0],0,0,0);
    o[d0]=__builtin_amdgcn_mfma_f32_32x32x16_bf16(pa2,PK(2),o[d0],0,0,0);
    o[d0]=__builtin_amdgcn_mfma_f32_32x32x16_bf16(pa3,PK(3),o[d0],0,0,0);
    #undef PK
  }
}

template<int THRL,int MODE,bool BOUND> __device__ __forceinline__ void attn_unit(const int tid,const bf16*Qw,const bf16*__restrict__ Kh,const bf16*__restrict__ Vh,const int NT,const bf16*Gp,bf16*Ow,char*shm,
                                                                 const int cmap,const __attribute__((address_space(3))) float*tabc,const int qw,const float bl,const float br,const float kbound,const float badd){
  const int lane=tid&63,r32=lane&31,hi=lane>>5; const int wid=__builtin_amdgcn_readfirstlane(tid>>6);
  const unsigned lds0=(unsigned)(uintptr_t)shm;
  float*wsf=(float*)(shm+LDS_WS)+wid*64;
  const unsigned koff=(unsigned)(lane*DM+wid*8)*2u;
  const unsigned voff=(unsigned)((16*(wid&3)+(lane>>2))*DM+(wid>>2)*32+(lane&3)*8)*2u;
  const unsigned kdst=lds0+LDS_K+wid*1024, vdst=lds0+LDS_V+wid*1024;
  #define DMA_K(t,slot) glds16s(Kh+(long)(t)*KVBLK*DM,koff,(unsigned)__builtin_amdgcn_readfirstlane(kdst+(slot)))
  #define DMA_V(t,slot) glds16s(Vh+(long)(t)*KVBLK*DM,voff,(unsigned)__builtin_amdgcn_readfirstlane(vdst+(slot)))
  const int vb0=(int)(lds0+LDS_V)+((lane>>4)&1)*32+(lane&3)*8+(4*hi+((lane&15)>>2))*64;
  const char*Kbase=shm+LDS_K; bf16x8 kf[8];
  const lds_cptr shm3=(lds_cptr)shm; const lds_cptr kp0=shm3+LDS_K+hi*1024+r32*16; const lds_cptr kpLo=kp0+(MODE==1?cmap*4096:0), kpHi=kp0+(MODE==1?(1-cmap)*4096:4096); const lds_cptr vp0=shm3+LDS_V+((lane>>4)&1)*32+(lane&3)*8+(4*hi+((lane&15)>>2))*64;
  DMA_K(0,0);DMA_V(0,0);DMA_K(1,SLOTB);
  bf16x8 qr[4];
  #pragma unroll
  for(int d0=0;d0<4;++d0){ if(MODE==0||d0<2)qr[d0]=*reinterpret_cast<const bf16x8*>(&Qw[(long)r32*DM+d0*16+hi*8]); else qr[d0]=(bf16x8){0,0,0,0,0,0,0,0}; }
  float mrow=0.f;
  if(BOUND){ float q2=0.f;
    #pragma unroll
    for(int d0=0;d0<(MODE==1?2:4);++d0){
      #pragma unroll
      for(int e=0;e<8;++e){ const float x=__builtin_bit_cast(float,(unsigned)(unsigned short)qr[d0][e]<<16); q2+=x*x; } }
    { auto rr=__builtin_amdgcn_permlane32_swap(__float_as_uint(q2),__float_as_uint(q2),false,false); q2=__uint_as_float(rr[0])+__uint_as_float(rr[1]); }
    mrow=sqrtf(q2)*kbound+badd; }
  float mhat=0.f,l_reg=0.f;f32x16 o[2];o[0]=f32x16{};o[1]=f32x16{};f32x16 negm=f32x16{};asm volatile("":"+v"(negm));
  const unsigned blu=__builtin_amdgcn_readfirstlane(__float_as_uint(bl)), bru=__builtin_amdgcn_readfirstlane(__float_as_uint(br)); unsigned curbu=0u; float curb=0.f;
  #define cbias_(t) ((64*(t)+63-qw<=-91)?blu:((64*(t)-qw-31>=91)?bru:0u))
  #define CBSET(t) do{ if(MODE==1){ const unsigned cb_=cbias_(t); if(cb_!=curbu){ curbu=cb_; curb=__uint_as_float(curbu); _Pragma("unroll") for(int r=0;r<16;++r)negm[r]=curb-mhat; asm volatile("":"+v"(negm)); } } }while(0)
  #define BIASHOOK(P0,P1,t) do{ if(MODE==1){ if(64*(t)+63-qw>-91&&64*(t)-qw-31<91){ const __attribute__((address_space(3))) float*tp_=tabc+(320+64*(t)-qw-r32+4*hi); \
      _Pragma("unroll") for(int r=0;r<16;++r){const int kk_=(r&3)+8*(r>>2);P0[r]+=tp_[kk_];P1[r]+=tp_[kk_+32];} } } }while(0)
  #define CMASK(P0,P1,t) BIASHOOK(P0,P1,t)
  bool resc=false;
  #define START(P0,P1) do{ const float rm=BOUND?mrow:rowmax(P0,P1); resc=false; \
    { const float dl=rm; mhat=fadd_s(mhat,dl); \
      _Pragma("unroll") for(int r=0;r<16;++r){P0[r]=fsub_s(P0[r],dl);P1[r]=fsub_s(P1[r],dl);} \
      _Pragma("unroll") for(int r=0;r<16;++r)negm[r]=curb-mhat; asm volatile("":"+v"(negm)); } \
    _Pragma("unroll") for(int r=0;r<16;++r)P0[r]=__builtin_amdgcn_exp2f(P0[r]); }while(0)
  #define RESC() do{ if(resc){ asm volatile("s_waitcnt lgkmcnt(0)":::"memory"); \
      _Pragma("unroll") for(int d_=0;d_<2;++d_) _Pragma("unroll") for(int r=0;r<16;++r)o[d_][r]*=wsf[crow(r,hi)]; } }while(0)
  f32x16 pA0,pA1,pB0,pB1;
  int sl_prev=0,sl_cur=0,sl_next=SLOTB;
  #define ROT() do{sl_prev=sl_cur;sl_cur=sl_next;sl_next=(sl_next==(NSLOT-1)*SLOTB)?0:sl_next+SLOTB;}while(0)
  DMA_K(2,2*SLOTB);
  WAIT_BAR(3);
  if(MODE==1){ curbu=cbias_(0); curb=__uint_as_float(curbu); _Pragma("unroll") for(int r=0;r<16;++r)negm[r]=curb; asm volatile("":"+v"(negm)); }
  kload4(kf,kpLo);if(MODE==0)kload4(kf+4,kpHi);
  pA0=__builtin_amdgcn_mfma_f32_32x32x16_bf16(kf[0],qr[0],negm,0,0,0);pA1=__builtin_amdgcn_mfma_f32_32x32x16_bf16(kf[1],qr[0],negm,0,0,0);
  _Pragma("unroll") for(int d0=1;d0<(MODE==1?2:4);++d0){pA0=__builtin_amdgcn_mfma_f32_32x32x16_bf16(kf[2*d0],qr[d0],pA0,0,0,0);pA1=__builtin_amdgcn_mfma_f32_32x32x16_bf16(kf[2*d0+1],qr[d0],pA1,0,0,0);}
  asm volatile("s_nop 15\n\ts_nop 7":"+v"(pA0),"+v"(pA1));CMASK(pA0,pA1,0);
  START(pA0,pA1);
  _Pragma("unroll") for(int r=0;r<16;++r)pA1[r]=__builtin_amdgcn_exp2f(pA1[r]);
  WAIT_BAR(0);
  DMA_K(3,0);DMA_V(1,SLOTB);
  ROT();
  kload4(kf,kpLo+sl_cur);if(MODE==0)kload4(kf+4,kpHi+sl_cur);
  WAIT_BAR(2);
  s16x4 vlo[8],vhi[8]; u32x4 pw0,pw1,pw2,pw3;
  #define PKW(P,B) cvtpk_s(P[B],P[B+1])
  #define PAF(k) __builtin_bit_cast(bf16x8,pw##k)
  #define VFR(i) (bf16x8){vlo[i][0],vlo[i][1],vlo[i][2],vlo[i][3],vhi[i][0],vhi[i][1],vhi[i][2],vhi[i][3]}
  #define PIN(x) asm volatile("":"+v"(x))
  #define MX3(a,b,c) __builtin_fmaxf(__builtin_fmaxf((a),(b)),(c))
  #define GAPA(MF,A0,A1,A2,A3,W0,W1,PW) do{ MF; sacc+=A0; sacc+=A1; sacc+=A2; sacc+=A3; PIN(sacc); W0; W1; PIN(PW); SBAR(); }while(0)
  #define EX(v) __builtin_amdgcn_exp2f(v)
  #define GAPB(MF,X,B) do{ MF; X[B]=EX(X[B]); X[B+1]=EX(X[B+1]); X[B+2]=EX(X[B+2]); X[B+3]=EX(X[B+3]); PIN(X); SBAR(); }while(0)
  #define VRD(i) do{ vlo[i]=vtr(vp_+(((i)>>2)*4096+((i)&3)*1024)); vhi[i]=vtr(vp_+(((i)>>2)*4096+((i)&3)*1024+512)); }while(0)
  #define KRD(G,j) do{ if(G){ if((j)<2){kload2(kf,kpLo+sl_next,(j));}else if(MODE==0){kload2(kf+4,kpHi+sl_next,(j)-2);} SBAR(); } }while(0)
  #define STEP(C0,C1,P0,P1,t,GK,GV,GL) do{ SBAR(); \
    const lds_cptr vp_=vp0+sl_prev; \
    VRD(0); SBAR(); float sacc=(P0[0]+P0[1]); \
    GAPA(C0=__builtin_amdgcn_mfma_f32_32x32x16_bf16(kf[0],qr[0],negm,0,0,0), P0[2],P0[3],P0[4],P0[5],     pw0[0]=PKW(P0,0), pw0[1]=PKW(P0,2), pw0); \
    VRD(4); SBAR(); GAPA(C1=__builtin_amdgcn_mfma_f32_32x32x16_bf16(kf[1],qr[0],negm,0,0,0), P0[6],P0[7],P0[8],P0[9],     pw0[2]=PKW(P0,4), pw0[3]=PKW(P0,6), pw0); \
    VRD(1); SBAR(); GAPA(C0=__builtin_amdgcn_mfma_f32_32x32x16_bf16(kf[2],qr[1],C0,0,0,0),   P0[10],P0[11],P0[12],P0[13], pw1[0]=PKW(P0,8), pw1[1]=PKW(P0,10), pw1); \
    VRD(5); SBAR(); GAPA(C1=__builtin_amdgcn_mfma_f32_32x32x16_bf16(kf[3],qr[1],C1,0,0,0),   P0[14],P0[15],P1[0],P1[1],   pw1[2]=PKW(P0,12),pw1[3]=PKW(P0,14), pw1); \
    VRD(2); SBAR(); GAPA(if(MODE==0)C0=__builtin_amdgcn_mfma_f32_32x32x16_bf16(kf[4],qr[2],C0,0,0,0),   P1[2],P1[3],P1[4],P1[5],     pw2[0]=PKW(P1,0), pw2[1]=PKW(P1,2), pw2); \
    VRD(6); SBAR(); GAPA(if(MODE==0)C1=__builtin_amdgcn_mfma_f32_32x32x16_bf16(kf[5],qr[2],C1,0,0,0),   P1[6],P1[7],P1[8],P1[9],     pw2[2]=PKW(P1,4), pw2[3]=PKW(P1,6), pw2); \
    VRD(3); SBAR(); GAPA(if(MODE==0)C0=__builtin_amdgcn_mfma_f32_32x32x16_bf16(kf[6],qr[3],C0,0,0,0),   P1[10],P1[11],P1[12],P1[13], pw3[0]=PKW(P1,8), pw3[1]=PKW(P1,10), pw3); \
    VRD(7); SBAR(); GAPA(if(MODE==0)C1=__builtin_amdgcn_mfma_f32_32x32x16_bf16(kf[7],qr[3],C1,0,0,0),   P1[14],P1[15],0.f,0.f,       pw3[2]=PKW(P1,12),pw3[3]=PKW(P1,14), pw3); \
    l_reg+=sacc; \
    if(GK){DMA_K((t)+3,sl_cur);} if(GV){DMA_V((t)+1,sl_next);} \
    CMASK(C0,C1,t); \
    if(!BOUND){ float a=MX3(C0[0],C0[1],C1[0]),b=MX3(C0[2],C0[3],C1[1]); a=MX3(a,C1[2],C1[3]); \
      _Pragma("unroll") for(int r=4;r<16;r+=4){a=MX3(a,C0[r],C0[r+1]);b=MX3(b,C0[r+2],C0[r+3]);a=MX3(a,C1[r],C1[r+1]);b=MX3(b,C1[r+2],C1[r+3]);} \
      float rm=__builtin_fmaxf(a,b); { auto rr=__builtin_amdgcn_permlane32_swap(__float_as_uint(rm),__float_as_uint(rm),false,false); rm=__builtin_fmaxf(__uint_as_float(rr[0]),__uint_as_float(rr[1])); } \
      resc=false; \
      if(__builtin_expect(__any(rm>(float)THRL),0)){ const float dl=__builtin_fmaxf(rm,0.f); mhat+=dl; \
        _Pragma("unroll") for(int r=0;r<16;++r){C0[r]-=dl;C1[r]-=dl;} \
        _Pragma("unroll") for(int r=0;r<16;++r)negm[r]=curb-mhat; asm volatile("":"+v"(negm)); \
        const float f=__builtin_amdgcn_exp2f(-dl); l_reg*=f; if(hi==0)wsf[r32]=f; resc=true; } } \
    SBAR(); \
    GAPB(o[0]=__builtin_amdgcn_mfma_f32_32x32x16_bf16(PAF(0),VFR(0),o[0],0,0,0), C0,0); \
    GAPB(o[1]=__builtin_amdgcn_mfma_f32_32x32x16_bf16(PAF(0),VFR(4),o[1],0,0,0), C0,4); \
    KRD(GL,0); GAPB(o[0]=__builtin_amdgcn_mfma_f32_32x32x16_bf16(PAF(1),VFR(1),o[0],0,0,0), C0,8); \
    KRD(GL,1); GAPB(o[1]=__builtin_amdgcn_mfma_f32_32x32x16_bf16(PAF(1),VFR(5),o[1],0,0,0), C0,12); \
    KRD(GL,2); GAPB(o[0]=__builtin_amdgcn_mfma_f32_32x32x16_bf16(PAF(2),VFR(2),o[0],0,0,0), C1,0); \
    KRD(GL,3); GAPB(o[1]=__builtin_amdgcn_mfma_f32_32x32x16_bf16(PAF(2),VFR(6),o[1],0,0,0), C1,4); \
    GAPB(o[0]=__builtin_amdgcn_mfma_f32_32x32x16_bf16(PAF(3),VFR(3),o[0],0,0,0), C1,8); \
    GAPB(o[1]=__builtin_amdgcn_mfma_f32_32x32x16_bf16(PAF(3),VFR(7),o[1],0,0,0), C1,12); \
    }while(0)
  int t=1;
  #undef CMASK
  #define CMASK(P0,P1,t) BIASHOOK(P0,P1,t)
  for(;t+9<NT;t+=6){
    { constexpr int sl_prev=0,sl_cur=SLOTB,sl_next=2*SLOTB; CBSET(t);   STEP(pB0,pB1,pA0,pA1,t,true,true,true);     WAIT_BAR(2); RESC(); }
    { constexpr int sl_prev=SLOTB,sl_cur=2*SLOTB,sl_next=0; CBSET(t+1); STEP(pA0,pA1,pB0,pB1,t+1,true,true,true);   WAIT_BAR(2); RESC(); }
    { constexpr int sl_prev=2*SLOTB,sl_cur=0,sl_next=SLOTB; CBSET(t+2); STEP(pB0,pB1,pA0,pA1,t+2,true,true,true);   WAIT_BAR(2); RESC(); }
    { constexpr int sl_prev=0,sl_cur=SLOTB,sl_next=2*SLOTB; CBSET(t+3); STEP(pA0,pA1,pB0,pB1,t+3,true,true,true);   WAIT_BAR(2); RESC(); }
    { constexpr int sl_prev=SLOTB,sl_cur=2*SLOTB,sl_next=0; CBSET(t+4); STEP(pB0,pB1,pA0,pA1,t+4,true,true,true);   WAIT_BAR(2); RESC(); }
    { constexpr int sl_prev=2*SLOTB,sl_cur=0,sl_next=SLOTB; CBSET(t+5); STEP(pA0,pA1,pB0,pB1,t+5,true,true,true);   WAIT_BAR(2); RESC(); }
  }
  for(;t+5<NT;t+=2){
    CBSET(t);   STEP(pB0,pB1,pA0,pA1,t,true,true,true);     WAIT_BAR(2); RESC(); ROT();
    CBSET(t+1); STEP(pA0,pA1,pB0,pB1,t+1,true,true,true);   WAIT_BAR(2); RESC(); ROT();
  }
  #undef CMASK
  #define CMASK(P0,P1,t) BIASHOOK(P0,P1,t)
  #define ENDW(tt) do{ if((tt)+3<NT){WAIT_BAR(2);} else if((tt)+2<NT){WAIT_BAR(1);} else {WAIT_BAR(0);} }while(0)
  for(;t+1<NT;t+=2){
    CBSET(t);   STEP(pB0,pB1,pA0,pA1,t,(t+3<NT),(t+1<NT),(t+1<NT));       ENDW(t);   RESC(); ROT();
    CBSET(t+1); STEP(pA0,pA1,pB0,pB1,t+1,(t+4<NT),(t+2<NT),(t+2<NT));     ENDW(t+1); RESC(); ROT();
  }
  CBSET(NT-1); STEP(pB0,pB1,pA0,pA1,NT-1,false,false,false); RESC();
  { float sacc=pB0[0]+pB0[1]; _Pragma("unroll") for(int r=2;r<16;++r)sacc+=pB0[r]; _Pragma("unroll") for(int r=0;r<16;++r)sacc+=pB1[r]; l_reg+=sacc;
    pw0=(u32x4){PKW(pB0,0),PKW(pB0,2),PKW(pB0,4),PKW(pB0,6)};pw1=(u32x4){PKW(pB0,8),PKW(pB0,10),PKW(pB0,12),PKW(pB0,14)};pw2=(u32x4){PKW(pB1,0),PKW(pB1,2),PKW(pB1,4),PKW(pB1,6)};pw3=(u32x4){PKW(pB1,8),PKW(pB1,10),PKW(pB1,12),PKW(pB1,14)};
    SBAR(); pv(o,vb0+sl_cur,PAF(0),PAF(1),PAF(2),PAF(3)); }
  #undef PKW
  #undef PAF
  #undef VFR
  #undef PIN
  #undef MX3
  #undef GAPA
  #undef GAPB
  #undef EX
  #undef VRD
  #undef KRD
  #undef STEP
  #undef ENDW
  {auto rr=__builtin_amdgcn_permlane32_swap(__float_as_uint(l_reg),__float_as_uint(l_reg),false,false);l_reg=__uint_as_float(rr[0])+__uint_as_float(rr[1]);}
  if(hi==0)wsf[32+r32]=l_reg;asm volatile("s_waitcnt lgkmcnt(0)":::"memory");
  float rli[16];
  #pragma unroll
  for(int r=0;r<16;++r)rli[r]=__builtin_amdgcn_rcpf(wsf[32+crow(r,hi)]);
  { bf16*stg=(bf16*)(shm+LDS_OST)+wid*2048;
    #pragma unroll
    for(int r=0;r<16;++r){const int orow=crow(r,hi);
      #pragma unroll
      for(int d0=0;d0<2;++d0)stg[orow*64+d0*32+r32]=(bf16)(pk2(o[d0][r]*rli[r],0.f)&0xffffu);}
    asm volatile("s_waitcnt lgkmcnt(0)":::"memory");
    if(MODE==0){
    #pragma unroll
    for(int i=0;i<4;++i){const int row=i*8+(lane>>3),ch=lane&7; const u32x4 v=*(const u32x4*)(stg+row*64+ch*8); const u32x4 g=*(const u32x4*)(Gp+(long)row*DM+ch*8);
      u32x4 w; w.x=pk2(bflo(v.x)*fa::silu(bflo(g.x)),bfhi(v.x)*fa::silu(bfhi(g.x))); w.y=pk2(bflo(v.y)*fa::silu(bflo(g.y)),bfhi(v.y)*fa::silu(bfhi(g.y)));
      w.z=pk2(bflo(v.z)*fa::silu(bflo(g.z)),bfhi(v.z)*fa::silu(bfhi(g.z))); w.w=pk2(bflo(v.w)*fa::silu(bflo(g.w)),bfhi(v.w)*fa::silu(bfhi(g.w)));
      *(u32x4*)(Ow+(long)row*MIXW+ch*8)=w;} } }
  asm volatile("s_waitcnt lgkmcnt(0)\n\ts_barrier":::"memory");
  #undef DMA_K
  #undef DMA_V
  #undef CMASK
  #undef cbias_
  #undef CBSET
  #undef BIASHOOK
  #undef START
  #undef RESC
  #undef ROT
}
#undef SBAR
#undef WAIT_BAR
}
#define SBAR() __builtin_amdgcn_sched_barrier(0)

typedef GAS unsigned gu32;
#define XB_TMO      128
#define XB_XCNT(j)  (256  + 64 * (j))
#define XB_XSUB(j)  (1280 + 64 * (j))
#define XB_XGEN(j)  (2304 + 64 * (j))
#define XB_TOP      3328
#define XB_TOPGEN   3392
#define XCD_BAR_WORDS 3456
#define XB_SPIN_CAP (1u << 22)
__device__ __forceinline__ unsigned xb_ld(unsigned* p)              { return __hip_atomic_load(p, __ATOMIC_RELAXED, __HIP_MEMORY_SCOPE_AGENT); }
__device__ __forceinline__ unsigned xb_add(unsigned* p, unsigned v) { return __hip_atomic_fetch_add(p, v, __ATOMIC_RELAXED, __HIP_MEMORY_SCOPE_AGENT); }
__device__ __forceinline__ unsigned xb_xcc_id() { return (unsigned)__builtin_amdgcn_s_getreg((3 << 11) | 20) & 0xFu; }
#define XB_SPIN(cond, bar) do { unsigned _sp = 0; while (cond) { __builtin_amdgcn_s_sleep(1); \
    if ((++_sp & 255u) == 0u) { if (xb_ld(&(bar)[XB_TMO])) break; if (_sp > XB_SPIN_CAP) { atomicAdd(&(bar)[XB_TMO], 1u); break; } } } } while (0)
__device__ __forceinline__ bool is_thread0() { unsigned t_ = threadIdx.x; asm volatile("" : "+v"(t_)); return t_ == 0u; }
struct XcdBarrier { unsigned* bar; unsigned x; volatile LAS unsigned* st; };
__device__ __forceinline__ XcdBarrier xcd_barrier_post(unsigned* bar, volatile LAS unsigned* st) {
    XcdBarrier b; b.bar = bar; b.x = xb_xcc_id(); b.st = st;
    if (threadIdx.x == 0) (void)xb_add(&bar[XB_XCNT(b.x)], 1u);
    return b;
}
__device__ __forceinline__ void xcd_barrier_complete(unsigned* bar, unsigned x, unsigned& nloc, unsigned& nx) {
    const unsigned G = gridDim.x * gridDim.y * gridDim.z;
    unsigned sum, cnt, mine, sp = 0u;
    for (;;) {
        sum = 0u; cnt = 0u; mine = 0u;
#pragma unroll
        for (unsigned j = 0; j < 16; ++j) { const unsigned c = xb_ld(&bar[XB_XCNT(j)]); sum += c; cnt += (c > 0u) ? 1u : 0u; mine = (j == x) ? c : mine; }
        if (sum == G) break;
        __builtin_amdgcn_s_sleep(1);
        if ((++sp & 255u) == 0u) { if (xb_ld(&bar[XB_TMO])) break; if (sp > XB_SPIN_CAP) { atomicAdd(&bar[XB_TMO], 1u); break; } }
    }
    nloc = mine > 0u ? mine : 1u; nx = cnt > 0u ? cnt : 1u;
}
__device__ __forceinline__ void xcd_barrier(const XcdBarrier& b) {
    asm volatile("s_waitcnt vmcnt(0)" ::: "memory");
    __syncthreads();
    if (is_thread0()) {
        unsigned* bar = b.bar;
        __builtin_amdgcn_s_waitcnt(0);
        unsigned nloc = b.st[0], nx = b.st[1];
        if (nloc == 0u) { xcd_barrier_complete(bar, b.x, nloc, nx); b.st[0] = nloc; b.st[1] = nx; }
        const unsigned old = xb_add(&bar[XB_XSUB(b.x)], 1u);
        const unsigned gen = old / nloc;
        if (old + 1u == (gen + 1u) * nloc) {
            __builtin_amdgcn_fence(__ATOMIC_RELEASE, "agent");
            asm volatile("s_waitcnt vmcnt(0)" ::: "memory");
            const unsigned og = xb_add(&bar[XB_TOP], 1u);
            const unsigned tg = og / nx;
            if (og + 1u == (tg + 1u) * nx) xb_add(&bar[XB_TOPGEN], 1u);
            else XB_SPIN(xb_ld(&bar[XB_TOPGEN]) == tg, bar);
            xb_add(&bar[XB_XGEN(b.x)], 1u);
            __builtin_amdgcn_fence(__ATOMIC_ACQUIRE, "agent");
            asm volatile("s_waitcnt vmcnt(0)" ::: "memory");
        } else {
            XB_SPIN(xb_ld(&bar[XB_XGEN(b.x)]) == gen, bar);
            __builtin_amdgcn_fence(__ATOMIC_ACQUIRE, "agent");
            asm volatile("s_waitcnt vmcnt(0)" ::: "memory");
        }
    }
    __syncthreads();
}

constexpr int CW_SPLIT = 8192;
__device__ __forceinline__ void split_arrive(unsigned* cnt, volatile LAS unsigned* st) {
    asm volatile("s_waitcnt vmcnt(0)" ::: "memory");
    __syncthreads();
    if (is_thread0()) {
        const unsigned nloc = st[0];
        if (nloc == 0u) {
            __builtin_amdgcn_fence(__ATOMIC_RELEASE, "agent");
            asm volatile("s_waitcnt vmcnt(0)" ::: "memory");
            (void)xb_add(cnt, 1u);
        } else {
            const unsigned old = xb_add(cnt + 16 + xb_xcc_id(), 1u);
            if (old + 1u == nloc) {
                __builtin_amdgcn_fence(__ATOMIC_RELEASE, "agent");
                asm volatile("s_waitcnt vmcnt(0)" ::: "memory");
                (void)xb_add(cnt, nloc);
            }
        }
    }
}
template <bool ACQ = true>
__device__ __forceinline__ void split_wait(unsigned* cnt, unsigned want) {
    if (is_thread0()) {
        unsigned sp = 0u;
        while (__hip_atomic_load(cnt, __ATOMIC_RELAXED, __HIP_MEMORY_SCOPE_AGENT) < want) { __builtin_amdgcn_s_sleep(2); if (++sp > (1u << 24)) break; }
        if (ACQ) { __builtin_amdgcn_fence(__ATOMIC_ACQUIRE, "agent");
        asm volatile("s_waitcnt vmcnt(0)" ::: "memory"); }
    }
    __syncthreads();
}

struct Frame {
    LAS unsigned char* lds;
    int tid, lane, wave, vcu, G; int tabs;
    const float* const __attribute__((address_space(4)))* in; float* out; unsigned char* ws;
    bf16_t *WIN, *WOUT, *XNM, *PROJ, *BPART; float *BLSE, *TAB;
};
__device__ __forceinline__ float wave_sum(float v) {
#pragma unroll
    for (int o = 1; o < 64; o <<= 1) v += __shfl_xor(v, o);
    return v;
}
__device__ __forceinline__ int t5_bucket(int rel) {
    const int dist = rel < 0 ? -rel : rel; int v;
    if (dist < 8) v = dist; else { const unsigned q = (unsigned)(dist * dist) >> 6; const int k = 31 - __builtin_clz(q); v = 8 + k; if (v > 15) v = 15; }
    return v + (rel > 0 ? 16 : 0);
}
__device__ __forceinline__ float in_colscale(int n) {
    if (n >= C_BQ && n < C_BK) return 0.125f * LOG2E;
    if (n >= C_CQ && n < C_CK) return 0.17677669529663687f * LOG2E;
    if (n >= C_DQ && n < C_DK) return 0.125f * LOG2E;
    return 1.f;
}
template <bool IN>
__device__ __forceinline__ void transpose_item(const float* W, const float* g, int K, int N, bf16_t* WT, LAS float* scr, int item, int lane) {
    const int nblk = N / 32, kb = item / nblk, nb = item % nblk, k0 = 64 * kb, n0 = 32 * nb;
#pragma unroll 8
    for (int i = 0; i < 32; ++i) { const int kk = 2 * i + (lane >> 5); float w = W[(size_t)(k0 + kk) * N + n0 + (lane & 31)]; if (IN) w *= g[k0 + kk]; scr[kk * 33 + (lane & 31)] = w; }
    asm volatile("s_waitcnt lgkmcnt(0)" ::: "memory");
    const int c = lane & 7;
#pragma unroll
    for (int j = 0; j < 4; ++j) { const int n = (lane >> 3) + 8 * j; const LAS float* s = scr + (8 * c) * 33 + n; const float cs = IN ? in_colscale(n0 + n) : 1.f;
        u32x4 o; o.x = pk2(s[0 * 33] * cs, s[1 * 33] * cs); o.y = pk2(s[2 * 33] * cs, s[3 * 33] * cs); o.z = pk2(s[4 * 33] * cs, s[5 * 33] * cs); o.w = pk2(s[6 * 33] * cs, s[7 * 33] * cs);
        *(u32x4*)(WT + (size_t)(n0 + n) * K + k0 + 8 * c) = o; }
    asm volatile("s_waitcnt lgkmcnt(0)" ::: "memory");
}
__device__ __forceinline__ void phase_prologue(Frame& F) {
    LAS float* scr = (LAS float*)(F.lds + F.wave * 16384);
    const int gw = F.vcu * 8 + F.wave, NGW = F.G * 8;
    constexpr int I_IN = (DMODEL / 64) * (INW / 32), I_OUT = (MIXW / 64) * (DMODEL / 32);
    constexpr int NITEMS = DEPTH * (I_IN + I_OUT);
    for (int it = gw; it < NITEMS; it += NGW) {
        int r = it;
        if (r < DEPTH * I_IN) { const int l = r / I_IN; r -= l * I_IN; transpose_item<true>(F.in[2] + (size_t)l * DMODEL * INW, F.in[4] + l * DMODEL, DMODEL, INW, F.WIN + (size_t)l * INW * DMODEL, scr, r, F.lane); continue; }
        r -= DEPTH * I_IN; { const int l = r / I_OUT; r -= l * I_OUT; transpose_item<false>(F.in[3] + (size_t)l * MIXW * DMODEL, nullptr, MIXW, DMODEL, F.WOUT + (size_t)l * DMODEL * MIXW, scr, r, F.lane); }
    }
    { float* T = F.TAB; const float* t5 = F.in[8]; const int G_ = F.G;
      for (int pc = (int)blockIdx.x; pc < 12; pc += G_) {
        if (pc < 4) { const int i = pc * 512 + F.tid; const int pos = i >> 4, k = i & 15; const float f = exp2f(-(float)k * (13.287712379549449f / 16.f)); const float a = (float)pos * f; T[T_ROPE + 2 * i] = cosf(a); T[T_ROPE + 2 * i + 1] = sinf(a); }
        else if (pc < 8) { const int h = pc - 4; for (int j = F.tid; j < 641; j += 512) { const int rel = j - 320; T[T_C + h * 641 + j] = t5[t5_bucket(rel) * 8 + 4 + h] * LOG2E; } }
        else if (pc < 11) { const int g = pc - 8; const int d = (g == 0) ? 1 : (g == 1 ? 4 : 16);
            for (int j = F.tid; j < 4 * 320; j += 512) { const int h = j / 320, off = j % 320 - 158; T[T_B + g * (4 * 320) + j] = (off < -64 || off > 64) ? -INFINITY : t5[t5_bucket(off * d) * 8 + h] * LOG2E; } }
        else {
        { const int lh = F.wave; const float* rp = F.in[14] + (size_t)lh * 465; float m = -1e30f;
          for (int i = F.lane; i < 465; i += 64) m = fmaxf(m, rp[i] * LOG2E);
          for (int o_ = 32; o_; o_ >>= 1) m = fmaxf(m, __shfl_xor(m, o_));
          if (F.lane == 0) T[T_BMAXD + lh] = m; }
        if (F.tid >= 68 && F.tid < 72) { const int h = F.tid - 68; float m = -1e30f; for (int bk = 0; bk < 32; ++bk) m = fmaxf(m, t5[bk * 8 + h] * LOG2E); T[T_BMAXB + h] = m; }
        if (F.tid >= 64 && F.tid < 68) { const int h = F.tid - 64; float m = -1e30f; for (int bk = 0; bk < 32; ++bk) m = fmaxf(m, t5[bk * 8 + 4 + h] * LOG2E); T[T_BMAX + h] = m; }
        if (F.tid < DEPTH) { const int l = F.tid; float s1 = 0.f, s2 = 0.f; for (int i = 0; i < 32; ++i) { s1 += F.in[9][l * 32 + i] * F.in[10][l * 32 + i]; s2 += F.in[11][l * 32 + i] * F.in[12][l * 32 + i]; }
            const float li = 0.8f - 0.6f * expf(-0.3f * (float)l); T[T_LAM + l] = expf(s1) - expf(s2) + li; }
        }
      } }
}
__device__ __forceinline__ void phase_xn_rows(Frame& F, int row_lo, int row_hi, int gw, int NGW) {
    constexpr int NB = 4;
    for (int m0 = row_lo + gw; m0 < row_hi; m0 += NB * NGW) {
        f32x4 v[NB][4];
#pragma unroll
        for (int k = 0; k < NB; ++k) { int m = m0 + k * NGW; if (m >= row_hi) m = row_hi - 1;
            const float* src = (m < RS) ? F.in[0] + (size_t)m * DMODEL : F.in[1] + (size_t)(m - RS) * DMODEL;
            const f32x4* xr = (const f32x4*)src + F.lane;
#pragma unroll
            for (int j = 0; j < 4; ++j) v[k][j] = xr[64 * j]; }
#pragma unroll
        for (int k = 0; k < NB; ++k) { const int m = m0 + k * NGW; if (m < row_hi) { float s = 0.f;
#pragma unroll
            for (int j = 0; j < 4; ++j) s += (v[k][j].x * v[k][j].x + v[k][j].y * v[k][j].y) + (v[k][j].z * v[k][j].z + v[k][j].w * v[k][j].w);
            const float r = 1.f / sqrtf(wave_sum(s) * (1.f / DMODEL) + RMS_EPS);
            u32x2* o8 = (u32x2*)(F.XNM + (size_t)m * DMODEL) + F.lane;
#pragma unroll
            for (int j = 0; j < 4; ++j) { u32x2 w; w.x = pk2(v[k][j].x * r, v[k][j].y * r); w.y = pk2(v[k][j].z * r, v[k][j].w * r); o8[64 * j] = w; } } }
    }
}
__device__ __forceinline__ void phase_final(Frame& F) {
    const int gw = F.vcu * 8 + F.wave, NGW = F.G * 8; const float* g = F.in[5];
    for (int m = gw; m < MTOT; m += NGW) {
        f32x4* xr = (f32x4*)(F.out + (size_t)m * DMODEL) + F.lane; f32x4 v[4]; float s = 0.f;
#pragma unroll
        for (int j = 0; j < 4; ++j) { v[j] = xr[64 * j]; s += (v[j].x * v[j].x + v[j].y * v[j].y) + (v[j].z * v[j].z + v[j].w * v[j].w); }
        const float r = 1.f / sqrtf(wave_sum(s) * (1.f / DMODEL) + RMS_EPS);
#pragma unroll
        for (int j = 0; j < 4; ++j) { const f32x4 gg = *((const f32x4*)g + F.lane + 64 * j); xr[64 * j] = v[j] * r * gg; }
    }
}
__device__ __forceinline__ void phase_prepB(Frame& F, int s, int layer) {
    const int gw = F.vcu * 8 + F.wave, NGW = F.G * 8; const int lane = F.lane, half = lane >> 5, l32 = lane & 31;
    unsigned* kmaxB = (unsigned*)(F.ws + WS_CTL) + CW_KMAXB + (layer * 2 + s) * 4; unsigned* kmaxD = (unsigned*)(F.ws + WS_CTL) + CW_KMAXD + (layer * 2 + s) * 4;
    float kmB = 0.f, kmD = 0.f;
    for (int i0 = 0; gw + NGW * 2 * i0 < RS; i0 += 4) {
        u32x4 w[4], wd[4];
#pragma unroll
        for (int i = 0; i < 4; ++i) { const int lr = gw + NGW * (2 * (i0 + i) + half);
            w[i] = (lr < RS) ? *(const u32x4*)(F.PROJ + (size_t)lr * INW + C_BK + l32 * 8) : (u32x4){0u, 0u, 0u, 0u};
            wd[i] = (lr < RS) ? *(const u32x4*)(F.PROJ + (size_t)lr * INW + C_DK + l32 * 8) : (u32x4){0u, 0u, 0u, 0u}; }
#pragma unroll
        for (int i = 0; i < 4; ++i) { const float r[8] = {bflo(w[i].x), bfhi(w[i].x), bflo(w[i].y), bfhi(w[i].y), bflo(w[i].z), bfhi(w[i].z), bflo(w[i].w), bfhi(w[i].w)}; float k2 = 0.f;
            const float rd[8] = {bflo(wd[i].x), bfhi(wd[i].x), bflo(wd[i].y), bfhi(wd[i].y), bflo(wd[i].z), bfhi(wd[i].z), bflo(wd[i].w), bfhi(wd[i].w)}; float d2 = 0.f;
#pragma unroll
            for (int j = 0; j < 8; ++j) { k2 += r[j] * r[j]; d2 += rd[j] * rd[j]; }
            k2 += __shfl_xor(k2, 1); k2 += __shfl_xor(k2, 2); k2 += __shfl_xor(k2, 4);
            d2 += __shfl_xor(d2, 1); d2 += __shfl_xor(d2, 2); d2 += __shfl_xor(d2, 4);
            kmB = fmaxf(kmB, k2); kmD = fmaxf(kmD, d2); }
    }
    kmB = fmaxf(kmB, __shfl_xor(kmB, 32)); kmD = fmaxf(kmD, __shfl_xor(kmD, 32));
    { LAS float* red = (LAS float*)(F.lds + fa::L_WS);
      if (lane < 32 && (lane & 7) == 0) { red[F.wave * 8 + (lane >> 3)] = kmB; red[F.wave * 8 + 4 + (lane >> 3)] = kmD; }
      asm volatile("s_waitcnt lgkmcnt(0)\n\ts_barrier" ::: "memory");
      if (F.tid < 8) { float m = 0.f;
#pragma unroll
          for (int w_ = 0; w_ < 8; ++w_) m = fmaxf(m, red[w_ * 8 + F.tid]);
          atomicMax(F.tid < 4 ? kmaxB + F.tid : kmaxD + (F.tid - 4), __float_as_uint(sqrtf(m))); }
      asm volatile("s_waitcnt lgkmcnt(0)\n\ts_barrier" ::: "memory"); }
}
__device__ __forceinline__ void phase_prep(Frame& F, int s, int layer) {
    const int gw = F.vcu * 8 + F.wave, NGW = F.G * 8; const int n = s ? 2048 : 8192;
    const float* gq = F.in[6] + layer * 64; const float* gk = F.in[7] + layer * 64;
    LAS const float* rope = (LAS const float*)(F.lds + LT_ROPE);
    const int lane = F.lane, hh = lane >> 3, c = lane & 7;
    unsigned* kmaxA = (unsigned*)(F.ws + WS_CTL) + CW_KMAXA + (layer * 2 + s) * 2; unsigned* kmaxC = (unsigned*)(F.ws + WS_CTL) + CW_KMAXC + (layer * 2 + s) * 8;
    float kmA = 0.f, kmC = 0.f;
    float gv[8];
#pragma unroll
    for (int j = 0; j < 8; ++j) gv[j] = ((hh < 4 ? gq : gk) + c * 8)[j];
    const float sgn = (c & 2) ? 1.f : -1.f; const float qs = (hh < 4) ? 0.125f * LOG2E : 1.f;
    constexpr int NB = 4;
    for (int lr0 = gw; lr0 < RS; lr0 += NB * NGW) {
        u32x4 wA[NB], wC[NB];
#pragma unroll
        for (int k = 0; k < NB; ++k) { const int lr = lr0 + k * NGW; wA[k] = (u32x4){0u, 0u, 0u, 0u}; wC[k] = wA[k];
            if (lr < RS) { if (lane < 48) wA[k] = *(const u32x4*)(F.PROJ + (size_t)lr * INW + hh * 64 + c * 8);
                           if (lane < 32) wC[k] = *(const u32x4*)(F.PROJ + (size_t)lr * INW + C_CK + lane * 8); } }
#pragma unroll
        for (int k = 0; k < NB; ++k) { const int lr = lr0 + k * NGW; if (lr < RS) {
            const u32x4 w = wA[k]; float v[8] = {bflo(w.x), bfhi(w.x), bflo(w.y), bfhi(w.y), bflo(w.z), bfhi(w.z), bflo(w.w), bfhi(w.w)};
            float ss = 0.f;
#pragma unroll
            for (int j = 0; j < 8; ++j) ss += v[j] * v[j];
            ss += __shfl_xor(ss, 1); ss += __shfl_xor(ss, 2); ss += __shfl_xor(ss, 4);
            const float rinv = 1.f / sqrtf(ss * (1.f / 64.f) + RMS_EPS);
            const int t = lr % n; const int pos = (c < 4) ? (t >> 6) : (t & 63);
            float o[8];
#pragma unroll
            for (int j = 0; j < 8; ++j) { v[j] = v[j] * rinv * gv[j]; }
#pragma unroll
            for (int j = 0; j < 8; ++j) { const float pr = __shfl_xor(v[j], 2); const int i = 8 * (c & 1) + j; const float cs = rope[(pos * 16 + i) * 2], sn = rope[(pos * 16 + i) * 2 + 1];
                o[j] = (v[j] * cs + sgn * pr * sn) * qs; }
            u32x4 ow; ow.x = pk2(o[0], o[1]); ow.y = pk2(o[2], o[3]); ow.z = pk2(o[4], o[5]); ow.w = pk2(o[6], o[7]);
            if (lane < 48) *(u32x4*)(F.PROJ + (size_t)lr * INW + hh * 64 + c * 8) = ow;
            { const float r[8] = {bflo(ow.x), bfhi(ow.x), bflo(ow.y), bfhi(ow.y), bflo(ow.z), bfhi(ow.z), bflo(ow.w), bfhi(ow.w)}; float k2 = 0.f;
#pragma unroll
              for (int j = 0; j < 8; ++j) k2 += r[j] * r[j];
              k2 += __shfl_xor(k2, 1); k2 += __shfl_xor(k2, 2); k2 += __shfl_xor(k2, 4);
              kmA = fmaxf(kmA, k2); }
            { const u32x4 wc = wC[k]; const float r[8] = {bflo(wc.x), bfhi(wc.x), bflo(wc.y), bfhi(wc.y), bflo(wc.z), bfhi(wc.z), bflo(wc.w), bfhi(wc.w)}; float k2 = 0.f;
#pragma unroll
              for (int j = 0; j < 8; ++j) k2 += r[j] * r[j];
              k2 += __shfl_xor(k2, 1); k2 += __shfl_xor(k2, 2);
              kmC = fmaxf(kmC, k2); } } }
    }
    { LAS float* red = (LAS float*)(F.lds + fa::L_WS);
      if (lane == 32 || lane == 40) red[F.wave * 14 + (hh - 4)] = kmA;
      if (lane < 32 && (lane & 3) == 0) red[F.wave * 14 + 2 + (lane >> 2)] = kmC;
      asm volatile("s_waitcnt lgkmcnt(0)\n\ts_barrier" ::: "memory");
      if (F.tid < 10) { float m = 0.f;
#pragma unroll
          for (int w = 0; w < 8; ++w) m = fmaxf(m, red[w * 14 + F.tid]);
          atomicMax(F.tid < 2 ? kmaxA + F.tid : kmaxC + (F.tid - 2), __float_as_uint(sqrtf(m))); }
      asm volatile("s_waitcnt lgkmcnt(0)\n\ts_barrier" ::: "memory"); }
}

struct KVLinear {
    const bf16_t* kbase; const bf16_t* vbase;
    __device__ __forceinline__ const bf16_t* tk(int t) const { return kbase + (size_t)(64 * t) * INW; }
    __device__ __forceinline__ const bf16_t* tv(int t) const { return vbase + (size_t)(64 * t) * INW; }
    __device__ __forceinline__ int rmul() const { return 1; }
    __device__ __forceinline__ const bf16_t* kptr(int t, int j) const { return kbase + (size_t)(64 * t + j) * INW; }
    __device__ __forceinline__ const bf16_t* vptr(int t, int j) const { return vbase + (size_t)(64 * t + j) * INW; }
};
struct KVStrided {
    const bf16_t* kbase; const bf16_t* vbase; int d; int ntr;
    __device__ __forceinline__ const bf16_t* tk(int t) const { const int g2 = t >= ntr ? 1 : 0; const int tt = t - g2 * ntr; return kbase + (size_t)(g2 + d * 64 * tt) * INW; }
    __device__ __forceinline__ const bf16_t* tv(int t) const { const int g2 = t >= ntr ? 1 : 0; const int tt = t - g2 * ntr; return vbase + (size_t)(g2 + d * 64 * tt) * INW; }
    __device__ __forceinline__ int rmul() const { return d; }
    __device__ __forceinline__ const bf16_t* kptr(int t, int j) const { const int g2 = t >= ntr ? 1 : 0; const int tt = t - g2 * ntr; return kbase + (size_t)(g2 + d * (64 * tt + j)) * INW; }
    __device__ __forceinline__ const bf16_t* vptr(int t, int j) const { const int g2 = t >= ntr ? 1 : 0; const int tt = t - g2 * ntr; return vbase + (size_t)(g2 + d * (64 * tt + j)) * INW; }
};
struct HookNone { __device__ __forceinline__ bool skip(int) const { return false; } __device__ __forceinline__ float cbias(int) const { return 0.f; } __device__ __forceinline__ void apply(f32x16&, f32x16&, int) const {} };

__device__ __forceinline__ void store_gated(Frame& F, LAS const float* stg, size_t lrow0, size_t grow0, int gate_col, int mix_col, int lane) {
#pragma unroll
    for (int i = 0; i < 4; ++i) { const int row = i * 8 + (lane >> 3), ch = lane & 7;
        const f32x4 a = *(LAS const f32x4*)(stg + row * 64 + ch * 8), b = *(LAS const f32x4*)(stg + row * 64 + ch * 8 + 4);
        const u32x4 gw = *(const u32x4*)(F.PROJ + (lrow0 + row) * INW + gate_col + ch * 8);
        u32x4 w; w.x = pk2(a.x * fa::silu(bflo(gw.x)), a.y * fa::silu(bfhi(gw.x))); w.y = pk2(a.z * fa::silu(bflo(gw.y)), a.w * fa::silu(bfhi(gw.y)));
        w.z = pk2(b.x * fa::silu(bflo(gw.z)), b.y * fa::silu(bfhi(gw.z))); w.w = pk2(b.z * fa::silu(bflo(gw.w)), b.w * fa::silu(bfhi(gw.w)));
        *(u32x4*)(F.XNM + (grow0 + row) * MIXW + mix_col + ch * 8) = w; }
}

__device__ __forceinline__ void unit_A(Frame& F, int s, int layer, int bh, int qb) {
    const int n = s ? 2048 : 8192; const int b = bh >> 2, h = bh & 3;
    int tid_ = F.tid; asm volatile("" : "+v"(tid_)); const int wid = __builtin_amdgcn_readfirstlane(tid_ >> 6);
    const size_t rowbase = (size_t)b * n; const int q0 = qb * 256 + wid * 32;
    const bf16_t* Qw = F.PROJ + (rowbase + q0) * INW + C_AQ + h * 64;
    const bf16_t* Kh = F.PROJ + rowbase * INW + C_AK + (h >> 1) * 64; const bf16_t* Vh = F.PROJ + rowbase * INW + C_AV + (h >> 1) * 64;
    const bf16_t* Gp = F.PROJ + (rowbase + q0) * INW + C_AG + h * 64;
    bf16_t* Ow = F.XNM + ((size_t)s * RS + rowbase + q0) * MIXW + h * 64;
    const float kbA = __uint_as_float(((const unsigned*)(F.ws + WS_CTL))[CW_KMAXA + (layer * 2 + s) * 2 + (h >> 1)]) * 1.01f;
    tb::attn_unit<8, 0, true>(tid_, Qw, Kh, Vh, n / 64, Gp, Ow, (char*)(unsigned char*)F.lds, 0, nullptr, 0, 0.f, 0.f, kbA, 0.f);
}

struct HookC {
    LAS const float* tab;
    int qw;
    int r32, hi; float bl, br;
    __device__ __forceinline__ bool skip(int) const { return false; }
    __device__ __forceinline__ float cbias(int t) const {
        const int maxrel = 64 * t + 63 - qw, minrel = 64 * t - qw - 31;
        return (maxrel <= -91) ? bl : ((minrel >= 91) ? br : 0.f);
    }
    __device__ __forceinline__ void apply(f32x16& p0, f32x16& p1, int t) const {
        const int maxrel = 64 * t + 63 - qw, minrel = 64 * t - qw - 31;
        if (maxrel > -91 && minrel < 91) { LAS const float* tp = tab + (320 + 64 * t - qw - r32 + 4 * hi);
#pragma unroll
            for (int r = 0; r < 16; ++r) { const int kk = (r & 3) + 8 * (r >> 2); p0[r] += tp[kk]; p1[r] += tp[kk + 32]; } }
    }
};
__device__ __forceinline__ void unit_C(Frame& F, int s, int layer, int bh, int qb) {
    const int n = s ? 2048 : 8192; const int b = bh >> 2, h = bh & 3; int tid_ = F.tid; asm volatile("" : "+v"(tid_)); const int lane = tid_ & 63, r32 = lane & 31, hi = lane >> 5, wid = __builtin_amdgcn_readfirstlane(tid_ >> 6);
    const size_t rowbase = (size_t)b * n; const int q0 = qb * 256; const int qw = q0 + wid * 32;
    LAS float* tab = (LAS float*)(F.lds + fa::L_TAB);
    for (int i = tid_; i < 641; i += 512) tab[i] = F.TAB[T_C + h * 641 + i];
    asm volatile("s_waitcnt vmcnt(0) lgkmcnt(0)\n\ts_barrier" ::: "memory");
    const bf16_t* qptr = F.PROJ + (rowbase + qw + r32) * INW + C_CQ + h * 64;
    KVLinear kv{F.PROJ + rowbase * INW + C_CK + h * 64, F.PROJ + rowbase * INW + C_CV + h * 64};
    f32x16 o1[2], o2[2];
    HookC hk{tab, qw, r32, hi, tab[320 - 100], tab[320 + 100]};
    fa::flash_core_dual_sp(F.lds, qptr, kv, n / 64, hk, o1, o2, tid_);
    const float lam = F.TAB[T_LAM + layer]; const float li = layer == 0 ? 0.2f : 0.35550907f; const float* sg = F.in[13] + layer * 64;
#pragma unroll
    for (int r = 0; r < 16; ++r) { o1[0][r] -= lam * o2[0][r]; o1[1][r] -= lam * o2[1][r]; }
    LAS float* stg = (LAS float*)(F.lds + fa::L_OST) + wid * 2048;
    fa::stage_o(stg, o1, r32, hi);
#pragma unroll
    for (int i = 0; i < 4; ++i) { const int row = i * 8 + (lane >> 3), ch = lane & 7;
        const f32x4 a0 = *(LAS const f32x4*)(stg + row * 64 + ch * 8), a1 = *(LAS const f32x4*)(stg + row * 64 + ch * 8 + 4);
        const float v[8] = {a0.x, a0.y, a0.z, a0.w, a1.x, a1.y, a1.z, a1.w};
        float ss = 0.f;
#pragma unroll
        for (int k = 0; k < 8; ++k) ss += v[k] * v[k];
        ss += __shfl_xor(ss, 1); ss += __shfl_xor(ss, 2); ss += __shfl_xor(ss, 4);
        const float sc = (1.f - li) / sqrtf(ss * (1.f / 64.f) + RMS_EPS);
        const size_t lrow = rowbase + qw + row;
        const u32x4 gw = *(const u32x4*)(F.PROJ + lrow * INW + C_CG + h * 64 + ch * 8);
        const float g[8] = {bflo(gw.x), bfhi(gw.x), bflo(gw.y), bfhi(gw.y), bflo(gw.z), bfhi(gw.z), bflo(gw.w), bfhi(gw.w)};
        float y[8];
#pragma unroll
        for (int k = 0; k < 8; ++k) y[k] = v[k] * sc * sg[ch * 8 + k] * fa::silu(g[k]);
        u32x4 w; w.x = pk2(y[0], y[1]); w.y = pk2(y[2], y[3]); w.z = pk2(y[4], y[5]); w.w = pk2(y[6], y[7]);
        *(u32x4*)(F.XNM + ((size_t)s * RS + lrow) * MIXW + 512 + h * 64 + ch * 8) = w; }
    asm volatile("s_waitcnt lgkmcnt(0)\n\ts_barrier" ::: "memory");
}

__device__ __forceinline__ void unit_Cv(Frame& F, int s, int layer, int bh, int qb) {
    const int n = s ? 2048 : 8192; const int b = bh >> 2, h = bh & 3; int tid_ = F.tid; asm volatile("" : "+v"(tid_)); const int lane = tid_ & 63, r32 = lane & 31, hi = lane >> 5, wid = __builtin_amdgcn_readfirstlane(tid_ >> 6);
    const int map = wid >> 2; const size_t rowbase = (size_t)b * n; const int q0 = qb * 128; const int qw = q0 + (wid & 3) * 32;
    LAS float* tab = (LAS float*)(F.lds + fa::L_TAB);
    for (int i = tid_; i < 641; i += 512) tab[i] = F.TAB[T_C + h * 641 + i];
    asm volatile("s_waitcnt vmcnt(0) lgkmcnt(0)\n\ts_barrier" ::: "memory");
    const bf16_t* qptr = F.PROJ + (rowbase + qw + r32) * INW + C_CQ + h * 64 + map * 32;
    KVLinear kv{F.PROJ + rowbase * INW + C_CK + h * 64, F.PROJ + rowbase * INW + C_CV + h * 64};
    f32x16 o[2]; float mh, lt;
    HookC hk{tab, qw, r32, hi, tab[320 - 100], tab[320 + 100]};
    fa::flash_core_sp<2>(F.lds, qptr, kv, n / 64, hk, map * 4096, o, mh, lt, tid_);
    LAS float* stg = (LAS float*)(F.lds + fa::L_OST) + wid * 2048;
    fa::stage_o(stg, o, r32, hi);
    asm volatile("s_waitcnt lgkmcnt(0)\n\ts_barrier" ::: "memory");
    const float lam = F.TAB[T_LAM + layer]; const float li = layer == 0 ? 0.2f : 0.35550907f; const float* sg = F.in[13] + layer * 64;
    LAS const float* S1 = (LAS const float*)(F.lds + fa::L_OST); LAS const float* S2 = S1 + 4 * 2048;
#pragma unroll
    for (int j = 0; j < 2; ++j) { const int row = 16 * wid + 8 * j + (lane >> 3), ch = lane & 7;
        const int off = (row >> 5) * 2048 + (row & 31) * 64 + ch * 8;
        const f32x4 a0 = *(LAS const f32x4*)(S1 + off), a1 = *(LAS const f32x4*)(S1 + off + 4), b0 = *(LAS const f32x4*)(S2 + off), b1 = *(LAS const f32x4*)(S2 + off + 4);
        float v[8] = {a0.x - lam * b0.x, a0.y - lam * b0.y, a0.z - lam * b0.z, a0.w - lam * b0.w, a1.x - lam * b1.x, a1.y - lam * b1.y, a1.z - lam * b1.z, a1.w - lam * b1.w};
        float ss = 0.f;
#pragma unroll
        for (int k = 0; k < 8; ++k) ss += v[k] * v[k];
        ss += __shfl_xor(ss, 1); ss += __shfl_xor(ss, 2); ss += __shfl_xor(ss, 4);
        const float sc = (1.f - li) / sqrtf(ss * (1.f / 64.f) + RMS_EPS);
        const size_t lrow = rowbase + q0 + row;
        const u32x4 gw = *(const u32x4*)(F.PROJ + lrow * INW + C_CG + h * 64 + ch * 8);
        const float g[8] = {bflo(gw.x), bfhi(gw.x), bflo(gw.y), bfhi(gw.y), bflo(gw.z), bfhi(gw.z), bflo(gw.w), bfhi(gw.w)};
        float y[8];
#pragma unroll
        for (int k = 0; k < 8; ++k) y[k] = v[k] * sc * sg[ch * 8 + k] * fa::silu(g[k]);
        u32x4 w; w.x = pk2(y[0], y[1]); w.y = pk2(y[2], y[3]); w.z = pk2(y[4], y[5]); w.w = pk2(y[6], y[7]);
        *(u32x4*)(F.XNM + ((size_t)s * RS + lrow) * MIXW + 512 + h * 64 + ch * 8) = w; }
    asm volatile("s_waitcnt lgkmcnt(0)\n\ts_barrier" ::: "memory");
}

__device__ __forceinline__ void unit_Ct(Frame& F, int s, int layer, int bh, int qb) {
    const int n = s ? 2048 : 8192; const int b = bh >> 2, h = bh & 3;
    int tid_ = F.tid; asm volatile("" : "+v"(tid_)); const int lane = tid_ & 63, wid = __builtin_amdgcn_readfirstlane(tid_ >> 6);
    const int cmap = wid >> 2; const size_t rowbase = (size_t)b * n; const int q0 = qb * 128; const int qw = q0 + (wid & 3) * 32;
    LAS float* tab = (LAS float*)(F.lds + LT_C) + h * 641;
    const bf16_t* Qw = F.PROJ + (rowbase + qw) * INW + C_CQ + h * 64 + cmap * 32;
    const bf16_t* Kh = F.PROJ + rowbase * INW + C_CK + h * 64; const bf16_t* Vh = F.PROJ + rowbase * INW + C_CV + h * 64;
    const float kbC = __uint_as_float(((const unsigned*)(F.ws + WS_CTL))[CW_KMAXC + (layer * 2 + s) * 8 + h * 2 + cmap]) * 1.01f;
    tb::attn_unit<8, 1, true>(tid_, Qw, Kh, Vh, n / 64, nullptr, nullptr, (char*)(unsigned char*)F.lds, cmap, tab, qw, tab[320 - 100], tab[320 + 100], kbC, F.TAB[T_BMAX + h]);
    const float lam = F.TAB[T_LAM + layer]; const float li = layer == 0 ? 0.2f : 0.35550907f; const float* sg = F.in[13] + layer * 64;
    LAS const bf16_t* S1 = (LAS const bf16_t*)(F.lds + tb::LDS_OST); LAS const bf16_t* S2 = S1 + 4 * 2048;
#pragma unroll
    for (int j = 0; j < 2; ++j) { const int row = 16 * wid + 8 * j + (lane >> 3), ch = lane & 7;
        const int off = (row >> 5) * 2048 + (row & 31) * 64 + ch * 8;
        const u32x4 a = *(LAS const u32x4*)(S1 + off), c = *(LAS const u32x4*)(S2 + off);
        float v[8] = {bflo(a.x) - lam * bflo(c.x), bfhi(a.x) - lam * bfhi(c.x), bflo(a.y) - lam * bflo(c.y), bfhi(a.y) - lam * bfhi(c.y),
                      bflo(a.z) - lam * bflo(c.z), bfhi(a.z) - lam * bfhi(c.z), bflo(a.w) - lam * bflo(c.w), bfhi(a.w) - lam * bfhi(c.w)};
        float ss = 0.f;
#pragma unroll
        for (int k = 0; k < 8; ++k) ss += v[k] * v[k];
        ss += __shfl_xor(ss, 1); ss += __shfl_xor(ss, 2); ss += __shfl_xor(ss, 4);
        const float sc = (1.f - li) / sqrtf(ss * (1.f / 64.f) + RMS_EPS);
        const size_t lrow = rowbase + q0 + row;
        const u32x4 gw = *(const u32x4*)(F.PROJ + lrow * INW + C_CG + h * 64 + ch * 8);
        const float g[8] = {bflo(gw.x), bfhi(gw.x), bflo(gw.y), bfhi(gw.y), bflo(gw.z), bfhi(gw.z), bflo(gw.w), bfhi(gw.w)};
        float y[8];
#pragma unroll
        for (int k = 0; k < 8; ++k) y[k] = v[k] * sc * sg[ch * 8 + k] * fa::silu(g[k]);
        u32x4 w; w.x = pk2(y[0], y[1]); w.y = pk2(y[2], y[3]); w.z = pk2(y[4], y[5]); w.w = pk2(y[6], y[7]);
        *(u32x4*)(F.XNM + ((size_t)s * RS + lrow) * MIXW + 512 + h * 64 + ch * 8) = w; }
    asm volatile("s_waitcnt lgkmcnt(0)\n\ts_barrier" ::: "memory");
}

struct HookB {
    LAS const float* tab;
    int qw, L, kb0;
    int r32, hi;
    __device__ __forceinline__ bool skip(int t) const { const int kb = kb0 + 64 * t; return (qw >= L) || (kb + 63 < qw - 64) || (kb > qw + 95); }
    __device__ __forceinline__ void apply(f32x16& p0, f32x16& p1, int t) const {
        LAS const float* tp = tab + (kb0 + 64 * t + 4 * hi - (qw + r32) + 158);
#pragma unroll
        for (int r = 0; r < 16; ++r) { const int kk = (r & 3) + 8 * (r >> 2); p0[r] += tp[kk]; p1[r] += tp[kk + 32]; }
    }
};
struct BPar { int g, h, d, L, NT, tlo, q0, pack, res; size_t rowbase; };
__device__ __forceinline__ BPar b_decode(int s_in, int u_in) {
    int u = u_in; asm volatile("" : "+s"(u));
    int s = s_in; asm volatile("" : "+s"(s));
    int g, bh, res, qblk, pack = 0;
    if (s == 0) { g = u >> 8; const int rest = u & 255, k = rest & 31; bh = rest >> 5; const int lper = (g == 0) ? 5 : (g == 1 ? 3 : 1); res = k >> lper; qblk = k & ((1 << lper) - 1); }
    else if (u < 256) { g = 0; bh = u >> 3; res = 0; qblk = u & 7; }
    else if (u < 512) { const int r = u - 256; g = 1; bh = r >> 3; res = (r & 7) >> 1; qblk = r & 1; }
    else { const int r = u - 512; g = 2; bh = r >> 3; res = (r & 7) * 2; qblk = 0; pack = 1; }
    BPar P; const int n = 8192 >> (s << 1); P.g = g; P.h = bh & 3; P.d = (g == 0) ? 1 : (g == 1 ? 4 : 16); P.L = n / P.d; P.rowbase = (size_t)(bh >> 2) * n; P.res = res; P.q0 = qblk * 256; P.pack = pack;
    int tlo = (P.q0 - 64) >> 6; if (tlo < 0) tlo = 0; int thi = (P.q0 + 319) >> 6; const int tmax = (P.L - 1) >> 6; if (thi > tmax) thi = tmax;
    P.tlo = tlo; P.NT = thi - tlo + 1; return P;
}
__device__ __forceinline__ void b_dma(Frame& F, const BPar& P, const int tid) {
    const int lane = tid & 63; const int wid = __builtin_amdgcn_readfirstlane(tid >> 6);
    const unsigned lds0 = (unsigned)(uintptr_t)F.lds;
    const unsigned kdst = lds0 + fa::L_AK + wid * 1024, vdst = lds0 + fa::L_AV + wid * 1024;
    const int vrow_j = 16 * (wid & 3) + (lane >> 2), vcol = (wid >> 2) * 32 + (lane & 3) * 8;
    const size_t krow0 = P.rowbase + P.res + (size_t)P.d * 64 * P.tlo;
    KVStrided kv{F.PROJ + krow0 * INW + C_BK + P.h * 64, F.PROJ + krow0 * INW + C_BV + P.h * 64, P.d, P.NT};
    const unsigned koffv = (unsigned)(kv.rmul() * lane * INW + wid * 8) * 2u, voffv = (unsigned)(kv.rmul() * vrow_j * INW + vcol) * 2u;
    const int NTD = P.pack ? 2 * P.NT : P.NT;
    for (int t = 0; t < NTD; ++t) {
        fa::glds16s(kv.tk(t), koffv, (unsigned)__builtin_amdgcn_readfirstlane(kdst + t * fa::SLOTB));
        fa::glds16s(kv.tv(t), voffv, (unsigned)__builtin_amdgcn_readfirstlane(vdst + t * fa::SLOTB)); }
}
__device__ __forceinline__ void b_qload(Frame& F, const BPar& P, const int tid, bf16x8 (&qr)[4]) {
    const int lane = tid & 63, r32 = lane & 31, hi = lane >> 5; const int wid = __builtin_amdgcn_readfirstlane(tid >> 6);
    const int wg2 = P.pack ? (wid >> 2) : 0; const int qw = P.pack ? (wid & 3) * 32 : P.q0 + wid * 32;
    int qidx = qw + r32; if (qidx >= P.L) qidx = P.L - 1;
    const bf16_t* qptr = F.PROJ + (P.rowbase + P.res + wg2 + (size_t)P.d * qidx) * INW + C_BQ + P.h * 64;
#pragma unroll
    for (int d0 = 0; d0 < 4; ++d0) qr[d0] = *(const bf16x8*)(qptr + d0 * 16 + hi * 8);
}
constexpr int L_BST = 96 * 1024;
__device__ __forceinline__ void epilogue_B(Frame& F, int s, int u_in, f32x16 (&o)[2], float mh, float lt) {
    int u = u_in; asm volatile("" : "+s"(u));
    const BPar P = b_decode(s, u);
    int tid_ = F.tid; asm volatile("" : "+v"(tid_)); const int lane = tid_ & 63, r32 = lane & 31, hi = lane >> 5, wid = __builtin_amdgcn_readfirstlane(tid_ >> 6);
    const int g = P.g, h = P.h, d = P.d, L = P.L; const size_t rowbase = P.rowbase; const int res = P.res;
    const int wg2 = P.pack ? (wid >> 2) : 0; const int qw = P.pack ? (wid & 3) * 32 : P.q0 + wid * 32;
    int qidx = qw + r32; const bool active = qw < L; if (qidx >= L) qidx = L - 1;
    const size_t qrow = rowbase + res + wg2 + (size_t)d * qidx;
    { auto rr = __builtin_amdgcn_permlane32_swap(__float_as_uint(lt), __float_as_uint(lt), false, false); lt = __uint_as_float(rr[0]) + __uint_as_float(rr[1]); }
    LAS float* wsf = (LAS float*)(F.lds + fa::L_WS) + wid * 64;
    if (hi == 0) wsf[32 + r32] = lt;
    asm volatile("s_waitcnt lgkmcnt(0)" ::: "memory");
    float rli[16];
#pragma unroll
    for (int r = 0; r < 16; ++r) rli[r] = __builtin_amdgcn_rcpf(wsf[32 + fa::crow(r, hi)]);
    LAS bf16_t* stg = (LAS bf16_t*)(F.lds + L_BST) + wid * 1024;
    bf16_t* BP = F.BPART + (size_t)g * RS * 256;
#pragma unroll
    for (int half = 0; half < 2; ++half) {
#pragma unroll
        for (int rr_ = 0; rr_ < 8; ++rr_) { const int r = half * 8 + rr_; const int lrow = fa::crow(r, hi) - 16 * half;
#pragma unroll
            for (int d0 = 0; d0 < 2; ++d0) stg[lrow * 64 + d0 * 32 + r32] = (bf16_t)(pk2(o[d0][r] * rli[r], 0.f) & 0xffffu); }
        asm volatile("s_waitcnt lgkmcnt(0)" ::: "memory");
        if (active) {
#pragma unroll
            for (int i = 0; i < 2; ++i) { const int row = i * 8 + (lane >> 3), ch = lane & 7;
                const u32x4 w = *(LAS const u32x4*)(stg + row * 64 + ch * 8);
                const size_t orow = rowbase + res + wg2 + (size_t)d * (qw + 16 * half + row);
                *(u32x4*)(BP + orow * 256 + h * 64 + ch * 8) = w; } }
        asm volatile("s_waitcnt lgkmcnt(0)" ::: "memory");
    }
    if (active && hi == 0) F.BLSE[((size_t)g * RS + qrow) * 4 + h] = mh + __log2f(lt);
}
__device__ __forceinline__ void epilogue_B_fused(Frame& F, int s, int u_in, f32x16 (&o)[2], float mh, float lt) {
    int u = u_in; asm volatile("" : "+s"(u));
    const BPar P = b_decode(s, u);
    int tid_ = F.tid; asm volatile("" : "+v"(tid_)); const int lane = tid_ & 63, r32 = lane & 31, hi = lane >> 5, wid = __builtin_amdgcn_readfirstlane(tid_ >> 6);
    const int h = P.h, d = P.d, L = P.L; const size_t rowbase = P.rowbase; const int res = P.res;
    const int qw = P.q0 + wid * 32; const bool active = qw < L;
    u32x4 p1[4], p2[4], gt[4]; float l1[4], l2[4];
#pragma unroll
    for (int q = 0; q < 4; ++q) { const int rloc = (q >> 1) * 16 + (q & 1) * 8 + (lane >> 3), ch = lane & 7; int rr_ = qw + rloc; if (rr_ >= L) rr_ = L - 1;
        const size_t tok = rowbase + res + (size_t)d * rr_;
        p1[q] = *(const u32x4*)(F.BPART + ((size_t)1 * RS + tok) * 256 + h * 64 + ch * 8); p2[q] = *(const u32x4*)(F.BPART + ((size_t)2 * RS + tok) * 256 + h * 64 + ch * 8);
        l1[q] = F.BLSE[((size_t)1 * RS + tok) * 4 + h]; l2[q] = F.BLSE[((size_t)2 * RS + tok) * 4 + h];
        gt[q] = *(const u32x4*)(F.PROJ + tok * INW + C_BG + h * 64 + ch * 8); }
    { auto rr = __builtin_amdgcn_permlane32_swap(__float_as_uint(lt), __float_as_uint(lt), false, false); lt = __uint_as_float(rr[0]) + __uint_as_float(rr[1]); }
    LAS float* wsf = (LAS float*)(F.lds + fa::L_WS) + wid * 64;
    if (hi == 0) { wsf[32 + r32] = lt; wsf[r32] = mh + __log2f(lt); }
    asm volatile("s_waitcnt lgkmcnt(0)" ::: "memory");
    float rli[16];
#pragma unroll
    for (int r = 0; r < 16; ++r) rli[r] = __builtin_amdgcn_rcpf(wsf[32 + fa::crow(r, hi)]);
    LAS bf16_t* stg = (LAS bf16_t*)(F.lds + L_BST) + wid * 1024;
#pragma unroll
    for (int half = 0; half < 2; ++half) {
#pragma unroll
        for (int rr_ = 0; rr_ < 8; ++rr_) { const int r = half * 8 + rr_; const int lrow = fa::crow(r, hi) - 16 * half;
#pragma unroll
            for (int d0 = 0; d0 < 2; ++d0) stg[lrow * 64 + d0 * 32 + r32] = (bf16_t)(pk2(o[d0][r] * rli[r], 0.f) & 0xffffu); }
        asm volatile("s_waitcnt lgkmcnt(0)" ::: "memory");
        if (active) {
#pragma unroll
            for (int i = 0; i < 2; ++i) { const int q = half * 2 + i; const int row = i * 8 + (lane >> 3), ch = lane & 7; const int rloc = 16 * half + row;
                const u32x4 w0 = *(LAS const u32x4*)(stg + row * 64 + ch * 8);
                const float ls0 = wsf[rloc], ls1 = l1[q], ls2 = l2[q];
                const float m = fmaxf(ls0, fmaxf(ls1, ls2));
                const float e0 = exp2f(ls0 - m), e1 = exp2f(ls1 - m), e2 = exp2f(ls2 - m); const float inv = 1.f / (e0 + e1 + e2);
                const float a0 = e0 * inv, a1 = e1 * inv, a2 = e2 * inv;
                const unsigned W0[4] = {w0.x, w0.y, w0.z, w0.w}, W1[4] = {p1[q].x, p1[q].y, p1[q].z, p1[q].w}, W2[4] = {p2[q].x, p2[q].y, p2[q].z, p2[q].w}, G_[4] = {gt[q].x, gt[q].y, gt[q].z, gt[q].w};
                unsigned ow[4];
#pragma unroll
                for (int k = 0; k < 4; ++k) { const float ylo = a0 * bflo(W0[k]) + a1 * bflo(W1[k]) + a2 * bflo(W2[k]), yhi = a0 * bfhi(W0[k]) + a1 * bfhi(W1[k]) + a2 * bfhi(W2[k]);
                    ow[k] = pk2(ylo * fa::silu(bflo(G_[k])), yhi * fa::silu(bfhi(G_[k]))); }
                const size_t tok = rowbase + res + (size_t)d * (qw + rloc);
                *(u32x4*)(F.XNM + ((size_t)s * RS + tok) * MIXW + 256 + h * 64 + ch * 8) = (u32x4){ow[0], ow[1], ow[2], ow[3]}; } }
        asm volatile("s_waitcnt lgkmcnt(0)" ::: "memory");
    }
}
template <bool FUSE>
__device__ __forceinline__ void unit_B(Frame& F, int s, int layer, int u, int un, bf16x8 (&qr)[4]) {
    const BPar P = b_decode(s, u);
    int tid_ = F.tid; asm volatile("" : "+v"(tid_)); const int lane = tid_ & 63, r32 = lane & 31, hi = lane >> 5, wid = __builtin_amdgcn_readfirstlane(tid_ >> 6);
    const int g = P.g, h = P.h, d = P.d, L = P.L; const size_t rowbase = P.rowbase; const int res = P.res;
    const int wg2 = P.pack ? (wid >> 2) : 0; const int qw = P.pack ? (wid & 3) * 32 : P.q0 + wid * 32;
    LAS float* tab = (LAS float*)(F.lds + LT_B) + (g * 4 + h) * 320;
    int qidx = qw + r32; const bool active = qw < L; if (qidx >= L) qidx = L - 1;
    const size_t qrow = rowbase + res + wg2 + (size_t)d * qidx;
    f32x16 o[2]; float mh, lt;
    LAS const float* bk = (LAS const float*)(F.lds + LT_BK);
    fa::b3_compute(F.lds, qr, P.NT, wg2 * P.NT, tab, qw, 64 * P.tlo, active, bk[h], bk[4 + h], o, mh, lt, tid_);
    if (un >= 0) { const BPar PN = b_decode(s, un); b_dma(F, PN, tid_); b_qload(F, PN, tid_, qr); }
    if constexpr (FUSE) epilogue_B_fused(F, s, u, o, mh, lt); else epilogue_B(F, s, u, o, mh, lt);
}
__device__ __forceinline__ void phase_bcomb(Frame& F, int s) {
    const int gw = F.vcu * 8 + F.wave, NGW = F.G * 8; const int lane = F.lane, h = lane >> 4, c4 = (lane & 15) * 4;
    constexpr int NB = 4;
    for (int lr0 = gw; lr0 < RS; lr0 += NB * NGW) {
        float ls[NB][3]; u32x2 pv_[NB][3]; u32x2 gt[NB];
#pragma unroll
        for (int k = 0; k < NB; ++k) { int lr = lr0 + k * NGW; if (lr >= RS) lr = RS - 1;
#pragma unroll
            for (int g = 0; g < 3; ++g) { ls[k][g] = F.BLSE[((size_t)g * RS + lr) * 4 + h]; pv_[k][g] = *(const u32x2*)(F.BPART + ((size_t)g * RS + lr) * 256 + h * 64 + c4); }
            gt[k] = *(const u32x2*)(F.PROJ + (size_t)lr * INW + C_BG + h * 64 + c4); }
#pragma unroll
        for (int k = 0; k < NB; ++k) { const int lr = lr0 + k * NGW; if (lr < RS) {
            const float m = fmaxf(ls[k][0], fmaxf(ls[k][1], ls[k][2]));
            float w[3], ws_ = 0.f;
#pragma unroll
            for (int g = 0; g < 3; ++g) { w[g] = exp2f(ls[k][g] - m); ws_ += w[g]; }
            const float inv = 1.f / ws_; float y[4] = {0.f, 0.f, 0.f, 0.f};
#pragma unroll
            for (int g = 0; g < 3; ++g) { const float wg = w[g] * inv; y[0] += wg * bflo(pv_[k][g].x); y[1] += wg * bfhi(pv_[k][g].x); y[2] += wg * bflo(pv_[k][g].y); y[3] += wg * bfhi(pv_[k][g].y); }
            u32x2 ow; ow.x = pk2(y[0] * fa::silu(bflo(gt[k].x)), y[1] * fa::silu(bfhi(gt[k].x))); ow.y = pk2(y[2] * fa::silu(bflo(gt[k].y)), y[3] * fa::silu(bfhi(gt[k].y)));
            *(u32x2*)(F.XNM + ((size_t)s * RS + lr) * MIXW + 256 + h * 64 + c4) = ow; } }
    }
}

struct HookD {
    LAS const float* tab;
    int R, kr_lo, r0, c, cs, hi;
    __device__ __forceinline__ bool skip(int t) const { const int kr = kr_lo + t; return kr < r0 || kr > r0 + 7; }
    __device__ __forceinline__ void apply(f32x16& p0, f32x16& p1, int t) const {
        const int kr = kr_lo + t; LAS const float* tp = tab + (kr - R + 7) * 31 + 15 - c + 4 * hi;
#pragma unroll
        for (int r = 0; r < 16; ++r) { const int kk = (r & 3) + 8 * (r >> 2);
            { const int kc = kk + 4 * hi; const bool ok = (unsigned)(kc - cs) < 16u; const float bv = tp[ok ? kk : (c - 4 * hi)]; p0[r] = ok ? p0[r] + bv : -INFINITY; }
            { const int kc = kk + 32 + 4 * hi; const bool ok = (unsigned)(kc - cs) < 16u; const float bv = tp[ok ? kk + 32 : (c - 4 * hi)]; p1[r] = ok ? p1[r] + bv : -INFINITY; } }
    }
};
__device__ __forceinline__ int d_r0(int R, int rows) { int v = R - 4; if (v < 0) v = 0; if (v > rows - 8) v = rows - 8; return v; }
__device__ __forceinline__ void unit_D(Frame& F, int s, int layer, int bh, int u4) {
    const int n = s ? 2048 : 8192; const int rows = n >> 6; const int b = bh >> 2, h = bh & 3; int tid_ = F.tid; asm volatile("" : "+v"(tid_)); const int lane = tid_ & 63, r32 = lane & 31, wid = __builtin_amdgcn_readfirstlane(tid_ >> 6);
    const size_t rowbase = (size_t)b * n; const int R0 = 4 * u4;
    const int kr_lo = d_r0(R0, rows), kr_hi = d_r0(R0 + 3, rows) + 7; const int NT = kr_hi - kr_lo + 1;
    const int R = R0 + (wid >> 1), c = 32 * (wid & 1) + r32; const int r0w = d_r0(R, rows);
    const size_t qrow = rowbase + 64 * R + c;
    const bf16_t* qptr = F.PROJ + qrow * INW + C_DQ + h * 64;
    const size_t krow0 = rowbase + (size_t)64 * kr_lo;
    KVLinear kv{F.PROJ + krow0 * INW + C_DK + h * 64, F.PROJ + krow0 * INW + C_DV + h * 64};
    LAS const float* bk = (LAS const float*)(F.lds + LT_BK);
    f32x16 o[2];
    fa::flash_core_d(F.lds, qptr, kv, NT, r0w - kr_lo, r0w + 7 - kr_lo, kr_lo - R + 7, c, bk[8 + h], bk[12 + h], F.in[14] + ((size_t)layer * 4 + h) * 465, o, tid_);
    LAS float* stg = (LAS float*)(F.lds + fa::L_OST) + wid * 2048;
    fa::stage_o(stg, o, r32, lane >> 5);
    const size_t lrow0 = rowbase + 64 * R + 32 * (wid & 1);
    store_gated(F, stg, lrow0, (size_t)s * RS + lrow0, C_DG + h * 64, 768 + h * 64, lane);
    asm volatile("s_waitcnt lgkmcnt(0)\n\ts_barrier" ::: "memory");
}

__device__ __forceinline__ void phase_mixers(Frame& F, int s, int layer) {
    const int G = F.G, v = F.vcu;
    const int sh = s ? 3 : 5;
    unsigned* c_prep = (unsigned*)(F.ws + WS_CTL) + CW_SPLIT + 64 * (2 * (layer * 2 + s));
    unsigned* c_b = c_prep + 64;
    unsigned* c_pb = (unsigned*)(F.ws + WS_CTL) + CW_SPLIT + 64 * 8 + 64 * (layer * 2 + s);
#ifndef UN_MASK
#define UN_MASK 0xF
#endif
    { LAS float* tc = (LAS float*)(F.lds + LT_C); LAS float* tbb = (LAS float*)(F.lds + LT_B);
      if (!MK_ONE_LAUNCH) { LAS float* tr_ = (LAS float*)(F.lds + LT_ROPE); for (int i = F.tid; i < 128 * 16 * 2; i += 512) tr_[i] = F.TAB[T_ROPE + i]; }
      if (!F.tabs) {
      for (int i = F.tid; i < 12 * 320; i += 512) tbb[i] = F.TAB[T_B + i];
      for (int i = F.tid; i < 4 * 641; i += 512) tc[i] = F.TAB[T_C + i];
      F.tabs = 1; }
      asm volatile("s_waitcnt vmcnt(0) lgkmcnt(0)\n\ts_barrier" ::: "memory"); }
    phase_prepB(F, s, layer);
    split_arrive(c_pb, (volatile LAS unsigned*)(F.lds + MISC_OFF) + 8);
    phase_prep(F, s, layer);
    split_arrive(c_prep, (volatile LAS unsigned*)(F.lds + MISC_OFF) + 8);
    split_wait<false>(c_pb, (unsigned)G);
    { LAS float* bk = (LAS float*)(F.lds + LT_BK);
      { int t_ = F.tid; asm volatile("" : "+v"(t_));
        if (t_ < 16) { const int grp = t_ >> 2, j = t_ & 3; float val;
          if (grp == 0) val = __uint_as_float(xb_ld((unsigned*)(F.ws + WS_CTL) + CW_KMAXB + (layer * 2 + s) * 4 + j)) * 1.01f;
          else if (grp == 1) val = F.TAB[T_BMAXB + j];
          else if (grp == 2) val = __uint_as_float(xb_ld((unsigned*)(F.ws + WS_CTL) + CW_KMAXD + (layer * 2 + s) * 4 + j)) * 1.01f;
          else val = F.TAB[T_BMAXD + layer * 4 + j];
          bk[t_] = val; } }
      asm volatile("s_waitcnt vmcnt(0) lgkmcnt(0)\n\ts_barrier" ::: "memory"); }
    if (UN_MASK & 4) { const int nB = 768; bf16x8 qrB[4];
        const int u0 = (v >= 256) ? v : v + ((256 - v + G - 1) / G) * G;
        if (u0 < nB) { const BPar P0 = b_decode(s, u0); int tid_ = F.tid; asm volatile("" : "+v"(tid_)); b_dma(F, P0, tid_); b_qload(F, P0, tid_, qrB); }
        for (int u = u0; u < nB; u += G) unit_B<false>(F, s, layer, u, (u + G < nB) ? u + G : -1, qrB);
        asm volatile("s_waitcnt vmcnt(0) lgkmcnt(0)\n\ts_barrier" ::: "memory"); }
    split_arrive(c_b, (volatile LAS unsigned*)(F.lds + MISC_OFF) + 8);
    if (UN_MASK & 8) for (int u = v; u < 256; u += G) unit_D(F, s, layer, u >> sh, u & ((1 << sh) - 1));
    split_wait(c_prep, (unsigned)G);
    if (UN_MASK & 2) for (int u = v; u < 512; u += G) unit_Ct(F, s, layer, u >> (sh + 1), u & ((2 << sh) - 1));
    if (UN_MASK & 1) for (int u = v; u < 256; u += G) unit_A(F, s, layer, u >> sh, u & ((1 << sh) - 1));
    if (UN_MASK & 4) { bf16x8 qrB[4];
        if (v < 256) { const BPar P0 = b_decode(s, v); int tid_ = F.tid; asm volatile("" : "+v"(tid_)); b_dma(F, P0, tid_); b_qload(F, P0, tid_, qrB); }
        split_wait(c_b, (unsigned)G);
        for (int u = v; u < 256; u += G) unit_B<true>(F, s, layer, u, (u + G < 256) ? u + G : -1, qrB);
        asm volatile("s_waitcnt vmcnt(0) lgkmcnt(0)\n\ts_barrier" ::: "memory"); }
}

constexpr int N_PHASES = 11;
#ifndef PH_MASK
#define PH_MASK 0xFF
#endif
#define PH_ON(b) ((PH_MASK >> (b)) & 1)
struct Args { const float* in[15]; float* out; unsigned char* ws; int ph_lo, ph_hi; };
template <bool XB>
__global__ void __launch_bounds__(512, 2) enc_fwd(Args args) {
    extern __shared__ __attribute__((aligned(16))) unsigned char lds_raw[];
    Frame F;
    F.lds = (LAS unsigned char*)lds_raw; F.tabs = 0;
    F.tid = threadIdx.x; F.lane = F.tid & 63; F.wave = __builtin_amdgcn_readfirstlane(F.tid >> 6);
    F.G = gridDim.x; { const int bx = blockIdx.x; F.vcu = (F.G % 8 == 0) ? (bx % 8) * (F.G / 8) + bx / 8 : bx; }
    typedef __attribute__((address_space(4))) const unsigned char* kaptr_t;
    unsigned char* ws0 = args.ws; const int wave0 = __builtin_amdgcn_readfirstlane((int)threadIdx.x >> 6);
    volatile LAS unsigned* MISC = (volatile LAS unsigned*)(F.lds + MISC_OFF);
    for (int u = F.tid; u < (LDS_BYTES - LDSCTL_OFF) / 4; u += 512) ((LAS unsigned*)(F.lds + LDSCTL_OFF))[u] = 0u;
    __syncthreads();
    const bool multi = (args.ph_hi - args.ph_lo) > 1;
    XcdBarrier bar; bar.bar = (unsigned*)(ws0 + WS_CTL) + CW_BAR; bar.x = 0; bar.st = nullptr;
    if (multi) bar = xcd_barrier_post((unsigned*)(ws0 + WS_CTL) + CW_BAR, MISC + 8);

    for (int p = args.ph_lo; p < args.ph_hi; ++p) {
        { unsigned z_; asm volatile("s_mov_b32 %0, 0" : "=s"(z_)); int t_ = (wave0 << 6) | (int)__builtin_amdgcn_mbcnt_hi(~0u, __builtin_amdgcn_mbcnt_lo(~0u, z_)); asm volatile("" : "+v"(t_)); F.tid = t_; F.lane = t_ & 63; F.wave = __builtin_amdgcn_readfirstlane(t_ >> 6); }
        { kaptr_t ka = (kaptr_t)__builtin_amdgcn_kernarg_segment_ptr(); asm volatile("" : "+s"(ka));
          F.in = (const float* const __attribute__((address_space(4)))*)ka;
          unsigned char* ws_ = *(unsigned char* const __attribute__((address_space(4)))*)(ka + 16 * 8); float* out_ = *(float* const __attribute__((address_space(4)))*)(ka + 15 * 8); F.out = out_; F.ws = ws_;
          F.WIN = (bf16_t*)(ws_ + WS_WIN); F.WOUT = (bf16_t*)(ws_ + WS_WOUT); F.XNM = (bf16_t*)(ws_ + WS_XNM); F.PROJ = (bf16_t*)(ws_ + WS_PROJ);
          F.BPART = (bf16_t*)(ws_ + WS_BPART); F.BLSE = (float*)(ws_ + WS_BLSE); F.TAB = (float*)(ws_ + WS_TAB); }
        int kind, layer = 0, st = 0;
        if (p == 0) kind = 0;
        else { layer = (p - 1) / 5; const int r = (p - 1) % 5; if (r == 4) kind = 4; else { kind = 2 + (r & 1); st = r >> 1; } }
        if (kind == 0) { phase_prologue(F); phase_xn_rows(F, 0, RS, F.vcu * 8 + F.wave, F.G * 8); }
        else if (kind == 4) {
            pg8::Gemm g{F.XNM, F.WOUT + (size_t)layer * DMODEL * MIXW, MTOT, DMODEL, MIXW};
            pg8::PanelRms st_{(float*)(F.ws + WS_XSLOT), (unsigned*)(F.ws + WS_CTL) + CW_PANEL + layer * 128 * 64, RMS_EPS};
            for (int rd = 0; rd < 2; ++rd) {
                if (MK_ONE_LAUNCH && rd == 1) split_wait((unsigned*)(F.ws + WS_CTL) + CW_SPLIT + 64 * (12 + layer), (unsigned)F.G);
                pg8::RoundOrder S; { const int c_ = (int)blockIdx.x; S.so.init(MTOT, DMODEL, F.G, (c_ >> 3) * 8 + rd * 4 + ((c_ & 7) >> 1)); S.round = c_ & 1; }
                if (layer == 0) { pg8::EpiRmsOut<false, XB> E{F.in[0], F.in[1], RS, F.out, F.XNM, nullptr, DMODEL, st_, (bf16_t*)(F.ws + WS_X1)};
                    pg8::gemm_phase<pg8::EpiRmsOut<false, XB>, pg8::RoundOrder, false, true>(F.lds, g, S, E, F.tid); }
                else { pg8::EpiRmsOut<true, XB> E{F.out, F.out + (size_t)RS * DMODEL, RS, F.out, nullptr, F.in[5], DMODEL, st_, (bf16_t*)(F.ws + WS_X1)};
                    pg8::gemm_phase<pg8::EpiRmsOut<true, XB>, pg8::RoundOrder, false, true>(F.lds, g, S, E, F.tid); }
                if (MK_ONE_LAUNCH && rd == 0 && layer == 0) split_arrive((unsigned*)(F.ws + WS_CTL) + CW_SPLIT + 64 * 14, MISC + 8);
            }
        } else if (kind == 2) {
            const bool raw = XB && layer == 1;
            const bf16_t* Abase = raw ? (const bf16_t*)(F.ws + WS_X1) : (const bf16_t*)F.XNM;
            pg8::Gemm g{Abase + (size_t)st * RS * DMODEL, F.WIN + (size_t)layer * INW * DMODEL, RS, INW, DMODEL}; pg8::StaticOrder S; S.init(RS, INW, F.G, (int)blockIdx.x);
            if (MK_ONE_LAUNCH && st == 1) S.gate = (unsigned*)(F.ws + WS_CTL) + CW_SPLIT + 64 * (15 + layer);
            pg8::EpiBf16 E{F.PROJ, INW, raw ? (const float*)(F.ws + WS_XSLOT) + (size_t)st * RS * 4 : nullptr, RMS_EPS};
            pg8::gemm_phase<pg8::EpiBf16, pg8::StaticOrder, true, true>(F.lds, g, S, E, F.tid);
            if (layer == 0 && st == 0) {
                const int nwg_ = (RS / 256) * (INW / 256), extra = nwg_ % F.G, c_ = (int)blockIdx.x;
                if (extra == 0) phase_xn_rows(F, RS, MTOT, c_ * 8 + F.wave, F.G * 8);
                else if (c_ >= extra) phase_xn_rows(F, RS, MTOT, (c_ - extra) * 8 + F.wave, (F.G - extra) * 8); }
        } else phase_mixers(F, st, layer);
        if (p + 1 < args.ph_hi) {
            int pp = p; asm volatile("" : "+s"(pp));
            if (MK_ONE_LAUNCH && (pp == 4 || pp == 9 || pp == 5 || pp == 2 || pp == 7)) {
                kaptr_t ka2 = (kaptr_t)__builtin_amdgcn_kernarg_segment_ptr(); asm volatile("" : "+s"(ka2));
                unsigned* cs_ = (unsigned*)(*(unsigned char* const __attribute__((address_space(4)))*)(ka2 + 16 * 8) + WS_CTL) + CW_SPLIT;
                if (pp == 5) split_wait(cs_ + 64 * 14, (unsigned)gridDim.x);
                else split_arrive(cs_ + 64 * (pp == 4 ? 12 : pp == 9 ? 13 : pp == 2 ? 15 : 16), MISC + 8);
            } else {
                const bool pre_ = MK_ONE_LAUNCH && (pp == 1 || pp == 3 || pp == 6 || pp == 8);
                float rp_[8];
#pragma unroll
                for (int k_ = 0; k_ < 8; ++k_) rp_[k_] = 0.f;
                if (pre_) {
#pragma unroll
                    for (int k_ = 0; k_ < 8; ++k_) rp_[k_] = F.TAB[T_ROPE + F.tid + 512 * k_]; }
                xcd_barrier(bar);
                if (pre_) { LAS float* tr_ = (LAS float*)(F.lds + LT_ROPE);
#pragma unroll
                    for (int k_ = 0; k_ < 8; ++k_) tr_[F.tid + 512 * k_] = rp_[k_]; }
            }
        }
    }
}

extern "C" void kernel_launch(void* const* d_in, const int* in_sizes, int n_in, void* d_out, int out_size, void* d_ws, size_t ws_size, hipStream_t stream) {
    static int grid = 0;
    if (grid == 0) {
        if (n_in != 15 || out_size != MTOT * DMODEL || ws_size < WS_END) { fprintf(stderr, "kernel_launch: unexpected shapes (n_in %d out %d ws %zu)\n", n_in, out_size, ws_size); grid = -1; return; }
        int dev = 0, cus = 0, per_cu = 0;
        if (hipGetDevice(&dev) != hipSuccess || hipDeviceGetAttribute(&cus, hipDeviceAttributeMultiprocessorCount, dev) != hipSuccess) { grid = -1; return; }
        const void* kfn = (ws_size >= WS_END_X1) ? (const void*)enc_fwd<true> : (const void*)enc_fwd<false>;
        if (hipFuncSetAttribute(kfn, hipFuncAttributeMaxDynamicSharedMemorySize, LDS_BYTES) != hipSuccess) { fprintf(stderr, "kernel_launch: hipFuncSetAttribute failed\n"); grid = -1; return; }
        if (hipOccupancyMaxActiveBlocksPerMultiprocessor(&per_cu, kfn, 512, LDS_BYTES) != hipSuccess || per_cu < 1) { fprintf(stderr, "kernel_launch: occupancy query says %d\n", per_cu); per_cu = 1; }
        (void)hipGetLastError();
        grid = cus;
    }
    if (grid < 0) return;
    (void)hipMemsetAsync((char*)d_ws + WS_CTL, 0, CTL_ZERO_BYTES, stream);
    Args a{};
    for (int i = 0; i < 15; ++i) a.in[i] = (const float*)d_in[i];
    a.out = (float*)d_out; a.ws = (unsigned char*)d_ws;
#if MK_ONE_LAUNCH
    a.ph_lo = 0; a.ph_hi = N_PHASES;
    if (ws_size >= WS_END_X1) hipLaunchKernelGGL(enc_fwd<true>, dim3(grid), dim3(512), LDS_BYTES, stream, a);
    else hipLaunchKernelGGL(enc_fwd<false>, dim3(grid), dim3(512), LDS_BYTES, stream, a);
#else
    for (int p = 0; p < N_PHASES; ++p) { a.ph_lo = p; a.ph_hi = p + 1; hipLaunchKernelGGL(enc_fwd<false>, dim3(grid), dim3(512), LDS_BYTES, stream, a); }
#endif
}
```
